# Optimizing an MI355X kernel written in HIP

```python
import math
import jax, jax.numpy as jnp
from jax import lax
import numpy as np

D_MODEL = 1024
BATCH = 16
SEQ = 4096
DEPTH = 2

GRID_W = 64
CTX_LEN = 256
HEAD_DIM = 64
N_Q_HEADS = 8
N_KV_HEADS = 2
GQA_GROUP = N_Q_HEADS // N_KV_HEADS
ATTN_WIDTH = N_Q_HEADS * HEAD_DIM
KV_WIDTH = N_KV_HEADS * HEAD_DIM
RNN_WIDTH = 512
RNN_BLOCKS = 8
RNN_BLOCK_DIM = RNN_WIDTH // RNN_BLOCKS
CONV_WIDTH = 4
LRU_C = 8.0
WINDOW = 128
Q_BLOCK = 128
ROPE_BASE = 10000.0
N_BRANCHES = 3
BRANCH_WIDTH = 512
N_IN = 2 * RNN_WIDTH + 2 * (ATTN_WIDTH + 2 * KV_WIDTH) + N_BRANCHES * D_MODEL
N_EXPERTS = 16
N_GROUPS = 4
EXPERTS_PER_GROUP = N_EXPERTS // N_GROUPS
TOP_K = 2
D_EXPERT = 1024
EPS = 1e-6
NEG_INF = -1e30

kernel_name = "hybrid_rglru_gqa_window_moe_diffusion"


def rms_norm(x, g):
    xf = x.astype(jnp.float32)
    y = xf * lax.rsqrt(jnp.mean(xf * xf, axis=-1, keepdims=True) + EPS)
    return (y * g.astype(jnp.float32)).astype(x.dtype)


def modulate(x, g, shift, scale):
    return rms_norm(x, g) * (1 + scale) + shift


def rope_tables(rows):
    row = jnp.repeat(jnp.arange(rows, dtype=jnp.float32), GRID_W)
    col = jnp.tile(jnp.arange(GRID_W, dtype=jnp.float32), rows)
    n_freq = HEAD_DIM // 4
    inv = ROPE_BASE ** (-jnp.arange(n_freq, dtype=jnp.float32) / n_freq)
    ang = jnp.concatenate([row[:, None] * inv, col[:, None] * inv], axis=-1)
    return jnp.cos(ang), jnp.sin(ang)


def apply_rope(t, cos, sin):
    half = HEAD_DIM // 2
    shape = (cos.shape[0],) + (1,) * (t.ndim - 3) + (half,)
    cos = cos.reshape(shape).astype(t.dtype)
    sin = sin.reshape(shape).astype(t.dtype)
    t1, t2 = t[..., :half], t[..., half:]
    return jnp.concatenate([t1 * cos - t2 * sin, t2 * cos + t1 * sin], axis=-1)


def attend(q, k, v, mask=None, sink=None):
    s = jnp.einsum('bqhgd,bkhd->bhgqk', q, k).astype(jnp.float32) * (HEAD_DIM ** -0.5)
    if mask is not None:
        s = jnp.where(mask, s, NEG_INF)
    if sink is not None:
        sk = jnp.broadcast_to(sink.astype(jnp.float32).reshape(1, N_KV_HEADS, GQA_GROUP, 1, 1), s.shape[:-1] + (1,))
        p = jax.nn.softmax(jnp.concatenate([s, sk], axis=-1), axis=-1)[..., :-1]
    else:
        p = jax.nn.softmax(s, axis=-1)
    return jnp.einsum('bhgqk,bkhd->bqhgd', p.astype(v.dtype), v)


def global_attention_latent(q, k_lat, v_lat, k_ctx, v_ctx):
    B, S = q.shape[:2]
    k = jnp.concatenate([k_ctx, k_lat], axis=1)
    v = jnp.concatenate([v_ctx, v_lat], axis=1)
    nb = S // Q_BLOCK
    qb = q.reshape(B, nb, Q_BLOCK, N_KV_HEADS, GQA_GROUP, HEAD_DIM).swapaxes(0, 1)
    ob = lax.map(lambda qi: attend(qi, k, v), qb)
    return ob.swapaxes(0, 1).reshape(B, S, ATTN_WIDTH)


def window_attention_latent(q, k_lat, v_lat, k_ctx, v_ctx, sink):
    B, S = q.shape[:2]
    nb = S // Q_BLOCK
    band = Q_BLOCK + 2 * WINDOW
    pad = ((0, 0), (WINDOW, WINDOW), (0, 0), (0, 0))
    kp = jnp.pad(k_lat, pad)
    vp = jnp.pad(v_lat, pad)
    qq = jnp.arange(Q_BLOCK)[:, None]
    kk = jnp.arange(band)[None, :]
    in_win = jnp.abs(kk - WINDOW - qq) <= WINDOW
    ctx_mask = jnp.ones((Q_BLOCK, k_ctx.shape[1]), dtype=bool)
    qb = q.reshape(B, nb, Q_BLOCK, N_KV_HEADS, GQA_GROUP, HEAD_DIM).swapaxes(0, 1)

    def blk(args):
        qi, bi = args
        start = bi * Q_BLOCK
        kw = lax.dynamic_slice_in_dim(kp, start, band, axis=1)
        vw = lax.dynamic_slice_in_dim(vp, start, band, axis=1)
        key_pos = start - WINDOW + kk
        valid = in_win & (key_pos >= 0) & (key_pos < S)
        mask = jnp.concatenate([ctx_mask, valid], axis=1)
        return attend(qi, jnp.concatenate([k_ctx, kw], axis=1), jnp.concatenate([v_ctx, vw], axis=1), mask, sink)

    ob = lax.map(blk, (qb, jnp.arange(nb)))
    return ob.swapaxes(0, 1).reshape(B, S, ATTN_WIDTH)


def centred_dwconv(x, w, b):
    left = CONV_WIDTH // 2
    right = CONV_WIDTH - 1 - left
    T = x.shape[1]
    xp = jnp.pad(x, ((0, 0), (left, right), (0, 0)))
    return sum(xp[:, k:k + T] * w[k] for k in range(CONV_WIDTH)) + b


def _lin_combine(e1, e2):
    a1, b1 = e1
    a2, b2 = e2
    return a1 * a2, a2 * b1 + b2


def rglru(xr, wa, ba, wx, bx, lam, h0, reverse):
    B, T, _ = xr.shape
    xf = xr.astype(jnp.float32)
    xb = xf.reshape(B, T, RNN_BLOCKS, RNN_BLOCK_DIM)
    r = jax.nn.sigmoid(jnp.einsum('btnd,nde->btne', xb, wa.astype(jnp.float32)).reshape(B, T, RNN_WIDTH) + ba)
    i = jax.nn.sigmoid(jnp.einsum('btnd,nde->btne', xb, wx.astype(jnp.float32)).reshape(B, T, RNN_WIDTH) + bx)
    log_a = -LRU_C * r * jax.nn.softplus(-lam.astype(jnp.float32))
    a = jnp.exp(log_a)
    b = jnp.sqrt(-jnp.expm1(2.0 * log_a)) * (i * xf)
    a_cum, h = lax.associative_scan(_lin_combine, (a, b), axis=1, reverse=reverse)
    h = h + a_cum * h0[:, None, :]
    final = h[:, 0] if reverse else h[:, -1]
    return h, final


def _split_columns(p):
    sizes = (RNN_WIDTH, RNN_WIDTH, ATTN_WIDTH, KV_WIDTH, KV_WIDTH, ATTN_WIDTH, KV_WIDTH, KV_WIDTH, N_BRANCHES * D_MODEL)
    out, start = [], 0
    for n in sizes:
        out.append(p[..., start:start + n])
        start += n
    return out


def project_stream(h, w_in, b_merge, conv_w, conv_b, q_g, k_g, rope):
    B, T, _ = h.shape
    xr, gr, gq, gk, gv, wq, wk, wv, mg = _split_columns(h @ w_in)
    xr = centred_dwconv(xr, conv_w, conv_b)
    gr = jax.nn.gelu(gr)
    qs = (B, T, N_KV_HEADS, GQA_GROUP, HEAD_DIM)
    ks = (B, T, N_KV_HEADS, HEAD_DIM)
    gq = rms_norm(gq.reshape(qs), q_g[0])
    gk = rms_norm(gk.reshape(ks), k_g[0])
    gv = gv.reshape(ks)
    wq = rms_norm(wq.reshape(qs), q_g[1])
    wk = rms_norm(wk.reshape(ks), k_g[1])
    wv = wv.reshape(ks)
    if rope is not None:
        cos, sin = rope
        gq, gk, wq, wk = [apply_rope(t, cos, sin) for t in (gq, gk, wq, wk)]
    mg = jax.nn.sigmoid((mg + b_merge).astype(jnp.float32)).astype(h.dtype).reshape(B, T, N_BRANCHES, D_MODEL)
    return xr, gr, gq, gk, gv, wq, wk, wv, mg


def merge_branches(ys, mg, w_branch, w_out):
    merged = sum(mg[:, :, b] * (ys[b] @ w_branch[b]) for b in range(N_BRANCHES))
    return merged @ w_out


def moe(h, router_w, router_b, w1, w3, w2):
    B, T, D = h.shape
    t = h.reshape(-1, D)
    s = jax.nn.sigmoid(t.astype(jnp.float32) @ router_w.astype(jnp.float32))
    sel = s + router_b.astype(jnp.float32)
    grp_score = lax.top_k(sel.reshape(-1, N_GROUPS, EXPERTS_PER_GROUP), TOP_K)[0].sum(-1)
    best = jnp.argmax(grp_score, axis=-1)
    expert_group = jnp.arange(N_EXPERTS) // EXPERTS_PER_GROUP
    emask = expert_group[None, :] == best[:, None]
    _, idx = lax.top_k(jnp.where(emask, sel, NEG_INF), TOP_K)
    w = jnp.take_along_axis(s, idx, axis=-1)
    w = w / jnp.sum(w, axis=-1, keepdims=True)
    combine = jnp.sum(jax.nn.one_hot(idx, N_EXPERTS, dtype=jnp.float32) * w[..., None], axis=1)
    out = jnp.zeros(t.shape, jnp.float32)
    for e in range(N_EXPERTS):
        hid = jax.nn.silu(t @ w1[e]) * (t @ w3[e])
        out = out + combine[:, e:e + 1] * (hid @ w2[e]).astype(jnp.float32)
    return out.astype(h.dtype).reshape(B, T, D)


def setup_inputs(seed: int = 0) -> dict:
    key = jax.random.key(seed)
    ks = jax.random.split(key, 32)
    f32 = jnp.float32
    L, D = DEPTH, D_MODEL

    def nrm(k, shape, scale):
        return jax.random.normal(k, shape, f32) * scale

    a0 = jax.random.uniform(ks[16], (L, 2, RNN_WIDTH), f32, 0.9, 0.999)
    p = a0 ** (1.0 / LRU_C)
    lam = jnp.log(p) - jnp.log1p(-p)
    return {
        "x": nrm(ks[0], (BATCH, SEQ, D), 1.0),
        "c": nrm(ks[1], (BATCH, D), 1.0),
        "ctx": nrm(ks[2], (BATCH, CTX_LEN, D), 1.0),
        "c_ctx": nrm(ks[3], (D,), 1.0),
        "w_mod": nrm(ks[4], (L, D, 6 * D), D ** -0.5),
        "b_mod": nrm(ks[5], (L, 6 * D), 0.02),
        "norm1_g": 1.0 + nrm(ks[6], (L, D), 0.02),
        "norm2_g": 1.0 + nrm(ks[7], (L, D), 0.02),
        "w_in": nrm(ks[8], (L, D, N_IN), D ** -0.5),
        "b_merge": nrm(ks[9], (L, N_BRANCHES * D), 0.02),
        "conv_w": nrm(ks[10], (L, CONV_WIDTH, RNN_WIDTH), CONV_WIDTH ** -0.5),
        "conv_b": nrm(ks[11], (L, RNN_WIDTH), 0.02),
        "lru_wa": nrm(ks[12], (L, 2, RNN_BLOCKS, RNN_BLOCK_DIM, RNN_BLOCK_DIM), RNN_BLOCK_DIM ** -0.5),
        "lru_ba": nrm(ks[13], (L, 2, RNN_WIDTH), 0.02),
        "lru_wx": nrm(ks[14], (L, 2, RNN_BLOCKS, RNN_BLOCK_DIM, RNN_BLOCK_DIM), RNN_BLOCK_DIM ** -0.5),
        "lru_bx": nrm(ks[15], (L, 2, RNN_WIDTH), 0.02),
        "lru_lambda": lam,
        "q_norm_g": 1.0 + nrm(ks[17], (L, 2, HEAD_DIM), 0.02),
        "k_norm_g": 1.0 + nrm(ks[18], (L, 2, HEAD_DIM), 0.02),
        "sink": nrm(ks[19], (L, N_Q_HEADS), 1.0),
        "w_branch": nrm(ks[20], (L, N_BRANCHES, BRANCH_WIDTH, D), BRANCH_WIDTH ** -0.5),
        "w_out": nrm(ks[21], (L, D, D), D ** -0.5),
        "router_w": nrm(ks[22], (D, N_EXPERTS), D ** -0.5),
        "router_b": nrm(ks[23], (N_EXPERTS,), 0.01),
        "expert_w1": nrm(ks[24], (L, N_EXPERTS, D, D_EXPERT), D ** -0.5),
        "expert_w3": nrm(ks[25], (L, N_EXPERTS, D, D_EXPERT), D ** -0.5),
        "expert_w2": nrm(ks[26], (L, N_EXPERTS, D_EXPERT, D), D_EXPERT ** -0.5),
    }


def reference(x, c, ctx, c_ctx, w_mod, b_mod, norm1_g, norm2_g, w_in, b_merge, conv_w, conv_b,
              lru_wa, lru_ba, lru_wx, lru_bx, lru_lambda, q_norm_g, k_norm_g, sink, w_branch, w_out,
              router_w, router_b, expert_w1, expert_w3, expert_w2):
    B, S, _ = x.shape
    rows = S // GRID_W
    rope = rope_tables(rows)
    sc = jax.nn.silu(c)
    scc = jax.nn.silu(c_ctx)
    xc = ctx
    zero_state = jnp.zeros((B, RNN_WIDTH), jnp.float32)
    for l in range(DEPTH):
        last = l == DEPTH - 1
        sh1, sc1, g1, sh2, sc2, g2 = jnp.split((sc @ w_mod[l] + b_mod[l])[:, None, :], 6, axis=-1)
        sh1c, sc1c, g1c, sh2c, sc2c, g2c = jnp.split(scc @ w_mod[l] + b_mod[l], 6, axis=-1)

        h = modulate(x, norm1_g[l], sh1, sc1)
        hc = modulate(xc, norm1_g[l], sh1c, sc1c)
        xr_c, gr_c, gq_c, gk_c, gv_c, wq_c, wk_c, wv_c, mg_c = project_stream(
            hc, w_in[l], b_merge[l], conv_w[l], conv_b[l], q_norm_g[l], k_norm_g[l], None)
        xr, gr, gq, gk, gv, wq, wk, wv, mg = project_stream(
            h, w_in[l], b_merge[l], conv_w[l], conv_b[l], q_norm_g[l], k_norm_g[l], rope)

        hf_c, s_fwd = rglru(xr_c, lru_wa[l, 0], lru_ba[l, 0], lru_wx[l, 0], lru_bx[l, 0], lru_lambda[l, 0], zero_state, False)
        hb_c, s_bwd = rglru(xr_c, lru_wa[l, 1], lru_ba[l, 1], lru_wx[l, 1], lru_bx[l, 1], lru_lambda[l, 1], zero_state, True)
        hf, _ = rglru(xr, lru_wa[l, 0], lru_ba[l, 0], lru_wx[l, 0], lru_bx[l, 0], lru_lambda[l, 0], s_fwd, False)
        hb, _ = rglru(xr, lru_wa[l, 1], lru_ba[l, 1], lru_wx[l, 1], lru_bx[l, 1], lru_lambda[l, 1], s_bwd, True)
        y_rnn = (hf + hb).astype(x.dtype) * gr
        y_glob = global_attention_latent(gq, gk, gv, gk_c, gv_c)
        y_win = window_attention_latent(wq, wk, wv, wk_c, wv_c, sink[l])
        x = x + g1 * merge_branches((y_rnn, y_glob, y_win), mg, w_branch[l], w_out[l])

        if not last:
            n_ctx = xc.shape[1]
            y_rnn_c = (hf_c + hb_c).astype(xc.dtype) * gr_c
            y_glob_c = attend(gq_c, gk_c, gv_c).reshape(B, n_ctx, ATTN_WIDTH)
            y_win_c = attend(wq_c, wk_c, wv_c, sink=sink[l]).reshape(B, n_ctx, ATTN_WIDTH)
            xc = xc + g1c * merge_branches((y_rnn_c, y_glob_c, y_win_c), mg_c, w_branch[l], w_out[l])
            h2 = modulate(x, norm2_g[l], sh2, sc2)
            h2c = modulate(xc, norm2_g[l], sh2c, sc2c)
            y_all = moe(jnp.concatenate([h2c, h2], axis=1), router_w, router_b,
                        expert_w1[l], expert_w3[l], expert_w2[l])
            xc = xc + g2c * y_all[:, :n_ctx]
            x = x + g2 * y_all[:, n_ctx:]
        else:
            h2 = modulate(x, norm2_g[l], sh2, sc2)
            x = x + g2 * moe(h2, router_w, router_b, expert_w1[l], expert_w3[l], expert_w2[l])
    return x
```

```cpp
#include <hip/hip_runtime.h>
#include <hip/hip_bf16.h>
#include <cstdio>
#include <cstdint>
#include <cmath>

#define GAS __attribute__((address_space(1)))
#define LAS __attribute__((address_space(3)))
typedef unsigned short bf16_t;
typedef short bf16x8 __attribute__((ext_vector_type(8)));
typedef float f32x4 __attribute__((ext_vector_type(4)));
typedef float f32x2 __attribute__((ext_vector_type(2)));
typedef unsigned u32x4 __attribute__((ext_vector_type(4)));
typedef unsigned u32x2 __attribute__((ext_vector_type(2)));

constexpr int NB = 16, SEQ = 4096, NCTX = 256, TB = SEQ + NCTX, T = NB * TB;
constexpr int D = 1024, NIN = 5632, NL = 2, NE = 16;
constexpr int C_XR = 0, C_GR = 512, C_GQ = 1024, C_GK = 1536, C_GV = 1664, C_WQ = 1792, C_WK = 2304, C_WV = 2432, C_MG = 2560;
constexpr float EPS = 1e-6f;
constexpr int PMAX = 143360;

__device__ __forceinline__ unsigned cvt_pk_bf16(float lo, float hi) { unsigned r; asm volatile("v_cvt_pk_bf16_f32 %0, %1, %2" : "=v"(r) : "v"(lo), "v"(hi)); return r; }
__device__ __forceinline__ float bf_lo(unsigned u) { return __uint_as_float(u << 16); }
__device__ __forceinline__ float bf_hi(unsigned u) { return __uint_as_float(u & 0xffff0000u); }
__device__ __forceinline__ float fast_sigmoid(float v) { return __builtin_amdgcn_rcpf(1.0f + __builtin_amdgcn_exp2f(-1.4426950409f * v)); }
__device__ __forceinline__ float gelu_tanh(float v) { return v * __builtin_amdgcn_rcpf(1.0f + __builtin_amdgcn_exp2f(-2.3022082f * v * (1.0f + 0.044715f * v * v))); }

namespace pg8 {
constexpr int BM = 256, BK = 64, HALF = 128, HTB = HALF * BK * 2, STAGE_BYTES = 8 * HTB, NXCD = 8, WGM = 8;
__host__ __device__ __forceinline__ int lds_byte(int r, int c) { const int st = (r >> 4) * 2 + (c >> 5), rr = r & 15, cc = c & 31, ob = rr * 64 + cc * 2; return st * 1024 + (ob ^ (((ob >> 9) & 1) << 5)); }
__host__ __device__ __forceinline__ void stage_rc(int b, int& R, int& C) { const int st = b / 1024, sb = b % 1024, swz = sb ^ (((sb >> 9) & 1) << 5); R = (st >> 1) * 16 + swz / 64; C = (st & 1) * 32 + (swz % 64) / 2; }
__host__ __device__ __forceinline__ int perm32(int rho) { const int n = rho >> 4, i = rho & 15; return 8 * (i >> 2) + 4 * n + (i & 3); }

struct Unit { int pm, pn, aux; const char* A; const char* B; };
struct Gemm { int K, lda, ldb; };

__device__ __forceinline__ bool tile_order(long L, int nM, int nN, int& pm, int& pn) {
    const int nwg = nM * nN; if (L >= nwg) return false;
    int wgid = (int)L; { const int q = nwg / NXCD, r = nwg % NXCD, xcd = wgid % NXCD, off = wgid / NXCD; wgid = (xcd < r ? xcd * (q + 1) : r * (q + 1) + (xcd - r) * q) + off; }
    const int nig = WGM * nN, gid = wgid / nig, fm = gid * WGM, gsz = (nM - fm) < WGM ? (nM - fm) : WGM;
    pm = fm + ((wgid % nig) % gsz); pn = (wgid % nig) / gsz; return true;
}

template <class Epi, class Sched>
__device__ __forceinline__ void gemm_phase(LAS unsigned char* lds, const Gemm g, const Sched& S, const Epi& E) {
    int tid_ = threadIdx.x; asm volatile("" : "+v"(tid_));
    const int tid = tid_, wid = __builtin_amdgcn_readfirstlane(tid >> 6), lane = tid & 63, wr = wid >> 2, wc = wid & 3, fr = lane & 15, fq = lane >> 4;
    const int K = g.K, nt = K / BK;
    unsigned voffA[2], voffB[2];
#pragma unroll
    for (int i = 0; i < 2; ++i) { int R, C; stage_rc(tid * 16 + i * 8192, R, C); const int Rb = (R & ~31) + perm32(R & 31);
        voffA[i] = (unsigned)(R * g.lda + C) * 2u; voffB[i] = (unsigned)(Rb * g.ldb + C) * 2u; }
    const size_t kstep = (size_t)(BK * 2);
    const size_t hstepA = (size_t)HALF * g.lda * 2, hstepB = (size_t)HALF * g.ldb * 2;
    const unsigned ldsw = (unsigned)wid * 1024u;
    const int aoff = lds_byte(wr * 64 + fr, fq * 8), boff = lds_byte(wc * 32 + fr, fq * 8);
#define PG8_SA(b, h) (((b) * 2 + (h)) * HTB)
#define PG8_SB(b, h) ((4 + (b) * 2 + (h)) * HTB)
#define PG8_STAGE(bufoff, gbase, voff) do { _Pragma("unroll") for (int _i = 0; _i < 2; ++_i) \
        __builtin_amdgcn_global_load_lds((const unsigned*)((const char*)(gbase) + (voff)[_i]), (LAS unsigned*)(lds + (bufoff) + ldsw + _i * 8192), 16, 0, 0); } while (0)
#define PG8_LDA(dst, b, h) do { _Pragma("unroll") for (int m = 0; m < 4; ++m) _Pragma("unroll") for (int k = 0; k < 2; ++k) dst[m][k] = *(const LAS bf16x8*)(lds + PG8_SA(b, h) + aoff + m * 2048 + k * 1024); } while (0)
#define PG8_LDB(dst, b, h) do { _Pragma("unroll") for (int n = 0; n < 2; ++n) _Pragma("unroll") for (int k = 0; k < 2; ++k) dst[n][k] = *(const LAS bf16x8*)(lds + PG8_SB(b, h) + boff + n * 2048 + k * 1024); } while (0)
#define PG8_MMA(ai, bj, At, Bt) do { __builtin_amdgcn_s_setprio(1); _Pragma("unroll") for (int m = 0; m < 4; ++m) _Pragma("unroll") for (int n = 0; n < 2; ++n) _Pragma("unroll") for (int k = 0; k < 2; ++k) \
        acc[ai][bj][m][n] = __builtin_amdgcn_mfma_f32_16x16x32_bf16(Bt[n][k], At[m][k], acc[ai][bj][m][n], 0, 0, 0); __builtin_amdgcn_s_setprio(0); } while (0)
#define PG8_WAIT_V(n) asm volatile("s_waitcnt vmcnt(" #n ")" ::: "memory")
#define PG8_WAIT_L(n) asm volatile("s_waitcnt lgkmcnt(" #n ")" ::: "memory")
#define PG8_BAR __builtin_amdgcn_s_barrier()
#define PG8_SCHED __builtin_amdgcn_sched_barrier(0)
    Unit cur, nxt; int ui = 0;
    if (!S.next(0, cur)) return;
    f32x4 acc[2][2][4][2];
#pragma unroll
    for (int a = 0; a < 2; ++a)
#pragma unroll
        for (int b = 0; b < 2; ++b)
#pragma unroll
            for (int m = 0; m < 4; ++m)
#pragma unroll
                for (int n = 0; n < 2; ++n) acc[a][b][m][n] = (f32x4){0.f, 0.f, 0.f, 0.f};
    bf16x8 At[4][2], B0[2][2], B1[2][2];
    const char* cA = cur.A; const char* cB = cur.B;
    PG8_STAGE(PG8_SB(0, 0), cB, voffB); PG8_STAGE(PG8_SB(0, 1), cB + hstepB, voffB); PG8_STAGE(PG8_SA(0, 0), cA, voffA); PG8_STAGE(PG8_SA(0, 1), cA + hstepA, voffA);
    if (wr == 1) PG8_BAR;
    PG8_WAIT_V(2); PG8_BAR;
    PG8_STAGE(PG8_SB(1, 0), cB + kstep, voffB); PG8_STAGE(PG8_SA(1, 0), cA + kstep, voffA); PG8_STAGE(PG8_SB(1, 1), cB + hstepB + kstep, voffB);
    PG8_WAIT_V(6); PG8_BAR;
    for (;;) {
        const bool has_next = S.next(ui + 1, nxt);
        const char* nA = has_next ? nxt.A : cA; const char* nB = has_next ? nxt.B : cB;
        for (int t = 0; t < nt; t += 2) {
            const bool last = (t == nt - 2);
            const char* a1 = cA + (size_t)(t + 1) * kstep;
            const char* a2 = last ? nA : cA + (size_t)(t + 2) * kstep; const char* b2 = last ? nB : cB + (size_t)(t + 2) * kstep;
            const char* a3 = a2 + kstep; const char* b3 = b2 + kstep;
            PG8_LDB(B0, 0, 0); PG8_LDB(B1, 0, 1); PG8_SCHED; PG8_LDA(At, 0, 0); PG8_STAGE(PG8_SA(1, 1), a1 + hstepA, voffA);
            PG8_WAIT_V(8); PG8_WAIT_L(0); PG8_BAR; PG8_MMA(0, 0, At, B0); PG8_MMA(0, 1, At, B1); PG8_BAR; PG8_SCHED;
            PG8_LDA(At, 0, 1); PG8_STAGE(PG8_SB(0, 0), b2, voffB); PG8_STAGE(PG8_SB(0, 1), b2 + hstepB, voffB); PG8_STAGE(PG8_SA(0, 0), a2, voffA);
            PG8_WAIT_V(8); PG8_WAIT_L(0); PG8_BAR; PG8_MMA(1, 0, At, B0); PG8_MMA(1, 1, At, B1); PG8_BAR; PG8_SCHED;
            PG8_LDB(B0, 1, 0); PG8_LDB(B1, 1, 1); PG8_SCHED; PG8_LDA(At, 1, 0); PG8_STAGE(PG8_SA(0, 1), a2 + hstepA, voffA);
            PG8_WAIT_V(8); PG8_WAIT_L(0); PG8_BAR; PG8_MMA(0, 0, At, B0); PG8_MMA(0, 1, At, B1); PG8_BAR; PG8_SCHED;
            PG8_LDA(At, 1, 1); PG8_STAGE(PG8_SB(1, 0), b3, voffB); PG8_STAGE(PG8_SB(1, 1), b3 + hstepB, voffB); PG8_STAGE(PG8_SA(1, 0), a3, voffA);
            PG8_WAIT_V(8); PG8_WAIT_L(0); PG8_BAR; PG8_MMA(1, 0, At, B0); PG8_MMA(1, 1, At, B1); PG8_BAR; PG8_SCHED;
        }
        if (wr == 0) PG8_BAR;
        E(acc, cur, wr, wc, fr, fq);
        if (!has_next) break;
#pragma unroll
        for (int a = 0; a < 2; ++a)
#pragma unroll
            for (int b = 0; b < 2; ++b)
#pragma unroll
                for (int m = 0; m < 4; ++m)
#pragma unroll
                    for (int n = 0; n < 2; ++n) acc[a][b][m][n] = (f32x4){0.f, 0.f, 0.f, 0.f};
        cur = nxt; cA = nA; cB = nB; ++ui;
        if (wr == 1) PG8_BAR;
    }
    PG8_WAIT_V(0);
    PG8_BAR;
#undef PG8_SA
#undef PG8_SB
#undef PG8_STAGE
#undef PG8_LDA
#undef PG8_LDB
#undef PG8_MMA
#undef PG8_WAIT_V
#undef PG8_WAIT_L
#undef PG8_BAR
#undef PG8_SCHED
}

struct EpiProj {
    bf16_t* O; const float* bmerge;
    __device__ __forceinline__ void operator()(const f32x4 (&acc)[2][2][4][2], const Unit& u, int wr, int wc, int fr, int fq) const {
        const int row0 = u.pm * BM + wr * 64 + fr, col0 = u.pn * BM + wc * 32 + 8 * fq;
        const int mode = (u.pn == 2 || u.pn == 3) ? 1 : (u.pn >= 10 ? 2 : 0);
        f32x4 bv[2][2];
#pragma unroll
        for (int bj = 0; bj < 2; ++bj)
#pragma unroll
            for (int n = 0; n < 2; ++n) bv[bj][n] = (mode == 2) ? *(const f32x4*)(bmerge + (col0 - C_MG) + bj * HALF + 4 * n) : (f32x4){0.f, 0.f, 0.f, 0.f};
#pragma unroll
        for (int ai = 0; ai < 2; ++ai)
#pragma unroll
            for (int m = 0; m < 4; ++m) { bf16_t* rowp = O + (size_t)(row0 + ai * HALF + m * 16) * NIN + col0;
#pragma unroll
                for (int bj = 0; bj < 2; ++bj) { f32x4 v0 = acc[ai][bj][m][0] + bv[bj][0], v1 = acc[ai][bj][m][1] + bv[bj][1];
                    if (mode == 1) {
#pragma unroll
                        for (int j = 0; j < 4; ++j) { v0[j] = gelu_tanh(v0[j]); v1[j] = gelu_tanh(v1[j]); } }
                    else if (mode == 2) {
#pragma unroll
                        for (int j = 0; j < 4; ++j) { v0[j] = fast_sigmoid(v0[j]); v1[j] = fast_sigmoid(v1[j]); } }
                    u32x4 w; w.x = cvt_pk_bf16(v0[0], v0[1]); w.y = cvt_pk_bf16(v0[2], v0[3]); w.z = cvt_pk_bf16(v1[0], v1[1]); w.w = cvt_pk_bf16(v1[2], v1[3]);
                    *(u32x4*)(rowp + bj * HALF) = w; } }
    }
};
struct EpiPlain {
    bf16_t* O; int ldc;
    __device__ __forceinline__ void operator()(const f32x4 (&acc)[2][2][4][2], const Unit& u, int wr, int wc, int fr, int fq) const {
        const int row0 = u.pm * BM + wr * 64 + fr, col0 = u.pn * BM + wc * 32 + 8 * fq;
#pragma unroll
        for (int ai = 0; ai < 2; ++ai)
#pragma unroll
            for (int m = 0; m < 4; ++m) { bf16_t* rowp = O + (size_t)(row0 + ai * HALF + m * 16) * ldc + col0;
#pragma unroll
                for (int bj = 0; bj < 2; ++bj) { const f32x4 v0 = acc[ai][bj][m][0], v1 = acc[ai][bj][m][1];
                    u32x4 w; w.x = cvt_pk_bf16(v0[0], v0[1]); w.y = cvt_pk_bf16(v0[2], v0[3]); w.z = cvt_pk_bf16(v1[0], v1[1]); w.w = cvt_pk_bf16(v1[2], v1[3]);
                    *(u32x4*)(rowp + bj * HALF) = w; } }
    }
};
struct EpiMerge {
    const bf16_t* P; bf16_t* O;
    __device__ __forceinline__ void operator()(const f32x4 (&acc)[2][2][4][2], const Unit& u, int wr, int wc, int fr, int fq) const {
        const int row0 = u.pm * BM + wr * 64 + fr, col0 = u.pn * BM + wc * 32 + 8 * fq; const int b = u.aux;
#pragma unroll
        for (int ai = 0; ai < 2; ++ai)
#pragma unroll
            for (int m = 0; m < 4; ++m) { const size_t row = (size_t)(row0 + ai * HALF + m * 16);
                const bf16_t* gp = P + row * NIN + C_MG + b * D + col0; bf16_t* op = O + row * D + col0;
#pragma unroll
                for (int bj = 0; bj < 2; ++bj) { const u32x4 gt = *(const u32x4*)(gp + bj * HALF);
                    f32x4 v0 = acc[ai][bj][m][0], v1 = acc[ai][bj][m][1];
                    v0[0] *= bf_lo(gt.x); v0[1] *= bf_hi(gt.x); v0[2] *= bf_lo(gt.y); v0[3] *= bf_hi(gt.y);
                    v1[0] *= bf_lo(gt.z); v1[1] *= bf_hi(gt.z); v1[2] *= bf_lo(gt.w); v1[3] *= bf_hi(gt.w);
                    if (b > 0) { const u32x4 pv = *(const u32x4*)(op + bj * HALF);
                        v0[0] += bf_lo(pv.x); v0[1] += bf_hi(pv.x); v0[2] += bf_lo(pv.y); v0[3] += bf_hi(pv.y);
                        v1[0] += bf_lo(pv.z); v1[1] += bf_hi(pv.z); v1[2] += bf_lo(pv.w); v1[3] += bf_hi(pv.w); }
                    u32x4 w; w.x = cvt_pk_bf16(v0[0], v0[1]); w.y = cvt_pk_bf16(v0[2], v0[3]); w.z = cvt_pk_bf16(v1[0], v1[1]); w.w = cvt_pk_bf16(v1[2], v1[3]);
                    *(u32x4*)(op + bj * HALF) = w; } }
    }
};
struct EpiSwiglu {
    bf16_t* O;
    __device__ __forceinline__ void operator()(const f32x4 (&acc)[2][2][4][2], const Unit& u, int wr, int wc, int fr, int fq) const {
        const int row0 = u.pm * BM + wr * 64 + fr, col0 = u.pn * HALF + wc * 32 + 8 * fq;
#pragma unroll
        for (int ai = 0; ai < 2; ++ai)
#pragma unroll
            for (int m = 0; m < 4; ++m) { bf16_t* rowp = O + (size_t)(row0 + ai * HALF + m * 16) * D + col0;
                f32x4 v0 = acc[ai][0][m][0], v1 = acc[ai][0][m][1]; const f32x4 g0 = acc[ai][1][m][0], g1 = acc[ai][1][m][1];
#pragma unroll
                for (int j = 0; j < 4; ++j) { v0[j] = v0[j] * fast_sigmoid(v0[j]) * g0[j]; v1[j] = v1[j] * fast_sigmoid(v1[j]) * g1[j]; }
                u32x4 w; w.x = cvt_pk_bf16(v0[0], v0[1]); w.y = cvt_pk_bf16(v0[2], v0[3]); w.z = cvt_pk_bf16(v1[0], v1[1]); w.w = cvt_pk_bf16(v1[2], v1[3]);
                *(u32x4*)rowp = w; }
    }
};
}
namespace attn_body {
using bf16 = __hip_bfloat16;
using s16x4 = __attribute__((ext_vector_type(4))) short;
using f32x16 = __attribute__((ext_vector_type(16))) float;
constexpr int DM = NIN;
constexpr int NW = 8, QBLK = 32, QB = QBLK * NW, KVBLK = 64;
__device__ __forceinline__ int crow(int r, int hi) { return (r & 3) + 8 * (r >> 2) + 4 * hi; }
#define SBAR() __builtin_amdgcn_sched_barrier(0)
constexpr int NSLOT = 3, SLOTB = 8192;
constexpr int LDS_K = 0, LDS_V = NSLOT * SLOTB, LDS_WS = 2 * NSLOT * SLOTB, LDS_OST = LDS_WS + NW * 64 * 4, LDS_BYTES = LDS_OST + NW * 4096;
constexpr float LOG2E = 1.4426950408889634f;
constexpr float C2 = 0.125f * LOG2E;
__device__ __forceinline__ void glds16(const void* gsrc, unsigned lds_dst) { unsigned keep;
    asm volatile("s_mov_b32 %0, m0\n\ts_mov_b32 m0, %2\n\ts_nop 0\n\tglobal_load_lds_dwordx4 %1, off\n\ts_mov_b32 m0, %0" : "=&s"(keep) : "v"(gsrc), "s"(lds_dst) : "memory"); }
__device__ __forceinline__ float max3f(float a, float b, float c) { float r; asm("v_max3_f32 %0, %1, %2, %3" : "=v"(r) : "v"(a), "v"(b), "v"(c)); return r; }
__device__ __forceinline__ float max2f(float a, float b) { float r; asm("v_max_f32_e32 %0, %1, %2" : "=v"(r) : "v"(a), "v"(b)); return r; }
__device__ __forceinline__ float fadd_s(float a, float b) { float r; asm("v_add_f32_e32 %0, %1, %2" : "=v"(r) : "v"(a), "v"(b)); return r; }
__device__ __forceinline__ float fsub_s(float a, float b) { float r; asm("v_sub_f32_e32 %0, %1, %2" : "=v"(r) : "v"(a), "v"(b)); return r; }
typedef float f32x2_t __attribute__((ext_vector_type(2))); typedef __bf16 bf16x2_t __attribute__((ext_vector_type(2)));
__device__ __forceinline__ unsigned cvtpk_s(float lo, float hi) { f32x2_t v = {lo, hi}; bf16x2_t b = __builtin_convertvector(v, bf16x2_t); return __builtin_bit_cast(unsigned, b); }
#define WAIT_BAR(N) asm volatile("s_waitcnt vmcnt(" #N ") lgkmcnt(0)\n\ts_barrier" ::: "memory")

__device__ __forceinline__ void qkt(f32x16& p0, f32x16& p1, const char* Kslot, const bf16x8* qr, const f32x16& negm, int r32, int hi) {
    const char* kb = Kslot + hi * 1024 + r32 * 16;
#pragma unroll
    for (int d0 = 0; d0 < 4; ++d0) {
        const bf16x8 b0 = *reinterpret_cast<const bf16x8*>(kb + d0 * 2048);
        const bf16x8 b1 = *reinterpret_cast<const bf16x8*>(kb + d0 * 2048 + 512);
        if (d0 == 0) { p0 = __builtin_amdgcn_mfma_f32_32x32x16_bf16(b0, qr[0], negm, 0, 0, 0); p1 = __builtin_amdgcn_mfma_f32_32x32x16_bf16(b1, qr[0], negm, 0, 0, 0); }
        else { p0 = __builtin_amdgcn_mfma_f32_32x32x16_bf16(b0, qr[d0], p0, 0, 0, 0); p1 = __builtin_amdgcn_mfma_f32_32x32x16_bf16(b1, qr[d0], p1, 0, 0, 0); } }
}
typedef __attribute__((address_space(3))) const char* lds_cptr;
typedef short v4i16_t __attribute__((ext_vector_type(4)));
__device__ __forceinline__ void kload8(bf16x8* kf, lds_cptr kp) {
    kf[0] = *(const LAS bf16x8*)(kp);        kf[1] = *(const LAS bf16x8*)(kp + 512);
    kf[2] = *(const LAS bf16x8*)(kp + 2048); kf[3] = *(const LAS bf16x8*)(kp + 2560);
    kf[4] = *(const LAS bf16x8*)(kp + 4096); kf[5] = *(const LAS bf16x8*)(kp + 4608);
    kf[6] = *(const LAS bf16x8*)(kp + 6144); kf[7] = *(const LAS bf16x8*)(kp + 6656);
}
__device__ __forceinline__ void kload2(bf16x8* kf, lds_cptr kp, int j) { kf[2 * j] = *(const LAS bf16x8*)(kp + j * 2048); kf[2 * j + 1] = *(const LAS bf16x8*)(kp + j * 2048 + 512); }
__device__ __forceinline__ s16x4 vtr(lds_cptr p) { return __builtin_bit_cast(s16x4, __builtin_amdgcn_ds_read_tr16_b64_v4i16((LAS v4i16_t*)p)); }
__device__ __forceinline__ float rowmax(const f32x16& p0, const f32x16& p1) {
    float a = max3f(p0[0], p0[1], p1[0]), b = max3f(p0[2], p0[3], p1[1]); a = max3f(a, p1[2], p1[3]);
#pragma unroll
    for (int r = 4; r < 16; r += 4) { a = max3f(a, p0[r], p0[r + 1]); b = max3f(b, p0[r + 2], p0[r + 3]); a = max3f(a, p1[r], p1[r + 1]); b = max3f(b, p1[r + 2], p1[r + 3]); }
    const float m = max2f(a, b);
    auto rr = __builtin_amdgcn_permlane32_swap(__float_as_uint(m), __float_as_uint(m), false, false);
    return max2f(__uint_as_float(rr[0]), __uint_as_float(rr[1]));
}
__device__ __forceinline__ void pv(f32x16* o, int vb, bf16x8 pa0, bf16x8 pa1, bf16x8 pa2, bf16x8 pa3) {
#pragma unroll
    for (int d0 = 0; d0 < 2; ++d0) { s16x4 lo[4], hi[4];
#pragma unroll
        for (int ks = 0; ks < 4; ++ks) {
            asm volatile("ds_read_b64_tr_b16 %0,%1 offset:%c2" : "=&v"(lo[ks]) : "v"(vb), "i"(d0 * 4096 + ks * 1024) : "memory");
            asm volatile("ds_read_b64_tr_b16 %0,%1 offset:%c2" : "=&v"(hi[ks]) : "v"(vb), "i"(d0 * 4096 + ks * 1024 + 512) : "memory"); }
        asm volatile("s_waitcnt lgkmcnt(0)" ::: "memory"); SBAR();
#define PK(k) (bf16x8){lo[k][0], lo[k][1], lo[k][2], lo[k][3], hi[k][0], hi[k][1], hi[k][2], hi[k][3]}
        o[d0] = __builtin_amdgcn_mfma_f32_32x32x16_bf16(pa0, PK(0), o[d0], 0, 0, 0);
        o[d0] = __builtin_amdgcn_mfma_f32_32x32x16_bf16(pa1, PK(1), o[d0], 0, 0, 0);
        o[d0] = __builtin_amdgcn_mfma_f32_32x32x16_bf16(pa2, PK(2), o[d0], 0, 0, 0);
        o[d0] = __builtin_amdgcn_mfma_f32_32x32x16_bf16(pa3, PK(3), o[d0], 0, 0, 0);
#undef PK
    }
}
__device__ __forceinline__ void wmask(f32x16& p0, f32x16& p1, int dk0, int hi) {
    const float NEG = -INFINITY; const int kb = dk0 + 4 * hi;
#pragma unroll
    for (int r = 0; r < 16; ++r) { const int d = kb + (r & 3) + 8 * (r >> 2); if (d > 128 || d < -128) p0[r] = NEG; if (d + 32 > 128 || d + 32 < -128) p1[r] = NEG; }
}

struct AttnArgs { bf16* P; const float* qg; const float* ropec; const float* ropes; float sink; };

template <int MODE, int THRL> __device__ __forceinline__ void attn_unit(int b, int h, int qb, const AttnArgs& aa, char* shm) {
    constexpr bool LAT = (MODE < 2), WIN = (MODE == 1), SINK = (MODE == 1 || MODE == 3);
    constexpr int NT = (MODE == 0) ? 68 : (MODE == 1 ? 12 : 4);
    constexpr int QCOL = (MODE == 0 || MODE == 2) ? C_GQ : C_WQ, KCOL = (MODE == 0 || MODE == 2) ? C_GK : C_WK, VCOL = (MODE == 0 || MODE == 2) ? C_GV : C_WV;
    int tid_ = threadIdx.x; asm volatile("" : "+v"(tid_));
    const int tid = tid_, lane = tid & 63, r32 = lane & 31, hi = lane >> 5; const int wid = __builtin_amdgcn_readfirstlane(tid >> 6);
    const long rowbase = (long)b * TB; const int q0 = qb * QB;
    const long qrow0 = rowbase + (LAT ? NCTX : 0) + q0 + wid * QBLK;
    const int kvh = h >> 2;
    const bf16* Qw = aa.P + qrow0 * DM + QCOL + h * 64;
    const bf16* Kh = aa.P + rowbase * DM + KCOL + kvh * 64, *Vh = aa.P + rowbase * DM + VCOL + kvh * 64;
    const unsigned lds0 = (unsigned)(uintptr_t)shm;
    float* wsf = (float*)(shm + LDS_WS) + wid * 64;
    const bf16* ksrc = Kh + (long)lane * DM + wid * 8;
    const bf16* vsrc = Vh + (long)(16 * (wid & 3) + (lane >> 2)) * DM + (wid >> 2) * 32 + (lane & 3) * 8;
    const unsigned kdst = lds0 + LDS_K + wid * 1024, vdst = lds0 + LDS_V + wid * 1024;
    int kstart = 0; if (WIN) { kstart = q0 - 128; kstart = kstart < 0 ? 0 : kstart; kstart = kstart > SEQ - 512 ? SEQ - 512 : kstart; }
#define TROW(t) (WIN ? (((t) < 4) ? 64 * (t) : NCTX + kstart + 64 * ((t) - 4)) : 64 * (t))
#define DMA_K(t, slot) glds16(ksrc + (long)TROW(t) * DM, (unsigned)__builtin_amdgcn_readfirstlane(kdst + (slot)))
#define DMA_V(t, slot) glds16(vsrc + (long)TROW(t) * DM, (unsigned)__builtin_amdgcn_readfirstlane(vdst + (slot)))
    const int vb0 = (int)(lds0 + LDS_V) + ((lane >> 4) & 1) * 32 + (lane & 3) * 8 + (4 * hi + ((lane & 15) >> 2)) * 64;
    const char* Kbase = shm + LDS_K; bf16x8 kf[8];
    const lds_cptr shm3 = (lds_cptr)shm; const lds_cptr kp0 = shm3 + LDS_K + hi * 1024 + r32 * 16; const lds_cptr vp0 = shm3 + LDS_V + ((lane >> 4) & 1) * 32 + (lane & 3) * 8 + (4 * hi + ((lane & 15) >> 2)) * 64;
    DMA_K(0, 0); DMA_V(0, 0); DMA_K(1, SLOTB);
    bf16x8 qr[4];
    {
        bf16x8 qraw[4];
#pragma unroll
        for (int d0 = 0; d0 < 4; ++d0) qraw[d0] = *reinterpret_cast<const bf16x8*>(&Qw[(long)r32 * DM + d0 * 16 + hi * 8]);
        float qf[4][8]; float ss = 0.f;
#pragma unroll
        for (int d0 = 0; d0 < 4; ++d0)
#pragma unroll
            for (int j = 0; j < 8; ++j) { qf[d0][j] = __uint_as_float(((unsigned)(unsigned short)qraw[d0][j]) << 16); ss += qf[d0][j] * qf[d0][j]; }
        { auto rr = __builtin_amdgcn_permlane32_swap(__float_as_uint(ss), __float_as_uint(ss), false, false); ss = __uint_as_float(rr[0]) + __uint_as_float(rr[1]); }
        const float rinv = 1.0f / sqrtf(ss * (1.0f / 64.0f) + EPS);
#pragma unroll
        for (int d0 = 0; d0 < 4; ++d0) { const f32x4 g0 = *(const f32x4*)(aa.qg + d0 * 16 + hi * 8), g1 = *(const f32x4*)(aa.qg + d0 * 16 + hi * 8 + 4);
#pragma unroll
            for (int j = 0; j < 4; ++j) { qf[d0][j] *= rinv * g0[j]; qf[d0][4 + j] *= rinv * g1[j]; } }
        if (LAT) {
            const int pos = q0 + wid * QBLK + r32;
#pragma unroll
            for (int pr = 0; pr < 2; ++pr) {
                const float* cp = aa.ropec + (size_t)pos * 32 + pr * 16 + hi * 8; const float* sp = aa.ropes + (size_t)pos * 32 + pr * 16 + hi * 8;
                const f32x4 c0 = *(const f32x4*)cp, c1 = *(const f32x4*)(cp + 4), s0 = *(const f32x4*)sp, s1 = *(const f32x4*)(sp + 4);
#pragma unroll
                for (int j = 0; j < 8; ++j) { const float c = j < 4 ? c0[j & 3] : c1[j & 3], s = j < 4 ? s0[j & 3] : s1[j & 3];
                    const float t1 = qf[pr][j], t2 = qf[pr + 2][j]; qf[pr][j] = t1 * c - t2 * s; qf[pr + 2][j] = t2 * c + t1 * s; } }
        }
#pragma unroll
        for (int d0 = 0; d0 < 4; ++d0) { u32x4 w; w.x = cvtpk_s(qf[d0][0] * C2, qf[d0][1] * C2); w.y = cvtpk_s(qf[d0][2] * C2, qf[d0][3] * C2); w.z = cvtpk_s(qf[d0][4] * C2, qf[d0][5] * C2); w.w = cvtpk_s(qf[d0][6] * C2, qf[d0][7] * C2);
            qr[d0] = __builtin_bit_cast(bf16x8, w); }
    }
    float mhat = 0.f, l_reg = 0.f; f32x16 o[2]; o[0] = f32x16{}; o[1] = f32x16{}; f32x16 negm = f32x16{}; asm volatile("" : "+v"(negm));
    const int dkq = kstart - (q0 + wid * QBLK + r32);
#define CMASK(P0, P1, t) do { if (WIN && (t) >= 4) wmask(P0, P1, dkq + 64 * ((t) - 4), hi); } while (0)
    bool resc = false;
#define START(P0, P1) do { const float rm = rowmax(P0, P1); resc = false; \
    { const float dl = rm; mhat = fadd_s(mhat, dl); \
      _Pragma("unroll") for (int r = 0; r < 16; ++r) { P0[r] = fsub_s(P0[r], dl); P1[r] = fsub_s(P1[r], dl); } \
      _Pragma("unroll") for (int r = 0; r < 16; ++r) negm[r] = -mhat; asm volatile("" : "+v"(negm)); } \
    _Pragma("unroll") for (int r = 0; r < 16; ++r) P0[r] = __builtin_amdgcn_exp2f(P0[r]); } while (0)
#define RESC() do { if (resc) { asm volatile("s_waitcnt lgkmcnt(0)" ::: "memory"); \
      _Pragma("unroll") for (int d_ = 0; d_ < 2; ++d_) _Pragma("unroll") for (int r = 0; r < 16; ++r) o[d_][r] *= wsf[crow(r, hi)]; } } while (0)
    f32x16 pA0, pA1, pB0, pB1;
    int sl_prev = 0, sl_cur = 0, sl_next = SLOTB;
#define ROT() do { sl_prev = sl_cur; sl_cur = sl_next; sl_next = (sl_next == (NSLOT - 1) * SLOTB) ? 0 : sl_next + SLOTB; } while (0)
    DMA_K(2, 2 * SLOTB);
    WAIT_BAR(3);
    qkt(pA0, pA1, Kbase, qr, negm, r32, hi); asm volatile("s_nop 15\n\ts_nop 7" : "+v"(pA0), "+v"(pA1)); CMASK(pA0, pA1, 0);
    START(pA0, pA1);
    _Pragma("unroll") for (int r = 0; r < 16; ++r) pA1[r] = __builtin_amdgcn_exp2f(pA1[r]);
    WAIT_BAR(0);
    DMA_K(3, 0); DMA_V(1, SLOTB);
    ROT();
    kload8(kf, kp0 + sl_cur);
    WAIT_BAR(2);
    s16x4 vlo[8], vhi[8]; u32x4 pw0, pw1, pw2, pw3;
#define PKW(P, B) cvtpk_s(P[B], P[B + 1])
#define PAF(k) __builtin_bit_cast(bf16x8, pw##k)
#define VFR(i) (bf16x8){vlo[i][0], vlo[i][1], vlo[i][2], vlo[i][3], vhi[i][0], vhi[i][1], vhi[i][2], vhi[i][3]}
#define PIN(x) asm volatile("" : "+v"(x))
#define MX3(a, b, c) __builtin_fmaxf(__builtin_fmaxf((a), (b)), (c))
#define GAPA(MF, A0, A1, A2, A3, W0, W1, PW) do { MF; sacc += A0; sacc += A1; sacc += A2; sacc += A3; PIN(sacc); W0; W1; PIN(PW); SBAR(); } while (0)
#define EX(v) __builtin_amdgcn_exp2f(v)
#define GAPB(MF, X, B) do { MF; X[B] = EX(X[B]); X[B + 1] = EX(X[B + 1]); X[B + 2] = EX(X[B + 2]); X[B + 3] = EX(X[B + 3]); PIN(X); SBAR(); } while (0)
#define VRD(i) do { vlo[i] = vtr(vp_ + (((i) >> 2) * 4096 + ((i) & 3) * 1024)); vhi[i] = vtr(vp_ + (((i) >> 2) * 4096 + ((i) & 3) * 1024 + 512)); } while (0)
#define KRD(G, j) do { if (G) { kload2(kf, kp0 + sl_next, j); SBAR(); } } while (0)
#define STEP(C0, C1, P0, P1, t, GK, GV, GL) do { SBAR(); \
    const lds_cptr vp_ = vp0 + sl_prev; \
    VRD(0); SBAR(); float sacc = (P0[0] + P0[1]); \
    GAPA(C0 = __builtin_amdgcn_mfma_f32_32x32x16_bf16(kf[0], qr[0], negm, 0, 0, 0), P0[2], P0[3], P0[4], P0[5],     pw0[0] = PKW(P0, 0), pw0[1] = PKW(P0, 2), pw0); \
    VRD(4); SBAR(); GAPA(C1 = __builtin_amdgcn_mfma_f32_32x32x16_bf16(kf[1], qr[0], negm, 0, 0, 0), P0[6], P0[7], P0[8], P0[9],     pw0[2] = PKW(P0, 4), pw0[3] = PKW(P0, 6), pw0); \
    VRD(1); SBAR(); GAPA(C0 = __builtin_amdgcn_mfma_f32_32x32x16_bf16(kf[2], qr[1], C0, 0, 0, 0),   P0[10], P0[11], P0[12], P0[13], pw1[0] = PKW(P0, 8), pw1[1] = PKW(P0, 10), pw1); \
    VRD(5); SBAR(); GAPA(C1 = __builtin_amdgcn_mfma_f32_32x32x16_bf16(kf[3], qr[1], C1, 0, 0, 0),   P0[14], P0[15], P1[0], P1[1],   pw1[2] = PKW(P0, 12), pw1[3] = PKW(P0, 14), pw1); \
    VRD(2); SBAR(); GAPA(C0 = __builtin_amdgcn_mfma_f32_32x32x16_bf16(kf[4], qr[2], C0, 0, 0, 0),   P1[2], P1[3], P1[4], P1[5],     pw2[0] = PKW(P1, 0), pw2[1] = PKW(P1, 2), pw2); \
    VRD(6); SBAR(); GAPA(C1 = __builtin_amdgcn_mfma_f32_32x32x16_bf16(kf[5], qr[2], C1, 0, 0, 0),   P1[6], P1[7], P1[8], P1[9],     pw2[2] = PKW(P1, 4), pw2[3] = PKW(P1, 6), pw2); \
    VRD(3); SBAR(); GAPA(C0 = __builtin_amdgcn_mfma_f32_32x32x16_bf16(kf[6], qr[3], C0, 0, 0, 0),   P1[10], P1[11], P1[12], P1[13], pw3[0] = PKW(P1, 8), pw3[1] = PKW(P1, 10), pw3); \
    VRD(7); SBAR(); GAPA(C1 = __builtin_amdgcn_mfma_f32_32x32x16_bf16(kf[7], qr[3], C1, 0, 0, 0),   P1[14], P1[15], 0.f, 0.f,       pw3[2] = PKW(P1, 12), pw3[3] = PKW(P1, 14), pw3); \
    l_reg += sacc; \
    if (GK) { DMA_K((t) + 3, sl_cur); } if (GV) { DMA_V((t) + 1, sl_next); } \
    CMASK(C0, C1, t); \
    { float a = MX3(C0[0], C0[1], C1[0]), b = MX3(C0[2], C0[3], C1[1]); a = MX3(a, C1[2], C1[3]); \
      _Pragma("unroll") for (int r = 4; r < 16; r += 4) { a = MX3(a, C0[r], C0[r + 1]); b = MX3(b, C0[r + 2], C0[r + 3]); a = MX3(a, C1[r], C1[r + 1]); b = MX3(b, C1[r + 2], C1[r + 3]); } \
      float rm = __builtin_fmaxf(a, b); { auto rr = __builtin_amdgcn_permlane32_swap(__float_as_uint(rm), __float_as_uint(rm), false, false); rm = __builtin_fmaxf(__uint_as_float(rr[0]), __uint_as_float(rr[1])); } \
      resc = false; \
      if (__builtin_expect(__any(rm > (float)THRL), 0)) { const float dl = __builtin_fmaxf(rm, 0.f); mhat += dl; \
        _Pragma("unroll") for (int r = 0; r < 16; ++r) { C0[r] -= dl; C1[r] -= dl; } \
        _Pragma("unroll") for (int r = 0; r < 16; ++r) negm[r] = -mhat; asm volatile("" : "+v"(negm)); \
        const float f = __builtin_amdgcn_exp2f(-dl); l_reg *= f; if (hi == 0) wsf[r32] = f; resc = true; } } \
    SBAR(); \
    GAPB(o[0] = __builtin_amdgcn_mfma_f32_32x32x16_bf16(PAF(0), VFR(0), o[0], 0, 0, 0), C0, 0); \
    GAPB(o[1] = __builtin_amdgcn_mfma_f32_32x32x16_bf16(PAF(0), VFR(4), o[1], 0, 0, 0), C0, 4); \
    KRD(GL, 0); GAPB(o[0] = __builtin_amdgcn_mfma_f32_32x32x16_bf16(PAF(1), VFR(1), o[0], 0, 0, 0), C0, 8); \
    KRD(GL, 1); GAPB(o[1] = __builtin_amdgcn_mfma_f32_32x32x16_bf16(PAF(1), VFR(5), o[1], 0, 0, 0), C0, 12); \
    KRD(GL, 2); GAPB(o[0] = __builtin_amdgcn_mfma_f32_32x32x16_bf16(PAF(2), VFR(2), o[0], 0, 0, 0), C1, 0); \
    KRD(GL, 3); GAPB(o[1] = __builtin_amdgcn_mfma_f32_32x32x16_bf16(PAF(2), VFR(6), o[1], 0, 0, 0), C1, 4); \
    GAPB(o[0] = __builtin_amdgcn_mfma_f32_32x32x16_bf16(PAF(3), VFR(3), o[0], 0, 0, 0), C1, 8); \
    GAPB(o[1] = __builtin_amdgcn_mfma_f32_32x32x16_bf16(PAF(3), VFR(7), o[1], 0, 0, 0), C1, 12); \
    } while (0)
    int t = 1;
    for (; t + 5 < NT; t += 2) {
        STEP(pB0, pB1, pA0, pA1, t, true, true, true);     WAIT_BAR(2); RESC(); ROT();
        STEP(pA0, pA1, pB0, pB1, t + 1, true, true, true); WAIT_BAR(2); RESC(); ROT();
    }
#define ENDW(tt) do { if ((tt) + 3 < NT) { WAIT_BAR(2); } else if ((tt) + 2 < NT) { WAIT_BAR(1); } else { WAIT_BAR(0); } } while (0)
    for (; t + 1 < NT; t += 2) {
        STEP(pB0, pB1, pA0, pA1, t, (t + 3 < NT), (t + 1 < NT), (t + 1 < NT));         ENDW(t);     RESC(); ROT();
        STEP(pA0, pA1, pB0, pB1, t + 1, (t + 4 < NT), (t + 2 < NT), (t + 2 < NT));     ENDW(t + 1); RESC(); ROT();
    }
    STEP(pB0, pB1, pA0, pA1, NT - 1, false, false, false); RESC();
    { float sacc = pB0[0] + pB0[1]; _Pragma("unroll") for (int r = 2; r < 16; ++r) sacc += pB0[r]; _Pragma("unroll") for (int r = 0; r < 16; ++r) sacc += pB1[r]; l_reg += sacc;
      pw0 = (u32x4){PKW(pB0, 0), PKW(pB0, 2), PKW(pB0, 4), PKW(pB0, 6)}; pw1 = (u32x4){PKW(pB0, 8), PKW(pB0, 10), PKW(pB0, 12), PKW(pB0, 14)}; pw2 = (u32x4){PKW(pB1, 0), PKW(pB1, 2), PKW(pB1, 4), PKW(pB1, 6)}; pw3 = (u32x4){PKW(pB1, 8), PKW(pB1, 10), PKW(pB1, 12), PKW(pB1, 14)};
      SBAR(); pv(o, vb0 + sl_cur, PAF(0), PAF(1), PAF(2), PAF(3)); }
#undef PKW
#undef PAF
#undef VFR
#undef PIN
#undef MX3
#undef GAPA
#undef GAPB
#undef EX
#undef VRD
#undef KRD
#undef STEP
#undef ENDW
    { auto rr = __builtin_amdgcn_permlane32_swap(__float_as_uint(l_reg), __float_as_uint(l_reg), false, false); l_reg = __uint_as_float(rr[0]) + __uint_as_float(rr[1]); }
    if (SINK) l_reg += __builtin_amdgcn_exp2f(aa.sink * LOG2E - mhat);
    if (hi == 0) wsf[32 + r32] = l_reg; asm volatile("s_waitcnt lgkmcnt(0)" ::: "memory");
    float rli[16];
#pragma unroll
    for (int r = 0; r < 16; ++r) rli[r] = __builtin_amdgcn_rcpf(wsf[32 + crow(r, hi)]);
    bf16* Ow = aa.P + qrow0 * DM + QCOL + h * 64;
    { bf16* stg = (bf16*)(shm + LDS_OST) + wid * 2048;
#pragma unroll
      for (int r = 0; r < 16; ++r) { const int orow = crow(r, hi);
#pragma unroll
          for (int d0 = 0; d0 < 2; ++d0) stg[orow * 64 + d0 * 32 + r32] = __float2bfloat16(o[d0][r] * rli[r]); }
      asm volatile("s_waitcnt lgkmcnt(0)" ::: "memory");
#pragma unroll
      for (int i = 0; i < 4; ++i) { const int row = i * 8 + (lane >> 3), ch = lane & 7; const u32x4 v = *(const u32x4*)(stg + row * 64 + ch * 8); *(u32x4*)(Ow + (long)row * DM + ch * 8) = v; } }
    asm volatile("s_waitcnt lgkmcnt(0)\n\ts_barrier" ::: "memory");
#undef DMA_K
#undef DMA_V
#undef TROW
#undef CMASK
#undef START
#undef RESC
#undef ROT
}
#undef SBAR
#undef WAIT_BAR
}
constexpr size_t MiB = 1u << 20;
constexpr size_t WS_CTL = 0, CTL_ZERO_BYTES = 1 * MiB;
constexpr size_t WS_MOD = 1 * MiB;
constexpr size_t WS_ROPE = 2 * MiB;
constexpr size_t WS_ROUTE = 3 * MiB;
constexpr size_t WS_WIN = 6 * MiB;
constexpr size_t WS_WBR = 28 * MiB;
constexpr size_t WS_WOUT = 34 * MiB;
constexpr size_t WS_XC = 38 * MiB;
constexpr size_t WS_A = 54 * MiB;
constexpr size_t WS_PROJ = 190 * MiB;
constexpr size_t WS_YBUF = WS_PROJ;
constexpr size_t WS_HG = WS_PROJ;
constexpr size_t WS_YP = WS_PROJ;
constexpr size_t WS_HID = WS_PROJ + 280 * MiB;
constexpr size_t WS_W13 = WS_PROJ + 560 * MiB;
constexpr size_t WS_W2 = WS_PROJ + 624 * MiB;
constexpr size_t WS_END = WS_PROJ + 748 * MiB;
static_assert((size_t)T * NIN * 2 == 748 * MiB && (size_t)T * D * 2 == 136 * MiB && (size_t)PMAX * D * 2 == 280 * MiB, "buffer sizes");
static_assert(WS_END <= 1024 * MiB, "workspace map fits 1 GiB");
constexpr int CW_CNT = 64;
constexpr int CW_BAR = 4096;

constexpr int RING_OFF = 0, RING_BYTES = 131072;
constexpr int LDSCTL_OFF = RING_BYTES, MISC_OFF = LDSCTL_OFF + 320;
constexpr int LDS_BYTES = 147456;
constexpr int NWAVES = 8;

typedef GAS unsigned gu32;
#define RLX_AGENT __ATOMIC_RELAXED, __HIP_MEMORY_SCOPE_AGENT
#define LDS_WAIT() asm volatile("s_waitcnt lgkmcnt(0)" ::: "memory")
#define VM_WAIT() asm volatile("s_waitcnt vmcnt(0)" ::: "memory")

#define XB_TMO      128
#define XB_XCNT(j)  (256  + 64 * (j))
#define XB_XSUB(j)  (1280 + 64 * (j))
#define XB_XGEN(j)  (2304 + 64 * (j))
#define XB_TOP      3328
#define XB_TOPGEN   3392
#define XCD_BAR_WORDS 3456
#define XB_SPIN_CAP (1u << 18)
__device__ __forceinline__ unsigned xb_ld(unsigned* p)              { return __hip_atomic_load(p, __ATOMIC_RELAXED, __HIP_MEMORY_SCOPE_AGENT); }
__device__ __forceinline__ unsigned xb_add(unsigned* p, unsigned v) { return __hip_atomic_fetch_add(p, v, __ATOMIC_RELAXED, __HIP_MEMORY_SCOPE_AGENT); }
__device__ __forceinline__ unsigned xb_xcc_id() { return (unsigned)__builtin_amdgcn_s_getreg((3 << 11) | 20) & 0xFu; }
#define XB_SPIN(cond, bar) do { unsigned _sp = 0; while (cond) { __builtin_amdgcn_s_sleep(1); \
    if ((++_sp & 255u) == 0u) { if (xb_ld(&(bar)[XB_TMO])) break; if (_sp > XB_SPIN_CAP) { atomicAdd(&(bar)[XB_TMO], 1u); break; } } } } while (0)
struct XcdBarrier { unsigned* bar; unsigned x; volatile LAS unsigned* st; };
__device__ __forceinline__ XcdBarrier xcd_barrier_post(unsigned* bar, volatile LAS unsigned* st) {
    XcdBarrier b; b.bar = bar; b.x = xb_xcc_id(); b.st = st;
    if (threadIdx.x == 0) (void)xb_add(&bar[XB_XCNT(b.x)], 1u);
    return b;
}
__device__ __forceinline__ void xcd_barrier_complete(unsigned* bar, unsigned x, unsigned& nloc, unsigned& nx) {
    const unsigned G = gridDim.x * gridDim.y * gridDim.z;
    unsigned sum, cnt, mine, sp = 0u;
    for (;;) {
        sum = 0u; cnt = 0u; mine = 0u;
#pragma unroll
        for (unsigned j = 0; j < 16; ++j) { const unsigned c = xb_ld(&bar[XB_XCNT(j)]); sum += c; cnt += (c > 0u) ? 1u : 0u; mine = (j == x) ? c : mine; }
        if (sum == G) break;
        __builtin_amdgcn_s_sleep(1);
        if ((++sp & 255u) == 0u) { if (xb_ld(&bar[XB_TMO])) break; if (sp > XB_SPIN_CAP) { atomicAdd(&bar[XB_TMO], 1u); break; } }
    }
    nloc = mine > 0u ? mine : 1u; nx = cnt > 0u ? cnt : 1u;
}
__device__ __forceinline__ void xcd_barrier(const XcdBarrier& b) {
    asm volatile("s_waitcnt vmcnt(0)" ::: "memory");
    __syncthreads();
    if (threadIdx.x == 0) {
        unsigned* bar = b.bar;
        __builtin_amdgcn_s_waitcnt(0);
        unsigned nloc = b.st[0], nx = b.st[1];
        if (nloc == 0u) { xcd_barrier_complete(bar, b.x, nloc, nx); b.st[0] = nloc; b.st[1] = nx; }
        const unsigned old = xb_add(&bar[XB_XSUB(b.x)], 1u);
        const unsigned gen = old / nloc;
        if (old + 1u == (gen + 1u) * nloc) {
            __builtin_amdgcn_fence(__ATOMIC_RELEASE, "agent");
            asm volatile("s_waitcnt vmcnt(0)" ::: "memory");
            const unsigned og = xb_add(&bar[XB_TOP], 1u);
            const unsigned tg = og / nx;
            if (og + 1u == (tg + 1u) * nx) xb_add(&bar[XB_TOPGEN], 1u);
            else XB_SPIN(xb_ld(&bar[XB_TOPGEN]) == tg, bar);
            __builtin_amdgcn_fence(__ATOMIC_ACQUIRE, "agent");
            xb_add(&bar[XB_XGEN(b.x)], 1u);
            asm volatile("s_waitcnt vmcnt(0)" ::: "memory");
        } else {
            XB_SPIN(xb_ld(&bar[XB_XGEN(b.x)]) == gen, bar);
            __builtin_amdgcn_fence(__ATOMIC_ACQUIRE, "agent");
            asm volatile("s_waitcnt vmcnt(0)" ::: "memory");
        }
    }
    __syncthreads();
}

struct Args { const float* in[27]; float* out; unsigned char* ws; };
struct KArgs { const GAS float* in[27]; GAS float* out; GAS unsigned char* ws; };
typedef const __attribute__((address_space(4))) KArgs* kargs_p;
__device__ __forceinline__ kargs_p kargs() { kargs_p p = (kargs_p)__builtin_amdgcn_kernarg_segment_ptr(); asm volatile("" : "+s"(p)); return p; }
struct Frame {
    LAS unsigned char* lds;
    int tid, lane, wave, vcu, G, gw, NGW, bid;
#define KIN(name, idx) __device__ __forceinline__ const float* name() const { return (const float*)kargs()->in[idx]; }
    KIN(x, 0) KIN(c, 1) KIN(ctx, 2) KIN(c_ctx, 3) KIN(w_mod, 4) KIN(b_mod, 5) KIN(norm1_g, 6) KIN(norm2_g, 7) KIN(w_in, 8) KIN(b_merge, 9) KIN(conv_w, 10) KIN(conv_b, 11)
    KIN(lru_wa, 12) KIN(lru_ba, 13) KIN(lru_wx, 14) KIN(lru_bx, 15) KIN(lru_lambda, 16) KIN(q_norm_g, 17) KIN(k_norm_g, 18) KIN(sink, 19) KIN(w_branch, 20) KIN(w_out, 21)
    KIN(router_w, 22) KIN(router_b, 23) KIN(ew1, 24) KIN(ew3, 25) KIN(ew2, 26)
#undef KIN
    __device__ __forceinline__ float* out() const { return (float*)kargs()->out; }
    __device__ __forceinline__ unsigned char* ws() const { return (unsigned char*)kargs()->ws; }
    __device__ __forceinline__ gu32* ctl() const { return (gu32*)(ws() + WS_CTL); }
#define KWS(type, name, off) __device__ __forceinline__ type* name() const { return (type*)(ws() + (off)); }
    KWS(float, MOD, WS_MOD) KWS(float, ROPEC, WS_ROPE) KWS(float, ROPES, WS_ROPE + (size_t)SEQ * 32 * 4) KWS(float, XC, WS_XC) KWS(float, HT, WS_A) KWS(unsigned, ROUTE, WS_ROUTE)
    KWS(bf16_t, WIN, WS_WIN) KWS(bf16_t, WBR, WS_WBR) KWS(bf16_t, WOUT, WS_WOUT) KWS(bf16_t, A, WS_A) KWS(bf16_t, PROJ, WS_PROJ) KWS(bf16_t, YBUF, WS_YBUF) KWS(bf16_t, HG, WS_HG)
    KWS(bf16_t, YP, WS_YP) KWS(bf16_t, HID, WS_HID) KWS(bf16_t, W13, WS_W13) KWS(bf16_t, W2, WS_W2)
#undef KWS
};
__device__ __forceinline__ Frame fresh(const Frame& F0) { Frame F = F0;
    asm volatile("" : "+s"(F.wave), "+s"(F.vcu), "+s"(F.G), "+s"(F.gw), "+s"(F.NGW), "+s"(F.bid), "+v"(F.tid), "+v"(F.lane)); return F; }
__device__ __forceinline__ float wave_sum(float v) {
#pragma unroll
    for (int o = 1; o < 64; o <<= 1) v += __shfl_xor(v, o);
    return v;
}
__device__ __forceinline__ const float* modp(const float* MODb, int l, int sel, int chunk) { return MODb + ((size_t)(l * 17 + sel) * 6 + chunk) * D; }

__device__ __forceinline__ void transpose_item(const float* W, int K, int N, bf16_t* WT, int k0, int n0, int drow0, LAS float* scr, int lane) {
#pragma unroll 8
    for (int i = 0; i < 32; ++i) { const int kk = 2 * i + (lane >> 5); scr[kk * 33 + (lane & 31)] = W[(size_t)(k0 + kk) * N + n0 + (lane & 31)]; }
    LDS_WAIT(); asm volatile("" ::: "memory");
    const int cc = lane & 7;
#pragma unroll
    for (int j = 0; j < 4; ++j) { const int n = (lane >> 3) + 8 * j; const LAS float* s = scr + (8 * cc) * 33 + n;
        u32x4 o; o.x = cvt_pk_bf16(s[0 * 33], s[1 * 33]); o.y = cvt_pk_bf16(s[2 * 33], s[3 * 33]); o.z = cvt_pk_bf16(s[4 * 33], s[5 * 33]); o.w = cvt_pk_bf16(s[6 * 33], s[7 * 33]);
        *(GAS u32x4*)(WT + (size_t)(drow0 + n) * K + k0 + 8 * cc) = o; }
    LDS_WAIT(); asm volatile("" ::: "memory");
}

__device__ __forceinline__ void p0_prologue(Frame& F) {
    LAS float* scr = (LAS float*)(F.lds + RING_OFF + F.wave * 16384);
    constexpr int I_IN = (D / 64) * (NIN / 32), I_BR = (512 / 64) * (D / 32), I_OUT = (D / 64) * (D / 32);
    constexpr int NITEMS = NL * (I_IN + 3 * I_BR + I_OUT);
    for (int it = F.gw; it < NITEMS; it += F.NGW) {
        int r = it; const int l = r / (I_IN + 3 * I_BR + I_OUT); r -= l * (I_IN + 3 * I_BR + I_OUT);
        if (r < I_IN) { const int nb = NIN / 32, kb = r / nb, n0 = 32 * (r % nb); transpose_item(F.w_in() + (size_t)l * D * NIN, D, NIN, F.WIN() + (size_t)l * NIN * D, 64 * kb, n0, n0, scr, F.lane); continue; }
        r -= I_IN;
        if (r < 3 * I_BR) { const int b = r / I_BR; r -= b * I_BR; const int nb = D / 32, kb = r / nb, n0 = 32 * (r % nb);
            transpose_item(F.w_branch() + (size_t)(l * 3 + b) * 512 * D, 512, D, F.WBR() + (size_t)(l * 3 + b) * D * 512, 64 * kb, n0, n0, scr, F.lane); continue; }
        r -= 3 * I_BR;
        { const int nb = D / 32, kb = r / nb, n0 = 32 * (r % nb); transpose_item(F.w_out() + (size_t)l * D * D, D, D, F.WOUT() + (size_t)l * D * D, 64 * kb, n0, n0, scr, F.lane); }
    }
    float* RC = F.ROPEC(); float* RS = F.ROPES();
    for (int i = blockIdx.x * (NWAVES * 64) + F.tid; i < SEQ * 32; i += F.G * NWAVES * 64) {
        const int pos = i >> 5, f = i & 31; const float inv = exp2f(-(float)(f & 15) * (13.287712379549449f / 16.0f));
        const float ang = (float)(f < 16 ? (pos >> 6) : (pos & 63)) * inv;
        const float rev = ang * 0.15915494309189535f; RC[i] = __builtin_amdgcn_cosf(rev); RS[i] = __builtin_amdgcn_sinf(rev);
    }
    __syncthreads();
    {
        LAS float* sc = (LAS float*)(F.lds + RING_OFF);
        LAS float* part = (LAS float*)(F.lds + RING_OFF + 17 * 1024 * 4);
        bool have_sc = false;
        for (int it = blockIdx.x; it < NL * 96; it += F.G) {
            if (!have_sc) { for (int i = F.tid; i < 17 * 1024; i += NWAVES * 64) { const int s = i >> 10, k = i & 1023; const float v = s < 16 ? F.c()[s * D + k] : F.c_ctx()[k]; sc[i] = v * fast_sigmoid(v); }
                have_sc = true; __syncthreads(); }
            const int l = it / 96, cg = it % 96, col = cg * 64 + F.lane;
            const float* wp = F.w_mod() + (size_t)l * D * 6 * D + col;
            float acc[17];
#pragma unroll
            for (int s = 0; s < 17; ++s) acc[s] = 0.f;
            const int kbeg = F.wave * 128;
#pragma unroll 4
            for (int k = kbeg; k < kbeg + 128; ++k) { const float w = wp[(size_t)k * 6 * D];
#pragma unroll
                for (int s = 0; s < 17; ++s) acc[s] += sc[s * 1024 + k] * w; }
#pragma unroll
            for (int s = 0; s < 17; ++s) part[(F.wave * 17 + s) * 64 + F.lane] = acc[s];
            __syncthreads();
            for (int i = F.tid; i < 17 * 64; i += NWAVES * 64) { const int s = i >> 6, cl = i & 63; float v = F.b_mod()[l * 6 * D + cg * 64 + cl];
#pragma unroll
                for (int w = 0; w < 8; ++w) v += part[(w * 17 + s) * 64 + cl];
                F.MOD()[(size_t)(l * 17 + s) * 6 * D + cg * 64 + cl] = v; }
            __syncthreads();
        }
    }
}

__device__ __forceinline__ void convert_experts(Frame& F, int l) {
    LAS float* scr = (LAS float*)(F.lds + RING_OFF + F.wave * 16384);
    constexpr int I_M = (D / 64) * (D / 32);
    for (int it = F.gw; it < NE * 3 * I_M; it += F.NGW) {
        const int e = it / (3 * I_M); int r = it - e * 3 * I_M; const int which = r / I_M; r -= which * I_M;
        const int kb = r / (D / 32), n0 = 32 * (r % (D / 32));
        const size_t eoff = (size_t)(l * NE + e) * D * D;
        if (which == 0) transpose_item(F.ew1() + eoff, D, D, F.W13() + (size_t)e * 2048 * D, 64 * kb, n0, 256 * (n0 >> 7) + (n0 & 127), scr, F.lane);
        else if (which == 1) transpose_item(F.ew3() + eoff, D, D, F.W13() + (size_t)e * 2048 * D, 64 * kb, n0, 256 * (n0 >> 7) + 128 + (n0 & 127), scr, F.lane);
        else transpose_item(F.ew2() + eoff, D, D, F.W2() + (size_t)e * D * D, 64 * kb, n0, n0, scr, F.lane);
    }
}

__device__ __forceinline__ void ld_row_f32(const float* p, int lane, f32x4 (&v)[4]) {
#pragma unroll
    for (int j = 0; j < 4; ++j) v[j] = *((const GAS f32x4*)p + lane + 64 * j);
}
__device__ __forceinline__ void st_row_f32(float* p, int lane, const f32x4 (&v)[4]) {
#pragma unroll
    for (int j = 0; j < 4; ++j) *((GAS f32x4*)p + lane + 64 * j) = v[j];
}
__device__ __forceinline__ void ld_row_bf16(const bf16_t* p, int lane, f32x4 (&v)[4]) {
#pragma unroll
    for (int j = 0; j < 4; ++j) { const u32x2 w = *((const GAS u32x2*)p + lane + 64 * j); v[j] = (f32x4){bf_lo(w.x), bf_hi(w.x), bf_lo(w.y), bf_hi(w.y)}; }
}
__device__ __forceinline__ void st_row_bf16(bf16_t* p, int lane, const f32x4 (&v)[4]) {
#pragma unroll
    for (int j = 0; j < 4; ++j) { u32x2 w; w.x = cvt_pk_bf16(v[j][0], v[j][1]); w.y = cvt_pk_bf16(v[j][2], v[j][3]); *((GAS u32x2*)p + lane + 64 * j) = w; }
}
__device__ __forceinline__ void norm_mod(const f32x4 (&v)[4], const float* g, const float* shift, const float* scale, int lane, f32x4 (&h)[4]) {
    float ss = 0.f;
#pragma unroll
    for (int j = 0; j < 4; ++j) ss += (v[j][0] * v[j][0] + v[j][1] * v[j][1]) + (v[j][2] * v[j][2] + v[j][3] * v[j][3]);
    const float rinv = 1.0f / sqrtf(wave_sum(ss) * (1.0f / D) + EPS);
#pragma unroll
    for (int j = 0; j < 4; ++j) { const f32x4 gg = *((const GAS f32x4*)g + lane + 64 * j), sh = *((const GAS f32x4*)shift + lane + 64 * j), sc = *((const GAS f32x4*)scale + lane + 64 * j);
        h[j] = (v[j] * rinv) * gg * (sc + 1.0f) + sh; }
}

__device__ __forceinline__ void r1_phase(Frame& F) {
    const float* MODb = F.MOD(); const float* xin = F.x(); const float* cin = F.ctx(); const float* g1n = F.norm1_g(); bf16_t* Ab = F.A();
    for (int row = F.gw; row < T; row += F.NGW) {
        const int b = row / TB, p = row - b * TB; const bool isc = p < NCTX;
        const float* src = isc ? cin + (size_t)(b * NCTX + p) * D : xin + (size_t)(b * SEQ + p - NCTX) * D; const int sel = isc ? 16 : b;
        f32x4 v[4], h[4]; ld_row_f32(src, F.lane, v);
        norm_mod(v, g1n, modp(MODb, 0, sel, 0), modp(MODb, 0, sel, 1), F.lane, h);
        st_row_bf16(Ab + (size_t)row * D, F.lane, h);
    }
}

__device__ __forceinline__ void kfix_phase(Frame& F, int l) {
    const int hs = F.lane >> 4, j4 = F.lane & 15, br = hs >> 1;
    const int col = (br ? C_WK : C_GK) + (hs & 1) * 64 + 2 * j4;
    const float* kg = F.k_norm_g() + (size_t)(l * 2 + br) * 64;
    const float g0 = kg[2 * j4], g1 = kg[2 * j4 + 1], g2 = kg[32 + 2 * j4], g3 = kg[32 + 2 * j4 + 1];
    bf16_t* Pb = F.PROJ(); const float* RC = F.ROPEC(); const float* RS = F.ROPES();
    for (int row = F.gw; row < T; row += F.NGW) {
        const int b = row / TB, p = row - b * TB;
        bf16_t* rp = Pb + (size_t)row * NIN + col;
        const unsigned w1 = *(const GAS unsigned*)rp, w2 = *(const GAS unsigned*)(rp + 32);
        float a0 = bf_lo(w1), a1 = bf_hi(w1), b0 = bf_lo(w2), b1 = bf_hi(w2);
        float ss = a0 * a0 + a1 * a1 + b0 * b0 + b1 * b1;
        ss += __shfl_xor(ss, 1); ss += __shfl_xor(ss, 2); ss += __shfl_xor(ss, 4); ss += __shfl_xor(ss, 8);
        const float rinv = 1.0f / sqrtf(ss * (1.0f / 64.0f) + EPS);
        a0 *= rinv * g0; a1 *= rinv * g1; b0 *= rinv * g2; b1 *= rinv * g3;
        if (p >= NCTX) { const int pos = p - NCTX; const f32x2 cs = *(const GAS f32x2*)(RC + (size_t)pos * 32 + 2 * j4), sn = *(const GAS f32x2*)(RS + (size_t)pos * 32 + 2 * j4);
            const float t0 = a0 * cs.x - b0 * sn.x, t1 = a1 * cs.y - b1 * sn.y, u0 = b0 * cs.x + a0 * sn.x, u1 = b1 * cs.y + a1 * sn.y; a0 = t0; a1 = t1; b0 = u0; b1 = u1; }
        *(GAS unsigned*)rp = cvt_pk_bf16(a0, a1); *(GAS unsigned*)(rp + 32) = cvt_pk_bf16(b0, b1);
    }
}
constexpr int SC_AOP = 0, SC_AOP_B = 64 * 144, SC_XCV = 2 * SC_AOP_B, SC_XCV_B = 64 * 68 * 4, SC_TOT = SC_XCV + 2 * SC_XCV_B, SC_TOT_B = 4 * 2 * 16 * 8;
__device__ __forceinline__ void scan_unit(Frame& F, int l, int uid, bool last_layer) {
    const int b = uid >> 4, n = (uid >> 1) & 7, chh = uid & 1;
    const int dir = F.wave >> 2, ht = F.tid & 255, w = F.wave & 3, lane = F.lane, col = lane & 15, quad = lane >> 4;
    LAS unsigned char* aop = F.lds + SC_AOP + dir * SC_AOP_B;
    LAS float* xcv = (LAS float*)(F.lds + SC_XCV + dir * SC_XCV_B);
    LAS f32x2* tot = (LAS f32x2*)(F.lds + SC_TOT + dir * SC_TOT_B);
    bf16x8 Bf[4][2];
    {
        const size_t wbase = ((size_t)((l * 2 + dir) * 8 + n)) * 64 * 64; const float* lwa = F.lru_wa(); const float* lwx = F.lru_wx();
#pragma unroll
        for (int q = 0; q < 4; ++q) { const float* wp = ((q < 2) ? lwa : lwx) + wbase + 32 * chh + 16 * (q & 1) + col;
#pragma unroll
            for (int ks = 0; ks < 2; ++ks) { u32x4 pk;
                const int k0 = 32 * ks + 8 * quad;
                pk.x = cvt_pk_bf16(wp[(size_t)(k0 + 0) * 64], wp[(size_t)(k0 + 1) * 64]); pk.y = cvt_pk_bf16(wp[(size_t)(k0 + 2) * 64], wp[(size_t)(k0 + 3) * 64]);
                pk.z = cvt_pk_bf16(wp[(size_t)(k0 + 4) * 64], wp[(size_t)(k0 + 5) * 64]); pk.w = cvt_pk_bf16(wp[(size_t)(k0 + 6) * 64], wp[(size_t)(k0 + 7) * 64]);
                Bf[q][ks] = __builtin_bit_cast(bf16x8, pk); } }
    }
    float ba[2], bx[2], nla[2]; const float* lba = F.lru_ba(); const float* lbx = F.lru_bx(); const float* llam = F.lru_lambda();
#pragma unroll
    for (int q = 0; q < 2; ++q) { const int gch = 64 * n + 32 * chh + 16 * q + col; const size_t o = (size_t)(l * 2 + dir) * 512 + gch;
        ba[q] = lba[o]; bx[q] = lbx[o]; const float lam = llam[o];
        const float sp = (lam > 15.f) ? __expf(-lam) : log1pf(__expf(-lam));
        nla[q] = -8.0f * sp; }
    const int cg = ht & 7; float cw[4][8], cb[8]; const float* cwp = F.conv_w(); const float* cbp = F.conv_b();
#pragma unroll
    for (int k = 0; k < 4; ++k)
#pragma unroll
        for (int c = 0; c < 8; ++c) cw[k][c] = cwp[(size_t)(l * 4 + k) * 512 + 64 * n + 8 * cg + c];
#pragma unroll
    for (int c = 0; c < 8; ++c) cb[c] = cbp[(size_t)l * 512 + 64 * n + 8 * cg + c];
    float hcar[2] = {0.f, 0.f};
    bf16_t* Pb = F.PROJ(); float* HTb = F.HT();
    const bf16_t* xrb = Pb + C_XR + 64 * n + 8 * cg;

    for (int seg = 0; seg < 2; ++seg) {
        const int nch = seg ? 64 : 4, seglen = nch * 64; const size_t rowseg0 = (size_t)b * TB + (seg ? NCTX : 0);
        const bool want_out = !(seg == 0 && last_layer);
        u32x4 raw[2][4];
#define SC_LOAD(i_) do { const int cidx_ = dir ? nch - 1 - (i_) : (i_); const int t0_ = 64 * cidx_; \
        _Pragma("unroll") for (int it = 0; it < 2; ++it) { const int s_ = (it * 256 + ht) >> 3; const int t_ = dir ? t0_ + 63 - s_ : t0_ + s_; \
            _Pragma("unroll") for (int dt = 0; dt < 4; ++dt) { const int tt = t_ + dt - 2; \
                raw[it][dt] = (tt >= 0 && tt < seglen) ? *(const GAS u32x4*)(xrb + (rowseg0 + tt) * NIN) : (u32x4){0u, 0u, 0u, 0u}; } } } while (0)
        SC_LOAD(0);
        for (int i = 0; i < nch; ++i) {
            const int cidx = dir ? nch - 1 - i : i, t0 = 64 * cidx;
#pragma unroll
            for (int it = 0; it < 2; ++it) { const int s = (it * 256 + ht) >> 3; float cv[8];
#pragma unroll
                for (int c2 = 0; c2 < 4; ++c2) { float lo = cb[2 * c2], hi2 = cb[2 * c2 + 1];
#pragma unroll
                    for (int dt = 0; dt < 4; ++dt) { const unsigned wv = raw[it][dt][c2]; lo += cw[dt][2 * c2] * bf_lo(wv); hi2 += cw[dt][2 * c2 + 1] * bf_hi(wv); }
                    cv[2 * c2] = lo; cv[2 * c2 + 1] = hi2; }
                u32x4 pk; pk.x = cvt_pk_bf16(cv[0], cv[1]); pk.y = cvt_pk_bf16(cv[2], cv[3]); pk.z = cvt_pk_bf16(cv[4], cv[5]); pk.w = cvt_pk_bf16(cv[6], cv[7]);
                *(LAS u32x4*)(aop + s * 144 + cg * 16) = pk;
                *(LAS f32x4*)(xcv + s * 68 + cg * 8) = (f32x4){cv[0], cv[1], cv[2], cv[3]}; *(LAS f32x4*)(xcv + s * 68 + cg * 8 + 4) = (f32x4){cv[4], cv[5], cv[6], cv[7]}; }
            if (i + 1 < nch) SC_LOAD(i + 1);
            if (i == nch / 2) VM_WAIT();
            __syncthreads();
            f32x4 gacc[4];
#pragma unroll
            for (int q = 0; q < 4; ++q) gacc[q] = (f32x4){0.f, 0.f, 0.f, 0.f};
#pragma unroll
            for (int ks = 0; ks < 2; ++ks) { const bf16x8 af = *(const LAS bf16x8*)(aop + (16 * w + col) * 144 + ks * 64 + quad * 16);
#pragma unroll
                for (int q = 0; q < 4; ++q) gacc[q] = __builtin_amdgcn_mfma_f32_16x16x32_bf16(af, Bf[q][ks], gacc[q], 0, 0, 0); }
            float av[2][4], bv[2][4], cA[2], cB[2];
#pragma unroll
            for (int q = 0; q < 2; ++q) {
#pragma unroll
                for (int j = 0; j < 4; ++j) { const float r = fast_sigmoid(gacc[q][j] + ba[q]), ig = fast_sigmoid(gacc[q + 2][j] + bx[q]);
                    const float la = nla[q] * r, a = __expf(la), z = 2.0f * la;
                    const float om = (z > -0.1f) ? -z * (1.0f + z * (0.5f + z * (0.16666667f + z * 0.041666668f))) : 1.0f - __expf(z);
                    const float xv = xcv[(16 * w + 4 * quad + j) * 68 + 32 * chh + 16 * q + col];
                    av[q][j] = a; bv[q][j] = sqrtf(om) * ig * xv; }
                cA[q] = av[q][0]; cB[q] = bv[q][0];
#pragma unroll
                for (int j = 1; j < 4; ++j) { cB[q] = av[q][j] * cB[q] + bv[q][j]; cA[q] *= av[q][j]; }
            }
            float iA[2], iB[2], eA[2], eB[2];
#pragma unroll
            for (int q = 0; q < 2; ++q) { iA[q] = cA[q]; iB[q] = cB[q];
                float pA = __shfl_up(iA[q], 16), pB = __shfl_up(iB[q], 16); if (quad >= 1) { iB[q] = iA[q] * pB + iB[q]; iA[q] = iA[q] * pA; }
                pA = __shfl_up(iA[q], 32); pB = __shfl_up(iB[q], 32); if (quad >= 2) { iB[q] = iA[q] * pB + iB[q]; iA[q] = iA[q] * pA; }
                eA[q] = __shfl_up(iA[q], 16); eB[q] = __shfl_up(iB[q], 16); if (quad == 0) { eA[q] = 1.0f; eB[q] = 0.0f; }
                if (quad == 3) tot[(w * 2 + q) * 16 + col] = (f32x2){iA[q], iB[q]}; }
            __syncthreads();
#pragma unroll
            for (int q = 0; q < 2; ++q) { float hin = hcar[q], hall = hcar[q];
#pragma unroll
                for (int ww = 0; ww < 4; ++ww) { const f32x2 tw = tot[(ww * 2 + q) * 16 + col]; hall = tw.x * hall + tw.y; if (ww < w) hin = hall; }
                hcar[q] = hall;
                float hv = eA[q] * hin + eB[q];
                const int gch = 64 * n + 32 * chh + 16 * q + col;
#pragma unroll
                for (int j = 0; j < 4; ++j) { hv = av[q][j] * hv + bv[q][j];
                    if (want_out) { const int s = 16 * w + 4 * quad + j; const int tt = dir ? t0 + 63 - s : t0 + s; const size_t row = rowseg0 + tt;
                        if (i < nch / 2) HTb[row * 512 + gch] = hv;
                        else { const float oth = __hip_atomic_load(HTb + row * 512 + gch, __ATOMIC_RELAXED, __HIP_MEMORY_SCOPE_AGENT);
                            bf16_t* gp = Pb + row * NIN + C_GR + gch; const float gr = __uint_as_float(((unsigned)*gp) << 16);
                            *gp = (bf16_t)(cvt_pk_bf16((hv + oth) * gr, 0.f) & 0xffffu); } } }
            }
        }
#undef SC_LOAD
        __syncthreads();
    }
}

__device__ __forceinline__ void r2_phase(Frame& F, int l) {
    LAS float* rw = (LAS float*)(F.lds + RING_OFF);
    for (int i = F.tid; i < 16 * 1024; i += NWAVES * 64) { const int e = i >> 10, k = i & 1023; rw[i] = F.router_w()[k * 16 + e]; }
    __syncthreads();
    float rb[16]; const float* rbp = F.router_b();
#pragma unroll
    for (int e = 0; e < 16; ++e) rb[e] = rbp[e];
    const int nrows = l == 0 ? T : NB * SEQ;
    const float* MODb = F.MOD(); float* XCb = F.XC(); float* outb = F.out(); const float* xin = F.x(); const float* cin = F.ctx(); const bf16_t* YB = F.YBUF(); bf16_t* Ab = F.A();
    const float* n2g = F.norm2_g() + (size_t)l * D; unsigned* RT = F.ROUTE(); gu32* cnt = F.ctl() + CW_CNT + l * 64;
    for (int idx = F.gw; idx < nrows; idx += F.NGW) {
        int b, p; if (l == 0) { b = idx / TB; p = idx - b * TB; } else { b = idx / SEQ; p = NCTX + idx - b * SEQ; }
        const int row = b * TB + p; const bool isc = p < NCTX; const int sel = isc ? 16 : b;
        float* xo = isc ? XCb + (size_t)(b * NCTX + p) * D : outb + (size_t)(b * SEQ + p - NCTX) * D;
        const float* xi = (l == 0) ? (isc ? cin + (size_t)(b * NCTX + p) * D : xin + (size_t)(b * SEQ + p - NCTX) * D) : xo;
        f32x4 v[4], y[4], h[4]; ld_row_f32(xi, F.lane, v); ld_row_bf16(YB + (size_t)row * D, F.lane, y);
        const float* g1 = modp(MODb, l, sel, 2);
#pragma unroll
        for (int j = 0; j < 4; ++j) { const f32x4 gg = *((const GAS f32x4*)g1 + F.lane + 64 * j); v[j] = v[j] + gg * y[j]; }
        st_row_f32(xo, F.lane, v);
        norm_mod(v, n2g, modp(MODb, l, sel, 3), modp(MODb, l, sel, 4), F.lane, h);
        st_row_bf16(Ab + (size_t)row * D, F.lane, h);
        float lg[16];
#pragma unroll
        for (int e = 0; e < 16; ++e) { float a = 0.f;
#pragma unroll
            for (int j = 0; j < 4; ++j) { const f32x4 wv = *(const LAS f32x4*)(rw + e * 1024 + 256 * j + 4 * F.lane); a += (h[j][0] * wv[0] + h[j][1] * wv[1]) + (h[j][2] * wv[2] + h[j][3] * wv[3]); }
            lg[e] = wave_sum(a); }
        float s[16], sl[16];
#pragma unroll
        for (int e = 0; e < 16; ++e) { s[e] = 1.0f / (1.0f + __expf(-lg[e])); sl[e] = s[e] + rb[e]; }
        float bestg = -INFINITY; int gi = 0;
#pragma unroll
        for (int g = 0; g < 4; ++g) { float m1 = -INFINITY, m2 = -INFINITY;
#pragma unroll
            for (int k = 0; k < 4; ++k) { const float t = sl[4 * g + k]; if (t > m1) { m2 = m1; m1 = t; } else if (t > m2) m2 = t; }
            const float gs = m1 + m2; if (gs > bestg) { bestg = gs; gi = g; } }
        float c4[4], s4[4];
#pragma unroll
        for (int k = 0; k < 4; ++k) { c4[k] = gi == 0 ? sl[k] : gi == 1 ? sl[4 + k] : gi == 2 ? sl[8 + k] : sl[12 + k]; s4[k] = gi == 0 ? s[k] : gi == 1 ? s[4 + k] : gi == 2 ? s[8 + k] : s[12 + k]; }
        int i0 = 0; float v0 = c4[0], w0 = s4[0];
#pragma unroll
        for (int k = 1; k < 4; ++k) if (c4[k] > v0) { v0 = c4[k]; i0 = k; w0 = s4[k]; }
        int i1 = -1; float v1 = -INFINITY, w1 = 0.f;
#pragma unroll
        for (int k = 0; k < 4; ++k) if (k != i0 && c4[k] > v1) { v1 = c4[k]; i1 = k; w1 = s4[k]; }
        const float wsum = w0 + w1; w0 /= wsum; w1 /= wsum;
        const int e0 = 4 * gi + i0, e1 = 4 * gi + i1;
        if (F.lane == 0) {
            const unsigned sl0 = __hip_atomic_fetch_add(cnt + e0, 1u, RLX_AGENT), sl1 = __hip_atomic_fetch_add(cnt + e1, 1u, RLX_AGENT);
            u32x4 r0 = {(unsigned)e0, sl0, (unsigned)e1, sl1}; u32x4 r1 = {__float_as_uint(w0), __float_as_uint(w1), 0u, 0u};
            *(GAS u32x4*)(RT + (size_t)row * 8) = r0; *(GAS u32x4*)(RT + (size_t)row * 8 + 4) = r1;
        }
    }
    __syncthreads();
}

__device__ __forceinline__ void build_ptab(Frame& F, int l, LAS int* ptab) {
    if (F.tid == 0) { int acc = 0; gu32* cntb = F.ctl() + CW_CNT + l * 64;
        for (int e = 0; e < NE; ++e) { ptab[e] = acc; const int c = (int)__hip_atomic_load(cntb + e, RLX_AGENT); acc += ((c + 255) >> 8) << 8; }
        ptab[NE] = acc; }
    __syncthreads();
}
__device__ __forceinline__ void gather_phase(Frame& F, int l, LAS int* ptab) {
    const int nrows = l == 0 ? T : NB * SEQ;
    const unsigned* RT = F.ROUTE(); const bf16_t* Ab = F.A(); bf16_t* HGb = F.HG();
    for (int idx = F.gw; idx < nrows; idx += F.NGW) {
        int row; if (l == 0) row = idx; else { const int b = idx / SEQ; row = b * TB + NCTX + idx - b * SEQ; }
        const u32x4 r0 = *(const GAS u32x4*)(RT + (size_t)row * 8);
        const size_t p0 = (size_t)ptab[r0.x] + r0.y, p1 = (size_t)ptab[r0.z] + r0.w;
        const GAS u32x4* src = (const GAS u32x4*)(Ab + (size_t)row * D) + F.lane;
        const u32x4 a = src[0], c = src[64];
        GAS u32x4* d0 = (GAS u32x4*)(HGb + p0 * D) + F.lane; GAS u32x4* d1 = (GAS u32x4*)(HGb + p1 * D) + F.lane;
        d0[0] = a; d0[64] = c; d1[0] = a; d1[64] = c;
    }
}
__device__ __forceinline__ void r3_phase(Frame& F, int l, LAS int* ptab) {
    const int nrows = l == 0 ? T : NB * SEQ;
    const float* MODb = F.MOD(); float* XCb = F.XC(); float* outb = F.out(); const bf16_t* YPb = F.YP(); bf16_t* Ab = F.A(); const unsigned* RT = F.ROUTE();
    const float* n1g = F.norm1_g() + (size_t)(l == 0 ? 1 : 0) * D;
    for (int idx = F.gw; idx < nrows; idx += F.NGW) {
        int b, p; if (l == 0) { b = idx / TB; p = idx - b * TB; } else { b = idx / SEQ; p = NCTX + idx - b * SEQ; }
        const int row = b * TB + p; const bool isc = p < NCTX; const int sel = isc ? 16 : b;
        const u32x4 r0 = *(const GAS u32x4*)(RT + (size_t)row * 8); const u32x2 r1 = *(const GAS u32x2*)(RT + (size_t)row * 8 + 4);
        const size_t p0 = (size_t)ptab[r0.x] + r0.y, p1 = (size_t)ptab[r0.z] + r0.w; const float w0 = __uint_as_float(r1.x), w1 = __uint_as_float(r1.y);
        float* xo = isc ? XCb + (size_t)(b * NCTX + p) * D : outb + (size_t)(b * SEQ + p - NCTX) * D;
        f32x4 v[4], y0[4], y1[4], h[4]; ld_row_f32(xo, F.lane, v); ld_row_bf16(YPb + p0 * D, F.lane, y0); ld_row_bf16(YPb + p1 * D, F.lane, y1);
        const float* g2 = modp(MODb, l, sel, 5);
#pragma unroll
        for (int j = 0; j < 4; ++j) { const f32x4 gg = *((const GAS f32x4*)g2 + F.lane + 64 * j); v[j] = v[j] + gg * (y0[j] * w0 + y1[j] * w1); }
        if (!isc) st_row_f32(xo, F.lane, v);
        if (l == 0) { norm_mod(v, n1g, modp(MODb, l + 1, sel, 0), modp(MODb, l + 1, sel, 1), F.lane, h); st_row_bf16(Ab + (size_t)row * D, F.lane, h); }
    }
}

struct SchedProj {
    const char* A; const char* B; int G, c;
    __device__ __forceinline__ bool next(int i, pg8::Unit& u) const { int pm, pn; if (!pg8::tile_order((long)i * G + c, T / 256, NIN / 256, pm, pn)) return false;
        u.pm = pm; u.pn = pn; u.aux = 0; u.A = A + (size_t)pm * 256 * D * 2; u.B = B + (size_t)pn * 256 * D * 2; return true; }
};
__device__ __forceinline__ int lat_tile(int pe) { return (pe >> 4) * 17 + 1 + (pe & 15); }
struct SchedMerge {
    const char* P; const char* B; int G, c, nM; bool lat_only;
    __device__ __forceinline__ bool next(int i, pg8::Unit& u) const { const int rnd = i / 3, br = i - rnd * 3; int pm, pn; if (!pg8::tile_order((long)rnd * G + c, nM, 4, pm, pn)) return false;
        if (lat_only) pm = lat_tile(pm);
        const int acol = br == 0 ? C_GR : (br == 1 ? C_GQ : C_WQ);
        u.pm = pm; u.pn = pn; u.aux = br; u.A = P + ((size_t)pm * 256 * NIN + acol) * 2; u.B = B + ((size_t)br * D + pn * 256) * 512 * 2; return true; }
};
struct SchedOut {
    const char* A; const char* B; int G, c, nM; bool lat_only;
    __device__ __forceinline__ bool next(int i, pg8::Unit& u) const { int pm, pn; if (!pg8::tile_order((long)i * G + c, nM, 4, pm, pn)) return false;
        if (lat_only) pm = lat_tile(pm);
        u.pm = pm; u.pn = pn; u.aux = 0; u.A = A + (size_t)pm * 256 * D * 2; u.B = B + (size_t)pn * 256 * D * 2; return true; }
};
struct SchedMoe {
    const char* A; const char* B; const LAS int* ptab; int G, c, npn;
    __device__ __forceinline__ bool next(int i, pg8::Unit& u) const { const int L = i * G + c; const int ntile = ptab[NE] >> 8; if (L >= ntile * npn) return false;
        const int j = L / npn, pn = L - j * npn; int e = 0;
#pragma unroll
        for (int k = 1; k < NE; ++k) e += (ptab[k] <= j * 256) ? 1 : 0;
        u.pm = j; u.pn = pn; u.aux = e; u.A = A + (size_t)j * 256 * D * 2; u.B = B + ((size_t)e * npn + pn) * 256 * D * 2; return true; }
};

static_assert(sizeof(Args) == sizeof(KArgs), "kernarg views");
__global__ void __launch_bounds__(NWAVES * 64, 2) mega_fwd(Args args) {
    extern __shared__ __attribute__((aligned(16))) unsigned char lds[];
    volatile LAS unsigned* MISC = (volatile LAS unsigned*)((LAS unsigned char*)lds + MISC_OFF);
    LAS int* ptab = (LAS int*)((LAS unsigned char*)lds + LDSCTL_OFF);
    Frame F0; {
    Frame& F = F0;
    F.lds = (LAS unsigned char*)lds;
    F.tid = threadIdx.x; F.lane = F.tid & 63; F.wave = __builtin_amdgcn_readfirstlane(F.tid >> 6);
    F.G = gridDim.x; { const int bx = blockIdx.x; F.vcu = (F.G % 8 == 0) ? (bx % 8) * (F.G / 8) + bx / 8 : bx; }
    F.gw = F.vcu * NWAVES + F.wave; F.NGW = F.G * NWAVES; F.bid = blockIdx.x; }
    for (int u = F0.tid; u < (LDS_BYTES - LDSCTL_OFF) / 4; u += NWAVES * 64) ((LAS unsigned*)(F0.lds + LDSCTL_OFF))[u] = 0u;
    __syncthreads();
    XcdBarrier bar = xcd_barrier_post((unsigned*)(F0.ctl() + CW_BAR), MISC + 8);
#define GRID_BAR() do { XcdBarrier b_ = bar; asm volatile("" : "+s"(b_.bar), "+s"(b_.x)); xcd_barrier(b_); } while (0)

    { Frame F = fresh(F0); p0_prologue(F); }
    GRID_BAR();
    { Frame F = fresh(F0); r1_phase(F); }
    GRID_BAR();

    for (int l = 0; l < NL; ++l) {
        const bool last = (l == NL - 1);
        { Frame F = fresh(F0);
            pg8::Gemm g{D, D, D}; SchedProj S{(const char*)F.A(), (const char*)(F.WIN() + (size_t)l * NIN * D), F.G, F.bid};
            pg8::EpiProj E{F.PROJ(), F.b_merge() + (size_t)l * 3 * D};
            pg8::gemm_phase(F.lds + RING_OFF, g, S, E);
        }
        GRID_BAR();
        { Frame F = fresh(F0); kfix_phase(F, l); }
        GRID_BAR();
        { Frame F = fresh(F0); for (int uid = F.vcu; uid < 256; uid += F.G) scan_unit(F, l, uid, last); }
        __syncthreads();
        { Frame F = fresh(F0);
            const int per = (2048 + F.G - 1) / F.G;
            attn_body::AttnArgs aa; aa.P = (attn_body::bf16*)F.PROJ(); aa.ropec = F.ROPEC(); aa.ropes = F.ROPES();
            aa.qg = F.q_norm_g() + (size_t)(l * 2 + 0) * 64; aa.sink = 0.f;
            for (int gid = F.vcu * per; gid < (F.vcu + 1) * per && gid < 2048; ++gid) { const int pair = gid >> 6, uu = gid & 63; const int b = pair >> 1, h = (pair & 1) * 4 + (uu >> 4), qb = uu & 15;
                attn_body::attn_unit<0, 8>(b, h, qb, aa, (char*)lds + RING_OFF); }
            aa.qg = F.q_norm_g() + (size_t)(l * 2 + 1) * 64;
            for (int gid = F.vcu * per; gid < (F.vcu + 1) * per && gid < 2048; ++gid) { const int pair = gid >> 6, uu = gid & 63; const int b = pair >> 1, h = (pair & 1) * 4 + (uu >> 4), qb = uu & 15;
                aa.sink = F.sink()[l * 8 + h];
                attn_body::attn_unit<1, 8>(b, h, qb, aa, (char*)lds + RING_OFF); }
            if (!last) {
                for (int cid = F.vcu; cid < 256; cid += F.G) { const int b = cid >> 4, h = (cid >> 1) & 7;
                    if (cid & 1) { aa.qg = F.q_norm_g() + (size_t)(l * 2 + 1) * 64; aa.sink = F.sink()[l * 8 + h]; attn_body::attn_unit<3, 8>(b, h, 0, aa, (char*)lds + RING_OFF); }
                    else { aa.qg = F.q_norm_g() + (size_t)(l * 2 + 0) * 64; aa.sink = 0.f; attn_body::attn_unit<2, 8>(b, h, 0, aa, (char*)lds + RING_OFF); } }
            }
        }
        GRID_BAR();
        { Frame F = fresh(F0);
            pg8::Gemm g{512, NIN, 512}; SchedMerge S{(const char*)F.PROJ(), (const char*)(F.WBR() + (size_t)l * 3 * D * 512), F.G, F.bid, last ? 256 : 272, last};
            pg8::EpiMerge E{F.PROJ(), F.A()};
            pg8::gemm_phase(F.lds + RING_OFF, g, S, E);
        }
        GRID_BAR();
        { Frame F = fresh(F0);
            pg8::Gemm g{D, D, D}; SchedOut S{(const char*)F.A(), (const char*)(F.WOUT() + (size_t)l * D * D), F.G, F.bid, last ? 256 : 272, last};
            pg8::EpiPlain E{F.YBUF(), D};
            pg8::gemm_phase(F.lds + RING_OFF, g, S, E);
        }
        GRID_BAR();
        { Frame F = fresh(F0); convert_experts(F, l); }
        __syncthreads();
        { Frame F = fresh(F0); r2_phase(F, l); }
        GRID_BAR();
        { Frame F = fresh(F0); build_ptab(F, l, ptab); gather_phase(F, l, ptab); }
        GRID_BAR();
        { Frame F = fresh(F0);
            pg8::Gemm g{D, D, D}; SchedMoe S{(const char*)F.HG(), (const char*)F.W13(), ptab, F.G, F.bid, 8};
            pg8::EpiSwiglu E{F.HID()};
            pg8::gemm_phase(F.lds + RING_OFF, g, S, E);
        }
        GRID_BAR();
        { Frame F = fresh(F0);
            pg8::Gemm g{D, D, D}; SchedMoe S{(const char*)F.HID(), (const char*)F.W2(), ptab, F.G, F.bid, 4};
            pg8::EpiPlain E{F.YP(), D};
            pg8::gemm_phase(F.lds + RING_OFF, g, S, E);
        }
        GRID_BAR();
        { Frame F = fresh(F0); r3_phase(F, l, ptab); }
        if (!last) GRID_BAR();
    }
}

extern "C" void kernel_launch(void* const* d_in, const int* in_sizes, int n_in, void* d_out, int out_size, void* d_ws, size_t ws_size, hipStream_t stream) {
    static int grid = 0;
    if (grid == 0) {
        if (n_in != 27 || in_sizes[0] != NB * SEQ * D || out_size != NB * SEQ * D || ws_size < WS_END) { fprintf(stderr, "kernel_launch: unexpected shapes / workspace (n_in %d, ws %zu < %zu)\n", n_in, ws_size, (size_t)WS_END); grid = -1; return; }
        int dev = 0, cus = 0, per_cu = 0;
        if (hipGetDevice(&dev) != hipSuccess || hipDeviceGetAttribute(&cus, hipDeviceAttributeMultiprocessorCount, dev) != hipSuccess) { grid = -1; return; }
        if (hipFuncSetAttribute((const void*)mega_fwd, hipFuncAttributeMaxDynamicSharedMemorySize, LDS_BYTES) != hipSuccess) { fprintf(stderr, "kernel_launch: hipFuncSetAttribute failed\n"); grid = -1; return; }
        if (hipOccupancyMaxActiveBlocksPerMultiprocessor(&per_cu, (const void*)mega_fwd, NWAVES * 64, LDS_BYTES) != hipSuccess || per_cu < 1) { fprintf(stderr, "kernel_launch: occupancy query says %d\n", per_cu); }
        (void)hipGetLastError();
        grid = cus;
    }
    if (grid < 0) return;
    if (hipMemsetAsync((char*)d_ws + WS_CTL, 0, CTL_ZERO_BYTES, stream) != hipSuccess) return;
    Args a{};
    for (int i = 0; i < 27; ++i) a.in[i] = (const float*)d_in[i];
    a.out = (float*)d_out; a.ws = (unsigned char*)d_ws;
    hipLaunchKernelGGL(mega_fwd, dim3(grid), dim3(NWAVES * 64), LDS_BYTES, stream, a);
}
```

```cpp
#define PROBE 0
#include <hip/hip_runtime.h>
#include <hip/hip_bf16.h>
#include <cstdio>
#include <cstdint>
#include <cmath>

#define GAS __attribute__((address_space(1)))
#define LAS __attribute__((address_space(3)))
typedef unsigned short bf16_t;
typedef short bf16x8 __attribute__((ext_vector_type(8)));
typedef float f32x4 __attribute__((ext_vector_type(4)));
typedef float f32x2 __attribute__((ext_vector_type(2)));
typedef unsigned u32x4 __attribute__((ext_vector_type(4)));
typedef unsigned u32x2 __attribute__((ext_vector_type(2)));

constexpr int NB = 16, SEQ = 4096, NCTX = 256, TB = SEQ + NCTX, T = NB * TB;
constexpr int D = 1024, NIN = 5632, NL = 2, NE = 16;
constexpr int C_XR = 0, C_GR = 512, C_GQ = 1024, C_GK = 1536, C_GV = 1664, C_WQ = 1792, C_WK = 2304, C_WV = 2432, C_MG = 2560;
constexpr float EPS = 1e-6f;
constexpr int PMAX = 143360;

__device__ __forceinline__ unsigned cvt_pk_bf16(float lo, float hi) { unsigned r; asm volatile("v_cvt_pk_bf16_f32 %0, %1, %2" : "=v"(r) : "v"(lo), "v"(hi)); return r; }
typedef int i32x8 __attribute__((ext_vector_type(8)));
typedef int i32x4 __attribute__((ext_vector_type(4)));
__device__ __forceinline__ unsigned pk4_fp8(float a, float b, float c, float d) {
    a = __builtin_fminf(__builtin_fmaxf(a, -448.f), 448.f); b = __builtin_fminf(__builtin_fmaxf(b, -448.f), 448.f); c = __builtin_fminf(__builtin_fmaxf(c, -448.f), 448.f); d = __builtin_fminf(__builtin_fmaxf(d, -448.f), 448.f);
    int w = __builtin_amdgcn_cvt_pk_fp8_f32(a, b, 0, false); w = __builtin_amdgcn_cvt_pk_fp8_f32(c, d, w, true); return (unsigned)w; }
__device__ __forceinline__ float bf_lo(unsigned u) { return __uint_as_float(u << 16); }
__device__ __forceinline__ float bf_hi(unsigned u) { return __uint_as_float(u & 0xffff0000u); }
__device__ __forceinline__ float fast_sigmoid(float v) { return __builtin_amdgcn_rcpf(1.0f + __builtin_amdgcn_exp2f(-1.4426950409f * v)); }
__device__ __forceinline__ float gelu_tanh(float v) { return v * __builtin_amdgcn_rcpf(1.0f + __builtin_amdgcn_exp2f(-2.3022082f * v * (1.0f + 0.044715f * v * v))); }

namespace pg8 {
constexpr int BM = 256, BK = 64, HALF = 128, HTB = HALF * BK * 2, STAGE_BYTES = 8 * HTB, NXCD = 8, WGM = 8;
__host__ __device__ __forceinline__ int lds_byte(int r, int c) { const int st = (r >> 4) * 2 + (c >> 5), rr = r & 15, cc = c & 31, ob = rr * 64 + cc * 2; return st * 1024 + (ob ^ (((ob >> 9) & 1) << 5)); }
__host__ __device__ __forceinline__ void stage_rc(int b, int& R, int& C) { const int st = b / 1024, sb = b % 1024, swz = sb ^ (((sb >> 9) & 1) << 5); R = (st >> 1) * 16 + swz / 64; C = (st & 1) * 32 + (swz % 64) / 2; }
__host__ __device__ __forceinline__ int perm32(int rho) { const int n = rho >> 4, i = rho & 15; return 8 * (i >> 2) + 4 * n + (i & 3); }

struct Unit { int pm, pn, aux; const char* A; const char* B; };
struct Gemm { int nt, ldaB, ldbB; };

__device__ __forceinline__ bool tile_order(long L, int nM, int nN, int& pm, int& pn) {
    const int nwg = nM * nN; if (L >= nwg) return false;
    int wgid = (int)L; { const int q = nwg / NXCD, r = nwg % NXCD, xcd = wgid % NXCD, off = wgid / NXCD; wgid = (xcd < r ? xcd * (q + 1) : r * (q + 1) + (xcd - r) * q) + off; }
    const int nig = WGM * nN, gid = wgid / nig, fm = gid * WGM, gsz = (nM - fm) < WGM ? (nM - fm) : WGM;
    pm = fm + ((wgid % nig) % gsz); pn = (wgid % nig) / gsz; return true;
}

template <class Epi, class Sched, bool FP8 = false>
__device__ __forceinline__ void gemm_phase(LAS unsigned char* lds, const Gemm g, const Sched& S, const Epi& E) {
    int tid_ = threadIdx.x; asm volatile("" : "+v"(tid_));
    const int tid = tid_, wid = __builtin_amdgcn_readfirstlane(tid >> 6), lane = tid & 63, wr = wid >> 2, wc = wid & 3, fr = lane & 15, fq = lane >> 4;
    int nt_ = g.nt; asm volatile("" : "+s"(nt_)); const int nt = nt_;
    unsigned voffA[2], voffB[2];
#pragma unroll
    for (int i = 0; i < 2; ++i) { int R, C; stage_rc(tid * 16 + i * 8192, R, C); const int Rb = (R & ~31) + perm32(R & 31);
        voffA[i] = (unsigned)(R * g.ldaB + C * 2); voffB[i] = (unsigned)(Rb * g.ldbB + C * 2); }
    const size_t kstep = (size_t)(BK * 2);
    const size_t hstepA = (size_t)HALF * g.ldaB, hstepB = (size_t)HALF * g.ldbB;
    const unsigned ldsw = (unsigned)wid * 1024u;
    const int aoff = lds_byte(wr * 64 + fr, fq * 8), boff = lds_byte(wc * 32 + fr, fq * 8);
#define PG8_SA(b, h) (((b) * 2 + (h)) * HTB)
#define PG8_SB(b, h) ((4 + (b) * 2 + (h)) * HTB)
#define PG8_STAGE(bufoff, gbase, voff) do { _Pragma("unroll") for (int _i = 0; _i < 2; ++_i) \
        __builtin_amdgcn_global_load_lds((const unsigned*)((const char*)(gbase) + (voff)[_i]), (LAS unsigned*)(lds + (bufoff) + ldsw + _i * 8192), 16, 0, 0); } while (0)
#define PG8_LDA(dst, b, h) do { _Pragma("unroll") for (int m = 0; m < 4; ++m) _Pragma("unroll") for (int k = 0; k < 2; ++k) dst[m][k] = *(const LAS bf16x8*)(lds + PG8_SA(b, h) + aoff + m * 2048 + k * 1024); } while (0)
#define PG8_LDB(dst, b, h) do { _Pragma("unroll") for (int n = 0; n < 2; ++n) _Pragma("unroll") for (int k = 0; k < 2; ++k) dst[n][k] = *(const LAS bf16x8*)(lds + PG8_SB(b, h) + boff + n * 2048 + k * 1024); } while (0)
#define PG8_CAT(x) __builtin_shufflevector(__builtin_bit_cast(i32x4, x[0]), __builtin_bit_cast(i32x4, x[1]), 0, 1, 2, 3, 4, 5, 6, 7)
#define PG8_MMA(ai, bj, At, Bt) do { __builtin_amdgcn_s_setprio(1); \
        if constexpr (FP8) { _Pragma("unroll") for (int m = 0; m < 4; ++m) _Pragma("unroll") for (int n = 0; n < 2; ++n) \
            asm volatile("v_mfma_scale_f32_16x16x128_f8f6f4 %0, %1, %2, %0, %3, %3 op_sel_hi:[0,0,0]" : "+v"(acc[ai][bj][m][n]) : "v"(PG8_CAT(Bt[n])), "v"(PG8_CAT(At[m])), "v"(scl1)); } \
        else { _Pragma("unroll") for (int m = 0; m < 4; ++m) _Pragma("unroll") for (int n = 0; n < 2; ++n) _Pragma("unroll") for (int k = 0; k < 2; ++k) \
            acc[ai][bj][m][n] = __builtin_amdgcn_mfma_f32_16x16x32_bf16(Bt[n][k], At[m][k], acc[ai][bj][m][n], 0, 0, 0); } \
        __builtin_amdgcn_s_setprio(0); } while (0)
#define PG8_WAIT_V(n) asm volatile("s_waitcnt vmcnt(" #n ")" ::: "memory")
#define PG8_WAIT_L(n) asm volatile("s_waitcnt lgkmcnt(" #n ")" ::: "memory")
#define PG8_BAR __builtin_amdgcn_s_barrier()
#define PG8_SCHED __builtin_amdgcn_sched_barrier(0)
    int scl1 = 0x7F7F7F7F; asm volatile("" : "+v"(scl1));
    Unit cur, nxt; int ui = 0;
    if (!S.next(0, cur)) return;
    f32x4 acc[2][2][4][2];
#pragma unroll
    for (int a = 0; a < 2; ++a)
#pragma unroll
        for (int b = 0; b < 2; ++b)
#pragma unroll
            for (int m = 0; m < 4; ++m)
#pragma unroll
                for (int n = 0; n < 2; ++n) acc[a][b][m][n] = (f32x4){0.f, 0.f, 0.f, 0.f};
    bf16x8 At[4][2], B0[2][2], B1[2][2];
    const char* cA = cur.A; const char* cB = cur.B;
    PG8_STAGE(PG8_SB(0, 0), cB, voffB); PG8_STAGE(PG8_SB(0, 1), cB + hstepB, voffB); PG8_STAGE(PG8_SA(0, 0), cA, voffA); PG8_STAGE(PG8_SA(0, 1), cA + hstepA, voffA);
    if (wr == 1) PG8_BAR;
    PG8_WAIT_V(2); PG8_BAR;
    PG8_STAGE(PG8_SB(1, 0), cB + kstep, voffB); PG8_STAGE(PG8_SA(1, 0), cA + kstep, voffA); PG8_STAGE(PG8_SB(1, 1), cB + hstepB + kstep, voffB);
    PG8_WAIT_V(6); PG8_BAR;
    for (;;) {
        const bool has_next = S.next(ui + 1, nxt);
        const char* nA = has_next ? nxt.A : cA; const char* nB = has_next ? nxt.B : cB;
        for (int t = 0; t < nt; t += 2) {
            const bool last = (t == nt - 2);
            const char* a1 = cA + (size_t)(t + 1) * kstep;
            const char* a2 = last ? nA : cA + (size_t)(t + 2) * kstep; const char* b2 = last ? nB : cB + (size_t)(t + 2) * kstep;
            const char* a3 = a2 + kstep; const char* b3 = b2 + kstep;
            PG8_LDB(B0, 0, 0); PG8_LDB(B1, 0, 1); PG8_SCHED; PG8_LDA(At, 0, 0); PG8_STAGE(PG8_SA(1, 1), a1 + hstepA, voffA);
            PG8_WAIT_V(8); PG8_WAIT_L(0); PG8_BAR; PG8_MMA(0, 0, At, B0); PG8_MMA(0, 1, At, B1); PG8_BAR; PG8_SCHED;
            PG8_LDA(At, 0, 1); PG8_STAGE(PG8_SB(0, 0), b2, voffB); PG8_STAGE(PG8_SB(0, 1), b2 + hstepB, voffB); PG8_STAGE(PG8_SA(0, 0), a2, voffA);
            PG8_WAIT_V(8); PG8_WAIT_L(0); PG8_BAR; PG8_MMA(1, 0, At, B0); PG8_MMA(1, 1, At, B1); PG8_BAR; PG8_SCHED;
            PG8_LDB(B0, 1, 0); PG8_LDB(B1, 1, 1); PG8_SCHED; PG8_LDA(At, 1, 0); PG8_STAGE(PG8_SA(0, 1), a2 + hstepA, voffA);
            PG8_WAIT_V(8); PG8_WAIT_L(0); PG8_BAR; PG8_MMA(0, 0, At, B0); PG8_MMA(0, 1, At, B1); PG8_BAR; PG8_SCHED;
            PG8_LDA(At, 1, 1); PG8_STAGE(PG8_SB(1, 0), b3, voffB); PG8_STAGE(PG8_SB(1, 1), b3 + hstepB, voffB); PG8_STAGE(PG8_SA(1, 0), a3, voffA);
            PG8_WAIT_V(8); PG8_WAIT_L(0); PG8_BAR; PG8_MMA(1, 0, At, B0); PG8_MMA(1, 1, At, B1); PG8_BAR; PG8_SCHED;
        }
        if (wr == 0) PG8_BAR;
        if constexpr (FP8) asm volatile("s_nop 15\n\ts_nop 15" ::: "memory");
        E(acc, cur, wr, wc, fr, fq);
        if (!has_next) break;
#pragma unroll
        for (int a = 0; a < 2; ++a)
#pragma unroll
            for (int b = 0; b < 2; ++b)
#pragma unroll
                for (int m = 0; m < 4; ++m)
#pragma unroll
                    for (int n = 0; n < 2; ++n) acc[a][b][m][n] = (f32x4){0.f, 0.f, 0.f, 0.f};
        cur = nxt; cA = nA; cB = nB; ++ui;
        if (wr == 1) PG8_BAR;
    }
    PG8_WAIT_V(0);
    PG8_BAR;
#undef PG8_SA
#undef PG8_SB
#undef PG8_STAGE
#undef PG8_LDA
#undef PG8_LDB
#undef PG8_MMA
#undef PG8_CAT
#undef PG8_WAIT_V
#undef PG8_WAIT_L
#undef PG8_BAR
#undef PG8_SCHED
}

struct EpiProj {
    bf16_t* O; const float* bmerge;
    __device__ __forceinline__ void operator()(const f32x4 (&acc)[2][2][4][2], const Unit& u, int wr, int wc, int fr, int fq) const {
        const int row0 = u.pm * BM + wr * 64 + fr, col0 = u.pn * BM + wc * 32 + 8 * fq;
        const int mode = (u.pn == 2 || u.pn == 3) ? 1 : (u.pn >= 10 ? 2 : 0);
        f32x4 bv[2][2];
#pragma unroll
        for (int bj = 0; bj < 2; ++bj)
#pragma unroll
            for (int n = 0; n < 2; ++n) bv[bj][n] = (mode == 2) ? *(const f32x4*)(bmerge + (col0 - C_MG) + bj * HALF + 4 * n) : (f32x4){0.f, 0.f, 0.f, 0.f};
#pragma unroll
        for (int ai = 0; ai < 2; ++ai)
#pragma unroll
            for (int m = 0; m < 4; ++m) { bf16_t* rowp = O + (size_t)(row0 + ai * HALF + m * 16) * NIN + col0;
#pragma unroll
                for (int bj = 0; bj < 2; ++bj) { f32x4 v0 = acc[ai][bj][m][0] + bv[bj][0], v1 = acc[ai][bj][m][1] + bv[bj][1];
                    if (mode == 1) {
#pragma unroll
                        for (int j = 0; j < 4; ++j) { v0[j] = gelu_tanh(v0[j]); v1[j] = gelu_tanh(v1[j]); } }
                    else if (mode == 2) {
#pragma unroll
                        for (int j = 0; j < 4; ++j) { v0[j] = fast_sigmoid(v0[j]); v1[j] = fast_sigmoid(v1[j]); } }
                    u32x4 w; w.x = cvt_pk_bf16(v0[0], v0[1]); w.y = cvt_pk_bf16(v0[2], v0[3]); w.z = cvt_pk_bf16(v1[0], v1[1]); w.w = cvt_pk_bf16(v1[2], v1[3]);
                    *(u32x4*)(rowp + bj * HALF) = w; } }
    }
};
struct EpiPlain {
    bf16_t* O; int ldc; float scale;
    __device__ __forceinline__ void operator()(const f32x4 (&acc)[2][2][4][2], const Unit& u, int wr, int wc, int fr, int fq) const {
        const int row0 = u.pm * BM + wr * 64 + fr, col0 = u.pn * BM + wc * 32 + 8 * fq;
#pragma unroll
        for (int ai = 0; ai < 2; ++ai)
#pragma unroll
            for (int m = 0; m < 4; ++m) { bf16_t* rowp = O + (size_t)(row0 + ai * HALF + m * 16) * ldc + col0;
#pragma unroll
                for (int bj = 0; bj < 2; ++bj) { const f32x4 v0 = acc[ai][bj][m][0] * scale, v1 = acc[ai][bj][m][1] * scale;
                    u32x4 w; w.x = cvt_pk_bf16(v0[0], v0[1]); w.y = cvt_pk_bf16(v0[2], v0[3]); w.z = cvt_pk_bf16(v1[0], v1[1]); w.w = cvt_pk_bf16(v1[2], v1[3]);
                    *(u32x4*)(rowp + bj * HALF) = w; } }
    }
};
struct EpiMerge {
    const bf16_t* P; bf16_t* O;
    __device__ __forceinline__ void operator()(const f32x4 (&acc)[2][2][4][2], const Unit& u, int wr, int wc, int fr, int fq) const {
        const int row0 = u.pm * BM + wr * 64 + fr, col0 = u.pn * BM + wc * 32 + 8 * fq; const int b = u.aux;
#pragma unroll
        for (int ai = 0; ai < 2; ++ai)
#pragma unroll
            for (int m = 0; m < 4; ++m) { const size_t row = (size_t)(row0 + ai * HALF + m * 16);
                const bf16_t* gp = P + row * NIN + C_MG + b * D + col0; bf16_t* op = O + row * D + col0;
#pragma unroll
                for (int bj = 0; bj < 2; ++bj) { const u32x4 gt = *(const u32x4*)(gp + bj * HALF);
                    f32x4 v0 = acc[ai][bj][m][0], v1 = acc[ai][bj][m][1];
                    v0[0] *= bf_lo(gt.x); v0[1] *= bf_hi(gt.x); v0[2] *= bf_lo(gt.y); v0[3] *= bf_hi(gt.y);
                    v1[0] *= bf_lo(gt.z); v1[1] *= bf_hi(gt.z); v1[2] *= bf_lo(gt.w); v1[3] *= bf_hi(gt.w);
                    if (b > 0) { const u32x4 pv = *(const u32x4*)(op + bj * HALF);
                        v0[0] += bf_lo(pv.x); v0[1] += bf_hi(pv.x); v0[2] += bf_lo(pv.y); v0[3] += bf_hi(pv.y);
                        v1[0] += bf_lo(pv.z); v1[1] += bf_hi(pv.z); v1[2] += bf_lo(pv.w); v1[3] += bf_hi(pv.w); }
                    u32x4 w; w.x = cvt_pk_bf16(v0[0], v0[1]); w.y = cvt_pk_bf16(v0[2], v0[3]); w.z = cvt_pk_bf16(v1[0], v1[1]); w.w = cvt_pk_bf16(v1[2], v1[3]);
                    *(u32x4*)(op + bj * HALF) = w; } }
    }
};
struct EpiSwiglu {
    unsigned char* O; float scale;
    __device__ __forceinline__ void operator()(const f32x4 (&acc)[2][2][4][2], const Unit& u, int wr, int wc, int fr, int fq) const {
        const int row0 = u.pm * BM + wr * 64 + fr, col0 = u.pn * HALF + wc * 32 + 8 * fq;
#pragma unroll
        for (int ai = 0; ai < 2; ++ai)
#pragma unroll
            for (int m = 0; m < 4; ++m) { unsigned char* rowp = O + (size_t)(row0 + ai * HALF + m * 16) * D + col0;
                f32x4 v0 = acc[ai][0][m][0] * scale, v1 = acc[ai][0][m][1] * scale; const f32x4 g0 = acc[ai][1][m][0] * scale, g1 = acc[ai][1][m][1] * scale;
#pragma unroll
                for (int j = 0; j < 4; ++j) { v0[j] = v0[j] * fast_sigmoid(v0[j]) * g0[j]; v1[j] = v1[j] * fast_sigmoid(v1[j]) * g1[j]; }
                u32x2 w; w.x = pk4_fp8(v0[0], v0[1], v0[2], v0[3]); w.y = pk4_fp8(v1[0], v1[1], v1[2], v1[3]);
                *(u32x2*)rowp = w; }
    }
};
}
namespace attn_body {
using bf16 = __hip_bfloat16;
using s16x4 = __attribute__((ext_vector_type(4))) short;
using f32x16 = __attribute__((ext_vector_type(16))) float;
constexpr int DM = NIN;
constexpr int NW = 8, QBLK = 32, QB = QBLK * NW, KVBLK = 64;
__device__ __forceinline__ int crow(int r, int hi) { return (r & 3) + 8 * (r >> 2) + 4 * hi; }
#define SBAR() __builtin_amdgcn_sched_barrier(0)
constexpr int NSLOT = 3, SLOTB = 8192;
constexpr int LDS_K = 0, LDS_V = NSLOT * SLOTB, LDS_WS = 2 * NSLOT * SLOTB, LDS_OST = LDS_WS + NW * 64 * 4, LDS_BYTES = LDS_OST + NW * 4096;
constexpr float LOG2E = 1.4426950408889634f;
constexpr float C2 = 0.125f * LOG2E;
__device__ __forceinline__ void glds16(const void* gsrc, unsigned lds_dst) { unsigned keep;
    asm volatile("s_mov_b32 %0, m0\n\ts_mov_b32 m0, %2\n\ts_nop 0\n\tglobal_load_lds_dwordx4 %1, off\n\ts_mov_b32 m0, %0" : "=&s"(keep) : "v"(gsrc), "s"(lds_dst) : "memory"); }
__device__ __forceinline__ float max3f(float a, float b, float c) { float r; asm("v_max3_f32 %0, %1, %2, %3" : "=v"(r) : "v"(a), "v"(b), "v"(c)); return r; }
__device__ __forceinline__ float max2f(float a, float b) { float r; asm("v_max_f32_e32 %0, %1, %2" : "=v"(r) : "v"(a), "v"(b)); return r; }
__device__ __forceinline__ float fadd_s(float a, float b) { float r; asm("v_add_f32_e32 %0, %1, %2" : "=v"(r) : "v"(a), "v"(b)); return r; }
__device__ __forceinline__ float fsub_s(float a, float b) { float r; asm("v_sub_f32_e32 %0, %1, %2" : "=v"(r) : "v"(a), "v"(b)); return r; }
typedef float f32x2_t __attribute__((ext_vector_type(2))); typedef __bf16 bf16x2_t __attribute__((ext_vector_type(2)));
__device__ __forceinline__ unsigned cvtpk_s(float lo, float hi) { f32x2_t v = {lo, hi}; bf16x2_t b = __builtin_convertvector(v, bf16x2_t); return __builtin_bit_cast(unsigned, b); }
#define WAIT_BAR(N) asm volatile("s_waitcnt vmcnt(" #N ") lgkmcnt(0)\n\ts_barrier" ::: "memory")

__device__ __forceinline__ void qkt(f32x16& p0, f32x16& p1, const char* Kslot, const bf16x8* qr, const f32x16& negm, int r32, int hi) {
    const char* kb = Kslot + hi * 1024 + r32 * 16;
#pragma unroll
    for (int d0 = 0; d0 < 4; ++d0) {
        const bf16x8 b0 = *reinterpret_cast<const bf16x8*>(kb + d0 * 2048);
        const bf16x8 b1 = *reinterpret_cast<const bf16x8*>(kb + d0 * 2048 + 512);
        if (d0 == 0) { p0 = __builtin_amdgcn_mfma_f32_32x32x16_bf16(b0, qr[0], negm, 0, 0, 0); p1 = __builtin_amdgcn_mfma_f32_32x32x16_bf16(b1, qr[0], negm, 0, 0, 0); }
        else { p0 = __builtin_amdgcn_mfma_f32_32x32x16_bf16(b0, qr[d0], p0, 0, 0, 0); p1 = __builtin_amdgcn_mfma_f32_32x32x16_bf16(b1, qr[d0], p1, 0, 0, 0); } }
}
typedef __attribute__((address_space(3))) const char* lds_cptr;
typedef short v4i16_t __attribute__((ext_vector_type(4)));
__device__ __forceinline__ void kload8(bf16x8* kf, lds_cptr kp) {
    kf[0] = *(const LAS bf16x8*)(kp);        kf[1] = *(const LAS bf16x8*)(kp + 512);
    kf[2] = *(const LAS bf16x8*)(kp + 2048); kf[3] = *(const LAS bf16x8*)(kp + 2560);
    kf[4] = *(const LAS bf16x8*)(kp + 4096); kf[5] = *(const LAS bf16x8*)(kp + 4608);
    kf[6] = *(const LAS bf16x8*)(kp + 6144); kf[7] = *(const LAS bf16x8*)(kp + 6656);
}
__device__ __forceinline__ void kload2(bf16x8* kf, lds_cptr kp, int j) { kf[2 * j] = *(const LAS bf16x8*)(kp + j * 2048); kf[2 * j + 1] = *(const LAS bf16x8*)(kp + j * 2048 + 512); }
__device__ __forceinline__ s16x4 vtr(lds_cptr p) { return __builtin_bit_cast(s16x4, __builtin_amdgcn_ds_read_tr16_b64_v4i16((LAS v4i16_t*)p)); }
__device__ __forceinline__ float rowmax(const f32x16& p0, const f32x16& p1) {
    float a = max3f(p0[0], p0[1], p1[0]), b = max3f(p0[2], p0[3], p1[1]); a = max3f(a, p1[2], p1[3]);
#pragma unroll
    for (int r = 4; r < 16; r += 4) { a = max3f(a, p0[r], p0[r + 1]); b = max3f(b, p0[r + 2], p0[r + 3]); a = max3f(a, p1[r], p1[r + 1]); b = max3f(b, p1[r + 2], p1[r + 3]); }
    const float m = max2f(a, b);
    auto rr = __builtin_amdgcn_permlane32_swap(__float_as_uint(m), __float_as_uint(m), false, false);
    return max2f(__uint_as_float(rr[0]), __uint_as_float(rr[1]));
}
__device__ __forceinline__ void pv(f32x16* o, int vb, bf16x8 pa0, bf16x8 pa1, bf16x8 pa2, bf16x8 pa3) {
#pragma unroll
    for (int d0 = 0; d0 < 2; ++d0) { s16x4 lo[4], hi[4];
#pragma unroll
        for (int ks = 0; ks < 4; ++ks) {
            asm volatile("ds_read_b64_tr_b16 %0,%1 offset:%c2" : "=&v"(lo[ks]) : "v"(vb), "i"(d0 * 4096 + ks * 1024) : "memory");
            asm volatile("ds_read_b64_tr_b16 %0,%1 offset:%c2" : "=&v"(hi[ks]) : "v"(vb), "i"(d0 * 4096 + ks * 1024 + 512) : "memory"); }
        asm volatile("s_waitcnt lgkmcnt(0)" ::: "memory"); SBAR();
#define PK(k) (bf16x8){lo[k][0], lo[k][1], lo[k][2], lo[k][3], hi[k][0], hi[k][1], hi[k][2], hi[k][3]}
        o[d0] = __builtin_amdgcn_mfma_f32_32x32x16_bf16(pa0, PK(0), o[d0], 0, 0, 0);
        o[d0] = __builtin_amdgcn_mfma_f32_32x32x16_bf16(pa1, PK(1), o[d0], 0, 0, 0);
        o[d0] = __builtin_amdgcn_mfma_f32_32x32x16_bf16(pa2, PK(2), o[d0], 0, 0, 0);
        o[d0] = __builtin_amdgcn_mfma_f32_32x32x16_bf16(pa3, PK(3), o[d0], 0, 0, 0);
#undef PK
    }
}
__device__ __forceinline__ void wmask(f32x16& p0, f32x16& p1, int dk0, int hi) {
    const float NEG = -INFINITY; const int kb = dk0 + 4 * hi;
#pragma unroll
    for (int r = 0; r < 16; ++r) { const int d = kb + (r & 3) + 8 * (r >> 2); if (d > 128 || d < -128) p0[r] = NEG; if (d + 32 > 128 || d + 32 < -128) p1[r] = NEG; }
}

struct AttnArgs { bf16* P; const float* qg; const float* ropec; const float* ropes; float sink; bool dry; };

template <int MODE, int THRL> __device__ __forceinline__ void attn_unit(int b, int h, int qb, const AttnArgs& aa, char* shm) {
    constexpr bool LAT = (MODE < 2), WIN = (MODE == 1), SINK = (MODE == 1 || MODE == 3);
    constexpr int NT = (MODE == 0) ? 68 : (MODE == 1 ? 12 : 4);
    constexpr int QCOL = (MODE == 0 || MODE == 2) ? C_GQ : C_WQ, KCOL = (MODE == 0 || MODE == 2) ? C_GK : C_WK, VCOL = (MODE == 0 || MODE == 2) ? C_GV : C_WV;
    int tid_ = threadIdx.x; asm volatile("" : "+v"(tid_));
    const int tid = tid_, lane = tid & 63, r32 = lane & 31, hi = lane >> 5; const int wid = __builtin_amdgcn_readfirstlane(tid >> 6);
    const long rowbase = (long)b * TB; const int q0 = qb * QB;
    const long qrow0 = rowbase + (LAT ? NCTX : 0) + q0 + wid * QBLK;
    const int kvh = h >> 2;
    const bf16* Qw = aa.P + qrow0 * DM + QCOL + h * 64;
    const bf16* Kh = aa.P + rowbase * DM + KCOL + kvh * 64, *Vh = aa.P + rowbase * DM + VCOL + kvh * 64;
    const unsigned lds0 = (unsigned)(uintptr_t)shm;
    float* wsf = (float*)(shm + LDS_WS) + wid * 64;
    const bf16* ksrc = Kh + (long)lane * DM + wid * 8;
    const bf16* vsrc = Vh + (long)(16 * (wid & 3) + (lane >> 2)) * DM + (wid >> 2) * 32 + (lane & 3) * 8;
    const unsigned kdst = lds0 + LDS_K + wid * 1024, vdst = lds0 + LDS_V + wid * 1024;
    int kstart = 0; if (WIN) { kstart = q0 - 128; kstart = kstart < 0 ? 0 : kstart; kstart = kstart > SEQ - 512 ? SEQ - 512 : kstart; }
#define TROW(t) (WIN ? (((t) < 4) ? 64 * (t) : NCTX + kstart + 64 * ((t) - 4)) : 64 * (t))
#define DMA_K(t, slot) glds16(ksrc + (long)TROW(t) * DM, (unsigned)__builtin_amdgcn_readfirstlane(kdst + (slot)))
#define DMA_V(t, slot) glds16(vsrc + (long)TROW(t) * DM, (unsigned)__builtin_amdgcn_readfirstlane(vdst + (slot)))
    const int vb0 = (int)(lds0 + LDS_V) + ((lane >> 4) & 1) * 32 + (lane & 3) * 8 + (4 * hi + ((lane & 15) >> 2)) * 64;
    const char* Kbase = shm + LDS_K; bf16x8 kf[8];
    const lds_cptr shm3 = (lds_cptr)shm; const lds_cptr kp0 = shm3 + LDS_K + hi * 1024 + r32 * 16; const lds_cptr vp0 = shm3 + LDS_V + ((lane >> 4) & 1) * 32 + (lane & 3) * 8 + (4 * hi + ((lane & 15) >> 2)) * 64;
    DMA_K(0, 0); DMA_V(0, 0); DMA_K(1, SLOTB);
    bf16x8 qr[4];
    {
        bf16x8 qraw[4];
#pragma unroll
        for (int d0 = 0; d0 < 4; ++d0) qraw[d0] = *reinterpret_cast<const bf16x8*>(&Qw[(long)r32 * DM + d0 * 16 + hi * 8]);
        float qf[4][8]; float ss = 0.f;
#pragma unroll
        for (int d0 = 0; d0 < 4; ++d0)
#pragma unroll
            for (int j = 0; j < 8; ++j) { qf[d0][j] = __uint_as_float(((unsigned)(unsigned short)qraw[d0][j]) << 16); ss += qf[d0][j] * qf[d0][j]; }
        { auto rr = __builtin_amdgcn_permlane32_swap(__float_as_uint(ss), __float_as_uint(ss), false, false); ss = __uint_as_float(rr[0]) + __uint_as_float(rr[1]); }
        const float rinv = 1.0f / sqrtf(ss * (1.0f / 64.0f) + EPS);
#pragma unroll
        for (int d0 = 0; d0 < 4; ++d0) { const f32x4 g0 = *(const f32x4*)(aa.qg + d0 * 16 + hi * 8), g1 = *(const f32x4*)(aa.qg + d0 * 16 + hi * 8 + 4);
#pragma unroll
            for (int j = 0; j < 4; ++j) { qf[d0][j] *= rinv * g0[j]; qf[d0][4 + j] *= rinv * g1[j]; } }
        if (LAT) {
            const int pos = q0 + wid * QBLK + r32;
#pragma unroll
            for (int pr = 0; pr < 2; ++pr) {
                const float* cp = aa.ropec + (size_t)pos * 32 + pr * 16 + hi * 8; const float* sp = aa.ropes + (size_t)pos * 32 + pr * 16 + hi * 8;
                const f32x4 c0 = *(const f32x4*)cp, c1 = *(const f32x4*)(cp + 4), s0 = *(const f32x4*)sp, s1 = *(const f32x4*)(sp + 4);
#pragma unroll
                for (int j = 0; j < 8; ++j) { const float c = j < 4 ? c0[j & 3] : c1[j & 3], s = j < 4 ? s0[j & 3] : s1[j & 3];
                    const float t1 = qf[pr][j], t2 = qf[pr + 2][j]; qf[pr][j] = t1 * c - t2 * s; qf[pr + 2][j] = t2 * c + t1 * s; } }
        }
#pragma unroll
        for (int d0 = 0; d0 < 4; ++d0) { u32x4 w; w.x = cvtpk_s(qf[d0][0] * C2, qf[d0][1] * C2); w.y = cvtpk_s(qf[d0][2] * C2, qf[d0][3] * C2); w.z = cvtpk_s(qf[d0][4] * C2, qf[d0][5] * C2); w.w = cvtpk_s(qf[d0][6] * C2, qf[d0][7] * C2);
            qr[d0] = __builtin_bit_cast(bf16x8, w); }
    }
    float mhat = 0.f, l_reg = 0.f; f32x16 o[2]; o[0] = f32x16{}; o[1] = f32x16{}; f32x16 negm = f32x16{}; asm volatile("" : "+v"(negm));
    const int dkq = kstart - (q0 + wid * QBLK + r32);
#define CMASK(P0, P1, t) do { if (WIN && (t) >= 4) wmask(P0, P1, dkq + 64 * ((t) - 4), hi); } while (0)
    bool resc = false;
#define START(P0, P1) do { const float rm = rowmax(P0, P1); resc = false; \
    { const float dl = rm; mhat = fadd_s(mhat, dl); \
      _Pragma("unroll") for (int r = 0; r < 16; ++r) { P0[r] = fsub_s(P0[r], dl); P1[r] = fsub_s(P1[r], dl); } \
      _Pragma("unroll") for (int r = 0; r < 16; ++r) negm[r] = -mhat; asm volatile("" : "+v"(negm)); } \
    _Pragma("unroll") for (int r = 0; r < 16; ++r) P0[r] = __builtin_amdgcn_exp2f(P0[r]); } while (0)
#define RESC() do { if (resc) { asm volatile("s_waitcnt lgkmcnt(0)" ::: "memory"); \
      _Pragma("unroll") for (int d_ = 0; d_ < 2; ++d_) _Pragma("unroll") for (int r = 0; r < 16; ++r) o[d_][r] *= wsf[crow(r, hi)]; } } while (0)
    f32x16 pA0, pA1, pB0, pB1;
    int sl_prev = 0, sl_cur = 0, sl_next = SLOTB;
#define ROT() do { sl_prev = sl_cur; sl_cur = sl_next; sl_next = (sl_next == (NSLOT - 1) * SLOTB) ? 0 : sl_next + SLOTB; } while (0)
    DMA_K(2, 2 * SLOTB);
    WAIT_BAR(3);
    qkt(pA0, pA1, Kbase, qr, negm, r32, hi); asm volatile("s_nop 15\n\ts_nop 7" : "+v"(pA0), "+v"(pA1)); CMASK(pA0, pA1, 0);
    START(pA0, pA1);
    _Pragma("unroll") for (int r = 0; r < 16; ++r) pA1[r] = __builtin_amdgcn_exp2f(pA1[r]);
    WAIT_BAR(0);
    DMA_K(3, 0); DMA_V(1, SLOTB);
    ROT();
    kload8(kf, kp0 + sl_cur);
    WAIT_BAR(2);
    s16x4 vlo[8], vhi[8]; u32x4 pw0, pw1, pw2, pw3;
#define PKW(P, B) cvtpk_s(P[B], P[B + 1])
#define PAF(k) __builtin_bit_cast(bf16x8, pw##k)
#define VFR(i) (bf16x8){vlo[i][0], vlo[i][1], vlo[i][2], vlo[i][3], vhi[i][0], vhi[i][1], vhi[i][2], vhi[i][3]}
#define PIN(x) asm volatile("" : "+v"(x))
#define MX3(a, b, c) __builtin_fmaxf(__builtin_fmaxf((a), (b)), (c))
#define GAPA(MF, A0, A1, A2, A3, W0, W1, PW) do { MF; sacc += A0; sacc += A1; sacc += A2; sacc += A3; PIN(sacc); W0; W1; PIN(PW); SBAR(); } while (0)
#define EX(v) __builtin_amdgcn_exp2f(v)
#define GAPB(MF, X, B) do { MF; X[B] = EX(X[B]); X[B + 1] = EX(X[B + 1]); X[B + 2] = EX(X[B + 2]); X[B + 3] = EX(X[B + 3]); PIN(X); SBAR(); } while (0)
#define VRD(i) do { vlo[i] = vtr(vp_ + (((i) >> 2) * 4096 + ((i) & 3) * 1024)); vhi[i] = vtr(vp_ + (((i) >> 2) * 4096 + ((i) & 3) * 1024 + 512)); } while (0)
#define KRD(G, j) do { if (G) { kload2(kf, kp0 + sl_next, j); SBAR(); } } while (0)
#define STEP(C0, C1, P0, P1, t, GK, GV, GL) do { SBAR(); \
    const lds_cptr vp_ = vp0 + sl_prev; \
    VRD(0); SBAR(); float sacc = (P0[0] + P0[1]); \
    GAPA(C0 = __builtin_amdgcn_mfma_f32_32x32x16_bf16(kf[0], qr[0], negm, 0, 0, 0), P0[2], P0[3], P0[4], P0[5],     pw0[0] = PKW(P0, 0), pw0[1] = PKW(P0, 2), pw0); \
    VRD(4); SBAR(); GAPA(C1 = __builtin_amdgcn_mfma_f32_32x32x16_bf16(kf[1], qr[0], negm, 0, 0, 0), P0[6], P0[7], P0[8], P0[9],     pw0[2] = PKW(P0, 4), pw0[3] = PKW(P0, 6), pw0); \
    VRD(1); SBAR(); GAPA(C0 = __builtin_amdgcn_mfma_f32_32x32x16_bf16(kf[2], qr[1], C0, 0, 0, 0),   P0[10], P0[11], P0[12], P0[13], pw1[0] = PKW(P0, 8), pw1[1] = PKW(P0, 10), pw1); \
    VRD(5); SBAR(); GAPA(C1 = __builtin_amdgcn_mfma_f32_32x32x16_bf16(kf[3], qr[1], C1, 0, 0, 0),   P0[14], P0[15], P1[0], P1[1],   pw1[2] = PKW(P0, 12), pw1[3] = PKW(P0, 14), pw1); \
    VRD(2); SBAR(); GAPA(C0 = __builtin_amdgcn_mfma_f32_32x32x16_bf16(kf[4], qr[2], C0, 0, 0, 0),   P1[2], P1[3], P1[4], P1[5],     pw2[0] = PKW(P1, 0), pw2[1] = PKW(P1, 2), pw2); \
    VRD(6); SBAR(); GAPA(C1 = __builtin_amdgcn_mfma_f32_32x32x16_bf16(kf[5], qr[2], C1, 0, 0, 0),   P1[6], P1[7], P1[8], P1[9],     pw2[2] = PKW(P1, 4), pw2[3] = PKW(P1, 6), pw2); \
    VRD(3); SBAR(); GAPA(C0 = __builtin_amdgcn_mfma_f32_32x32x16_bf16(kf[6], qr[3], C0, 0, 0, 0),   P1[10], P1[11], P1[12], P1[13], pw3[0] = PKW(P1, 8), pw3[1] = PKW(P1, 10), pw3); \
    VRD(7); SBAR(); GAPA(C1 = __builtin_amdgcn_mfma_f32_32x32x16_bf16(kf[7], qr[3], C1, 0, 0, 0),   P1[14], P1[15], 0.f, 0.f,       pw3[2] = PKW(P1, 12), pw3[3] = PKW(P1, 14), pw3); \
    l_reg += sacc; \
    if (GK) { DMA_K((t) + 3, sl_cur); } if (GV) { DMA_V((t) + 1, sl_next); } \
    CMASK(C0, C1, t); \
    { float a = MX3(C0[0], C0[1], C1[0]), b = MX3(C0[2], C0[3], C1[1]); a = MX3(a, C1[2], C1[3]); \
      _Pragma("unroll") for (int r = 4; r < 16; r += 4) { a = MX3(a, C0[r], C0[r + 1]); b = MX3(b, C0[r + 2], C0[r + 3]); a = MX3(a, C1[r], C1[r + 1]); b = MX3(b, C1[r + 2], C1[r + 3]); } \
      float rm = __builtin_fmaxf(a, b); { auto rr = __builtin_amdgcn_permlane32_swap(__float_as_uint(rm), __float_as_uint(rm), false, false); rm = __builtin_fmaxf(__uint_as_float(rr[0]), __uint_as_float(rr[1])); } \
      resc = false; \
      if (__builtin_expect(__any(rm > (float)THRL), 0)) { const float dl = __builtin_fmaxf(rm, 0.f); mhat += dl; \
        _Pragma("unroll") for (int r = 0; r < 16; ++r) { C0[r] -= dl; C1[r] -= dl; } \
        _Pragma("unroll") for (int r = 0; r < 16; ++r) negm[r] = -mhat; asm volatile("" : "+v"(negm)); \
        const float f = __builtin_amdgcn_exp2f(-dl); l_reg *= f; if (hi == 0) wsf[r32] = f; resc = true; } } \
    SBAR(); \
    GAPB(o[0] = __builtin_amdgcn_mfma_f32_32x32x16_bf16(PAF(0), VFR(0), o[0], 0, 0, 0), C0, 0); \
    GAPB(o[1] = __builtin_amdgcn_mfma_f32_32x32x16_bf16(PAF(0), VFR(4), o[1], 0, 0, 0), C0, 4); \
    KRD(GL, 0); GAPB(o[0] = __builtin_amdgcn_mfma_f32_32x32x16_bf16(PAF(1), VFR(1), o[0], 0, 0, 0), C0, 8); \
    KRD(GL, 1); GAPB(o[1] = __builtin_amdgcn_mfma_f32_32x32x16_bf16(PAF(1), VFR(5), o[1], 0, 0, 0), C0, 12); \
    KRD(GL, 2); GAPB(o[0] = __builtin_amdgcn_mfma_f32_32x32x16_bf16(PAF(2), VFR(2), o[0], 0, 0, 0), C1, 0); \
    KRD(GL, 3); GAPB(o[1] = __builtin_amdgcn_mfma_f32_32x32x16_bf16(PAF(2), VFR(6), o[1], 0, 0, 0), C1, 4); \
    GAPB(o[0] = __builtin_amdgcn_mfma_f32_32x32x16_bf16(PAF(3), VFR(3), o[0], 0, 0, 0), C1, 8); \
    GAPB(o[1] = __builtin_amdgcn_mfma_f32_32x32x16_bf16(PAF(3), VFR(7), o[1], 0, 0, 0), C1, 12); \
    } while (0)
    int t = 1;
    for (; t + 5 < NT; t += 2) {
        STEP(pB0, pB1, pA0, pA1, t, true, true, true);     WAIT_BAR(2); RESC(); ROT();
        STEP(pA0, pA1, pB0, pB1, t + 1, true, true, true); WAIT_BAR(2); RESC(); ROT();
    }
#define ENDW(tt) do { if ((tt) + 3 < NT) { WAIT_BAR(2); } else if ((tt) + 2 < NT) { WAIT_BAR(1); } else { WAIT_BAR(0); } } while (0)
    for (; t + 1 < NT; t += 2) {
        STEP(pB0, pB1, pA0, pA1, t, (t + 3 < NT), (t + 1 < NT), (t + 1 < NT));         ENDW(t);     RESC(); ROT();
        STEP(pA0, pA1, pB0, pB1, t + 1, (t + 4 < NT), (t + 2 < NT), (t + 2 < NT));     ENDW(t + 1); RESC(); ROT();
    }
    STEP(pB0, pB1, pA0, pA1, NT - 1, false, false, false); RESC();
    { float sacc = pB0[0] + pB0[1]; _Pragma("unroll") for (int r = 2; r < 16; ++r) sacc += pB0[r]; _Pragma("unroll") for (int r = 0; r < 16; ++r) sacc += pB1[r]; l_reg += sacc;
      pw0 = (u32x4){PKW(pB0, 0), PKW(pB0, 2), PKW(pB0, 4), PKW(pB0, 6)}; pw1 = (u32x4){PKW(pB0, 8), PKW(pB0, 10), PKW(pB0, 12), PKW(pB0, 14)}; pw2 = (u32x4){PKW(pB1, 0), PKW(pB1, 2), PKW(pB1, 4), PKW(pB1, 6)}; pw3 = (u32x4){PKW(pB1, 8), PKW(pB1, 10), PKW(pB1, 12), PKW(pB1, 14)};
      SBAR(); pv(o, vb0 + sl_cur, PAF(0), PAF(1), PAF(2), PAF(3)); }
#undef PKW
#undef PAF
#undef VFR
#undef PIN
#undef MX3
#undef GAPA
#undef GAPB
#undef EX
#undef VRD
#undef KRD
#undef STEP
#undef ENDW
    { auto rr = __builtin_amdgcn_permlane32_swap(__float_as_uint(l_reg), __float_as_uint(l_reg), false, false); l_reg = __uint_as_float(rr[0]) + __uint_as_float(rr[1]); }
    if (SINK) l_reg += __builtin_amdgcn_exp2f(aa.sink * LOG2E - mhat);
    if (hi == 0) wsf[32 + r32] = l_reg; asm volatile("s_waitcnt lgkmcnt(0)" ::: "memory");
    float rli[16];
#pragma unroll
    for (int r = 0; r < 16; ++r) rli[r] = __builtin_amdgcn_rcpf(wsf[32 + crow(r, hi)]);
    bf16* Ow = aa.P + qrow0 * DM + QCOL + h * 64;
    { bf16* stg = (bf16*)(shm + LDS_OST) + wid * 2048;
#pragma unroll
      for (int r = 0; r < 16; ++r) { const int orow = crow(r, hi);
#pragma unroll
          for (int d0 = 0; d0 < 2; ++d0) stg[orow * 64 + d0 * 32 + r32] = __float2bfloat16(o[d0][r] * rli[r]); }
      asm volatile("s_waitcnt lgkmcnt(0)" ::: "memory");
#pragma unroll
      for (int i = 0; i < 4; ++i) { const int row = i * 8 + (lane >> 3), ch = lane & 7; const u32x4 v = *(const u32x4*)(stg + row * 64 + ch * 8); if (!aa.dry) *(u32x4*)(Ow + (long)row * DM + ch * 8) = v; } }
    asm volatile("s_waitcnt lgkmcnt(0)\n\ts_barrier" ::: "memory");
#undef DMA_K
#undef DMA_V
#undef TROW
#undef CMASK
#undef START
#undef RESC
#undef ROT
}
#undef SBAR
#undef WAIT_BAR
}
constexpr size_t MiB = 1u << 20;
constexpr size_t WS_CTL = 0, CTL_ZERO_BYTES = 1 * MiB;
constexpr size_t WS_MOD = 1 * MiB;
constexpr size_t WS_ROPE = 2 * MiB;
constexpr size_t WS_ROUTE = 3 * MiB;
constexpr size_t WS_WIN = 6 * MiB;
constexpr size_t WS_WBR = 28 * MiB;
constexpr size_t WS_WOUT = 34 * MiB;
constexpr size_t WS_XC = 38 * MiB;
constexpr size_t WS_A = 54 * MiB;
constexpr size_t WS_PROJ = 190 * MiB;
constexpr size_t WS_YBUF = WS_PROJ;
constexpr size_t WS_HG = WS_PROJ + 420 * MiB;
constexpr size_t WS_H8 = WS_A;
constexpr size_t WS_YP = WS_PROJ;
constexpr size_t WS_HID = WS_PROJ + 280 * MiB;
constexpr size_t WS_W13 = WS_PROJ + 560 * MiB;
constexpr size_t WS_W2 = WS_PROJ + 624 * MiB;
constexpr size_t WS_END = WS_PROJ + 748 * MiB;
static_assert((size_t)T * NIN * 2 == 748 * MiB && (size_t)T * D * 2 == 136 * MiB && (size_t)PMAX * D * 2 == 280 * MiB, "buffer sizes");
static_assert(WS_END <= 1024 * MiB, "workspace map fits 1 GiB");
constexpr int CW_CNT = 64;
constexpr int CW_BAR = 4096;

constexpr int RING_OFF = 0, RING_BYTES = 131072;
constexpr int LDSCTL_OFF = RING_BYTES, MISC_OFF = LDSCTL_OFF + 320;
constexpr int LDS_BYTES = 147456;
constexpr int NWAVES = 8;

typedef GAS unsigned gu32;
#define RLX_AGENT __ATOMIC_RELAXED, __HIP_MEMORY_SCOPE_AGENT
#define LDS_WAIT() asm volatile("s_waitcnt lgkmcnt(0)" ::: "memory")
#define VM_WAIT() asm volatile("s_waitcnt vmcnt(0)" ::: "memory")

#define XB_TMO      128
#define XB_XCNT(j)  (256  + 64 * (j))
#define XB_XSUB(j)  (1280 + 64 * (j))
#define XB_XGEN(j)  (2304 + 64 * (j))
#define XB_TOP      3328
#define XB_TOPGEN   3392
#define XCD_BAR_WORDS 3456
#define XB_SPIN_CAP (1u << 18)
__device__ __forceinline__ unsigned xb_ld(unsigned* p)              { return __hip_atomic_load(p, __ATOMIC_RELAXED, __HIP_MEMORY_SCOPE_AGENT); }
__device__ __forceinline__ unsigned xb_add(unsigned* p, unsigned v) { return __hip_atomic_fetch_add(p, v, __ATOMIC_RELAXED, __HIP_MEMORY_SCOPE_AGENT); }
__device__ __forceinline__ unsigned xb_xcc_id() { return (unsigned)__builtin_amdgcn_s_getreg((3 << 11) | 20) & 0xFu; }
#define XB_SPIN(cond, bar) do { unsigned _sp = 0; while (cond) { __builtin_amdgcn_s_sleep(1); \
    if ((++_sp & 255u) == 0u) { if (xb_ld(&(bar)[XB_TMO])) break; if (_sp > XB_SPIN_CAP) { atomicAdd(&(bar)[XB_TMO], 1u); break; } } } } while (0)
struct XcdBarrier { unsigned* bar; unsigned x; volatile LAS unsigned* st; };
__device__ __forceinline__ XcdBarrier xcd_barrier_post(unsigned* bar, volatile LAS unsigned* st) {
    XcdBarrier b; b.bar = bar; b.x = xb_xcc_id(); b.st = st;
    if (threadIdx.x == 0) (void)xb_add(&bar[XB_XCNT(b.x)], 1u);
    return b;
}
__device__ __forceinline__ void xcd_barrier_complete(unsigned* bar, unsigned x, unsigned& nloc, unsigned& nx) {
    const unsigned G = gridDim.x * gridDim.y * gridDim.z;
    unsigned sum, cnt, mine, sp = 0u;
    for (;;) {
        sum = 0u; cnt = 0u; mine = 0u;
#pragma unroll
        for (unsigned j = 0; j < 16; ++j) { const unsigned c = xb_ld(&bar[XB_XCNT(j)]); sum += c; cnt += (c > 0u) ? 1u : 0u; mine = (j == x) ? c : mine; }
        if (sum == G) break;
        __builtin_amdgcn_s_sleep(1);
        if ((++sp & 255u) == 0u) { if (xb_ld(&bar[XB_TMO])) break; if (sp > XB_SPIN_CAP) { atomicAdd(&bar[XB_TMO], 1u); break; } }
    }
    nloc = mine > 0u ? mine : 1u; nx = cnt > 0u ? cnt : 1u;
}
__device__ __forceinline__ void xcd_barrier(const XcdBarrier& b) {
    asm volatile("s_waitcnt vmcnt(0)" ::: "memory");
    __syncthreads();
    if (threadIdx.x == 0) {
        unsigned* bar = b.bar;
        __builtin_amdgcn_s_waitcnt(0);
        unsigned nloc = b.st[0], nx = b.st[1];
        if (nloc == 0u) { xcd_barrier_complete(bar, b.x, nloc, nx); b.st[0] = nloc; b.st[1] = nx; }
        const unsigned old = xb_add(&bar[XB_XSUB(b.x)], 1u);
        const unsigned gen = old / nloc;
        if (old + 1u == (gen + 1u) * nloc) {
            __builtin_amdgcn_fence(__ATOMIC_RELEASE, "agent");
            asm volatile("s_waitcnt vmcnt(0)" ::: "memory");
            const unsigned og = xb_add(&bar[XB_TOP], 1u);
            const unsigned tg = og / nx;
            if (og + 1u == (tg + 1u) * nx) xb_add(&bar[XB_TOPGEN], 1u);
            else XB_SPIN(xb_ld(&bar[XB_TOPGEN]) == tg, bar);
            __builtin_amdgcn_fence(__ATOMIC_ACQUIRE, "agent");
            xb_add(&bar[XB_XGEN(b.x)], 1u);
            asm volatile("s_waitcnt vmcnt(0)" ::: "memory");
        } else {
            XB_SPIN(xb_ld(&bar[XB_XGEN(b.x)]) == gen, bar);
            __builtin_amdgcn_fence(__ATOMIC_ACQUIRE, "agent");
            asm volatile("s_waitcnt vmcnt(0)" ::: "memory");
        }
    }
    __syncthreads();
}

struct Args { const float* in[27]; float* out; unsigned char* ws; };
struct KArgs { const GAS float* in[27]; GAS float* out; GAS unsigned char* ws; };
typedef const __attribute__((address_space(4))) KArgs* kargs_p;
__device__ __forceinline__ kargs_p kargs() { kargs_p p = (kargs_p)__builtin_amdgcn_kernarg_segment_ptr(); asm volatile("" : "+s"(p)); return p; }
struct Frame {
    LAS unsigned char* lds;
    int tid, lane, wave, vcu, G, gw, NGW, bid;
#define KIN(name, idx) __device__ __forceinline__ const float* name() const { return (const float*)kargs()->in[idx]; }
    KIN(x, 0) KIN(c, 1) KIN(ctx, 2) KIN(c_ctx, 3) KIN(w_mod, 4) KIN(b_mod, 5) KIN(norm1_g, 6) KIN(norm2_g, 7) KIN(w_in, 8) KIN(b_merge, 9) KIN(conv_w, 10) KIN(conv_b, 11)
    KIN(lru_wa, 12) KIN(lru_ba, 13) KIN(lru_wx, 14) KIN(lru_bx, 15) KIN(lru_lambda, 16) KIN(q_norm_g, 17) KIN(k_norm_g, 18) KIN(sink, 19) KIN(w_branch, 20) KIN(w_out, 21)
    KIN(router_w, 22) KIN(router_b, 23) KIN(ew1, 24) KIN(ew3, 25) KIN(ew2, 26)
#undef KIN
    __device__ __forceinline__ float* out() const { return (float*)kargs()->out; }
    __device__ __forceinline__ unsigned char* ws() const { return (unsigned char*)kargs()->ws; }
    __device__ __forceinline__ gu32* ctl() const { return (gu32*)(ws() + WS_CTL); }
#define KWS(type, name, off) __device__ __forceinline__ type* name() const { return (type*)(ws() + (off)); }
    KWS(float, MOD, WS_MOD) KWS(float, ROPEC, WS_ROPE) KWS(float, ROPES, WS_ROPE + (size_t)SEQ * 32 * 4) KWS(float, XC, WS_XC) KWS(float, HT, WS_A) KWS(unsigned, ROUTE, WS_ROUTE)
    KWS(bf16_t, WIN, WS_WIN) KWS(bf16_t, WBR, WS_WBR) KWS(bf16_t, WOUT, WS_WOUT) KWS(bf16_t, A, WS_A) KWS(bf16_t, PROJ, WS_PROJ) KWS(bf16_t, YBUF, WS_YBUF) KWS(unsigned char, HG, WS_HG)
    KWS(bf16_t, YP, WS_YP) KWS(unsigned char, HID, WS_HID) KWS(unsigned char, W13, WS_W13) KWS(unsigned char, W2, WS_W2) KWS(unsigned char, H8, WS_H8)
#undef KWS
};
__device__ __forceinline__ Frame fresh(const Frame& F0) { Frame F = F0;
    asm volatile("" : "+s"(F.wave), "+s"(F.vcu), "+s"(F.G), "+s"(F.gw), "+s"(F.NGW), "+s"(F.bid), "+v"(F.tid), "+v"(F.lane)); return F; }
__device__ __forceinline__ float wave_sum(float v) {
#pragma unroll
    for (int o = 1; o < 64; o <<= 1) v += __shfl_xor(v, o);
    return v;
}
__device__ __forceinline__ const float* modp(const float* MODb, int l, int sel, int chunk) { return MODb + ((size_t)(l * 17 + sel) * 6 + chunk) * D; }

__device__ __forceinline__ void transpose_item(const float* W, int K, int N, bf16_t* WT, int k0, int n0, int drow0, LAS float* scr, int lane) {
#pragma unroll 8
    for (int i = 0; i < 32; ++i) { const int kk = 2 * i + (lane >> 5); scr[kk * 33 + (lane & 31)] = W[(size_t)(k0 + kk) * N + n0 + (lane & 31)]; }
    LDS_WAIT(); asm volatile("" ::: "memory");
    const int cc = lane & 7;
#pragma unroll
    for (int j = 0; j < 4; ++j) { const int n = (lane >> 3) + 8 * j; const LAS float* s = scr + (8 * cc) * 33 + n;
        u32x4 o; o.x = cvt_pk_bf16(s[0 * 33], s[1 * 33]); o.y = cvt_pk_bf16(s[2 * 33], s[3 * 33]); o.z = cvt_pk_bf16(s[4 * 33], s[5 * 33]); o.w = cvt_pk_bf16(s[6 * 33], s[7 * 33]);
        *(GAS u32x4*)(WT + (size_t)(drow0 + n) * K + k0 + 8 * cc) = o; }
    LDS_WAIT(); asm volatile("" ::: "memory");
}

__device__ __forceinline__ void transpose_item_fp8(const float* W, int K, int N, unsigned char* WT, int k0, int n0, int drow0, float scale, LAS float* scr, int lane) {
#pragma unroll 8
    for (int i = 0; i < 32; ++i) { const int kk = 2 * i + (lane >> 5); scr[kk * 33 + (lane & 31)] = W[(size_t)(k0 + kk) * N + n0 + (lane & 31)]; }
    LDS_WAIT(); asm volatile("" ::: "memory");
    const int cc = lane & 7;
#pragma unroll
    for (int j = 0; j < 4; ++j) { const int n = (lane >> 3) + 8 * j; const LAS float* s = scr + (8 * cc) * 33 + n;
        u32x2 o; o.x = pk4_fp8(s[0 * 33] * scale, s[1 * 33] * scale, s[2 * 33] * scale, s[3 * 33] * scale); o.y = pk4_fp8(s[4 * 33] * scale, s[5 * 33] * scale, s[6 * 33] * scale, s[7 * 33] * scale);
        *(GAS u32x2*)(WT + (size_t)(drow0 + n) * K + k0 + 8 * cc) = o; }
    LDS_WAIT(); asm volatile("" ::: "memory");
}
__device__ __forceinline__ void p0_prologue(Frame& F) {
    LAS float* scr = (LAS float*)(F.lds + RING_OFF + F.wave * 16384);
    constexpr int I_IN = (D / 64) * (NIN / 32), I_BR = (512 / 64) * (D / 32), I_OUT = (D / 64) * (D / 32);
    constexpr int NITEMS = NL * (I_IN + 3 * I_BR + I_OUT);
    for (int it = F.gw; it < NITEMS; it += F.NGW) {
        int r = it; const int l = r / (I_IN + 3 * I_BR + I_OUT); r -= l * (I_IN + 3 * I_BR + I_OUT);
        if (r < I_IN) { const int nb = NIN / 32, kb = r / nb, n0 = 32 * (r % nb); transpose_item(F.w_in() + (size_t)l * D * NIN, D, NIN, F.WIN() + (size_t)l * NIN * D, 64 * kb, n0, n0, scr, F.lane); continue; }
        r -= I_IN;
        if (r < 3 * I_BR) { const int b = r / I_BR; r -= b * I_BR; const int nb = D / 32, kb = r / nb, n0 = 32 * (r % nb);
            transpose_item(F.w_branch() + (size_t)(l * 3 + b) * 512 * D, 512, D, F.WBR() + (size_t)(l * 3 + b) * D * 512, 64 * kb, n0, n0, scr, F.lane); continue; }
        r -= 3 * I_BR;
        { const int nb = D / 32, kb = r / nb, n0 = 32 * (r % nb); transpose_item(F.w_out() + (size_t)l * D * D, D, D, F.WOUT() + (size_t)l * D * D, 64 * kb, n0, n0, scr, F.lane); }
    }
    float* RC = F.ROPEC(); float* RS = F.ROPES();
    for (int i = blockIdx.x * (NWAVES * 64) + F.tid; i < SEQ * 32; i += F.G * NWAVES * 64) {
        const int pos = i >> 5, f = i & 31; const float inv = exp2f(-(float)(f & 15) * (13.287712379549449f / 16.0f));
        const float ang = (float)(f < 16 ? (pos >> 6) : (pos & 63)) * inv;
        const float rev = ang * 0.15915494309189535f; RC[i] = __builtin_amdgcn_cosf(rev); RS[i] = __builtin_amdgcn_sinf(rev);
    }
    __syncthreads();
    {
        LAS float* sc = (LAS float*)(F.lds + RING_OFF);
        LAS float* part = (LAS float*)(F.lds + RING_OFF + 17 * 1024 * 4);
        bool have_sc = false;
        for (int it = blockIdx.x; it < NL * 96; it += F.G) {
            if (!have_sc) { for (int i = F.tid; i < 17 * 1024; i += NWAVES * 64) { const int s = i >> 10, k = i & 1023; const float v = s < 16 ? F.c()[s * D + k] : F.c_ctx()[k]; sc[i] = v * fast_sigmoid(v); }
                have_sc = true; __syncthreads(); }
            const int l = it / 96, cg = it % 96, col = cg * 64 + F.lane;
            const float* wp = F.w_mod() + (size_t)l * D * 6 * D + col;
            float acc[17];
#pragma unroll
            for (int s = 0; s < 17; ++s) acc[s] = 0.f;
            const int kbeg = F.wave * 128;
#pragma unroll 4
            for (int k = kbeg; k < kbeg + 128; ++k) { const float w = wp[(size_t)k * 6 * D];
#pragma unroll
                for (int s = 0; s < 17; ++s) acc[s] += sc[s * 1024 + k] * w; }
#pragma unroll
            for (int s = 0; s < 17; ++s) part[(F.wave * 17 + s) * 64 + F.lane] = acc[s];
            __syncthreads();
            for (int i = F.tid; i < 17 * 64; i += NWAVES * 64) { const int s = i >> 6, cl = i & 63; float v = F.b_mod()[l * 6 * D + cg * 64 + cl];
#pragma unroll
                for (int w = 0; w < 8; ++w) v += part[(w * 17 + s) * 64 + cl];
                F.MOD()[(size_t)(l * 17 + s) * 6 * D + cg * 64 + cl] = v; }
            __syncthreads();
        }
    }
}

constexpr float WSCALE = 64.0f;
__device__ __forceinline__ void convert_experts(Frame& F, int l) {
    LAS float* scr = (LAS float*)(F.lds + RING_OFF + F.wave * 16384);
    constexpr int I_M = (D / 64) * (D / 32);
    for (int it = F.gw; it < NE * 3 * I_M; it += F.NGW) {
        const int e = it / (3 * I_M); int r = it - e * 3 * I_M; const int which = r / I_M; r -= which * I_M;
        const int kb = r / (D / 32), n0 = 32 * (r % (D / 32));
        const size_t eoff = (size_t)(l * NE + e) * D * D;
        if (which == 0) transpose_item_fp8(F.ew1() + eoff, D, D, F.W13() + (size_t)e * 2048 * D, 64 * kb, n0, 256 * (n0 >> 7) + (n0 & 127), WSCALE, scr, F.lane);
        else if (which == 1) transpose_item_fp8(F.ew3() + eoff, D, D, F.W13() + (size_t)e * 2048 * D, 64 * kb, n0, 256 * (n0 >> 7) + 128 + (n0 & 127), WSCALE, scr, F.lane);
        else transpose_item_fp8(F.ew2() + eoff, D, D, F.W2() + (size_t)e * D * D, 64 * kb, n0, n0, WSCALE, scr, F.lane);
    }
}

__device__ __forceinline__ void ld_row_f32(const float* p, int lane, f32x4 (&v)[4]) {
#pragma unroll
    for (int j = 0; j < 4; ++j) v[j] = *((const GAS f32x4*)p + lane + 64 * j);
}
__device__ __forceinline__ void st_row_f32(float* p, int lane, const f32x4 (&v)[4]) {
#pragma unroll
    for (int j = 0; j < 4; ++j) *((GAS f32x4*)p + lane + 64 * j) = v[j];
}
__device__ __forceinline__ void ld_row_bf16(const bf16_t* p, int lane, f32x4 (&v)[4]) {
#pragma unroll
    for (int j = 0; j < 4; ++j) { const u32x2 w = *((const GAS u32x2*)p + lane + 64 * j); v[j] = (f32x4){bf_lo(w.x), bf_hi(w.x), bf_lo(w.y), bf_hi(w.y)}; }
}
__device__ __forceinline__ void st_row_bf16(bf16_t* p, int lane, const f32x4 (&v)[4]) {
#pragma unroll
    for (int j = 0; j < 4; ++j) { u32x2 w; w.x = cvt_pk_bf16(v[j][0], v[j][1]); w.y = cvt_pk_bf16(v[j][2], v[j][3]); *((GAS u32x2*)p + lane + 64 * j) = w; }
}
__device__ __forceinline__ void st_row_fp8(unsigned char* p, int lane, const f32x4 (&v)[4]) {
#pragma unroll
    for (int j = 0; j < 4; ++j) *((GAS unsigned*)p + lane + 64 * j) = pk4_fp8(v[j][0], v[j][1], v[j][2], v[j][3]);
}
__device__ __forceinline__ void norm_mod(const f32x4 (&v)[4], const float* g, const float* shift, const float* scale, int lane, f32x4 (&h)[4]) {
    float ss = 0.f;
#pragma unroll
    for (int j = 0; j < 4; ++j) ss += (v[j][0] * v[j][0] + v[j][1] * v[j][1]) + (v[j][2] * v[j][2] + v[j][3] * v[j][3]);
    const float rinv = 1.0f / sqrtf(wave_sum(ss) * (1.0f / D) + EPS);
#pragma unroll
    for (int j = 0; j < 4; ++j) { const f32x4 gg = *((const GAS f32x4*)g + lane + 64 * j), sh = *((const GAS f32x4*)shift + lane + 64 * j), sc = *((const GAS f32x4*)scale + lane + 64 * j);
        h[j] = (v[j] * rinv) * gg * (sc + 1.0f) + sh; }
}

__device__ __forceinline__ void r1_phase(Frame& F) {
    const float* MODb = F.MOD(); const float* xin = F.x(); const float* cin = F.ctx(); const float* g1n = F.norm1_g(); bf16_t* Ab = F.A();
    for (int row = F.gw; row < T; row += F.NGW) {
        const int b = row / TB, p = row - b * TB; const bool isc = p < NCTX;
        const float* src = isc ? cin + (size_t)(b * NCTX + p) * D : xin + (size_t)(b * SEQ + p - NCTX) * D; const int sel = isc ? 16 : b;
        f32x4 v[4], h[4]; ld_row_f32(src, F.lane, v);
        norm_mod(v, g1n, modp(MODb, 0, sel, 0), modp(MODb, 0, sel, 1), F.lane, h);
        st_row_bf16(Ab + (size_t)row * D, F.lane, h);
    }
}

__device__ __forceinline__ void kfix_phase(Frame& F, int l, bool dry = false) {
    const int hs = F.lane >> 4, j4 = F.lane & 15, br = hs >> 1;
    const int col = (br ? C_WK : C_GK) + (hs & 1) * 64 + 2 * j4;
    const float* kg = F.k_norm_g() + (size_t)(l * 2 + br) * 64;
    const float g0 = kg[2 * j4], g1 = kg[2 * j4 + 1], g2 = kg[32 + 2 * j4], g3 = kg[32 + 2 * j4 + 1];
    bf16_t* Pb = F.PROJ(); const float* RC = F.ROPEC(); const float* RS = F.ROPES();
    for (int row = F.gw; row < T; row += F.NGW) {
        const int b = row / TB, p = row - b * TB;
        bf16_t* rp = Pb + (size_t)row * NIN + col;
        const unsigned w1 = *(const GAS unsigned*)rp, w2 = *(const GAS unsigned*)(rp + 32);
        float a0 = bf_lo(w1), a1 = bf_hi(w1), b0 = bf_lo(w2), b1 = bf_hi(w2);
        float ss = a0 * a0 + a1 * a1 + b0 * b0 + b1 * b1;
        ss += __shfl_xor(ss, 1); ss += __shfl_xor(ss, 2); ss += __shfl_xor(ss, 4); ss += __shfl_xor(ss, 8);
        const float rinv = 1.0f / sqrtf(ss * (1.0f / 64.0f) + EPS);
        a0 *= rinv * g0; a1 *= rinv * g1; b0 *= rinv * g2; b1 *= rinv * g3;
        if (p >= NCTX) { const int pos = p - NCTX; const f32x2 cs = *(const GAS f32x2*)(RC + (size_t)pos * 32 + 2 * j4), sn = *(const GAS f32x2*)(RS + (size_t)pos * 32 + 2 * j4);
            const float t0 = a0 * cs.x - b0 * sn.x, t1 = a1 * cs.y - b1 * sn.y, u0 = b0 * cs.x + a0 * sn.x, u1 = b1 * cs.y + a1 * sn.y; a0 = t0; a1 = t1; b0 = u0; b1 = u1; }
        if (!dry) { *(GAS unsigned*)rp = cvt_pk_bf16(a0, a1); *(GAS unsigned*)(rp + 32) = cvt_pk_bf16(b0, b1); }
    }
}
constexpr int SC_AOP = 0, SC_AOP_B = 64 * 144, SC_XCV = 2 * SC_AOP_B, SC_XCV_B = 64 * 68 * 4, SC_TOT = SC_XCV + 2 * SC_XCV_B, SC_TOT_B = 4 * 2 * 16 * 8;
__device__ __forceinline__ void scan_unit(Frame& F, int l, int uid, bool last_layer, bool dry = false) {
    const int b = uid >> 4, n = (uid >> 1) & 7, chh = uid & 1;
    const int dir = F.wave >> 2, ht = F.tid & 255, w = F.wave & 3, lane = F.lane, col = lane & 15, quad = lane >> 4;
    LAS unsigned char* aop = F.lds + SC_AOP + dir * SC_AOP_B;
    LAS float* xcv = (LAS float*)(F.lds + SC_XCV + dir * SC_XCV_B);
    LAS f32x2* tot = (LAS f32x2*)(F.lds + SC_TOT + dir * SC_TOT_B);
    bf16x8 Bf[4][2];
    {
        const size_t wbase = ((size_t)((l * 2 + dir) * 8 + n)) * 64 * 64; const float* lwa = F.lru_wa(); const float* lwx = F.lru_wx();
#pragma unroll
        for (int q = 0; q < 4; ++q) { const float* wp = ((q < 2) ? lwa : lwx) + wbase + 32 * chh + 16 * (q & 1) + col;
#pragma unroll
            for (int ks = 0; ks < 2; ++ks) { u32x4 pk;
                const int k0 = 32 * ks + 8 * quad;
                pk.x = cvt_pk_bf16(wp[(size_t)(k0 + 0) * 64], wp[(size_t)(k0 + 1) * 64]); pk.y = cvt_pk_bf16(wp[(size_t)(k0 + 2) * 64], wp[(size_t)(k0 + 3) * 64]);
                pk.z = cvt_pk_bf16(wp[(size_t)(k0 + 4) * 64], wp[(size_t)(k0 + 5) * 64]); pk.w = cvt_pk_bf16(wp[(size_t)(k0 + 6) * 64], wp[(size_t)(k0 + 7) * 64]);
                Bf[q][ks] = __builtin_bit_cast(bf16x8, pk); } }
    }
    float ba[2], bx[2], nla[2]; const float* lba = F.lru_ba(); const float* lbx = F.lru_bx(); const float* llam = F.lru_lambda();
#pragma unroll
    for (int q = 0; q < 2; ++q) { const int gch = 64 * n + 32 * chh + 16 * q + col; const size_t o = (size_t)(l * 2 + dir) * 512 + gch;
        ba[q] = lba[o]; bx[q] = lbx[o]; const float lam = llam[o];
        const float sp = (lam > 15.f) ? __expf(-lam) : log1pf(__expf(-lam));
        nla[q] = -8.0f * sp; }
    const int cg = ht & 7; float cw[4][8], cb[8]; const float* cwp = F.conv_w(); const float* cbp = F.conv_b();
#pragma unroll
    for (int k = 0; k < 4; ++k)
#pragma unroll
        for (int c = 0; c < 8; ++c) cw[k][c] = cwp[(size_t)(l * 4 + k) * 512 + 64 * n + 8 * cg + c];
#pragma unroll
    for (int c = 0; c < 8; ++c) cb[c] = cbp[(size_t)l * 512 + 64 * n + 8 * cg + c];
    float hcar[2] = {0.f, 0.f};
    bf16_t* Pb = F.PROJ(); float* HTb = F.HT();
    const bf16_t* xrb = Pb + C_XR + 64 * n + 8 * cg;

    for (int seg = 0; seg < 2; ++seg) {
        const int nch = seg ? 64 : 4, seglen = nch * 64; const size_t rowseg0 = (size_t)b * TB + (seg ? NCTX : 0);
        const bool want_out = !(seg == 0 && last_layer) && !dry;
        u32x4 raw[2][4];
#define SC_LOAD(i_) do { const int cidx_ = dir ? nch - 1 - (i_) : (i_); const int t0_ = 64 * cidx_; \
        _Pragma("unroll") for (int it = 0; it < 2; ++it) { const int s_ = (it * 256 + ht) >> 3; const int t_ = dir ? t0_ + 63 - s_ : t0_ + s_; \
            _Pragma("unroll") for (int dt = 0; dt < 4; ++dt) { const int tt = t_ + dt - 2; \
                raw[it][dt] = (tt >= 0 && tt < seglen) ? *(const GAS u32x4*)(xrb + (rowseg0 + tt) * NIN) : (u32x4){0u, 0u, 0u, 0u}; } } } while (0)
        SC_LOAD(0);
        for (int i = 0; i < nch; ++i) {
            const int cidx = dir ? nch - 1 - i : i, t0 = 64 * cidx;
#pragma unroll
            for (int it = 0; it < 2; ++it) { const int s = (it * 256 + ht) >> 3; float cv[8];
#pragma unroll
                for (int c2 = 0; c2 < 4; ++c2) { float lo = cb[2 * c2], hi2 = cb[2 * c2 + 1];
#pragma unroll
                    for (int dt = 0; dt < 4; ++dt) { const unsigned wv = raw[it][dt][c2]; lo += cw[dt][2 * c2] * bf_lo(wv); hi2 += cw[dt][2 * c2 + 1] * bf_hi(wv); }
                    cv[2 * c2] = lo; cv[2 * c2 + 1] = hi2; }
                u32x4 pk; pk.x = cvt_pk_bf16(cv[0], cv[1]); pk.y = cvt_pk_bf16(cv[2], cv[3]); pk.z = cvt_pk_bf16(cv[4], cv[5]); pk.w = cvt_pk_bf16(cv[6], cv[7]);
                *(LAS u32x4*)(aop + s * 144 + cg * 16) = pk;
                *(LAS f32x4*)(xcv + s * 68 + cg * 8) = (f32x4){cv[0], cv[1], cv[2], cv[3]}; *(LAS f32x4*)(xcv + s * 68 + cg * 8 + 4) = (f32x4){cv[4], cv[5], cv[6], cv[7]}; }
            if (i + 1 < nch) SC_LOAD(i + 1);
            if (i == nch / 2) VM_WAIT();
            __syncthreads();
            f32x4 gacc[4];
#pragma unroll
            for (int q = 0; q < 4; ++q) gacc[q] = (f32x4){0.f, 0.f, 0.f, 0.f};
#pragma unroll
            for (int ks = 0; ks < 2; ++ks) { const bf16x8 af = *(const LAS bf16x8*)(aop + (16 * w + col) * 144 + ks * 64 + quad * 16);
#pragma unroll
                for (int q = 0; q < 4; ++q) gacc[q] = __builtin_amdgcn_mfma_f32_16x16x32_bf16(af, Bf[q][ks], gacc[q], 0, 0, 0); }
            float av[2][4], bv[2][4], cA[2], cB[2];
#pragma unroll
            for (int q = 0; q < 2; ++q) {
#pragma unroll
                for (int j = 0; j < 4; ++j) { const float r = fast_sigmoid(gacc[q][j] + ba[q]), ig = fast_sigmoid(gacc[q + 2][j] + bx[q]);
                    const float la = nla[q] * r, a = __expf(la), z = 2.0f * la;
                    const float om = (z > -0.1f) ? -z * (1.0f + z * (0.5f + z * (0.16666667f + z * 0.041666668f))) : 1.0f - __expf(z);
                    const float xv = xcv[(16 * w + 4 * quad + j) * 68 + 32 * chh + 16 * q + col];
                    av[q][j] = a; bv[q][j] = sqrtf(om) * ig * xv; }
                cA[q] = av[q][0]; cB[q] = bv[q][0];
#pragma unroll
                for (int j = 1; j < 4; ++j) { cB[q] = av[q][j] * cB[q] + bv[q][j]; cA[q] *= av[q][j]; }
            }
            float iA[2], iB[2], eA[2], eB[2];
#pragma unroll
            for (int q = 0; q < 2; ++q) { iA[q] = cA[q]; iB[q] = cB[q];
                float pA = __shfl_up(iA[q], 16), pB = __shfl_up(iB[q], 16); if (quad >= 1) { iB[q] = iA[q] * pB + iB[q]; iA[q] = iA[q] * pA; }
                pA = __shfl_up(iA[q], 32); pB = __shfl_up(iB[q], 32); if (quad >= 2) { iB[q] = iA[q] * pB + iB[q]; iA[q] = iA[q] * pA; }
                eA[q] = __shfl_up(iA[q], 16); eB[q] = __shfl_up(iB[q], 16); if (quad == 0) { eA[q] = 1.0f; eB[q] = 0.0f; }
                if (quad == 3) tot[(w * 2 + q) * 16 + col] = (f32x2){iA[q], iB[q]}; }
            __syncthreads();
#pragma unroll
            for (int q = 0; q < 2; ++q) { float hin = hcar[q], hall = hcar[q];
#pragma unroll
                for (int ww = 0; ww < 4; ++ww) { const f32x2 tw = tot[(ww * 2 + q) * 16 + col]; hall = tw.x * hall + tw.y; if (ww < w) hin = hall; }
                hcar[q] = hall;
                float hv = eA[q] * hin + eB[q];
                const int gch = 64 * n + 32 * chh + 16 * q + col;
#pragma unroll
                for (int j = 0; j < 4; ++j) { hv = av[q][j] * hv + bv[q][j];
                    if (want_out) { const int s = 16 * w + 4 * quad + j; const int tt = dir ? t0 + 63 - s : t0 + s; const size_t row = rowseg0 + tt;
                        if (i < nch / 2) HTb[row * 512 + gch] = hv;
                        else { const float oth = __hip_atomic_load(HTb + row * 512 + gch, __ATOMIC_RELAXED, __HIP_MEMORY_SCOPE_AGENT);
                            bf16_t* gp = Pb + row * NIN + C_GR + gch; const float gr = __uint_as_float(((unsigned)*gp) << 16);
                            *gp = (bf16_t)(cvt_pk_bf16((hv + oth) * gr, 0.f) & 0xffffu); } } }
            }
        }
#undef SC_LOAD
        __syncthreads();
    }
}

__device__ __forceinline__ void r2_phase(Frame& F, int l, bool dry = false) {
    LAS float* rw = (LAS float*)(F.lds + RING_OFF);
    for (int i = F.tid; i < 16 * 1024; i += NWAVES * 64) { const int e = i >> 10, k = i & 1023; rw[i] = F.router_w()[k * 16 + e]; }
    __syncthreads();
    float rb[16]; const float* rbp = F.router_b();
#pragma unroll
    for (int e = 0; e < 16; ++e) rb[e] = rbp[e];
    const int nrows = l == 0 ? T : NB * SEQ;
    const float* MODb = F.MOD(); float* XCb = F.XC(); float* outb = F.out(); const float* xin = F.x(); const float* cin = F.ctx(); const bf16_t* YB = F.YBUF(); unsigned char* H8b = F.H8();
    const float* n2g = F.norm2_g() + (size_t)l * D; unsigned* RT = F.ROUTE(); gu32* cnt = F.ctl() + CW_CNT + l * 64;
    for (int idx = F.gw; idx < nrows; idx += F.NGW) {
        int b, p; if (l == 0) { b = idx / TB; p = idx - b * TB; } else { b = idx / SEQ; p = NCTX + idx - b * SEQ; }
        const int row = b * TB + p; const bool isc = p < NCTX; const int sel = isc ? 16 : b;
        float* xo = isc ? XCb + (size_t)(b * NCTX + p) * D : outb + (size_t)(b * SEQ + p - NCTX) * D;
        const float* xi = (l == 0) ? (isc ? cin + (size_t)(b * NCTX + p) * D : xin + (size_t)(b * SEQ + p - NCTX) * D) : xo;
        f32x4 v[4], y[4], h[4]; ld_row_f32(xi, F.lane, v); ld_row_bf16(YB + (size_t)row * D, F.lane, y);
        const float* g1 = modp(MODb, l, sel, 2);
#pragma unroll
        for (int j = 0; j < 4; ++j) { const f32x4 gg = *((const GAS f32x4*)g1 + F.lane + 64 * j); v[j] = v[j] + gg * y[j]; }
        if (!dry) st_row_f32(xo, F.lane, v);
        norm_mod(v, n2g, modp(MODb, l, sel, 3), modp(MODb, l, sel, 4), F.lane, h);
        if (!dry) st_row_fp8(H8b + (size_t)row * D, F.lane, h);
        float lg[16]; LAS float* rwl = rw; asm volatile("" : "+v"(rwl));
#pragma unroll
        for (int e = 0; e < 16; ++e) { float a = 0.f;
#pragma unroll
            for (int j = 0; j < 4; ++j) { const f32x4 wv = *(const LAS f32x4*)(rwl + e * 1024 + 256 * j + 4 * F.lane); a += (h[j][0] * wv[0] + h[j][1] * wv[1]) + (h[j][2] * wv[2] + h[j][3] * wv[3]); }
            lg[e] = wave_sum(a); }
        float s[16], sl[16];
#pragma unroll
        for (int e = 0; e < 16; ++e) { s[e] = 1.0f / (1.0f + __expf(-lg[e])); sl[e] = s[e] + rb[e]; }
        float bestg = -INFINITY; int gi = 0;
#pragma unroll
        for (int g = 0; g < 4; ++g) { float m1 = -INFINITY, m2 = -INFINITY;
#pragma unroll
            for (int k = 0; k < 4; ++k) { const float t = sl[4 * g + k]; if (t > m1) { m2 = m1; m1 = t; } else if (t > m2) m2 = t; }
            const float gs = m1 + m2; if (gs > bestg) { bestg = gs; gi = g; } }
        float c4[4], s4[4];
#pragma unroll
        for (int k = 0; k < 4; ++k) { c4[k] = gi == 0 ? sl[k] : gi == 1 ? sl[4 + k] : gi == 2 ? sl[8 + k] : sl[12 + k]; s4[k] = gi == 0 ? s[k] : gi == 1 ? s[4 + k] : gi == 2 ? s[8 + k] : s[12 + k]; }
        int i0 = 0; float v0 = c4[0], w0 = s4[0];
#pragma unroll
        for (int k = 1; k < 4; ++k) if (c4[k] > v0) { v0 = c4[k]; i0 = k; w0 = s4[k]; }
        int i1 = -1; float v1 = -INFINITY, w1 = 0.f;
#pragma unroll
        for (int k = 0; k < 4; ++k) if (k != i0 && c4[k] > v1) { v1 = c4[k]; i1 = k; w1 = s4[k]; }
        const float wsum = w0 + w1; w0 /= wsum; w1 /= wsum;
        const int e0 = 4 * gi + i0, e1 = 4 * gi + i1;
        if (F.lane == 0 && !dry) {
            const unsigned sl0 = __hip_atomic_fetch_add(cnt + e0, 1u, RLX_AGENT), sl1 = __hip_atomic_fetch_add(cnt + e1, 1u, RLX_AGENT);
            u32x4 r0 = {(unsigned)e0, sl0, (unsigned)e1, sl1}; u32x4 r1 = {__float_as_uint(w0), __float_as_uint(w1), 0u, 0u};
            *(GAS u32x4*)(RT + (size_t)row * 8) = r0; *(GAS u32x4*)(RT + (size_t)row * 8 + 4) = r1;
        }
    }
    __syncthreads();
}

__device__ __forceinline__ void build_ptab(Frame& F, int l, LAS int* ptab) {
    if (F.tid == 0) { int acc = 0; gu32* cntb = F.ctl() + CW_CNT + l * 64;
        for (int e = 0; e < NE; ++e) { ptab[e] = acc; const int c = (int)__hip_atomic_load(cntb + e, RLX_AGENT); acc += ((c + 255) >> 8) << 8; }
        ptab[NE] = acc; }
    __syncthreads();
}
__device__ __forceinline__ void gather_phase(Frame& F, int l, LAS int* ptab) {
    const int nrows = l == 0 ? T : NB * SEQ;
    const unsigned* RT = F.ROUTE(); const unsigned char* Ab = F.H8(); unsigned char* HGb = F.HG();
    for (int idx = F.gw; idx < nrows; idx += F.NGW) {
        int row; if (l == 0) row = idx; else { const int b = idx / SEQ; row = b * TB + NCTX + idx - b * SEQ; }
        const u32x4 r0 = *(const GAS u32x4*)(RT + (size_t)row * 8);
        const size_t p0 = (size_t)ptab[r0.x] + r0.y, p1 = (size_t)ptab[r0.z] + r0.w;
        const GAS u32x4* src = (const GAS u32x4*)(Ab + (size_t)row * D) + F.lane;
        const u32x4 a = src[0];
        *((GAS u32x4*)(HGb + p0 * D) + F.lane) = a; *((GAS u32x4*)(HGb + p1 * D) + F.lane) = a;
    }
}
__device__ __forceinline__ void r3_phase(Frame& F, int l, LAS int* ptab, bool dry = false) {
    const int nrows = l == 0 ? T : NB * SEQ;
    const float* MODb = F.MOD(); float* XCb = F.XC(); float* outb = F.out(); const bf16_t* YPb = F.YP(); bf16_t* Ab = F.A(); const unsigned* RT = F.ROUTE();
    const float* n1g = F.norm1_g() + (size_t)(l == 0 ? 1 : 0) * D;
    for (int idx = F.gw; idx < nrows; idx += F.NGW) {
        int b, p; if (l == 0) { b = idx / TB; p = idx - b * TB; } else { b = idx / SEQ; p = NCTX + idx - b * SEQ; }
        const int row = b * TB + p; const bool isc = p < NCTX; const int sel = isc ? 16 : b;
        const u32x4 r0 = *(const GAS u32x4*)(RT + (size_t)row * 8); const u32x2 r1 = *(const GAS u32x2*)(RT + (size_t)row * 8 + 4);
        const size_t p0 = (size_t)ptab[r0.x] + r0.y, p1 = (size_t)ptab[r0.z] + r0.w; const float w0 = __uint_as_float(r1.x), w1 = __uint_as_float(r1.y);
        float* xo = isc ? XCb + (size_t)(b * NCTX + p) * D : outb + (size_t)(b * SEQ + p - NCTX) * D;
        f32x4 v[4], y0[4], y1[4], h[4]; ld_row_f32(xo, F.lane, v); ld_row_bf16(YPb + p0 * D, F.lane, y0); ld_row_bf16(YPb + p1 * D, F.lane, y1);
        const float* g2 = modp(MODb, l, sel, 5);
#pragma unroll
        for (int j = 0; j < 4; ++j) { const f32x4 gg = *((const GAS f32x4*)g2 + F.lane + 64 * j); v[j] = v[j] + gg * (y0[j] * w0 + y1[j] * w1); }
        if (!isc && !dry) st_row_f32(xo, F.lane, v);
        if (l == 0) { norm_mod(v, n1g, modp(MODb, l + 1, sel, 0), modp(MODb, l + 1, sel, 1), F.lane, h); if (!dry) st_row_bf16(Ab + (size_t)row * D, F.lane, h); }
    }
}

struct SchedProj {
    const char* A; const char* B; int G, c;
    __device__ __forceinline__ bool next(int i, pg8::Unit& u) const { int pm, pn; if (!pg8::tile_order((long)i * G + c, T / 256, NIN / 256, pm, pn)) return false;
        u.pm = pm; u.pn = pn; u.aux = 0; u.A = A + (size_t)pm * 256 * D * 2; u.B = B + (size_t)pn * 256 * D * 2; return true; }
};
__device__ __forceinline__ int lat_tile(int pe) { return (pe >> 4) * 17 + 1 + (pe & 15); }
struct SchedMerge {
    const char* P; const char* B; int G, c, nM; bool lat_only;
    __device__ __forceinline__ bool next(int i, pg8::Unit& u) const { const int rnd = i / 3, br = i - rnd * 3; int pm, pn; if (!pg8::tile_order((long)rnd * G + c, nM, 4, pm, pn)) return false;
        if (lat_only) pm = lat_tile(pm);
        const int acol = br == 0 ? C_GR : (br == 1 ? C_GQ : C_WQ);
        u.pm = pm; u.pn = pn; u.aux = br; u.A = P + ((size_t)pm * 256 * NIN + acol) * 2; u.B = B + ((size_t)br * D + pn * 256) * 512 * 2; return true; }
};
struct SchedOut {
    const char* A; const char* B; int G, c, nM; bool lat_only;
    __device__ __forceinline__ bool next(int i, pg8::Unit& u) const { int pm, pn; if (!pg8::tile_order((long)i * G + c, nM, 4, pm, pn)) return false;
        if (lat_only) pm = lat_tile(pm);
        u.pm = pm; u.pn = pn; u.aux = 0; u.A = A + (size_t)pm * 256 * D * 2; u.B = B + (size_t)pn * 256 * D * 2; return true; }
};
struct SchedMoe {
    const char* A; const char* B; const LAS int* ptab; int G, c, npn;
    __device__ __forceinline__ bool next(int i, pg8::Unit& u) const { const int L = i * G + c; const int ntile = ptab[NE] >> 8; if (L >= ntile * npn) return false;
        const int j = L / npn, pn = L - j * npn; int e = 0;
#pragma unroll
        for (int k = 1; k < NE; ++k) e += (ptab[k] <= j * 256) ? 1 : 0;
        u.pm = j; u.pn = pn; u.aux = e; u.A = A + (size_t)j * 256 * D; u.B = B + ((size_t)e * npn + pn) * 256 * D; return true; }
};

#ifndef PROBE
#define PROBE 0
#endif
static_assert(sizeof(Args) == sizeof(KArgs), "kernarg views");
__global__ void __launch_bounds__(NWAVES * 64, 2) mega_fwd(Args args) {
    extern __shared__ __attribute__((aligned(16))) unsigned char lds[];
    volatile LAS unsigned* MISC = (volatile LAS unsigned*)((LAS unsigned char*)lds + MISC_OFF);
    LAS int* ptab = (LAS int*)((LAS unsigned char*)lds + LDSCTL_OFF);
    Frame F0; {
    Frame& F = F0;
    F.lds = (LAS unsigned char*)lds;
    F.tid = threadIdx.x; F.lane = F.tid & 63; F.wave = __builtin_amdgcn_readfirstlane(F.tid >> 6);
    F.G = gridDim.x; { const int bx = blockIdx.x; F.vcu = (F.G % 8 == 0) ? (bx % 8) * (F.G / 8) + bx / 8 : bx; }
    F.gw = F.vcu * NWAVES + F.wave; F.NGW = F.G * NWAVES; F.bid = blockIdx.x; }
    for (int u = F0.tid; u < (LDS_BYTES - LDSCTL_OFF) / 4; u += NWAVES * 64) ((LAS unsigned*)(F0.lds + LDSCTL_OFF))[u] = 0u;
    __syncthreads();
    XcdBarrier bar = xcd_barrier_post((unsigned*)(F0.ctl() + CW_BAR), MISC + 8);
#define GRID_BAR() do { XcdBarrier b_ = bar; asm volatile("" : "+s"(b_.bar), "+s"(b_.x)); xcd_barrier(b_); } while (0)

    { Frame F = fresh(F0); p0_prologue(F); }
    if (PROBE == 13) { __syncthreads(); Frame F = fresh(F0); p0_prologue(F); }
    GRID_BAR();
    { Frame F = fresh(F0); r1_phase(F); }
    if (PROBE == 17) { Frame F = fresh(F0); r1_phase(F); }
    GRID_BAR();

    for (int l = 0; l < NL; ++l) {
        const bool last = (l == NL - 1);
        { Frame F = fresh(F0);
            pg8::Gemm g{D / 64, D * 2, D * 2}; SchedProj S{(const char*)F.A(), (const char*)(F.WIN() + (size_t)l * NIN * D), F.G, F.bid};
            pg8::EpiProj E{F.PROJ(), F.b_merge() + (size_t)l * 3 * D};
            pg8::gemm_phase(F.lds + RING_OFF, g, S, E);
            if (PROBE == 1) { __syncthreads(); pg8::gemm_phase(F.lds + RING_OFF, g, S, E); }
        }
        GRID_BAR();
        if (PROBE == 14) { Frame F = fresh(F0); kfix_phase(F, l, __hip_atomic_load(F.ctl() + 8, RLX_AGENT) == 0u); }
        { Frame F = fresh(F0); kfix_phase(F, l); }
        GRID_BAR();
        if (PROBE == 4) { Frame F = fresh(F0); const bool dry = __hip_atomic_load(F.ctl() + 8, RLX_AGENT) == 0u; for (int uid = F.vcu; uid < 256; uid += F.G) scan_unit(F, l, uid, last, dry); __syncthreads(); }
        { Frame F = fresh(F0); for (int uid = F.vcu; uid < 256; uid += F.G) scan_unit(F, l, uid, last); }
        __syncthreads();
        { Frame F = fresh(F0);
            const int per = (2048 + F.G - 1) / F.G;
            attn_body::AttnArgs aa; aa.P = (attn_body::bf16*)F.PROJ(); aa.ropec = F.ROPEC(); aa.ropes = F.ROPES(); aa.dry = false;
            aa.qg = F.q_norm_g() + (size_t)(l * 2 + 0) * 64; aa.sink = 0.f;
            if (PROBE == 11) { aa.dry = __hip_atomic_load(F.ctl() + 8, RLX_AGENT) == 0u; for (int gid = F.vcu * per; gid < (F.vcu + 1) * per && gid < 2048; ++gid) { const int pair = gid >> 6, uu = gid & 63; const int b = pair >> 1, h = (pair & 1) * 4 + (uu >> 4), qb = uu & 15;
                attn_body::attn_unit<0, 8>(b, h, qb, aa, (char*)lds + RING_OFF); } aa.dry = false; }
            if (PROBE != 9) for (int gid = F.vcu * per; gid < (F.vcu + 1) * per && gid < 2048; ++gid) { const int pair = gid >> 6, uu = gid & 63; const int b = pair >> 1, h = (pair & 1) * 4 + (uu >> 4), qb = uu & 15;
                attn_body::attn_unit<0, 8>(b, h, qb, aa, (char*)lds + RING_OFF); }
            aa.qg = F.q_norm_g() + (size_t)(l * 2 + 1) * 64;
            if (PROBE == 12) { aa.dry = __hip_atomic_load(F.ctl() + 8, RLX_AGENT) == 0u; for (int gid = F.vcu * per; gid < (F.vcu + 1) * per && gid < 2048; ++gid) { const int pair = gid >> 6, uu = gid & 63; const int b = pair >> 1, h = (pair & 1) * 4 + (uu >> 4), qb = uu & 15;
                aa.sink = 0.f; attn_body::attn_unit<1, 8>(b, h, qb, aa, (char*)lds + RING_OFF); } aa.dry = false; }
            if (PROBE != 10) for (int gid = F.vcu * per; gid < (F.vcu + 1) * per && gid < 2048; ++gid) { const int pair = gid >> 6, uu = gid & 63; const int b = pair >> 1, h = (pair & 1) * 4 + (uu >> 4), qb = uu & 15;
                aa.sink = F.sink()[l * 8 + h];
                attn_body::attn_unit<1, 8>(b, h, qb, aa, (char*)lds + RING_OFF); }
            if (!last) {
                for (int cid = F.vcu; cid < 256; cid += F.G) { const int b = cid >> 4, h = (cid >> 1) & 7;
                    if (cid & 1) { aa.qg = F.q_norm_g() + (size_t)(l * 2 + 1) * 64; aa.sink = F.sink()[l * 8 + h]; attn_body::attn_unit<3, 8>(b, h, 0, aa, (char*)lds + RING_OFF); }
                    else { aa.qg = F.q_norm_g() + (size_t)(l * 2 + 0) * 64; aa.sink = 0.f; attn_body::attn_unit<2, 8>(b, h, 0, aa, (char*)lds + RING_OFF); } }
            }
        }
        GRID_BAR();
        { Frame F = fresh(F0);
            pg8::Gemm g{512 / 64, NIN * 2, 512 * 2}; SchedMerge S{(const char*)F.PROJ(), (const char*)(F.WBR() + (size_t)l * 3 * D * 512), F.G, F.bid, last ? 256 : 272, last};
            pg8::EpiMerge E{F.PROJ(), F.A()};
            pg8::gemm_phase(F.lds + RING_OFF, g, S, E);
            if (PROBE == 2) { __syncthreads(); pg8::gemm_phase(F.lds + RING_OFF, g, S, E); }
        }
        GRID_BAR();
        { Frame F = fresh(F0);
            pg8::Gemm g{D / 64, D * 2, D * 2}; SchedOut S{(const char*)F.A(), (const char*)(F.WOUT() + (size_t)l * D * D), F.G, F.bid, last ? 256 : 272, last};
            pg8::EpiPlain E{F.YBUF(), D, 1.0f};
            pg8::gemm_phase(F.lds + RING_OFF, g, S, E);
            if (PROBE == 3) { __syncthreads(); pg8::gemm_phase(F.lds + RING_OFF, g, S, E); }
        }
        GRID_BAR();
        { Frame F = fresh(F0); convert_experts(F, l); }
        __syncthreads();
        if (PROBE == 7) { Frame F = fresh(F0); convert_experts(F, l); __syncthreads(); }
        if (PROBE == 15) { Frame F = fresh(F0); r2_phase(F, l, __hip_atomic_load(F.ctl() + 8, RLX_AGENT) == 0u); }
        { Frame F = fresh(F0); r2_phase(F, l); }
        GRID_BAR();
        { Frame F = fresh(F0); build_ptab(F, l, ptab); gather_phase(F, l, ptab); if (PROBE == 8) gather_phase(F, l, ptab); }
        GRID_BAR();
        { Frame F = fresh(F0);
            pg8::Gemm g{D / 128, D, D}; SchedMoe S{(const char*)F.HG(), (const char*)F.W13(), ptab, F.G, F.bid, 8};
            pg8::EpiSwiglu E{F.HID(), 1.0f / WSCALE};
            pg8::gemm_phase<pg8::EpiSwiglu, SchedMoe, true>(F.lds + RING_OFF, g, S, E);
            if (PROBE == 5) { __syncthreads(); pg8::gemm_phase<pg8::EpiSwiglu, SchedMoe, true>(F.lds + RING_OFF, g, S, E); }
        }
        GRID_BAR();
        { Frame F = fresh(F0);
            pg8::Gemm g{D / 128, D, D}; SchedMoe S{(const char*)F.HID(), (const char*)F.W2(), ptab, F.G, F.bid, 4};
            pg8::EpiPlain E{F.YP(), D, 1.0f / WSCALE};
            pg8::gemm_phase<pg8::EpiPlain, SchedMoe, true>(F.lds + RING_OFF, g, S, E);
            if (PROBE == 6) { __syncthreads(); pg8::gemm_phase<pg8::EpiPlain, SchedMoe, true>(F.lds + RING_OFF, g, S, E); }
        }
        GRID_BAR();
        if (PROBE == 16) { Frame F = fresh(F0); r3_phase(F, l, ptab, __hip_atomic_load(F.ctl() + 8, RLX_AGENT) == 0u); }
        { Frame F = fresh(F0); r3_phase(F, l, ptab); }
        if (!last) GRID_BAR();
    }
}

extern "C" void kernel_launch(void* const* d_in, const int* in_sizes, int n_in, void* d_out, int out_size, void* d_ws, size_t ws_size, hipStream_t stream) {
    static int grid = 0;
    if (grid == 0) {
        if (n_in != 27 || in_sizes[0] != NB * SEQ * D || out_size != NB * SEQ * D || ws_size < WS_END) { fprintf(stderr, "kernel_launch: unexpected shapes / workspace (n_in %d, ws %zu < %zu)\n", n_in, ws_size, (size_t)WS_END); grid = -1; return; }
        int dev = 0, cus = 0, per_cu = 0;
        if (hipGetDevice(&dev) != hipSuccess || hipDeviceGetAttribute(&cus, hipDeviceAttributeMultiprocessorCount, dev) != hipSuccess) { grid = -1; return; }
        if (hipFuncSetAttribute((const void*)mega_fwd, hipFuncAttributeMaxDynamicSharedMemorySize, LDS_BYTES) != hipSuccess) { fprintf(stderr, "kernel_launch: hipFuncSetAttribute failed\n"); grid = -1; return; }
        if (hipOccupancyMaxActiveBlocksPerMultiprocessor(&per_cu, (const void*)mega_fwd, NWAVES * 64, LDS_BYTES) != hipSuccess || per_cu < 1) { fprintf(stderr, "kernel_launch: occupancy query says %d\n", per_cu); }
        (void)hipGetLastError();
        grid = cus;
    }
    if (grid < 0) return;
    if (hipMemsetAsync((char*)d_ws + WS_CTL, 0, CTL_ZERO_BYTES, stream) != hipSuccess) return;
    Args a{};
    for (int i = 0; i < 27; ++i) a.in[i] = (const float*)d_in[i];
    a.out = (float*)d_out; a.ws = (unsigned char*)d_ws;
    hipLaunchKernelGGL(mega_fwd, dim3(grid), dim3(NWAVES * 64), LDS_BYTES, stream, a);
}
```

```cpp
#define PROBE 0
#include <hip/hip_runtime.h>
#include <hip/hip_bf16.h>
#include <cstdio>
#include <cstdint>
#include <cmath>

#define GAS __attribute__((address_space(1)))
#define LAS __attribute__((address_space(3)))
typedef unsigned short bf16_t;
typedef short bf16x8 __attribute__((ext_vector_type(8)));
typedef float f32x4 __attribute__((ext_vector_type(4)));
typedef float f32x2 __attribute__((ext_vector_type(2)));
typedef unsigned u32x4 __attribute__((ext_vector_type(4)));
typedef unsigned u32x2 __attribute__((ext_vector_type(2)));

constexpr int NB = 16, SEQ = 4096, NCTX = 256, TB = SEQ + NCTX, T = NB * TB;
constexpr int D = 1024, NIN = 5632, NL = 2, NE = 16;
constexpr int C_XR = 0, C_GR = 512, C_GQ = 1024, C_GK = 1536, C_GV = 1664, C_WQ = 1792, C_WK = 2304, C_WV = 2432, C_MG = 2560;
constexpr float EPS = 1e-6f;
constexpr int PMAX = 143360;

__device__ __forceinline__ unsigned cvt_pk_bf16(float lo, float hi) { unsigned r; asm volatile("v_cvt_pk_bf16_f32 %0, %1, %2" : "=v"(r) : "v"(lo), "v"(hi)); return r; }
typedef int i32x8 __attribute__((ext_vector_type(8)));
typedef int i32x4 __attribute__((ext_vector_type(4)));
__device__ __forceinline__ unsigned pk4_fp8(float a, float b, float c, float d) {
    a = __builtin_fminf(__builtin_fmaxf(a, -448.f), 448.f); b = __builtin_fminf(__builtin_fmaxf(b, -448.f), 448.f); c = __builtin_fminf(__builtin_fmaxf(c, -448.f), 448.f); d = __builtin_fminf(__builtin_fmaxf(d, -448.f), 448.f);
    int w = __builtin_amdgcn_cvt_pk_fp8_f32(a, b, 0, false); w = __builtin_amdgcn_cvt_pk_fp8_f32(c, d, w, true); return (unsigned)w; }
__device__ __forceinline__ float bf_lo(unsigned u) { return __uint_as_float(u << 16); }
__device__ __forceinline__ float bf_hi(unsigned u) { return __uint_as_float(u & 0xffff0000u); }
__device__ __forceinline__ float fast_sigmoid(float v) { return __builtin_amdgcn_rcpf(1.0f + __builtin_amdgcn_exp2f(-1.4426950409f * v)); }
__device__ __forceinline__ float gelu_tanh(float v) { return v * __builtin_amdgcn_rcpf(1.0f + __builtin_amdgcn_exp2f(-2.3022082f * v * (1.0f + 0.044715f * v * v))); }

namespace pg8 {
constexpr int BM = 256, BK = 64, HALF = 128, HTB = HALF * BK * 2, STAGE_BYTES = 8 * HTB, NXCD = 8, WGM = 8;
__host__ __device__ __forceinline__ int lds_byte(int r, int c) { const int st = (r >> 4) * 2 + (c >> 5), rr = r & 15, cc = c & 31, ob = rr * 64 + cc * 2; return st * 1024 + (ob ^ (((ob >> 9) & 1) << 5)); }
__host__ __device__ __forceinline__ void stage_rc(int b, int& R, int& C) { const int st = b / 1024, sb = b % 1024, swz = sb ^ (((sb >> 9) & 1) << 5); R = (st >> 1) * 16 + swz / 64; C = (st & 1) * 32 + (swz % 64) / 2; }
__host__ __device__ __forceinline__ int perm32(int rho) { const int n = rho >> 4, i = rho & 15; return 8 * (i >> 2) + 4 * n + (i & 3); }

struct Unit { int pm, pn, aux; const char* A; const char* B; };
struct Gemm { int nt, ldaB, ldbB; };

__device__ __forceinline__ bool tile_order(long L, int nM, int nN, int& pm, int& pn) {
    const int nwg = nM * nN; if (L >= nwg) return false;
    int wgid = (int)L; { const int q = nwg / NXCD, r = nwg % NXCD, xcd = wgid % NXCD, off = wgid / NXCD; wgid = (xcd < r ? xcd * (q + 1) : r * (q + 1) + (xcd - r) * q) + off; }
    const int nig = WGM * nN, gid = wgid / nig, fm = gid * WGM, gsz = (nM - fm) < WGM ? (nM - fm) : WGM;
    pm = fm + ((wgid % nig) % gsz); pn = (wgid % nig) / gsz; return true;
}

template <class Epi, class Sched, bool FP8 = false>
__device__ __forceinline__ void gemm_phase(LAS unsigned char* lds, const Gemm g, const Sched& S, const Epi& E) {
    int tid_ = threadIdx.x; asm volatile("" : "+v"(tid_));
    const int tid = tid_, wid = __builtin_amdgcn_readfirstlane(tid >> 6), lane = tid & 63, wr = wid >> 2, wc = wid & 3, fr = lane & 15, fq = lane >> 4;
    int nt_ = g.nt; asm volatile("" : "+s"(nt_)); const int nt = nt_;
    unsigned voffA[2], voffB[2];
#pragma unroll
    for (int i = 0; i < 2; ++i) { int R, C; stage_rc(tid * 16 + i * 8192, R, C); const int Rb = (R & ~31) + perm32(R & 31);
        voffA[i] = (unsigned)(R * g.ldaB + C * 2); voffB[i] = (unsigned)(Rb * g.ldbB + C * 2); }
    const size_t kstep = (size_t)(BK * 2);
    const size_t hstepA = (size_t)HALF * g.ldaB, hstepB = (size_t)HALF * g.ldbB;
    const unsigned ldsw = (unsigned)wid * 1024u;
    const int aoff = lds_byte(wr * 64 + fr, fq * 8), boff = lds_byte(wc * 32 + fr, fq * 8);
#define PG8_SA(b, h) (((b) * 2 + (h)) * HTB)
#define PG8_SB(b, h) ((4 + (b) * 2 + (h)) * HTB)
#define PG8_STAGE(bufoff, gbase, voff) do { _Pragma("unroll") for (int _i = 0; _i < 2; ++_i) \
        __builtin_amdgcn_global_load_lds((const unsigned*)((const char*)(gbase) + (voff)[_i]), (LAS unsigned*)(lds + (bufoff) + ldsw + _i * 8192), 16, 0, 0); } while (0)
#define PG8_LDA(dst, b, h) do { _Pragma("unroll") for (int m = 0; m < 4; ++m) _Pragma("unroll") for (int k = 0; k < 2; ++k) dst[m][k] = *(const LAS bf16x8*)(lds + PG8_SA(b, h) + aoff + m * 2048 + k * 1024); } while (0)
#define PG8_LDB(dst, b, h) do { _Pragma("unroll") for (int n = 0; n < 2; ++n) _Pragma("unroll") for (int k = 0; k < 2; ++k) dst[n][k] = *(const LAS bf16x8*)(lds + PG8_SB(b, h) + boff + n * 2048 + k * 1024); } while (0)
#define PG8_CAT(x) __builtin_shufflevector(__builtin_bit_cast(i32x4, x[0]), __builtin_bit_cast(i32x4, x[1]), 0, 1, 2, 3, 4, 5, 6, 7)
#define PG8_MMA(ai, bj, At, Bt) do { __builtin_amdgcn_s_setprio(1); \
        if constexpr (FP8) { _Pragma("unroll") for (int m = 0; m < 4; ++m) _Pragma("unroll") for (int n = 0; n < 2; ++n) \
            asm volatile("v_mfma_scale_f32_16x16x128_f8f6f4 %0, %1, %2, %0, %3, %3 op_sel_hi:[0,0,0]" : "+v"(acc[ai][bj][m][n]) : "v"(PG8_CAT(Bt[n])), "v"(PG8_CAT(At[m])), "v"(scl1)); } \
        else { _Pragma("unroll") for (int m = 0; m < 4; ++m) _Pragma("unroll") for (int n = 0; n < 2; ++n) _Pragma("unroll") for (int k = 0; k < 2; ++k) \
            acc[ai][bj][m][n] = __builtin_amdgcn_mfma_f32_16x16x32_bf16(Bt[n][k], At[m][k], acc[ai][bj][m][n], 0, 0, 0); } \
        __builtin_amdgcn_s_setprio(0); } while (0)
#define PG8_WAIT_V(n) asm volatile("s_waitcnt vmcnt(" #n ")" ::: "memory")
#define PG8_WAIT_L(n) asm volatile("s_waitcnt lgkmcnt(" #n ")" ::: "memory")
#define PG8_BAR __builtin_amdgcn_s_barrier()
#define PG8_SCHED __builtin_amdgcn_sched_barrier(0)
    int scl1 = 0x7F7F7F7F; asm volatile("" : "+v"(scl1));
    Unit cur, nxt; int ui = 0;
    if (!S.next(0, cur)) return;
    f32x4 acc[2][2][4][2];
#pragma unroll
    for (int a = 0; a < 2; ++a)
#pragma unroll
        for (int b = 0; b < 2; ++b)
#pragma unroll
            for (int m = 0; m < 4; ++m)
#pragma unroll
                for (int n = 0; n < 2; ++n) acc[a][b][m][n] = (f32x4){0.f, 0.f, 0.f, 0.f};
    bf16x8 At[4][2], B0[2][2], B1[2][2];
    const char* cA = cur.A; const char* cB = cur.B;
    PG8_STAGE(PG8_SB(0, 0), cB, voffB); PG8_STAGE(PG8_SB(0, 1), cB + hstepB, voffB); PG8_STAGE(PG8_SA(0, 0), cA, voffA); PG8_STAGE(PG8_SA(0, 1), cA + hstepA, voffA);
    if (wr == 1) PG8_BAR;
    PG8_WAIT_V(2); PG8_BAR;
    PG8_STAGE(PG8_SB(1, 0), cB + kstep, voffB); PG8_STAGE(PG8_SA(1, 0), cA + kstep, voffA); PG8_STAGE(PG8_SB(1, 1), cB + hstepB + kstep, voffB);
    PG8_WAIT_V(6); PG8_BAR;
    for (;;) {
        const bool has_next = S.next(ui + 1, nxt);
        const char* nA = has_next ? nxt.A : cA; const char* nB = has_next ? nxt.B : cB;
        for (int t = 0; t < nt; t += 2) {
            const bool last = (t == nt - 2);
            const char* a1 = cA + (size_t)(t + 1) * kstep;
            const char* a2 = last ? nA : cA + (size_t)(t + 2) * kstep; const char* b2 = last ? nB : cB + (size_t)(t + 2) * kstep;
            const char* a3 = a2 + kstep; const char* b3 = b2 + kstep;
            PG8_LDB(B0, 0, 0); PG8_LDB(B1, 0, 1); PG8_SCHED; PG8_LDA(At, 0, 0); PG8_STAGE(PG8_SA(1, 1), a1 + hstepA, voffA);
            PG8_WAIT_V(8); PG8_WAIT_L(0); PG8_BAR; PG8_MMA(0, 0, At, B0); PG8_MMA(0, 1, At, B1); PG8_BAR; PG8_SCHED;
            PG8_LDA(At, 0, 1); PG8_STAGE(PG8_SB(0, 0), b2, voffB); PG8_STAGE(PG8_SB(0, 1), b2 + hstepB, voffB); PG8_STAGE(PG8_SA(0, 0), a2, voffA);
            PG8_WAIT_V(8); PG8_WAIT_L(0); PG8_BAR; PG8_MMA(1, 0, At, B0); PG8_MMA(1, 1, At, B1); PG8_BAR; PG8_SCHED;
            PG8_LDB(B0, 1, 0); PG8_LDB(B1, 1, 1); PG8_SCHED; PG8_LDA(At, 1, 0); PG8_STAGE(PG8_SA(0, 1), a2 + hstepA, voffA);
            PG8_WAIT_V(8); PG8_WAIT_L(0); PG8_BAR; PG8_MMA(0, 0, At, B0); PG8_MMA(0, 1, At, B1); PG8_BAR; PG8_SCHED;
            PG8_LDA(At, 1, 1); PG8_STAGE(PG8_SB(1, 0), b3, voffB); PG8_STAGE(PG8_SB(1, 1), b3 + hstepB, voffB); PG8_STAGE(PG8_SA(1, 0), a3, voffA);
            PG8_WAIT_V(8); PG8_WAIT_L(0); PG8_BAR; PG8_MMA(1, 0, At, B0); PG8_MMA(1, 1, At, B1); PG8_BAR; PG8_SCHED;
        }
        if (wr == 0) PG8_BAR;
        if constexpr (FP8) asm volatile("s_nop 15\n\ts_nop 15" ::: "memory");
        E(acc, cur, wr, wc, fr, fq);
        if (!has_next) break;
#pragma unroll
        for (int a = 0; a < 2; ++a)
#pragma unroll
            for (int b = 0; b < 2; ++b)
#pragma unroll
                for (int m = 0; m < 4; ++m)
#pragma unroll
                    for (int n = 0; n < 2; ++n) acc[a][b][m][n] = (f32x4){0.f, 0.f, 0.f, 0.f};
        cur = nxt; cA = nA; cB = nB; ++ui;
        if (wr == 1) PG8_BAR;
    }
    PG8_WAIT_V(0);
    PG8_BAR;
#undef PG8_SA
#undef PG8_SB
#undef PG8_STAGE
#undef PG8_LDA
#undef PG8_LDB
#undef PG8_MMA
#undef PG8_CAT
#undef PG8_WAIT_V
#undef PG8_WAIT_L
#undef PG8_BAR
#undef PG8_SCHED
}

struct EpiProj {
    bf16_t* O; const float* bmerge;
    __device__ __forceinline__ void operator()(const f32x4 (&acc)[2][2][4][2], const Unit& u, int wr, int wc, int fr, int fq) const {
        const int row0 = u.pm * BM + wr * 64 + fr, col0 = u.pn * BM + wc * 32 + 8 * fq;
        const int mode = (u.pn == 2 || u.pn == 3) ? 1 : (u.pn >= 10 ? 2 : 0);
        f32x4 bv[2][2];
#pragma unroll
        for (int bj = 0; bj < 2; ++bj)
#pragma unroll
            for (int n = 0; n < 2; ++n) bv[bj][n] = (mode == 2) ? *(const f32x4*)(bmerge + (col0 - C_MG) + bj * HALF + 4 * n) : (f32x4){0.f, 0.f, 0.f, 0.f};
#pragma unroll
        for (int ai = 0; ai < 2; ++ai)
#pragma unroll
            for (int m = 0; m < 4; ++m) { bf16_t* rowp = O + (size_t)(row0 + ai * HALF + m * 16) * NIN + col0;
#pragma unroll
                for (int bj = 0; bj < 2; ++bj) { f32x4 v0 = acc[ai][bj][m][0] + bv[bj][0], v1 = acc[ai][bj][m][1] + bv[bj][1];
                    if (mode == 1) {
#pragma unroll
                        for (int j = 0; j < 4; ++j) { v0[j] = gelu_tanh(v0[j]); v1[j] = gelu_tanh(v1[j]); } }
                    else if (mode == 2) {
#pragma unroll
                        for (int j = 0; j < 4; ++j) { v0[j] = fast_sigmoid(v0[j]); v1[j] = fast_sigmoid(v1[j]); } }
                    u32x4 w; w.x = cvt_pk_bf16(v0[0], v0[1]); w.y = cvt_pk_bf16(v0[2], v0[3]); w.z = cvt_pk_bf16(v1[0], v1[1]); w.w = cvt_pk_bf16(v1[2], v1[3]);
                    *(u32x4*)(rowp + bj * HALF) = w; } }
    }
};
struct EpiPlain {
    bf16_t* O; int ldc; float scale;
    __device__ __forceinline__ void operator()(const f32x4 (&acc)[2][2][4][2], const Unit& u, int wr, int wc, int fr, int fq) const {
        const int row0 = u.pm * BM + wr * 64 + fr, col0 = u.pn * BM + wc * 32 + 8 * fq;
#pragma unroll
        for (int ai = 0; ai < 2; ++ai)
#pragma unroll
            for (int m = 0; m < 4; ++m) { bf16_t* rowp = O + (size_t)(row0 + ai * HALF + m * 16) * ldc + col0;
#pragma unroll
                for (int bj = 0; bj < 2; ++bj) { const f32x4 v0 = acc[ai][bj][m][0] * scale, v1 = acc[ai][bj][m][1] * scale;
                    u32x4 w; w.x = cvt_pk_bf16(v0[0], v0[1]); w.y = cvt_pk_bf16(v0[2], v0[3]); w.z = cvt_pk_bf16(v1[0], v1[1]); w.w = cvt_pk_bf16(v1[2], v1[3]);
                    *(u32x4*)(rowp + bj * HALF) = w; } }
    }
};
struct EpiMerge {
    const bf16_t* P; bf16_t* O;
    __device__ __forceinline__ void operator()(const f32x4 (&acc)[2][2][4][2], const Unit& u, int wr, int wc, int fr, int fq) const {
        const int row0 = u.pm * BM + wr * 64 + fr, col0 = u.pn * BM + wc * 32 + 8 * fq; const int b = u.aux;
#pragma unroll
        for (int ai = 0; ai < 2; ++ai)
#pragma unroll
            for (int m = 0; m < 4; ++m) { const size_t row = (size_t)(row0 + ai * HALF + m * 16);
                const bf16_t* gp = P + row * NIN + C_MG + b * D + col0; bf16_t* op = O + row * D + col0;
#pragma unroll
                for (int bj = 0; bj < 2; ++bj) { const u32x4 gt = *(const u32x4*)(gp + bj * HALF);
                    f32x4 v0 = acc[ai][bj][m][0], v1 = acc[ai][bj][m][1];
                    v0[0] *= bf_lo(gt.x); v0[1] *= bf_hi(gt.x); v0[2] *= bf_lo(gt.y); v0[3] *= bf_hi(gt.y);
                    v1[0] *= bf_lo(gt.z); v1[1] *= bf_hi(gt.z); v1[2] *= bf_lo(gt.w); v1[3] *= bf_hi(gt.w);
                    if (b > 0) { const u32x4 pv = *(const u32x4*)(op + bj * HALF);
                        v0[0] += bf_lo(pv.x); v0[1] += bf_hi(pv.x); v0[2] += bf_lo(pv.y); v0[3] += bf_hi(pv.y);
                        v1[0] += bf_lo(pv.z); v1[1] += bf_hi(pv.z); v1[2] += bf_lo(pv.w); v1[3] += bf_hi(pv.w); }
                    u32x4 w; w.x = cvt_pk_bf16(v0[0], v0[1]); w.y = cvt_pk_bf16(v0[2], v0[3]); w.z = cvt_pk_bf16(v1[0], v1[1]); w.w = cvt_pk_bf16(v1[2], v1[3]);
                    *(u32x4*)(op + bj * HALF) = w; } }
    }
};
struct EpiSwiglu {
    unsigned char* O; float scale;
    __device__ __forceinline__ void operator()(const f32x4 (&acc)[2][2][4][2], const Unit& u, int wr, int wc, int fr, int fq) const {
        const int row0 = u.pm * BM + wr * 64 + fr, col0 = u.pn * HALF + wc * 32 + 8 * fq;
#pragma unroll
        for (int ai = 0; ai < 2; ++ai)
#pragma unroll
            for (int m = 0; m < 4; ++m) { unsigned char* rowp = O + (size_t)(row0 + ai * HALF + m * 16) * D + col0;
                f32x4 v0 = acc[ai][0][m][0] * scale, v1 = acc[ai][0][m][1] * scale; const f32x4 g0 = acc[ai][1][m][0] * scale, g1 = acc[ai][1][m][1] * scale;
#pragma unroll
                for (int j = 0; j < 4; ++j) { v0[j] = v0[j] * fast_sigmoid(v0[j]) * g0[j]; v1[j] = v1[j] * fast_sigmoid(v1[j]) * g1[j]; }
                u32x2 w; w.x = pk4_fp8(v0[0], v0[1], v0[2], v0[3]); w.y = pk4_fp8(v1[0], v1[1], v1[2], v1[3]);
                *(u32x2*)rowp = w; }
    }
};
}
namespace attn_body {
using bf16 = __hip_bfloat16;
using s16x4 = __attribute__((ext_vector_type(4))) short;
using f32x16 = __attribute__((ext_vector_type(16))) float;
constexpr int DM = NIN;
constexpr int NW = 8, QBLK = 32, QB = QBLK * NW, KVBLK = 64;
__device__ __forceinline__ int crow(int r, int hi) { return (r & 3) + 8 * (r >> 2) + 4 * hi; }
#define SBAR() __builtin_amdgcn_sched_barrier(0)
constexpr int NSLOT = 3, SLOTB = 8192;
constexpr int LDS_K = 0, LDS_V = NSLOT * SLOTB, LDS_WS = 2 * NSLOT * SLOTB, LDS_OST = LDS_WS + NW * 64 * 4, LDS_BYTES = LDS_OST + NW * 4096;
constexpr float LOG2E = 1.4426950408889634f;
constexpr float C2 = 0.125f * LOG2E;
__device__ __forceinline__ void glds16(const void* gsrc, unsigned lds_dst) { unsigned keep;
    asm volatile("s_mov_b32 %0, m0\n\ts_mov_b32 m0, %2\n\ts_nop 0\n\tglobal_load_lds_dwordx4 %1, off\n\ts_mov_b32 m0, %0" : "=&s"(keep) : "v"(gsrc), "s"(lds_dst) : "memory"); }
__device__ __forceinline__ float max3f(float a, float b, float c) { float r; asm("v_max3_f32 %0, %1, %2, %3" : "=v"(r) : "v"(a), "v"(b), "v"(c)); return r; }
__device__ __forceinline__ float max2f(float a, float b) { float r; asm("v_max_f32_e32 %0, %1, %2" : "=v"(r) : "v"(a), "v"(b)); return r; }
__device__ __forceinline__ float fadd_s(float a, float b) { float r; asm("v_add_f32_e32 %0, %1, %2" : "=v"(r) : "v"(a), "v"(b)); return r; }
__device__ __forceinline__ float fsub_s(float a, float b) { float r; asm("v_sub_f32_e32 %0, %1, %2" : "=v"(r) : "v"(a), "v"(b)); return r; }
typedef float f32x2_t __attribute__((ext_vector_type(2))); typedef __bf16 bf16x2_t __attribute__((ext_vector_type(2)));
__device__ __forceinline__ unsigned cvtpk_s(float lo, float hi) { f32x2_t v = {lo, hi}; bf16x2_t b = __builtin_convertvector(v, bf16x2_t); return __builtin_bit_cast(unsigned, b); }
#define WAIT_BAR(N) asm volatile("s_waitcnt vmcnt(" #N ") lgkmcnt(0)\n\ts_barrier" ::: "memory")

__device__ __forceinline__ void qkt(f32x16& p0, f32x16& p1, const char* Kslot, const bf16x8* qr, const f32x16& negm, int r32, int hi) {
    const char* kb = Kslot + hi * 1024 + r32 * 16;
#pragma unroll
    for (int d0 = 0; d0 < 4; ++d0) {
        const bf16x8 b0 = *reinterpret_cast<const bf16x8*>(kb + d0 * 2048);
        const bf16x8 b1 = *reinterpret_cast<const bf16x8*>(kb + d0 * 2048 + 512);
        if (d0 == 0) { p0 = __builtin_amdgcn_mfma_f32_32x32x16_bf16(b0, qr[0], negm, 0, 0, 0); p1 = __builtin_amdgcn_mfma_f32_32x32x16_bf16(b1, qr[0], negm, 0, 0, 0); }
        else { p0 = __builtin_amdgcn_mfma_f32_32x32x16_bf16(b0, qr[d0], p0, 0, 0, 0); p1 = __builtin_amdgcn_mfma_f32_32x32x16_bf16(b1, qr[d0], p1, 0, 0, 0); } }
}
typedef __attribute__((address_space(3))) const char* lds_cptr;
typedef short v4i16_t __attribute__((ext_vector_type(4)));
__device__ __forceinline__ void kload8(bf16x8* kf, lds_cptr kp) {
    kf[0] = *(const LAS bf16x8*)(kp);        kf[1] = *(const LAS bf16x8*)(kp + 512);
    kf[2] = *(const LAS bf16x8*)(kp + 2048); kf[3] = *(const LAS bf16x8*)(kp + 2560);
    kf[4] = *(const LAS bf16x8*)(kp + 4096); kf[5] = *(const LAS bf16x8*)(kp + 4608);
    kf[6] = *(const LAS bf16x8*)(kp + 6144); kf[7] = *(const LAS bf16x8*)(kp + 6656);
}
__device__ __forceinline__ void kload2(bf16x8* kf, lds_cptr kp, int j) { kf[2 * j] = *(const LAS bf16x8*)(kp + j * 2048); kf[2 * j + 1] = *(const LAS bf16x8*)(kp + j * 2048 + 512); }
__device__ __forceinline__ s16x4 vtr(lds_cptr p) { return __builtin_bit_cast(s16x4, __builtin_amdgcn_ds_read_tr16_b64_v4i16((LAS v4i16_t*)p)); }
__device__ __forceinline__ float rowmax(const f32x16& p0, const f32x16& p1) {
    float a = max3f(p0[0], p0[1], p1[0]), b = max3f(p0[2], p0[3], p1[1]); a = max3f(a, p1[2], p1[3]);
#pragma unroll
    for (int r = 4; r < 16; r += 4) { a = max3f(a, p0[r], p0[r + 1]); b = max3f(b, p0[r + 2], p0[r + 3]); a = max3f(a, p1[r], p1[r + 1]); b = max3f(b, p1[r + 2], p1[r + 3]); }
    const float m = max2f(a, b);
    auto rr = __builtin_amdgcn_permlane32_swap(__float_as_uint(m), __float_as_uint(m), false, false);
    return max2f(__uint_as_float(rr[0]), __uint_as_float(rr[1]));
}
__device__ __forceinline__ void pv(f32x16* o, int vb, bf16x8 pa0, bf16x8 pa1, bf16x8 pa2, bf16x8 pa3) {
#pragma unroll
    for (int d0 = 0; d0 < 2; ++d0) { s16x4 lo[4], hi[4];
#pragma unroll
        for (int ks = 0; ks < 4; ++ks) {
            asm volatile("ds_read_b64_tr_b16 %0,%1 offset:%c2" : "=&v"(lo[ks]) : "v"(vb), "i"(d0 * 4096 + ks * 1024) : "memory");
            asm volatile("ds_read_b64_tr_b16 %0,%1 offset:%c2" : "=&v"(hi[ks]) : "v"(vb), "i"(d0 * 4096 + ks * 1024 + 512) : "memory"); }
        asm volatile("s_waitcnt lgkmcnt(0)" ::: "memory"); SBAR();
#define PK(k) (bf16x8){lo[k][0], lo[k][1], lo[k][2], lo[k][3], hi[k][0], hi[k][1], hi[k][2], hi[k][3]}
        o[d0] = __builtin_amdgcn_mfma_f32_32x32x16_bf16(pa0, PK(0), o[d0], 0, 0, 0);
        o[d0] = __builtin_amdgcn_mfma_f32_32x32x16_bf16(pa1, PK(1), o[d0], 0, 0, 0);
        o[d0] = __builtin_amdgcn_mfma_f32_32x32x16_bf16(pa2, PK(2), o[d0], 0, 0, 0);
        o[d0] = __builtin_amdgcn_mfma_f32_32x32x16_bf16(pa3, PK(3), o[d0], 0, 0, 0);
#undef PK
    }
}
__device__ __forceinline__ void wmask(f32x16& p0, f32x16& p1, int dk0, int hi) {
    const float NEG = -INFINITY; const int kb = dk0 + 4 * hi;
#pragma unroll
    for (int r = 0; r < 16; ++r) { const int d = kb + (r & 3) + 8 * (r >> 2); if (d > 128 || d < -128) p0[r] = NEG; if (d + 32 > 128 || d + 32 < -128) p1[r] = NEG; }
}

struct AttnArgs { bf16* P; const float* qg; const float* ropec; const float* ropes; float sink; bool dry; };

template <int MODE, int THRL> __device__ __forceinline__ void attn_unit(int b, int h, int qb, const AttnArgs& aa, char* shm) {
    constexpr bool LAT = (MODE < 2), WIN = (MODE == 1), SINK = (MODE == 1 || MODE == 3);
    constexpr int NT = (MODE == 0) ? 68 : (MODE == 1 ? 12 : 4);
    constexpr int QCOL = (MODE == 0 || MODE == 2) ? C_GQ : C_WQ, KCOL = (MODE == 0 || MODE == 2) ? C_GK : C_WK, VCOL = (MODE == 0 || MODE == 2) ? C_GV : C_WV;
    int tid_ = threadIdx.x; asm volatile("" : "+v"(tid_));
    const int tid = tid_, lane = tid & 63, r32 = lane & 31, hi = lane >> 5; const int wid = __builtin_amdgcn_readfirstlane(tid >> 6);
    const long rowbase = (long)b * TB; const int q0 = qb * QB;
    const long qrow0 = rowbase + (LAT ? NCTX : 0) + q0 + wid * QBLK;
    const int kvh = h >> 2;
    const bf16* Qw = aa.P + qrow0 * DM + QCOL + h * 64;
    const bf16* Kh = aa.P + rowbase * DM + KCOL + kvh * 64, *Vh = aa.P + rowbase * DM + VCOL + kvh * 64;
    const unsigned lds0 = (unsigned)(uintptr_t)shm;
    float* wsf = (float*)(shm + LDS_WS) + wid * 64;
    const bf16* ksrc = Kh + (long)lane * DM + wid * 8;
    const bf16* vsrc = Vh + (long)(16 * (wid & 3) + (lane >> 2)) * DM + (wid >> 2) * 32 + (lane & 3) * 8;
    const unsigned kdst = lds0 + LDS_K + wid * 1024, vdst = lds0 + LDS_V + wid * 1024;
    int kstart = 0; if (WIN) { kstart = q0 - 128; kstart = kstart < 0 ? 0 : kstart; kstart = kstart > SEQ - 512 ? SEQ - 512 : kstart; }
#define TROW(t) (WIN ? (((t) < 4) ? 64 * (t) : NCTX + kstart + 64 * ((t) - 4)) : 64 * (t))
#define DMA_K(t, slot) glds16(ksrc + (long)TROW(t) * DM, (unsigned)__builtin_amdgcn_readfirstlane(kdst + (slot)))
#define DMA_V(t, slot) glds16(vsrc + (long)TROW(t) * DM, (unsigned)__builtin_amdgcn_readfirstlane(vdst + (slot)))
    const int vb0 = (int)(lds0 + LDS_V) + ((lane >> 4) & 1) * 32 + (lane & 3) * 8 + (4 * hi + ((lane & 15) >> 2)) * 64;
    const char* Kbase = shm + LDS_K; bf16x8 kf[8];
    const lds_cptr shm3 = (lds_cptr)shm; const lds_cptr kp0 = shm3 + LDS_K + hi * 1024 + r32 * 16; const lds_cptr vp0 = shm3 + LDS_V + ((lane >> 4) & 1) * 32 + (lane & 3) * 8 + (4 * hi + ((lane & 15) >> 2)) * 64;
    DMA_K(0, 0); DMA_V(0, 0); DMA_K(1, SLOTB);
    bf16x8 qr[4];
    {
        bf16x8 qraw[4];
#pragma unroll
        for (int d0 = 0; d0 < 4; ++d0) qraw[d0] = *reinterpret_cast<const bf16x8*>(&Qw[(long)r32 * DM + d0 * 16 + hi * 8]);
        float qf[4][8]; float ss = 0.f;
#pragma unroll
        for (int d0 = 0; d0 < 4; ++d0)
#pragma unroll
            for (int j = 0; j < 8; ++j) { qf[d0][j] = __uint_as_float(((unsigned)(unsigned short)qraw[d0][j]) << 16); ss += qf[d0][j] * qf[d0][j]; }
        { auto rr = __builtin_amdgcn_permlane32_swap(__float_as_uint(ss), __float_as_uint(ss), false, false); ss = __uint_as_float(rr[0]) + __uint_as_float(rr[1]); }
        const float rinv = 1.0f / sqrtf(ss * (1.0f / 64.0f) + EPS);
#pragma unroll
        for (int d0 = 0; d0 < 4; ++d0) { const f32x4 g0 = *(const f32x4*)(aa.qg + d0 * 16 + hi * 8), g1 = *(const f32x4*)(aa.qg + d0 * 16 + hi * 8 + 4);
#pragma unroll
            for (int j = 0; j < 4; ++j) { qf[d0][j] *= rinv * g0[j]; qf[d0][4 + j] *= rinv * g1[j]; } }
        if (LAT) {
            const int pos = q0 + wid * QBLK + r32;
#pragma unroll
            for (int pr = 0; pr < 2; ++pr) {
                const float* cp = aa.ropec + (size_t)pos * 32 + pr * 16 + hi * 8; const float* sp = aa.ropes + (size_t)pos * 32 + pr * 16 + hi * 8;
                const f32x4 c0 = *(const f32x4*)cp, c1 = *(const f32x4*)(cp + 4), s0 = *(const f32x4*)sp, s1 = *(const f32x4*)(sp + 4);
#pragma unroll
                for (int j = 0; j < 8; ++j) { const float c = j < 4 ? c0[j & 3] : c1[j & 3], s = j < 4 ? s0[j & 3] : s1[j & 3];
                    const float t1 = qf[pr][j], t2 = qf[pr + 2][j]; qf[pr][j] = t1 * c - t2 * s; qf[pr + 2][j] = t2 * c + t1 * s; } }
        }
#pragma unroll
        for (int d0 = 0; d0 < 4; ++d0) { u32x4 w; w.x = cvtpk_s(qf[d0][0] * C2, qf[d0][1] * C2); w.y = cvtpk_s(qf[d0][2] * C2, qf[d0][3] * C2); w.z = cvtpk_s(qf[d0][4] * C2, qf[d0][5] * C2); w.w = cvtpk_s(qf[d0][6] * C2, qf[d0][7] * C2);
            qr[d0] = __builtin_bit_cast(bf16x8, w); }
    }
    float mhat = 0.f, l_reg = 0.f; f32x16 o[2]; o[0] = f32x16{}; o[1] = f32x16{}; f32x16 negm = f32x16{}; asm volatile("" : "+v"(negm));
    const int dkq = kstart - (q0 + wid * QBLK + r32);
#define CMASK(P0, P1, t) do { if (WIN && (t) >= 4) wmask(P0, P1, dkq + 64 * ((t) - 4), hi); } while (0)
    bool resc = false;
#define START(P0, P1) do { const float rm = rowmax(P0, P1); resc = false; \
    { const float dl = rm; mhat = fadd_s(mhat, dl); \
      _Pragma("unroll") for (int r = 0; r < 16; ++r) { P0[r] = fsub_s(P0[r], dl); P1[r] = fsub_s(P1[r], dl); } \
      _Pragma("unroll") for (int r = 0; r < 16; ++r) negm[r] = -mhat; asm volatile("" : "+v"(negm)); } \
    _Pragma("unroll") for (int r = 0; r < 16; ++r) P0[r] = __builtin_amdgcn_exp2f(P0[r]); } while (0)
#define RESC() do { if (resc) { asm volatile("s_waitcnt lgkmcnt(0)" ::: "memory"); \
      _Pragma("unroll") for (int d_ = 0; d_ < 2; ++d_) _Pragma("unroll") for (int r = 0; r < 16; ++r) o[d_][r] *= wsf[crow(r, hi)]; } } while (0)
    f32x16 pA0, pA1, pB0, pB1;
    int sl_prev = 0, sl_cur = 0, sl_next = SLOTB;
#define ROT() do { sl_prev = sl_cur; sl_cur = sl_next; sl_next = (sl_next == (NSLOT - 1) * SLOTB) ? 0 : sl_next + SLOTB; } while (0)
    DMA_K(2, 2 * SLOTB);
    WAIT_BAR(3);
    qkt(pA0, pA1, Kbase, qr, negm, r32, hi); asm volatile("s_nop 15\n\ts_nop 7" : "+v"(pA0), "+v"(pA1)); CMASK(pA0, pA1, 0);
    START(pA0, pA1);
    _Pragma("unroll") for (int r = 0; r < 16; ++r) pA1[r] = __builtin_amdgcn_exp2f(pA1[r]);
    WAIT_BAR(0);
    DMA_K(3, 0); DMA_V(1, SLOTB);
    ROT();
    kload8(kf, kp0 + sl_cur);
    WAIT_BAR(2);
    s16x4 vlo[8], vhi[8]; u32x4 pw0, pw1, pw2, pw3;
#define PKW(P, B) cvtpk_s(P[B], P[B + 1])
#define PAF(k) __builtin_bit_cast(bf16x8, pw##k)
#define VFR(i) (bf16x8){vlo[i][0], vlo[i][1], vlo[i][2], vlo[i][3], vhi[i][0], vhi[i][1], vhi[i][2], vhi[i][3]}
#define PIN(x) asm volatile("" : "+v"(x))
#define MX3(a, b, c) __builtin_fmaxf(__builtin_fmaxf((a), (b)), (c))
#define GAPA(MF, A0, A1, A2, A3, W0, W1, PW) do { MF; sacc += A0; sacc += A1; sacc += A2; sacc += A3; PIN(sacc); W0; W1; PIN(PW); SBAR(); } while (0)
#define EX(v) __builtin_amdgcn_exp2f(v)
#define GAPB(MF, X, B) do { MF; X[B] = EX(X[B]); X[B + 1] = EX(X[B + 1]); X[B + 2] = EX(X[B + 2]); X[B + 3] = EX(X[B + 3]); PIN(X); SBAR(); } while (0)
#define VRD(i) do { vlo[i] = vtr(vp_ + (((i) >> 2) * 4096 + ((i) & 3) * 1024)); vhi[i] = vtr(vp_ + (((i) >> 2) * 4096 + ((i) & 3) * 1024 + 512)); } while (0)
#define KRD(G, j) do { if (G) { kload2(kf, kp0 + sl_next, j); SBAR(); } } while (0)
#define STEP(C0, C1, P0, P1, t, GK, GV, GL) do { SBAR(); \
    const lds_cptr vp_ = vp0 + sl_prev; \
    VRD(0); SBAR(); float sacc = (P0[0] + P0[1]); \
    GAPA(C0 = __builtin_amdgcn_mfma_f32_32x32x16_bf16(kf[0], qr[0], negm, 0, 0, 0), P0[2], P0[3], P0[4], P0[5],     pw0[0] = PKW(P0, 0), pw0[1] = PKW(P0, 2), pw0); \
    VRD(4); SBAR(); GAPA(C1 = __builtin_amdgcn_mfma_f32_32x32x16_bf16(kf[1], qr[0], negm, 0, 0, 0), P0[6], P0[7], P0[8], P0[9],     pw0[2] = PKW(P0, 4), pw0[3] = PKW(P0, 6), pw0); \
    VRD(1); SBAR(); GAPA(C0 = __builtin_amdgcn_mfma_f32_32x32x16_bf16(kf[2], qr[1], C0, 0, 0, 0),   P0[10], P0[11], P0[12], P0[13], pw1[0] = PKW(P0, 8), pw1[1] = PKW(P0, 10), pw1); \
    VRD(5); SBAR(); GAPA(C1 = __builtin_amdgcn_mfma_f32_32x32x16_bf16(kf[3], qr[1], C1, 0, 0, 0),   P0[14], P0[15], P1[0], P1[1],   pw1[2] = PKW(P0, 12), pw1[3] = PKW(P0, 14), pw1); \
    VRD(2); SBAR(); GAPA(C0 = __builtin_amdgcn_mfma_f32_32x32x16_bf16(kf[4], qr[2], C0, 0, 0, 0),   P1[2], P1[3], P1[4], P1[5],     pw2[0] = PKW(P1, 0), pw2[1] = PKW(P1, 2), pw2); \
    VRD(6); SBAR(); GAPA(C1 = __builtin_amdgcn_mfma_f32_32x32x16_bf16(kf[5], qr[2], C1, 0, 0, 0),   P1[6], P1[7], P1[8], P1[9],     pw2[2] = PKW(P1, 4), pw2[3] = PKW(P1, 6), pw2); \
    VRD(3); SBAR(); GAPA(C0 = __builtin_amdgcn_mfma_f32_32x32x16_bf16(kf[6], qr[3], C0, 0, 0, 0),   P1[10], P1[11], P1[12], P1[13], pw3[0] = PKW(P1, 8), pw3[1] = PKW(P1, 10), pw3); \
    VRD(7); SBAR(); GAPA(C1 = __builtin_amdgcn_mfma_f32_32x32x16_bf16(kf[7], qr[3], C1, 0, 0, 0),   P1[14], P1[15], 0.f, 0.f,       pw3[2] = PKW(P1, 12), pw3[3] = PKW(P1, 14), pw3); \
    l_reg += sacc; \
    if (GK) { DMA_K((t) + 3, sl_cur); } if (GV) { DMA_V((t) + 1, sl_next); } \
    CMASK(C0, C1, t); \
    { float a = MX3(C0[0], C0[1], C1[0]), b = MX3(C0[2], C0[3], C1[1]); a = MX3(a, C1[2], C1[3]); \
      _Pragma("unroll") for (int r = 4; r < 16; r += 4) { a = MX3(a, C0[r], C0[r + 1]); b = MX3(b, C0[r + 2], C0[r + 3]); a = MX3(a, C1[r], C1[r + 1]); b = MX3(b, C1[r + 2], C1[r + 3]); } \
      float rm = __builtin_fmaxf(a, b); { auto rr = __builtin_amdgcn_permlane32_swap(__float_as_uint(rm), __float_as_uint(rm), false, false); rm = __builtin_fmaxf(__uint_as_float(rr[0]), __uint_as_float(rr[1])); } \
      resc = false; \
      if (__builtin_expect(__any(rm > (float)THRL), 0)) { const float dl = __builtin_fmaxf(rm, 0.f); mhat += dl; \
        _Pragma("unroll") for (int r = 0; r < 16; ++r) { C0[r] -= dl; C1[r] -= dl; } \
        _Pragma("unroll") for (int r = 0; r < 16; ++r) negm[r] = -mhat; asm volatile("" : "+v"(negm)); \
        const float f = __builtin_amdgcn_exp2f(-dl); l_reg *= f; if (hi == 0) wsf[r32] = f; resc = true; } } \
    SBAR(); \
    GAPB(o[0] = __builtin_amdgcn_mfma_f32_32x32x16_bf16(PAF(0), VFR(0), o[0], 0, 0, 0), C0, 0); \
    GAPB(o[1] = __builtin_amdgcn_mfma_f32_32x32x16_bf16(PAF(0), VFR(4), o[1], 0, 0, 0), C0, 4); \
    KRD(GL, 0); GAPB(o[0] = __builtin_amdgcn_mfma_f32_32x32x16_bf16(PAF(1), VFR(1), o[0], 0, 0, 0), C0, 8); \
    KRD(GL, 1); GAPB(o[1] = __builtin_amdgcn_mfma_f32_32x32x16_bf16(PAF(1), VFR(5), o[1], 0, 0, 0), C0, 12); \
    KRD(GL, 2); GAPB(o[0] = __builtin_amdgcn_mfma_f32_32x32x16_bf16(PAF(2), VFR(2), o[0], 0, 0, 0), C1, 0); \
    KRD(GL, 3); GAPB(o[1] = __builtin_amdgcn_mfma_f32_32x32x16_bf16(PAF(2), VFR(6), o[1], 0, 0, 0), C1, 4); \
    GAPB(o[0] = __builtin_amdgcn_mfma_f32_32x32x16_bf16(PAF(3), VFR(3), o[0], 0, 0, 0), C1, 8); \
    GAPB(o[1] = __builtin_amdgcn_mfma_f32_32x32x16_bf16(PAF(3), VFR(7), o[1], 0, 0, 0), C1, 12); \
    } while (0)
    int t = 1;
    for (; t + 5 < NT; t += 2) {
        STEP(pB0, pB1, pA0, pA1, t, true, true, true);     WAIT_BAR(2); RESC(); ROT();
        STEP(pA0, pA1, pB0, pB1, t + 1, true, true, true); WAIT_BAR(2); RESC(); ROT();
    }
#define ENDW(tt) do { if ((tt) + 3 < NT) { WAIT_BAR(2); } else if ((tt) + 2 < NT) { WAIT_BAR(1); } else { WAIT_BAR(0); } } while (0)
    for (; t + 1 < NT; t += 2) {
        STEP(pB0, pB1, pA0, pA1, t, (t + 3 < NT), (t + 1 < NT), (t + 1 < NT));         ENDW(t);     RESC(); ROT();
        STEP(pA0, pA1, pB0, pB1, t + 1, (t + 4 < NT), (t + 2 < NT), (t + 2 < NT));     ENDW(t + 1); RESC(); ROT();
    }
    STEP(pB0, pB1, pA0, pA1, NT - 1, false, false, false); RESC();
    { float sacc = pB0[0] + pB0[1]; _Pragma("unroll") for (int r = 2; r < 16; ++r) sacc += pB0[r]; _Pragma("unroll") for (int r = 0; r < 16; ++r) sacc += pB1[r]; l_reg += sacc;
      pw0 = (u32x4){PKW(pB0, 0), PKW(pB0, 2), PKW(pB0, 4), PKW(pB0, 6)}; pw1 = (u32x4){PKW(pB0, 8), PKW(pB0, 10), PKW(pB0, 12), PKW(pB0, 14)}; pw2 = (u32x4){PKW(pB1, 0), PKW(pB1, 2), PKW(pB1, 4), PKW(pB1, 6)}; pw3 = (u32x4){PKW(pB1, 8), PKW(pB1, 10), PKW(pB1, 12), PKW(pB1, 14)};
      SBAR(); pv(o, vb0 + sl_cur, PAF(0), PAF(1), PAF(2), PAF(3)); }
#undef PKW
#undef PAF
#undef VFR
#undef PIN
#undef MX3
#undef GAPA
#undef GAPB
#undef EX
#undef VRD
#undef KRD
#undef STEP
#undef ENDW
    { auto rr = __builtin_amdgcn_permlane32_swap(__float_as_uint(l_reg), __float_as_uint(l_reg), false, false); l_reg = __uint_as_float(rr[0]) + __uint_as_float(rr[1]); }
    if (SINK) l_reg += __builtin_amdgcn_exp2f(aa.sink * LOG2E - mhat);
    if (hi == 0) wsf[32 + r32] = l_reg; asm volatile("s_waitcnt lgkmcnt(0)" ::: "memory");
    float rli[16];
#pragma unroll
    for (int r = 0; r < 16; ++r) rli[r] = __builtin_amdgcn_rcpf(wsf[32 + crow(r, hi)]);
    bf16* Ow = aa.P + qrow0 * DM + QCOL + h * 64;
    { bf16* stg = (bf16*)(shm + LDS_OST) + wid * 2048;
#pragma unroll
      for (int r = 0; r < 16; ++r) { const int orow = crow(r, hi);
#pragma unroll
          for (int d0 = 0; d0 < 2; ++d0) stg[orow * 64 + d0 * 32 + r32] = __float2bfloat16(o[d0][r] * rli[r]); }
      asm volatile("s_waitcnt lgkmcnt(0)" ::: "memory");
#pragma unroll
      for (int i = 0; i < 4; ++i) { const int row = i * 8 + (lane >> 3), ch = lane & 7; const u32x4 v = *(const u32x4*)(stg + row * 64 + ch * 8); if (!aa.dry) *(u32x4*)(Ow + (long)row * DM + ch * 8) = v; } }
    asm volatile("s_waitcnt lgkmcnt(0)\n\ts_barrier" ::: "memory");
#undef DMA_K
#undef DMA_V
#undef TROW
#undef CMASK
#undef START
#undef RESC
#undef ROT
}
#undef SBAR
#undef WAIT_BAR
}
constexpr size_t MiB = 1u << 20;
constexpr size_t WS_CTL = 0, CTL_ZERO_BYTES = 1 * MiB;
constexpr size_t WS_MOD = 1 * MiB;
constexpr size_t WS_ROPE = 2 * MiB;
constexpr size_t WS_ROUTE = 3 * MiB;
constexpr size_t WS_WIN = 6 * MiB;
constexpr size_t WS_WBR = 28 * MiB;
constexpr size_t WS_WOUT = 34 * MiB;
constexpr size_t WS_XC = 38 * MiB;
constexpr size_t WS_A = 54 * MiB;
constexpr size_t WS_PROJ = 190 * MiB;
constexpr size_t WS_YBUF = WS_PROJ;
constexpr size_t WS_HG = WS_PROJ + 420 * MiB;
constexpr size_t WS_H8 = WS_A;
constexpr size_t WS_YP = WS_PROJ;
constexpr size_t WS_HID = WS_PROJ + 280 * MiB;
constexpr size_t WS_W13 = WS_PROJ + 560 * MiB;
constexpr size_t WS_W2 = WS_PROJ + 624 * MiB;
constexpr size_t WS_END = WS_PROJ + 748 * MiB;
static_assert((size_t)T * NIN * 2 == 748 * MiB && (size_t)T * D * 2 == 136 * MiB && (size_t)PMAX * D * 2 == 280 * MiB, "buffer sizes");
static_assert(WS_END <= 1024 * MiB, "workspace map fits 1 GiB");
constexpr int CW_CNT = 64;
constexpr int CW_BAR = 4096;

constexpr int RING_OFF = 0, RING_BYTES = 131072;
constexpr int LDSCTL_OFF = RING_BYTES, MISC_OFF = LDSCTL_OFF + 320;
constexpr int LDS_BYTES = 147456;
constexpr int NWAVES = 8;

typedef GAS unsigned gu32;
#define RLX_AGENT __ATOMIC_RELAXED, __HIP_MEMORY_SCOPE_AGENT
#define LDS_WAIT() asm volatile("s_waitcnt lgkmcnt(0)" ::: "memory")
#define VM_WAIT() asm volatile("s_waitcnt vmcnt(0)" ::: "memory")

#define XB_TMO      128
#define XB_XCNT(j)  (256  + 64 * (j))
#define XB_XSUB(j)  (1280 + 64 * (j))
#define XB_XGEN(j)  (2304 + 64 * (j))
#define XB_TOP      3328
#define XB_TOPGEN   3392
#define XCD_BAR_WORDS 3456
#define XB_SPIN_CAP (1u << 18)
__device__ __forceinline__ unsigned xb_ld(unsigned* p)              { return __hip_atomic_load(p, __ATOMIC_RELAXED, __HIP_MEMORY_SCOPE_AGENT); }
__device__ __forceinline__ unsigned xb_add(unsigned* p, unsigned v) { return __hip_atomic_fetch_add(p, v, __ATOMIC_RELAXED, __HIP_MEMORY_SCOPE_AGENT); }
__device__ __forceinline__ unsigned xb_xcc_id() { return (unsigned)__builtin_amdgcn_s_getreg((3 << 11) | 20) & 0xFu; }
#define XB_SPIN(cond, bar) do { unsigned _sp = 0; while (cond) { __builtin_amdgcn_s_sleep(1); \
    if ((++_sp & 255u) == 0u) { if (xb_ld(&(bar)[XB_TMO])) break; if (_sp > XB_SPIN_CAP) { atomicAdd(&(bar)[XB_TMO], 1u); break; } } } } while (0)
struct XcdBarrier { unsigned* bar; unsigned x; volatile LAS unsigned* st; };
__device__ __forceinline__ XcdBarrier xcd_barrier_post(unsigned* bar, volatile LAS unsigned* st) {
    XcdBarrier b; b.bar = bar; b.x = xb_xcc_id(); b.st = st;
    if (threadIdx.x == 0) (void)xb_add(&bar[XB_XCNT(b.x)], 1u);
    return b;
}
__device__ __forceinline__ void xcd_barrier_complete(unsigned* bar, unsigned x, unsigned& nloc, unsigned& nx) {
    const unsigned G = gridDim.x * gridDim.y * gridDim.z;
    unsigned sum, cnt, mine, sp = 0u;
    for (;;) {
        sum = 0u; cnt = 0u; mine = 0u;
#pragma unroll
        for (unsigned j = 0; j < 16; ++j) { const unsigned c = xb_ld(&bar[XB_XCNT(j)]); sum += c; cnt += (c > 0u) ? 1u : 0u; mine = (j == x) ? c : mine; }
        if (sum == G) break;
        __builtin_amdgcn_s_sleep(1);
        if ((++sp & 255u) == 0u) { if (xb_ld(&bar[XB_TMO])) break; if (sp > XB_SPIN_CAP) { atomicAdd(&bar[XB_TMO], 1u); break; } }
    }
    nloc = mine > 0u ? mine : 1u; nx = cnt > 0u ? cnt : 1u;
}
__device__ __forceinline__ void xcd_barrier(const XcdBarrier& b) {
    asm volatile("s_waitcnt vmcnt(0)" ::: "memory");
    __syncthreads();
    if (threadIdx.x == 0) {
        unsigned* bar = b.bar;
        __builtin_amdgcn_s_waitcnt(0);
        unsigned nloc = b.st[0], nx = b.st[1];
        if (nloc == 0u) { xcd_barrier_complete(bar, b.x, nloc, nx); b.st[0] = nloc; b.st[1] = nx; }
        const unsigned old = xb_add(&bar[XB_XSUB(b.x)], 1u);
        const unsigned gen = old / nloc;
        if (old + 1u == (gen + 1u) * nloc) {
            __builtin_amdgcn_fence(__ATOMIC_RELEASE, "agent");
            asm volatile("s_waitcnt vmcnt(0)" ::: "memory");
            const unsigned og = xb_add(&bar[XB_TOP], 1u);
            const unsigned tg = og / nx;
            if (og + 1u == (tg + 1u) * nx) xb_add(&bar[XB_TOPGEN], 1u);
            else XB_SPIN(xb_ld(&bar[XB_TOPGEN]) == tg, bar);
            __builtin_amdgcn_fence(__ATOMIC_ACQUIRE, "agent");
            xb_add(&bar[XB_XGEN(b.x)], 1u);
            asm volatile("s_waitcnt vmcnt(0)" ::: "memory");
        } else {
            XB_SPIN(xb_ld(&bar[XB_XGEN(b.x)]) == gen, bar);
            __builtin_amdgcn_fence(__ATOMIC_ACQUIRE, "agent");
            asm volatile("s_waitcnt vmcnt(0)" ::: "memory");
        }
    }
    __syncthreads();
}

struct Args { const float* in[27]; float* out; unsigned char* ws; };
struct KArgs { const GAS float* in[27]; GAS float* out; GAS unsigned char* ws; };
typedef const __attribute__((address_space(4))) KArgs* kargs_p;
__device__ __forceinline__ kargs_p kargs() { kargs_p p = (kargs_p)__builtin_amdgcn_kernarg_segment_ptr(); asm volatile("" : "+s"(p)); return p; }
struct Frame {
    LAS unsigned char* lds;
    int tid, lane, wave, vcu, G, gw, NGW, bid;
#define KIN(name, idx) __device__ __forceinline__ const float* name() const { return (const float*)kargs()->in[idx]; }
    KIN(x, 0) KIN(c, 1) KIN(ctx, 2) KIN(c_ctx, 3) KIN(w_mod, 4) KIN(b_mod, 5) KIN(norm1_g, 6) KIN(norm2_g, 7) KIN(w_in, 8) KIN(b_merge, 9) KIN(conv_w, 10) KIN(conv_b, 11)
    KIN(lru_wa, 12) KIN(lru_ba, 13) KIN(lru_wx, 14) KIN(lru_bx, 15) KIN(lru_lambda, 16) KIN(q_norm_g, 17) KIN(k_norm_g, 18) KIN(sink, 19) KIN(w_branch, 20) KIN(w_out, 21)
    KIN(router_w, 22) KIN(router_b, 23) KIN(ew1, 24) KIN(ew3, 25) KIN(ew2, 26)
#undef KIN
    __device__ __forceinline__ float* out() const { return (float*)kargs()->out; }
    __device__ __forceinline__ unsigned char* ws() const { return (unsigned char*)kargs()->ws; }
    __device__ __forceinline__ gu32* ctl() const { return (gu32*)(ws() + WS_CTL); }
#define KWS(type, name, off) __device__ __forceinline__ type* name() const { return (type*)(ws() + (off)); }
    KWS(float, MOD, WS_MOD) KWS(float, ROPEC, WS_ROPE) KWS(float, ROPES, WS_ROPE + (size_t)SEQ * 32 * 4) KWS(float, XC, WS_XC) KWS(float, HT, WS_A) KWS(unsigned, ROUTE, WS_ROUTE)
    KWS(bf16_t, WIN, WS_WIN) KWS(bf16_t, WBR, WS_WBR) KWS(bf16_t, WOUT, WS_WOUT) KWS(bf16_t, A, WS_A) KWS(bf16_t, PROJ, WS_PROJ) KWS(bf16_t, YBUF, WS_YBUF) KWS(unsigned char, HG, WS_HG)
    KWS(bf16_t, YP, WS_YP) KWS(unsigned char, HID, WS_HID) KWS(unsigned char, W13, WS_W13) KWS(unsigned char, W2, WS_W2) KWS(unsigned char, H8, WS_H8)
#undef KWS
};
__device__ __forceinline__ Frame fresh(const Frame& F0) { Frame F = F0;
    asm volatile("" : "+s"(F.wave), "+s"(F.vcu), "+s"(F.G), "+s"(F.gw), "+s"(F.NGW), "+s"(F.bid), "+v"(F.tid), "+v"(F.lane)); return F; }
__device__ __forceinline__ float wave_sum(float v) {
#pragma unroll
    for (int o = 1; o < 64; o <<= 1) v += __shfl_xor(v, o);
    return v;
}
__device__ __forceinline__ const float* modp(const float* MODb, int l, int sel, int chunk) { return MODb + ((size_t)(l * 17 + sel) * 6 + chunk) * D; }

__device__ __forceinline__ void transpose_item(const float* W, int K, int N, bf16_t* WT, int k0, int n0, int drow0, LAS float* scr, int lane) {
#pragma unroll 8
    for (int i = 0; i < 32; ++i) { const int kk = 2 * i + (lane >> 5); scr[kk * 33 + (lane & 31)] = W[(size_t)(k0 + kk) * N + n0 + (lane & 31)]; }
    LDS_WAIT(); asm volatile("" ::: "memory");
    const int cc = lane & 7;
#pragma unroll
    for (int j = 0; j < 4; ++j) { const int n = (lane >> 3) + 8 * j; const LAS float* s = scr + (8 * cc) * 33 + n;
        u32x4 o; o.x = cvt_pk_bf16(s[0 * 33], s[1 * 33]); o.y = cvt_pk_bf16(s[2 * 33], s[3 * 33]); o.z = cvt_pk_bf16(s[4 * 33], s[5 * 33]); o.w = cvt_pk_bf16(s[6 * 33], s[7 * 33]);
        *(GAS u32x4*)(WT + (size_t)(drow0 + n) * K + k0 + 8 * cc) = o; }
    LDS_WAIT(); asm volatile("" ::: "memory");
}

__device__ __forceinline__ void transpose_item_fp8(const float* W, int K, int N, unsigned char* WT, int k0, int n0, int drow0, float scale, LAS float* scr, int lane) {
#pragma unroll 8
    for (int i = 0; i < 32; ++i) { const int kk = 2 * i + (lane >> 5); scr[kk * 33 + (lane & 31)] = W[(size_t)(k0 + kk) * N + n0 + (lane & 31)]; }
    LDS_WAIT(); asm volatile("" ::: "memory");
    const int cc = lane & 7;
#pragma unroll
    for (int j = 0; j < 4; ++j) { const int n = (lane >> 3) + 8 * j; const LAS float* s = scr + (8 * cc) * 33 + n;
        u32x2 o; o.x = pk4_fp8(s[0 * 33] * scale, s[1 * 33] * scale, s[2 * 33] * scale, s[3 * 33] * scale); o.y = pk4_fp8(s[4 * 33] * scale, s[5 * 33] * scale, s[6 * 33] * scale, s[7 * 33] * scale);
        *(GAS u32x2*)(WT + (size_t)(drow0 + n) * K + k0 + 8 * cc) = o; }
    LDS_WAIT(); asm volatile("" ::: "memory");
}
__device__ __forceinline__ void p0_prologue(Frame& F) {
    LAS float* scr = (LAS float*)(F.lds + RING_OFF + F.wave * 16384);
    constexpr int I_IN = (D / 64) * (NIN / 32), I_BR = (512 / 64) * (D / 32), I_OUT = (D / 64) * (D / 32);
    constexpr int NITEMS = NL * (I_IN + 3 * I_BR + I_OUT);
    for (int it = F.gw; it < NITEMS; it += F.NGW) {
        int r = it; const int l = r / (I_IN + 3 * I_BR + I_OUT); r -= l * (I_IN + 3 * I_BR + I_OUT);
        if (r < I_IN) { const int nb = NIN / 32, kb = r / nb, n0 = 32 * (r % nb); transpose_item(F.w_in() + (size_t)l * D * NIN, D, NIN, F.WIN() + (size_t)l * NIN * D, 64 * kb, n0, n0, scr, F.lane); continue; }
        r -= I_IN;
        if (r < 3 * I_BR) { const int b = r / I_BR; r -= b * I_BR; const int nb = D / 32, kb = r / nb, n0 = 32 * (r % nb);
            transpose_item(F.w_branch() + (size_t)(l * 3 + b) * 512 * D, 512, D, F.WBR() + (size_t)(l * 3 + b) * D * 512, 64 * kb, n0, n0, scr, F.lane); continue; }
        r -= 3 * I_BR;
        { const int nb = D / 32, kb = r / nb, n0 = 32 * (r % nb); transpose_item(F.w_out() + (size_t)l * D * D, D, D, F.WOUT() + (size_t)l * D * D, 64 * kb, n0, n0, scr, F.lane); }
    }
    float* RC = F.ROPEC(); float* RS = F.ROPES();
    for (int i = blockIdx.x * (NWAVES * 64) + F.tid; i < SEQ * 32; i += F.G * NWAVES * 64) {
        const int pos = i >> 5, f = i & 31; const float inv = exp2f(-(float)(f & 15) * (13.287712379549449f / 16.0f));
        const float ang = (float)(f < 16 ? (pos >> 6) : (pos & 63)) * inv;
        const float rev = ang * 0.15915494309189535f; RC[i] = __builtin_amdgcn_cosf(rev); RS[i] = __builtin_amdgcn_sinf(rev);
    }
    __syncthreads();
    {
        LAS float* sc = (LAS float*)(F.lds + RING_OFF);
        LAS float* part = (LAS float*)(F.lds + RING_OFF + 17 * 1024 * 4);
        bool have_sc = false;
        for (int it = blockIdx.x; it < NL * 96; it += F.G) {
            if (!have_sc) { for (int i = F.tid; i < 17 * 1024; i += NWAVES * 64) { const int s = i >> 10, k = i & 1023; const float v = s < 16 ? F.c()[s * D + k] : F.c_ctx()[k]; sc[i] = v * fast_sigmoid(v); }
                have_sc = true; __syncthreads(); }
            const int l = it / 96, cg = it % 96, col = cg * 64 + F.lane;
            const float* wp = F.w_mod() + (size_t)l * D * 6 * D + col;
            float acc[17];
#pragma unroll
            for (int s = 0; s < 17; ++s) acc[s] = 0.f;
            const int kbeg = F.wave * 128;
#pragma unroll 4
            for (int k = kbeg; k < kbeg + 128; ++k) { const float w = wp[(size_t)k * 6 * D];
#pragma unroll
                for (int s = 0; s < 17; ++s) acc[s] += sc[s * 1024 + k] * w; }
#pragma unroll
            for (int s = 0; s < 17; ++s) part[(F.wave * 17 + s) * 64 + F.lane] = acc[s];
            __syncthreads();
            for (int i = F.tid; i < 17 * 64; i += NWAVES * 64) { const int s = i >> 6, cl = i & 63; float v = F.b_mod()[l * 6 * D + cg * 64 + cl];
#pragma unroll
                for (int w = 0; w < 8; ++w) v += part[(w * 17 + s) * 64 + cl];
                F.MOD()[(size_t)(l * 17 + s) * 6 * D + cg * 64 + cl] = v; }
            __syncthreads();
        }
    }
}

constexpr float WSCALE = 64.0f;
__device__ __forceinline__ void convert_experts(Frame& F, int l) {
    LAS float* scr = (LAS float*)(F.lds + RING_OFF + F.wave * 16384);
    constexpr int I_M = (D / 64) * (D / 32);
    for (int it = F.gw; it < NE * 3 * I_M; it += F.NGW) {
        const int e = it / (3 * I_M); int r = it - e * 3 * I_M; const int which = r / I_M; r -= which * I_M;
        const int kb = r / (D / 32), n0 = 32 * (r % (D / 32));
        const size_t eoff = (size_t)(l * NE + e) * D * D;
        if (which == 0) transpose_item_fp8(F.ew1() + eoff, D, D, F.W13() + (size_t)e * 2048 * D, 64 * kb, n0, 256 * (n0 >> 7) + (n0 & 127), WSCALE, scr, F.lane);
        else if (which == 1) transpose_item_fp8(F.ew3() + eoff, D, D, F.W13() + (size_t)e * 2048 * D, 64 * kb, n0, 256 * (n0 >> 7) + 128 + (n0 & 127), WSCALE, scr, F.lane);
        else transpose_item_fp8(F.ew2() + eoff, D, D, F.W2() + (size_t)e * D * D, 64 * kb, n0, n0, WSCALE, scr, F.lane);
    }
}

__device__ __forceinline__ void ld_row_f32(const float* p, int lane, f32x4 (&v)[4]) {
#pragma unroll
    for (int j = 0; j < 4; ++j) v[j] = *((const GAS f32x4*)p + lane + 64 * j);
}
__device__ __forceinline__ void st_row_f32(float* p, int lane, const f32x4 (&v)[4]) {
#pragma unroll
    for (int j = 0; j < 4; ++j) *((GAS f32x4*)p + lane + 64 * j) = v[j];
}
__device__ __forceinline__ void ld_row_bf16(const bf16_t* p, int lane, f32x4 (&v)[4]) {
#pragma unroll
    for (int j = 0; j < 4; ++j) { const u32x2 w = *((const GAS u32x2*)p + lane + 64 * j); v[j] = (f32x4){bf_lo(w.x), bf_hi(w.x), bf_lo(w.y), bf_hi(w.y)}; }
}
__device__ __forceinline__ void st_row_bf16(bf16_t* p, int lane, const f32x4 (&v)[4]) {
#pragma unroll
    for (int j = 0; j < 4; ++j) { u32x2 w; w.x = cvt_pk_bf16(v[j][0], v[j][1]); w.y = cvt_pk_bf16(v[j][2], v[j][3]); *((GAS u32x2*)p + lane + 64 * j) = w; }
}
__device__ __forceinline__ void st_row_fp8(unsigned char* p, int lane, const f32x4 (&v)[4]) {
#pragma unroll
    for (int j = 0; j < 4; ++j) *((GAS unsigned*)p + lane + 64 * j) = pk4_fp8(v[j][0], v[j][1], v[j][2], v[j][3]);
}
__device__ __forceinline__ void norm_mod(const f32x4 (&v)[4], const float* g, const float* shift, const float* scale, int lane, f32x4 (&h)[4]) {
    float ss = 0.f;
#pragma unroll
    for (int j = 0; j < 4; ++j) ss += (v[j][0] * v[j][0] + v[j][1] * v[j][1]) + (v[j][2] * v[j][2] + v[j][3] * v[j][3]);
    const float rinv = 1.0f / sqrtf(wave_sum(ss) * (1.0f / D) + EPS);
#pragma unroll
    for (int j = 0; j < 4; ++j) { const f32x4 gg = *((const GAS f32x4*)g + lane + 64 * j), sh = *((const GAS f32x4*)shift + lane + 64 * j), sc = *((const GAS f32x4*)scale + lane + 64 * j);
        h[j] = (v[j] * rinv) * gg * (sc + 1.0f) + sh; }
}

struct RowRange { int lo, hi; };
__device__ __forceinline__ RowRange wave_rows(const Frame& F, int n) { const int per = (n + F.NGW - 1) / F.NGW; RowRange r; r.lo = F.gw * per; r.hi = r.lo + per; if (r.hi > n) r.hi = n; if (r.lo > n) r.lo = n; return r; }
__device__ __forceinline__ void row_decode(int idx, bool all, int& b, int& p) { if (all) { b = idx / TB; p = idx - b * TB; } else { b = idx / SEQ; p = NCTX + idx - b * SEQ; } }
__device__ __forceinline__ void ld_vec(const float* p, int lane, f32x4 (&v)[4]) {
#pragma unroll
    for (int j = 0; j < 4; ++j) v[j] = *((const GAS f32x4*)p + lane + 64 * j);
}
__device__ __forceinline__ float row_rinv(const f32x4 (&v)[4]) {
    float ss = 0.f;
#pragma unroll
    for (int j = 0; j < 4; ++j) ss += (v[j][0] * v[j][0] + v[j][1] * v[j][1]) + (v[j][2] * v[j][2] + v[j][3] * v[j][3]);
    return 1.0f / sqrtf(wave_sum(ss) * (1.0f / D) + EPS);
}
__device__ __forceinline__ void r1_phase(Frame& F) {
    const float* MODb = F.MOD(); const float* xin = F.x(); const float* cin = F.ctx(); const float* g1n = F.norm1_g(); bf16_t* Ab = F.A();
    const RowRange rr = wave_rows(F, T);
    int cursel = -1; f32x4 gm[4], sh[4], vn[4];
#define R1_SRC(idx_) ({ int b_, p_; row_decode((idx_), true, b_, p_); (p_ < NCTX) ? cin + (size_t)(b_ * NCTX + p_) * D : xin + (size_t)(b_ * SEQ + p_ - NCTX) * D; })
    if (rr.lo < rr.hi) ld_row_f32(R1_SRC(rr.lo), F.lane, vn);
    for (int idx = rr.lo; idx < rr.hi; ++idx) {
        int b, p; row_decode(idx, true, b, p); const int sel = p < NCTX ? 16 : b;
        f32x4 v[4];
#pragma unroll
        for (int j = 0; j < 4; ++j) v[j] = vn[j];
        if (idx + 1 < rr.hi) ld_row_f32(R1_SRC(idx + 1), F.lane, vn);
        if (sel != cursel) { cursel = sel; f32x4 g[4], sc[4]; ld_vec(g1n, F.lane, g); ld_vec(modp(MODb, 0, sel, 1), F.lane, sc); ld_vec(modp(MODb, 0, sel, 0), F.lane, sh);
#pragma unroll
            for (int j = 0; j < 4; ++j) gm[j] = g[j] * (sc[j] + 1.0f); }
        const float rinv = row_rinv(v); f32x4 h[4];
#pragma unroll
        for (int j = 0; j < 4; ++j) h[j] = (v[j] * rinv) * gm[j] + sh[j];
        st_row_bf16(Ab + (size_t)idx * D, F.lane, h);
    }
#undef R1_SRC
}

__device__ __forceinline__ void kfix_phase(Frame& F, int l, bool dry = false) {
    const int hs = F.lane >> 4, j4 = F.lane & 15, br = hs >> 1;
    const int col = (br ? C_WK : C_GK) + (hs & 1) * 64 + 2 * j4;
    const float* kg = F.k_norm_g() + (size_t)(l * 2 + br) * 64;
    const float g0 = kg[2 * j4], g1 = kg[2 * j4 + 1], g2 = kg[32 + 2 * j4], g3 = kg[32 + 2 * j4 + 1];
    bf16_t* Pb = F.PROJ(); const float* RC = F.ROPEC(); const float* RS = F.ROPES();
    for (int row = F.gw; row < T; row += F.NGW) {
        const int b = row / TB, p = row - b * TB;
        bf16_t* rp = Pb + (size_t)row * NIN + col;
        const unsigned w1 = *(const GAS unsigned*)rp, w2 = *(const GAS unsigned*)(rp + 32);
        float a0 = bf_lo(w1), a1 = bf_hi(w1), b0 = bf_lo(w2), b1 = bf_hi(w2);
        float ss = a0 * a0 + a1 * a1 + b0 * b0 + b1 * b1;
        ss += __shfl_xor(ss, 1); ss += __shfl_xor(ss, 2); ss += __shfl_xor(ss, 4); ss += __shfl_xor(ss, 8);
        const float rinv = 1.0f / sqrtf(ss * (1.0f / 64.0f) + EPS);
        a0 *= rinv * g0; a1 *= rinv * g1; b0 *= rinv * g2; b1 *= rinv * g3;
        if (p >= NCTX) { const int pos = p - NCTX; const f32x2 cs = *(const GAS f32x2*)(RC + (size_t)pos * 32 + 2 * j4), sn = *(const GAS f32x2*)(RS + (size_t)pos * 32 + 2 * j4);
            const float t0 = a0 * cs.x - b0 * sn.x, t1 = a1 * cs.y - b1 * sn.y, u0 = b0 * cs.x + a0 * sn.x, u1 = b1 * cs.y + a1 * sn.y; a0 = t0; a1 = t1; b0 = u0; b1 = u1; }
        if (!dry) { *(GAS unsigned*)rp = cvt_pk_bf16(a0, a1); *(GAS unsigned*)(rp + 32) = cvt_pk_bf16(b0, b1); }
    }
}
constexpr int SC_AOP = 0, SC_AOP_B = 64 * 144, SC_XCV = 2 * SC_AOP_B, SC_XCV_B = 64 * 68 * 4, SC_TOT = SC_XCV + 2 * SC_XCV_B, SC_TOT_B = 4 * 2 * 16 * 8;
__device__ __forceinline__ void scan_unit(Frame& F, int l, int uid, bool last_layer, bool dry = false) {
    const int b = uid >> 4, n = (uid >> 1) & 7, chh = uid & 1;
    const int dir = F.wave >> 2, ht = F.tid & 255, w = F.wave & 3, lane = F.lane, col = lane & 15, quad = lane >> 4;
    LAS unsigned char* aop = F.lds + SC_AOP + dir * SC_AOP_B;
    LAS float* xcv = (LAS float*)(F.lds + SC_XCV + dir * SC_XCV_B);
    LAS f32x2* tot = (LAS f32x2*)(F.lds + SC_TOT + dir * SC_TOT_B);
    bf16x8 Bf[4][2];
    {
        const size_t wbase = ((size_t)((l * 2 + dir) * 8 + n)) * 64 * 64; const float* lwa = F.lru_wa(); const float* lwx = F.lru_wx();
#pragma unroll
        for (int q = 0; q < 4; ++q) { const float* wp = ((q < 2) ? lwa : lwx) + wbase + 32 * chh + 16 * (q & 1) + col;
#pragma unroll
            for (int ks = 0; ks < 2; ++ks) { u32x4 pk;
                const int k0 = 32 * ks + 8 * quad;
                pk.x = cvt_pk_bf16(wp[(size_t)(k0 + 0) * 64], wp[(size_t)(k0 + 1) * 64]); pk.y = cvt_pk_bf16(wp[(size_t)(k0 + 2) * 64], wp[(size_t)(k0 + 3) * 64]);
                pk.z = cvt_pk_bf16(wp[(size_t)(k0 + 4) * 64], wp[(size_t)(k0 + 5) * 64]); pk.w = cvt_pk_bf16(wp[(size_t)(k0 + 6) * 64], wp[(size_t)(k0 + 7) * 64]);
                Bf[q][ks] = __builtin_bit_cast(bf16x8, pk); } }
    }
    float ba[2], bx[2], nla[2]; const float* lba = F.lru_ba(); const float* lbx = F.lru_bx(); const float* llam = F.lru_lambda();
#pragma unroll
    for (int q = 0; q < 2; ++q) { const int gch = 64 * n + 32 * chh + 16 * q + col; const size_t o = (size_t)(l * 2 + dir) * 512 + gch;
        ba[q] = lba[o]; bx[q] = lbx[o]; const float lam = llam[o];
        const float sp = (lam > 15.f) ? __expf(-lam) : log1pf(__expf(-lam));
        nla[q] = -8.0f * sp; }
    const int cg = ht & 7; float cw[4][8], cb[8]; const float* cwp = F.conv_w(); const float* cbp = F.conv_b();
#pragma unroll
    for (int k = 0; k < 4; ++k)
#pragma unroll
        for (int c = 0; c < 8; ++c) cw[k][c] = cwp[(size_t)(l * 4 + k) * 512 + 64 * n + 8 * cg + c];
#pragma unroll
    for (int c = 0; c < 8; ++c) cb[c] = cbp[(size_t)l * 512 + 64 * n + 8 * cg + c];
    float hcar[2] = {0.f, 0.f};
    bf16_t* Pb = F.PROJ(); float* HTb = F.HT();
    const bf16_t* xrb = Pb + C_XR + 64 * n + 8 * cg;

    for (int seg = 0; seg < 2; ++seg) {
        const int nch = seg ? 64 : 4, seglen = nch * 64; const size_t rowseg0 = (size_t)b * TB + (seg ? NCTX : 0);
        const bool want_out = !(seg == 0 && last_layer) && !dry;
        u32x4 raw[2][4];
#define SC_LOAD(i_) do { const int cidx_ = dir ? nch - 1 - (i_) : (i_); const int t0_ = 64 * cidx_; \
        _Pragma("unroll") for (int it = 0; it < 2; ++it) { const int s_ = (it * 256 + ht) >> 3; const int t_ = dir ? t0_ + 63 - s_ : t0_ + s_; \
            _Pragma("unroll") for (int dt = 0; dt < 4; ++dt) { const int tt = t_ + dt - 2; \
                raw[it][dt] = (tt >= 0 && tt < seglen) ? *(const GAS u32x4*)(xrb + (rowseg0 + tt) * NIN) : (u32x4){0u, 0u, 0u, 0u}; } } } while (0)
        SC_LOAD(0);
        for (int i = 0; i < nch; ++i) {
            const int cidx = dir ? nch - 1 - i : i, t0 = 64 * cidx;
#pragma unroll
            for (int it = 0; it < 2; ++it) { const int s = (it * 256 + ht) >> 3; float cv[8];
#pragma unroll
                for (int c2 = 0; c2 < 4; ++c2) { float lo = cb[2 * c2], hi2 = cb[2 * c2 + 1];
#pragma unroll
                    for (int dt = 0; dt < 4; ++dt) { const unsigned wv = raw[it][dt][c2]; lo += cw[dt][2 * c2] * bf_lo(wv); hi2 += cw[dt][2 * c2 + 1] * bf_hi(wv); }
                    cv[2 * c2] = lo; cv[2 * c2 + 1] = hi2; }
                u32x4 pk; pk.x = cvt_pk_bf16(cv[0], cv[1]); pk.y = cvt_pk_bf16(cv[2], cv[3]); pk.z = cvt_pk_bf16(cv[4], cv[5]); pk.w = cvt_pk_bf16(cv[6], cv[7]);
                *(LAS u32x4*)(aop + s * 144 + cg * 16) = pk;
                *(LAS f32x4*)(xcv + s * 68 + cg * 8) = (f32x4){cv[0], cv[1], cv[2], cv[3]}; *(LAS f32x4*)(xcv + s * 68 + cg * 8 + 4) = (f32x4){cv[4], cv[5], cv[6], cv[7]}; }
            if (i + 1 < nch) SC_LOAD(i + 1);
            if (i == nch / 2) VM_WAIT();
            __syncthreads();
            f32x4 gacc[4];
#pragma unroll
            for (int q = 0; q < 4; ++q) gacc[q] = (f32x4){0.f, 0.f, 0.f, 0.f};
#pragma unroll
            for (int ks = 0; ks < 2; ++ks) { const bf16x8 af = *(const LAS bf16x8*)(aop + (16 * w + col) * 144 + ks * 64 + quad * 16);
#pragma unroll
                for (int q = 0; q < 4; ++q) gacc[q] = __builtin_amdgcn_mfma_f32_16x16x32_bf16(af, Bf[q][ks], gacc[q], 0, 0, 0); }
            float av[2][4], bv[2][4], cA[2], cB[2];
#pragma unroll
            for (int q = 0; q < 2; ++q) {
#pragma unroll
                for (int j = 0; j < 4; ++j) { const float r = fast_sigmoid(gacc[q][j] + ba[q]), ig = fast_sigmoid(gacc[q + 2][j] + bx[q]);
                    const float la = nla[q] * r, a = __expf(la), z = 2.0f * la;
                    const float om = (z > -0.1f) ? -z * (1.0f + z * (0.5f + z * (0.16666667f + z * 0.041666668f))) : 1.0f - __expf(z);
                    const float xv = xcv[(16 * w + 4 * quad + j) * 68 + 32 * chh + 16 * q + col];
                    av[q][j] = a; bv[q][j] = sqrtf(om) * ig * xv; }
                cA[q] = av[q][0]; cB[q] = bv[q][0];
#pragma unroll
                for (int j = 1; j < 4; ++j) { cB[q] = av[q][j] * cB[q] + bv[q][j]; cA[q] *= av[q][j]; }
            }
            float iA[2], iB[2], eA[2], eB[2];
#pragma unroll
            for (int q = 0; q < 2; ++q) { iA[q] = cA[q]; iB[q] = cB[q];
                float pA = __shfl_up(iA[q], 16), pB = __shfl_up(iB[q], 16); if (quad >= 1) { iB[q] = iA[q] * pB + iB[q]; iA[q] = iA[q] * pA; }
                pA = __shfl_up(iA[q], 32); pB = __shfl_up(iB[q], 32); if (quad >= 2) { iB[q] = iA[q] * pB + iB[q]; iA[q] = iA[q] * pA; }
                eA[q] = __shfl_up(iA[q], 16); eB[q] = __shfl_up(iB[q], 16); if (quad == 0) { eA[q] = 1.0f; eB[q] = 0.0f; }
                if (quad == 3) tot[(w * 2 + q) * 16 + col] = (f32x2){iA[q], iB[q]}; }
            __syncthreads();
#pragma unroll
            for (int q = 0; q < 2; ++q) { float hin = hcar[q], hall = hcar[q];
#pragma unroll
                for (int ww = 0; ww < 4; ++ww) { const f32x2 tw = tot[(ww * 2 + q) * 16 + col]; hall = tw.x * hall + tw.y; if (ww < w) hin = hall; }
                hcar[q] = hall;
                float hv = eA[q] * hin + eB[q];
                const int gch = 64 * n + 32 * chh + 16 * q + col;
#pragma unroll
                for (int j = 0; j < 4; ++j) { hv = av[q][j] * hv + bv[q][j];
                    if (want_out) { const int s = 16 * w + 4 * quad + j; const int tt = dir ? t0 + 63 - s : t0 + s; const size_t row = rowseg0 + tt;
                        if (i < nch / 2) HTb[row * 512 + gch] = hv;
                        else { const float oth = __hip_atomic_load(HTb + row * 512 + gch, __ATOMIC_RELAXED, __HIP_MEMORY_SCOPE_AGENT);
                            bf16_t* gp = Pb + row * NIN + C_GR + gch; const float gr = __uint_as_float(((unsigned)*gp) << 16);
                            *gp = (bf16_t)(cvt_pk_bf16((hv + oth) * gr, 0.f) & 0xffffu); } } }
            }
        }
#undef SC_LOAD
        __syncthreads();
    }
}

__device__ __forceinline__ void r2_phase(Frame& F, int l, bool dry = false) {
    LAS float* rw = (LAS float*)(F.lds + RING_OFF);
    { const float* rwp = F.router_w(); for (int i = F.tid; i < 16 * 1024; i += NWAVES * 64) { const int e = i >> 10, k = i & 1023; rw[i] = rwp[k * 16 + e]; } }
    __syncthreads();
    float rb[16]; const float* rbp = F.router_b();
#pragma unroll
    for (int e = 0; e < 16; ++e) rb[e] = rbp[e];
    const bool all = (l == 0); const int nrows = all ? T : NB * SEQ;
    const float* MODb = F.MOD(); float* XCb = F.XC(); float* outb = F.out(); const float* xin = F.x(); const float* cin = F.ctx(); const bf16_t* YB = F.YBUF(); unsigned char* H8b = F.H8();
    const float* n2g = F.norm2_g() + (size_t)l * D; unsigned* RT = F.ROUTE(); gu32* cnt = F.ctl() + CW_CNT + l * 64;
    const RowRange rr = wave_rows(F, nrows);
    int cursel = -1; f32x4 g1v[4], gm[4], sh[4], vn[4]; u32x2 yn[4];
    unsigned my_e0 = 0u, my_e1 = 0u; float my_w0 = 0.f, my_w1 = 0.f; int my_row = 0;
#define R2_XI(b_, p_) ((l == 0) ? (((p_) < NCTX) ? cin + (size_t)((b_) * NCTX + (p_)) * D : xin + (size_t)((b_) * SEQ + (p_) - NCTX) * D) : (const float*)(outb + (size_t)((b_) * SEQ + (p_) - NCTX) * D))
#define R2_LOAD(idx_) do { int b_, p_; row_decode((idx_), all, b_, p_); ld_row_f32(R2_XI(b_, p_), F.lane, vn); \
        _Pragma("unroll") for (int j = 0; j < 4; ++j) yn[j] = *((const GAS u32x2*)(YB + (size_t)(b_ * TB + p_) * D) + F.lane + 64 * j); } while (0)
    if (rr.lo < rr.hi) R2_LOAD(rr.lo);
    for (int c0 = rr.lo; c0 < rr.hi; c0 += 64) {
    const int c1 = (c0 + 64 < rr.hi) ? c0 + 64 : rr.hi;
    for (int idx = c0; idx < c1; ++idx) {
        int b, p; row_decode(idx, all, b, p);
        const int row = b * TB + p; const bool isc = p < NCTX; const int sel = isc ? 16 : b;
        float* xo = isc ? XCb + (size_t)(b * NCTX + p) * D : outb + (size_t)(b * SEQ + p - NCTX) * D;
        f32x4 v[4], h[4];
#pragma unroll
        for (int j = 0; j < 4; ++j) { const u32x2 w = yn[j]; v[j] = vn[j]; h[j] = (f32x4){bf_lo(w.x), bf_hi(w.x), bf_lo(w.y), bf_hi(w.y)}; }
        if (idx + 1 < rr.hi) R2_LOAD(idx + 1);
        if (sel != cursel) { cursel = sel; f32x4 g[4], sc[4]; ld_vec(n2g, F.lane, g); ld_vec(modp(MODb, l, sel, 4), F.lane, sc); ld_vec(modp(MODb, l, sel, 3), F.lane, sh); ld_vec(modp(MODb, l, sel, 2), F.lane, g1v);
#pragma unroll
            for (int j = 0; j < 4; ++j) gm[j] = g[j] * (sc[j] + 1.0f); }
#pragma unroll
        for (int j = 0; j < 4; ++j) v[j] = v[j] + g1v[j] * h[j];
        if (!dry) st_row_f32(xo, F.lane, v);
        const float rinv = row_rinv(v);
#pragma unroll
        for (int j = 0; j < 4; ++j) h[j] = (v[j] * rinv) * gm[j] + sh[j];
        if (!dry) st_row_fp8(H8b + (size_t)row * D, F.lane, h);
        float lg[16]; LAS float* rwl = rw; asm volatile("" : "+v"(rwl));
#pragma unroll
        for (int e = 0; e < 16; ++e) { float a = 0.f;
#pragma unroll
            for (int j = 0; j < 4; ++j) { const f32x4 wv = *(const LAS f32x4*)(rwl + e * 1024 + 256 * j + 4 * F.lane); a += (h[j][0] * wv[0] + h[j][1] * wv[1]) + (h[j][2] * wv[2] + h[j][3] * wv[3]); }
            lg[e] = wave_sum(a); }
        float s[16], sl[16];
#pragma unroll
        for (int e = 0; e < 16; ++e) { s[e] = 1.0f / (1.0f + __expf(-lg[e])); sl[e] = s[e] + rb[e]; }
        float bestg = -INFINITY; int gi = 0;
#pragma unroll
        for (int g = 0; g < 4; ++g) { float m1 = -INFINITY, m2 = -INFINITY;
#pragma unroll
            for (int k = 0; k < 4; ++k) { const float t = sl[4 * g + k]; if (t > m1) { m2 = m1; m1 = t; } else if (t > m2) m2 = t; }
            const float gs = m1 + m2; if (gs > bestg) { bestg = gs; gi = g; } }
        float c4[4], s4[4];
#pragma unroll
        for (int k = 0; k < 4; ++k) { c4[k] = gi == 0 ? sl[k] : gi == 1 ? sl[4 + k] : gi == 2 ? sl[8 + k] : sl[12 + k]; s4[k] = gi == 0 ? s[k] : gi == 1 ? s[4 + k] : gi == 2 ? s[8 + k] : s[12 + k]; }
        int i0 = 0; float v0 = c4[0], w0 = s4[0];
#pragma unroll
        for (int k = 1; k < 4; ++k) if (c4[k] > v0) { v0 = c4[k]; i0 = k; w0 = s4[k]; }
        int i1 = -1; float v1 = -INFINITY, w1 = 0.f;
#pragma unroll
        for (int k = 0; k < 4; ++k) if (k != i0 && c4[k] > v1) { v1 = c4[k]; i1 = k; w1 = s4[k]; }
        const float wsum = w0 + w1; w0 /= wsum; w1 /= wsum;
        if (F.lane == idx - c0) { my_e0 = (unsigned)(4 * gi + i0); my_e1 = (unsigned)(4 * gi + i1); my_w0 = w0; my_w1 = w1; my_row = row; }
    }
    if (!dry) {
        const int nmine = c1 - c0; const bool have = F.lane < nmine;
        unsigned r0 = 0u, r1 = 0u, mycnt = 0u;
        const unsigned long long ltm = (1ull << F.lane) - 1ull;
#pragma unroll
        for (int e = 0; e < 16; ++e) { const unsigned long long m0 = __ballot(have && my_e0 == (unsigned)e), m1 = __ballot(have && my_e1 == (unsigned)e);
            const unsigned c0 = (unsigned)__popcll(m0), c1 = (unsigned)__popcll(m1);
            if (my_e0 == (unsigned)e) r0 = (unsigned)__popcll(m0 & ltm);
            if (my_e1 == (unsigned)e) r1 = c0 + (unsigned)__popcll(m1 & ltm);
            if (F.lane == e) mycnt = c0 + c1; }
        unsigned base = 0u; if (F.lane < 16 && mycnt) base = __hip_atomic_fetch_add(cnt + F.lane, mycnt, RLX_AGENT);
        const unsigned b0 = (unsigned)__shfl((int)base, (int)my_e0), b1 = (unsigned)__shfl((int)base, (int)my_e1);
        if (have) { const u32x4 q0 = {my_e0, b0 + r0, my_e1, b1 + r1}; const u32x4 q1 = {__float_as_uint(my_w0), __float_as_uint(my_w1), 0u, 0u};
            *(GAS u32x4*)(RT + (size_t)my_row * 8) = q0; *(GAS u32x4*)(RT + (size_t)my_row * 8 + 4) = q1; }
    }
    }
#undef R2_LOAD
#undef R2_XI
    __syncthreads();
}

__device__ __forceinline__ void build_ptab(Frame& F, int l, LAS int* ptab) {
    if (F.tid == 0) { int acc = 0; gu32* cntb = F.ctl() + CW_CNT + l * 64;
        for (int e = 0; e < NE; ++e) { ptab[e] = acc; const int c = (int)__hip_atomic_load(cntb + e, RLX_AGENT); acc += ((c + 255) >> 8) << 8; }
        ptab[NE] = acc; }
    __syncthreads();
}
__device__ __forceinline__ void gather_phase(Frame& F, int l, LAS int* ptab) {
    const bool all = (l == 0); const int nrows = all ? T : NB * SEQ;
    const unsigned* RT = F.ROUTE(); const unsigned char* Ab = F.H8(); unsigned char* HGb = F.HG();
    const RowRange rr = wave_rows(F, nrows);
    for (int idx = rr.lo; idx < rr.hi; idx += 4) {
        u32x4 a[4]; size_t p0[4], p1[4];
#pragma unroll
        for (int k = 0; k < 4; ++k) if (idx + k < rr.hi) { int b, p; row_decode(idx + k, all, b, p); const int row = b * TB + p;
            const u32x4 r0 = *(const GAS u32x4*)(RT + (size_t)row * 8); p0[k] = (size_t)ptab[r0.x] + r0.y; p1[k] = (size_t)ptab[r0.z] + r0.w;
            a[k] = *((const GAS u32x4*)(Ab + (size_t)row * D) + F.lane); }
#pragma unroll
        for (int k = 0; k < 4; ++k) if (idx + k < rr.hi) { *((GAS u32x4*)(HGb + p0[k] * D) + F.lane) = a[k]; *((GAS u32x4*)(HGb + p1[k] * D) + F.lane) = a[k]; }
    }
}
__device__ __forceinline__ void r3_phase(Frame& F, int l, LAS int* ptab, bool dry = false) {
    const bool all = (l == 0); const int nrows = all ? T : NB * SEQ;
    const float* MODb = F.MOD(); float* XCb = F.XC(); float* outb = F.out(); const bf16_t* YPb = F.YP(); bf16_t* Ab = F.A(); const unsigned* RT = F.ROUTE();
    const float* n1g = F.norm1_g() + (size_t)(l == 0 ? 1 : 0) * D;
    const RowRange rr = wave_rows(F, nrows);
    int cursel = -1; f32x4 g2v[4], gm[4], sh[4], vn[4]; u32x2 y0n[4], y1n[4]; float w0n = 0.f, w1n = 0.f;
    u32x4 ra = {0u, 0u, 0u, 0u}; u32x2 rb2 = {0u, 0u};
#define R3_ROUTE(idx_) do { int b_, p_; row_decode((idx_), all, b_, p_); const int row_ = b_ * TB + p_; ra = *(const GAS u32x4*)(RT + (size_t)row_ * 8); rb2 = *(const GAS u32x2*)(RT + (size_t)row_ * 8 + 4); } while (0)
#define R3_LOAD(idx_) do { int b_, p_; row_decode((idx_), all, b_, p_); const u32x4 r0_ = ra; const u32x2 r1_ = rb2; \
        const size_t q0_ = (size_t)ptab[r0_.x] + r0_.y, q1_ = (size_t)ptab[r0_.z] + r0_.w; w0n = __uint_as_float(r1_.x); w1n = __uint_as_float(r1_.y); \
        ld_row_f32((p_ < NCTX) ? XCb + (size_t)(b_ * NCTX + p_) * D : outb + (size_t)(b_ * SEQ + p_ - NCTX) * D, F.lane, vn); \
        _Pragma("unroll") for (int j = 0; j < 4; ++j) { y0n[j] = *((const GAS u32x2*)(YPb + q0_ * D) + F.lane + 64 * j); y1n[j] = *((const GAS u32x2*)(YPb + q1_ * D) + F.lane + 64 * j); } } while (0)
    if (rr.lo < rr.hi) { R3_ROUTE(rr.lo); R3_LOAD(rr.lo); if (rr.lo + 1 < rr.hi) R3_ROUTE(rr.lo + 1); }
    for (int idx = rr.lo; idx < rr.hi; ++idx) {
        int b, p; row_decode(idx, all, b, p);
        const int row = b * TB + p; const bool isc = p < NCTX; const int sel = isc ? 16 : b;
        float* xo = isc ? XCb + (size_t)(b * NCTX + p) * D : outb + (size_t)(b * SEQ + p - NCTX) * D;
        f32x4 v[4], m[4]; const float w0 = w0n, w1 = w1n;
#pragma unroll
        for (int j = 0; j < 4; ++j) { const u32x2 a = y0n[j], c = y1n[j]; v[j] = vn[j];
            m[j] = (f32x4){bf_lo(a.x) * w0 + bf_lo(c.x) * w1, bf_hi(a.x) * w0 + bf_hi(c.x) * w1, bf_lo(a.y) * w0 + bf_lo(c.y) * w1, bf_hi(a.y) * w0 + bf_hi(c.y) * w1}; }
        if (idx + 1 < rr.hi) { R3_LOAD(idx + 1); if (idx + 2 < rr.hi) R3_ROUTE(idx + 2); }
        if (sel != cursel) { cursel = sel; ld_vec(modp(MODb, l, sel, 5), F.lane, g2v);
            if (l == 0) { f32x4 g[4], sc[4]; ld_vec(n1g, F.lane, g); ld_vec(modp(MODb, l + 1, sel, 1), F.lane, sc); ld_vec(modp(MODb, l + 1, sel, 0), F.lane, sh);
#pragma unroll
                for (int j = 0; j < 4; ++j) gm[j] = g[j] * (sc[j] + 1.0f); } }
#pragma unroll
        for (int j = 0; j < 4; ++j) v[j] = v[j] + g2v[j] * m[j];
        if (!isc && !dry) st_row_f32(xo, F.lane, v);
        if (l == 0) { const float rinv = row_rinv(v); f32x4 h[4];
#pragma unroll
            for (int j = 0; j < 4; ++j) h[j] = (v[j] * rinv) * gm[j] + sh[j];
            if (!dry) st_row_bf16(Ab + (size_t)row * D, F.lane, h); }
    }
#undef R3_LOAD
#undef R3_ROUTE
}

struct SchedProj {
    const char* A; const char* B; int G, c;
    __device__ __forceinline__ bool next(int i, pg8::Unit& u) const { int pm, pn; if (!pg8::tile_order((long)i * G + c, T / 256, NIN / 256, pm, pn)) return false;
        u.pm = pm; u.pn = pn; u.aux = 0; u.A = A + (size_t)pm * 256 * D * 2; u.B = B + (size_t)pn * 256 * D * 2; return true; }
};
__device__ __forceinline__ int lat_tile(int pe) { return (pe >> 4) * 17 + 1 + (pe & 15); }
struct SchedMerge {
    const char* P; const char* B; int G, c, nM; bool lat_only;
    __device__ __forceinline__ bool next(int i, pg8::Unit& u) const { const int rnd = i / 3, br = i - rnd * 3; int pm, pn; if (!pg8::tile_order((long)rnd * G + c, nM, 4, pm, pn)) return false;
        if (lat_only) pm = lat_tile(pm);
        const int acol = br == 0 ? C_GR : (br == 1 ? C_GQ : C_WQ);
        u.pm = pm; u.pn = pn; u.aux = br; u.A = P + ((size_t)pm * 256 * NIN + acol) * 2; u.B = B + ((size_t)br * D + pn * 256) * 512 * 2; return true; }
};
struct SchedOut {
    const char* A; const char* B; int G, c, nM; bool lat_only;
    __device__ __forceinline__ bool next(int i, pg8::Unit& u) const { int pm, pn; if (!pg8::tile_order((long)i * G + c, nM, 4, pm, pn)) return false;
        if (lat_only) pm = lat_tile(pm);
        u.pm = pm; u.pn = pn; u.aux = 0; u.A = A + (size_t)pm * 256 * D * 2; u.B = B + (size_t)pn * 256 * D * 2; return true; }
};
struct SchedMoe {
    const char* A; const char* B; const LAS int* ptab; int G, c, npn;
    __device__ __forceinline__ bool next(int i, pg8::Unit& u) const { const int L = i * G + c; const int ntile = ptab[NE] >> 8; if (L >= ntile * npn) return false;
        const int j = L / npn, pn = L - j * npn; int e = 0;
#pragma unroll
        for (int k = 1; k < NE; ++k) e += (ptab[k] <= j * 256) ? 1 : 0;
        u.pm = j; u.pn = pn; u.aux = e; u.A = A + (size_t)j * 256 * D; u.B = B + ((size_t)e * npn + pn) * 256 * D; return true; }
};

#ifndef PROBE
#define PROBE 0
#endif
static_assert(sizeof(Args) == sizeof(KArgs), "kernarg views");
__global__ void __launch_bounds__(NWAVES * 64, 2) mega_fwd(Args args) {
    extern __shared__ __attribute__((aligned(16))) unsigned char lds[];
    volatile LAS unsigned* MISC = (volatile LAS unsigned*)((LAS unsigned char*)lds + MISC_OFF);
    LAS int* ptab = (LAS int*)((LAS unsigned char*)lds + LDSCTL_OFF);
    Frame F0; {
    Frame& F = F0;
    F.lds = (LAS unsigned char*)lds;
    F.tid = threadIdx.x; F.lane = F.tid & 63; F.wave = __builtin_amdgcn_readfirstlane(F.tid >> 6);
    F.G = gridDim.x; { const int bx = blockIdx.x; F.vcu = (F.G % 8 == 0) ? (bx % 8) * (F.G / 8) + bx / 8 : bx; }
    F.gw = F.vcu * NWAVES + F.wave; F.NGW = F.G * NWAVES; F.bid = blockIdx.x; }
    for (int u = F0.tid; u < (LDS_BYTES - LDSCTL_OFF) / 4; u += NWAVES * 64) ((LAS unsigned*)(F0.lds + LDSCTL_OFF))[u] = 0u;
    __syncthreads();
    XcdBarrier bar = xcd_barrier_post((unsigned*)(F0.ctl() + CW_BAR), MISC + 8);
#define GRID_BAR() do { XcdBarrier b_ = bar; asm volatile("" : "+s"(b_.bar), "+s"(b_.x)); xcd_barrier(b_); } while (0)

    { Frame F = fresh(F0); p0_prologue(F); }
    if (PROBE == 13) { __syncthreads(); Frame F = fresh(F0); p0_prologue(F); }
    GRID_BAR();
    { Frame F = fresh(F0); r1_phase(F); }
    if (PROBE == 17) { Frame F = fresh(F0); r1_phase(F); }
    GRID_BAR();

    for (int l = 0; l < NL; ++l) {
        const bool last = (l == NL - 1);
        { Frame F = fresh(F0);
            pg8::Gemm g{D / 64, D * 2, D * 2}; SchedProj S{(const char*)F.A(), (const char*)(F.WIN() + (size_t)l * NIN * D), F.G, F.bid};
            pg8::EpiProj E{F.PROJ(), F.b_merge() + (size_t)l * 3 * D};
            pg8::gemm_phase(F.lds + RING_OFF, g, S, E);
            if (PROBE == 1) { __syncthreads(); pg8::gemm_phase(F.lds + RING_OFF, g, S, E); }
        }
        GRID_BAR();
        if (PROBE == 14) { Frame F = fresh(F0); kfix_phase(F, l, __hip_atomic_load(F.ctl() + 8, RLX_AGENT) == 0u); }
        { Frame F = fresh(F0); kfix_phase(F, l); }
        GRID_BAR();
        if (PROBE == 4) { Frame F = fresh(F0); const bool dry = __hip_atomic_load(F.ctl() + 8, RLX_AGENT) == 0u; for (int uid = F.vcu; uid < 256; uid += F.G) scan_unit(F, l, uid, last, dry); __syncthreads(); }
        { Frame F = fresh(F0); for (int uid = F.vcu; uid < 256; uid += F.G) scan_unit(F, l, uid, last); }
        __syncthreads();
        { Frame F = fresh(F0);
            const int per = (2048 + F.G - 1) / F.G;
            attn_body::AttnArgs aa; aa.P = (attn_body::bf16*)F.PROJ(); aa.ropec = F.ROPEC(); aa.ropes = F.ROPES(); aa.dry = false;
            aa.qg = F.q_norm_g() + (size_t)(l * 2 + 0) * 64; aa.sink = 0.f;
            if (PROBE == 11) { aa.dry = __hip_atomic_load(F.ctl() + 8, RLX_AGENT) == 0u; for (int gid = F.vcu * per; gid < (F.vcu + 1) * per && gid < 2048; ++gid) { const int pair = gid >> 6, uu = gid & 63; const int b = pair >> 1, h = (pair & 1) * 4 + (uu >> 4), qb = uu & 15;
                attn_body::attn_unit<0, 8>(b, h, qb, aa, (char*)lds + RING_OFF); } aa.dry = false; }
            if (PROBE != 9) for (int gid = F.vcu * per; gid < (F.vcu + 1) * per && gid < 2048; ++gid) { const int pair = gid >> 6, uu = gid & 63; const int b = pair >> 1, h = (pair & 1) * 4 + (uu >> 4), qb = uu & 15;
                attn_body::attn_unit<0, 8>(b, h, qb, aa, (char*)lds + RING_OFF); }
            aa.qg = F.q_norm_g() + (size_t)(l * 2 + 1) * 64;
            if (PROBE == 12) { aa.dry = __hip_atomic_load(F.ctl() + 8, RLX_AGENT) == 0u; for (int gid = F.vcu * per; gid < (F.vcu + 1) * per && gid < 2048; ++gid) { const int pair = gid >> 6, uu = gid & 63; const int b = pair >> 1, h = (pair & 1) * 4 + (uu >> 4), qb = uu & 15;
                aa.sink = 0.f; attn_body::attn_unit<1, 8>(b, h, qb, aa, (char*)lds + RING_OFF); } aa.dry = false; }
            if (PROBE != 10) for (int gid = F.vcu * per; gid < (F.vcu + 1) * per && gid < 2048; ++gid) { const int pair = gid >> 6, uu = gid & 63; const int b = pair >> 1, h = (pair & 1) * 4 + (uu >> 4), qb = uu & 15;
                aa.sink = F.sink()[l * 8 + h];
                attn_body::attn_unit<1, 8>(b, h, qb, aa, (char*)lds + RING_OFF); }
            if (!last) {
                for (int cid = F.vcu; cid < 256; cid += F.G) { const int b = cid >> 4, h = (cid >> 1) & 7;
                    if (cid & 1) { aa.qg = F.q_norm_g() + (size_t)(l * 2 + 1) * 64; aa.sink = F.sink()[l * 8 + h]; attn_body::attn_unit<3, 8>(b, h, 0, aa, (char*)lds + RING_OFF); }
                    else { aa.qg = F.q_norm_g() + (size_t)(l * 2 + 0) * 64; aa.sink = 0.f; attn_body::attn_unit<2, 8>(b, h, 0, aa, (char*)lds + RING_OFF); } }
            }
        }
        GRID_BAR();
        { Frame F = fresh(F0);
            pg8::Gemm g{512 / 64, NIN * 2, 512 * 2}; SchedMerge S{(const char*)F.PROJ(), (const char*)(F.WBR() + (size_t)l * 3 * D * 512), F.G, F.bid, last ? 256 : 272, last};
            pg8::EpiMerge E{F.PROJ(), F.A()};
            pg8::gemm_phase(F.lds + RING_OFF, g, S, E);
            if (PROBE == 2) { __syncthreads(); pg8::gemm_phase(F.lds + RING_OFF, g, S, E); }
        }
        GRID_BAR();
        { Frame F = fresh(F0);
            pg8::Gemm g{D / 64, D * 2, D * 2}; SchedOut S{(const char*)F.A(), (const char*)(F.WOUT() + (size_t)l * D * D), F.G, F.bid, last ? 256 : 272, last};
            pg8::EpiPlain E{F.YBUF(), D, 1.0f};
            pg8::gemm_phase(F.lds + RING_OFF, g, S, E);
            if (PROBE == 3) { __syncthreads(); pg8::gemm_phase(F.lds + RING_OFF, g, S, E); }
        }
        GRID_BAR();
        { Frame F = fresh(F0); convert_experts(F, l); }
        __syncthreads();
        if (PROBE == 7) { Frame F = fresh(F0); convert_experts(F, l); __syncthreads(); }
        if (PROBE == 15) { Frame F = fresh(F0); r2_phase(F, l, __hip_atomic_load(F.ctl() + 8, RLX_AGENT) == 0u); }
        { Frame F = fresh(F0); r2_phase(F, l); }
        GRID_BAR();
        { Frame F = fresh(F0); build_ptab(F, l, ptab); gather_phase(F, l, ptab); if (PROBE == 8) gather_phase(F, l, ptab); }
        GRID_BAR();
        { Frame F = fresh(F0);
            pg8::Gemm g{D / 128, D, D}; SchedMoe S{(const char*)F.HG(), (const char*)F.W13(), ptab, F.G, F.bid, 8};
            pg8::EpiSwiglu E{F.HID(), 1.0f / WSCALE};
            pg8::gemm_phase<pg8::EpiSwiglu, SchedMoe, true>(F.lds + RING_OFF, g, S, E);
            if (PROBE == 5) { __syncthreads(); pg8::gemm_phase<pg8::EpiSwiglu, SchedMoe, true>(F.lds + RING_OFF, g, S, E); }
        }
        GRID_BAR();
        { Frame F = fresh(F0);
            pg8::Gemm g{D / 128, D, D}; SchedMoe S{(const char*)F.HID(), (const char*)F.W2(), ptab, F.G, F.bid, 4};
            pg8::EpiPlain E{F.YP(), D, 1.0f / WSCALE};
            pg8::gemm_phase<pg8::EpiPlain, SchedMoe, true>(F.lds + RING_OFF, g, S, E);
            if (PROBE == 6) { __syncthreads(); pg8::gemm_phase<pg8::EpiPlain, SchedMoe, true>(F.lds + RING_OFF, g, S, E); }
        }
        GRID_BAR();
        if (PROBE == 16) { Frame F = fresh(F0); r3_phase(F, l, ptab, __hip_atomic_load(F.ctl() + 8, RLX_AGENT) == 0u); }
        { Frame F = fresh(F0); r3_phase(F, l, ptab); }
        if (!last) GRID_BAR();
    }
}

extern "C" void kernel_launch(void* const* d_in, const int* in_sizes, int n_in, void* d_out, int out_size, void* d_ws, size_t ws_size, hipStream_t stream) {
    static int grid = 0;
    if (grid == 0) {
        if (n_in != 27 || in_sizes[0] != NB * SEQ * D || out_size != NB * SEQ * D || ws_size < WS_END) { fprintf(stderr, "kernel_launch: unexpected shapes / workspace (n_in %d, ws %zu < %zu)\n", n_in, ws_size, (size_t)WS_END); grid = -1; return; }
        int dev = 0, cus = 0, per_cu = 0;
        if (hipGetDevice(&dev) != hipSuccess || hipDeviceGetAttribute(&cus, hipDeviceAttributeMultiprocessorCount, dev) != hipSuccess) { grid = -1; return; }
        if (hipFuncSetAttribute((const void*)mega_fwd, hipFuncAttributeMaxDynamicSharedMemorySize, LDS_BYTES) != hipSuccess) { fprintf(stderr, "kernel_launch: hipFuncSetAttribute failed\n"); grid = -1; return; }
        if (hipOccupancyMaxActiveBlocksPerMultiprocessor(&per_cu, (const void*)mega_fwd, NWAVES * 64, LDS_BYTES) != hipSuccess || per_cu < 1) { fprintf(stderr, "kernel_launch: occupancy query says %d\n", per_cu); }
        (void)hipGetLastError();
        grid = cus;
    }
    if (grid < 0) return;
    if (hipMemsetAsync((char*)d_ws + WS_CTL, 0, CTL_ZERO_BYTES, stream) != hipSuccess) return;
    Args a{};
    for (int i = 0; i < 27; ++i) a.in[i] = (const float*)d_in[i];
    a.out = (float*)d_out; a.ws = (unsigned char*)d_ws;
    hipLaunchKernelGGL(mega_fwd, dim3(grid), dim3(NWAVES * 64), LDS_BYTES, stream, a);
}
```

```cpp
#define PROBE 0
#include <hip/hip_runtime.h>
#include <hip/hip_bf16.h>
#include <cstdio>
#include <cstdint>
#include <cmath>

#define GAS __attribute__((address_space(1)))
#define LAS __attribute__((address_space(3)))
typedef unsigned short bf16_t;
typedef short bf16x8 __attribute__((ext_vector_type(8)));
typedef float f32x4 __attribute__((ext_vector_type(4)));
typedef float f32x2 __attribute__((ext_vector_type(2)));
typedef unsigned u32x4 __attribute__((ext_vector_type(4)));
typedef unsigned u32x2 __attribute__((ext_vector_type(2)));

constexpr int NB = 16, SEQ = 4096, NCTX = 256, TB = SEQ + NCTX, T = NB * TB;
constexpr int D = 1024, NIN = 5632, NL = 2, NE = 16;
constexpr int C_XR = 0, C_GR = 512, C_GQ = 1024, C_GK = 1536, C_GV = 1664, C_WQ = 1792, C_WK = 2304, C_WV = 2432, C_MG = 2560;
constexpr float EPS = 1e-6f;
constexpr int PMAX = 143360;

__device__ __forceinline__ unsigned cvt_pk_bf16(float lo, float hi) { unsigned r; asm volatile("v_cvt_pk_bf16_f32 %0, %1, %2" : "=v"(r) : "v"(lo), "v"(hi)); return r; }
typedef int i32x8 __attribute__((ext_vector_type(8)));
typedef int i32x4 __attribute__((ext_vector_type(4)));
__device__ __forceinline__ unsigned pk4_fp8(float a, float b, float c, float d) {
    a = __builtin_fminf(__builtin_fmaxf(a, -448.f), 448.f); b = __builtin_fminf(__builtin_fmaxf(b, -448.f), 448.f); c = __builtin_fminf(__builtin_fmaxf(c, -448.f), 448.f); d = __builtin_fminf(__builtin_fmaxf(d, -448.f), 448.f);
    int w = __builtin_amdgcn_cvt_pk_fp8_f32(a, b, 0, false); w = __builtin_amdgcn_cvt_pk_fp8_f32(c, d, w, true); return (unsigned)w; }
__device__ __forceinline__ float bf_lo(unsigned u) { return __uint_as_float(u << 16); }
__device__ __forceinline__ float bf_hi(unsigned u) { return __uint_as_float(u & 0xffff0000u); }
__device__ __forceinline__ float fast_sigmoid(float v) { return __builtin_amdgcn_rcpf(1.0f + __builtin_amdgcn_exp2f(-1.4426950409f * v)); }
__device__ __forceinline__ float gelu_tanh(float v) { return v * __builtin_amdgcn_rcpf(1.0f + __builtin_amdgcn_exp2f(-2.3022082f * v * (1.0f + 0.044715f * v * v))); }

namespace pg8 {
constexpr int BM = 256, BK = 64, HALF = 128, HTB = HALF * BK * 2, STAGE_BYTES = 8 * HTB, NXCD = 8, WGM = 8;
__host__ __device__ __forceinline__ int lds_byte(int r, int c) { const int st = (r >> 4) * 2 + (c >> 5), rr = r & 15, cc = c & 31, ob = rr * 64 + cc * 2; return st * 1024 + (ob ^ (((ob >> 9) & 1) << 5)); }
__host__ __device__ __forceinline__ void stage_rc(int b, int& R, int& C) { const int st = b / 1024, sb = b % 1024, swz = sb ^ (((sb >> 9) & 1) << 5); R = (st >> 1) * 16 + swz / 64; C = (st & 1) * 32 + (swz % 64) / 2; }
__host__ __device__ __forceinline__ int perm32(int rho) { const int n = rho >> 4, i = rho & 15; return 8 * (i >> 2) + 4 * n + (i & 3); }

struct Unit { int pm, pn, aux; const char* A; const char* B; };
struct Gemm { int nt, ldaB, ldbB; };

__device__ __forceinline__ bool tile_order(long L, int nM, int nN, int& pm, int& pn) {
    const int nwg = nM * nN; if (L >= nwg) return false;
    int wgid = (int)L; { const int q = nwg / NXCD, r = nwg % NXCD, xcd = wgid % NXCD, off = wgid / NXCD; wgid = (xcd < r ? xcd * (q + 1) : r * (q + 1) + (xcd - r) * q) + off; }
    const int nig = WGM * nN, gid = wgid / nig, fm = gid * WGM, gsz = (nM - fm) < WGM ? (nM - fm) : WGM;
    pm = fm + ((wgid % nig) % gsz); pn = (wgid % nig) / gsz; return true;
}

template <class Epi, class Sched, bool FP8 = false>
__device__ __forceinline__ void gemm_phase(LAS unsigned char* lds, const Gemm g, const Sched& S, const Epi& E) {
    int tid_ = threadIdx.x; asm volatile("" : "+v"(tid_));
    const int tid = tid_, wid = __builtin_amdgcn_readfirstlane(tid >> 6), lane = tid & 63, wr = wid >> 2, wc = wid & 3, fr = lane & 15, fq = lane >> 4;
    int nt_ = g.nt; asm volatile("" : "+s"(nt_)); const int nt = nt_;
    unsigned voffA[2], voffB[2];
#pragma unroll
    for (int i = 0; i < 2; ++i) { int R, C; stage_rc(tid * 16 + i * 8192, R, C); const int Rb = (R & ~31) + perm32(R & 31);
        voffA[i] = (unsigned)(R * g.ldaB + C * 2); voffB[i] = (unsigned)(Rb * g.ldbB + C * 2); }
    const size_t kstep = (size_t)(BK * 2);
    const size_t hstepA = (size_t)HALF * g.ldaB, hstepB = (size_t)HALF * g.ldbB;
    const unsigned ldsw = (unsigned)wid * 1024u;
    const int aoff = lds_byte(wr * 64 + fr, fq * 8), boff = lds_byte(wc * 32 + fr, fq * 8);
#define PG8_SA(b, h) (((b) * 2 + (h)) * HTB)
#define PG8_SB(b, h) ((4 + (b) * 2 + (h)) * HTB)
#define PG8_STAGE(bufoff, gbase, voff) do { _Pragma("unroll") for (int _i = 0; _i < 2; ++_i) \
        __builtin_amdgcn_global_load_lds((const unsigned*)((const char*)(gbase) + (voff)[_i]), (LAS unsigned*)(lds + (bufoff) + ldsw + _i * 8192), 16, 0, 0); } while (0)
#define PG8_LDA(dst, b, h) do { _Pragma("unroll") for (int m = 0; m < 4; ++m) _Pragma("unroll") for (int k = 0; k < 2; ++k) dst[m][k] = *(const LAS bf16x8*)(lds + PG8_SA(b, h) + aoff + m * 2048 + k * 1024); } while (0)
#define PG8_LDB(dst, b, h) do { _Pragma("unroll") for (int n = 0; n < 2; ++n) _Pragma("unroll") for (int k = 0; k < 2; ++k) dst[n][k] = *(const LAS bf16x8*)(lds + PG8_SB(b, h) + boff + n * 2048 + k * 1024); } while (0)
#define PG8_CAT(x) __builtin_shufflevector(__builtin_bit_cast(i32x4, x[0]), __builtin_bit_cast(i32x4, x[1]), 0, 1, 2, 3, 4, 5, 6, 7)
#define PG8_MMA(ai, bj, At, Bt) do { __builtin_amdgcn_s_setprio(1); \
        if constexpr (FP8) { _Pragma("unroll") for (int m = 0; m < 4; ++m) _Pragma("unroll") for (int n = 0; n < 2; ++n) \
            asm volatile("v_mfma_scale_f32_16x16x128_f8f6f4 %0, %1, %2, %0, %3, %3 op_sel_hi:[0,0,0]" : "+v"(acc[ai][bj][m][n]) : "v"(PG8_CAT(Bt[n])), "v"(PG8_CAT(At[m])), "v"(scl1)); } \
        else { _Pragma("unroll") for (int m = 0; m < 4; ++m) _Pragma("unroll") for (int n = 0; n < 2; ++n) _Pragma("unroll") for (int k = 0; k < 2; ++k) \
            acc[ai][bj][m][n] = __builtin_amdgcn_mfma_f32_16x16x32_bf16(Bt[n][k], At[m][k], acc[ai][bj][m][n], 0, 0, 0); } \
        __builtin_amdgcn_s_setprio(0); } while (0)
#define PG8_WAIT_V(n) asm volatile("s_waitcnt vmcnt(" #n ")" ::: "memory")
#define PG8_WAIT_L(n) asm volatile("s_waitcnt lgkmcnt(" #n ")" ::: "memory")
#define PG8_BAR __builtin_amdgcn_s_barrier()
#define PG8_SCHED __builtin_amdgcn_sched_barrier(0)
    int scl1 = 0x7F7F7F7F; asm volatile("" : "+v"(scl1));
    Unit cur, nxt; int ui = 0;
    if (!S.next(0, cur)) return;
    f32x4 acc[2][2][4][2];
#pragma unroll
    for (int a = 0; a < 2; ++a)
#pragma unroll
        for (int b = 0; b < 2; ++b)
#pragma unroll
            for (int m = 0; m < 4; ++m)
#pragma unroll
                for (int n = 0; n < 2; ++n) acc[a][b][m][n] = (f32x4){0.f, 0.f, 0.f, 0.f};
    bf16x8 At[4][2], B0[2][2], B1[2][2];
    const char* cA = cur.A; const char* cB = cur.B;
    PG8_STAGE(PG8_SB(0, 0), cB, voffB); PG8_STAGE(PG8_SB(0, 1), cB + hstepB, voffB); PG8_STAGE(PG8_SA(0, 0), cA, voffA); PG8_STAGE(PG8_SA(0, 1), cA + hstepA, voffA);
    if (wr == 1) PG8_BAR;
    PG8_WAIT_V(2); PG8_BAR;
    PG8_STAGE(PG8_SB(1, 0), cB + kstep, voffB); PG8_STAGE(PG8_SA(1, 0), cA + kstep, voffA); PG8_STAGE(PG8_SB(1, 1), cB + hstepB + kstep, voffB);
    PG8_WAIT_V(6); PG8_BAR;
    for (;;) {
        const bool has_next = S.next(ui + 1, nxt);
        const char* nA = has_next ? nxt.A : cA; const char* nB = has_next ? nxt.B : cB;
        for (int t = 0; t < nt; t += 2) {
            const bool last = (t == nt - 2);
            const char* a1 = cA + (size_t)(t + 1) * kstep;
            const char* a2 = last ? nA : cA + (size_t)(t + 2) * kstep; const char* b2 = last ? nB : cB + (size_t)(t + 2) * kstep;
            const char* a3 = a2 + kstep; const char* b3 = b2 + kstep;
            PG8_LDB(B0, 0, 0); PG8_LDB(B1, 0, 1); PG8_SCHED; PG8_LDA(At, 0, 0); PG8_STAGE(PG8_SA(1, 1), a1 + hstepA, voffA);
            PG8_WAIT_V(8); PG8_WAIT_L(0); PG8_BAR; PG8_MMA(0, 0, At, B0); PG8_MMA(0, 1, At, B1); PG8_BAR; PG8_SCHED;
            PG8_LDA(At, 0, 1); PG8_STAGE(PG8_SB(0, 0), b2, voffB); PG8_STAGE(PG8_SB(0, 1), b2 + hstepB, voffB); PG8_STAGE(PG8_SA(0, 0), a2, voffA);
            PG8_WAIT_V(8); PG8_WAIT_L(0); PG8_BAR; PG8_MMA(1, 0, At, B0); PG8_MMA(1, 1, At, B1); PG8_BAR; PG8_SCHED;
            PG8_LDB(B0, 1, 0); PG8_LDB(B1, 1, 1); PG8_SCHED; PG8_LDA(At, 1, 0); PG8_STAGE(PG8_SA(0, 1), a2 + hstepA, voffA);
            PG8_WAIT_V(8); PG8_WAIT_L(0); PG8_BAR; PG8_MMA(0, 0, At, B0); PG8_MMA(0, 1, At, B1); PG8_BAR; PG8_SCHED;
            PG8_LDA(At, 1, 1); PG8_STAGE(PG8_SB(1, 0), b3, voffB); PG8_STAGE(PG8_SB(1, 1), b3 + hstepB, voffB); PG8_STAGE(PG8_SA(1, 0), a3, voffA);
            PG8_WAIT_V(8); PG8_WAIT_L(0); PG8_BAR; PG8_MMA(1, 0, At, B0); PG8_MMA(1, 1, At, B1); PG8_BAR; PG8_SCHED;
        }
        if (wr == 0) PG8_BAR;
        if constexpr (FP8) asm volatile("s_nop 15\n\ts_nop 15" ::: "memory");
        E(acc, cur, wr, wc, fr, fq);
        if (!has_next) break;
#pragma unroll
        for (int a = 0; a < 2; ++a)
#pragma unroll
            for (int b = 0; b < 2; ++b)
#pragma unroll
                for (int m = 0; m < 4; ++m)
#pragma unroll
                    for (int n = 0; n < 2; ++n) acc[a][b][m][n] = (f32x4){0.f, 0.f, 0.f, 0.f};
        cur = nxt; cA = nA; cB = nB; ++ui;
        if (wr == 1) PG8_BAR;
    }
    PG8_WAIT_V(0);
    PG8_BAR;
#undef PG8_SA
#undef PG8_SB
#undef PG8_STAGE
#undef PG8_LDA
#undef PG8_LDB
#undef PG8_MMA
#undef PG8_CAT
#undef PG8_WAIT_V
#undef PG8_WAIT_L
#undef PG8_BAR
#undef PG8_SCHED
}

struct EpiProj {
    bf16_t* O; const float* bmerge; float scale;
    __device__ __forceinline__ void operator()(const f32x4 (&acc)[2][2][4][2], const Unit& u, int wr, int wc, int fr, int fq) const {
        const int row0 = u.pm * BM + wr * 64 + fr, col0 = u.pn * BM + wc * 32 + 8 * fq;
        const int mode = (u.pn == 2 || u.pn == 3) ? 1 : (u.pn >= 10 ? 2 : 0);
        f32x4 bv[2][2];
#pragma unroll
        for (int bj = 0; bj < 2; ++bj)
#pragma unroll
            for (int n = 0; n < 2; ++n) bv[bj][n] = (mode == 2) ? *(const f32x4*)(bmerge + (col0 - C_MG) + bj * HALF + 4 * n) : (f32x4){0.f, 0.f, 0.f, 0.f};
#pragma unroll
        for (int ai = 0; ai < 2; ++ai)
#pragma unroll
            for (int m = 0; m < 4; ++m) { bf16_t* rowp = O + (size_t)(row0 + ai * HALF + m * 16) * NIN + col0;
#pragma unroll
                for (int bj = 0; bj < 2; ++bj) { f32x4 v0 = acc[ai][bj][m][0] * scale + bv[bj][0], v1 = acc[ai][bj][m][1] * scale + bv[bj][1];
                    if (mode == 1) {
#pragma unroll
                        for (int j = 0; j < 4; ++j) { v0[j] = gelu_tanh(v0[j]); v1[j] = gelu_tanh(v1[j]); } }
                    else if (mode == 2) {
#pragma unroll
                        for (int j = 0; j < 4; ++j) { v0[j] = fast_sigmoid(v0[j]); v1[j] = fast_sigmoid(v1[j]); } }
                    u32x4 w; w.x = cvt_pk_bf16(v0[0], v0[1]); w.y = cvt_pk_bf16(v0[2], v0[3]); w.z = cvt_pk_bf16(v1[0], v1[1]); w.w = cvt_pk_bf16(v1[2], v1[3]);
                    *(u32x4*)(rowp + bj * HALF) = w; } }
    }
};
struct EpiPlain {
    bf16_t* O; int ldc; float scale;
    __device__ __forceinline__ void operator()(const f32x4 (&acc)[2][2][4][2], const Unit& u, int wr, int wc, int fr, int fq) const {
        const int row0 = u.pm * BM + wr * 64 + fr, col0 = u.pn * BM + wc * 32 + 8 * fq;
#pragma unroll
        for (int ai = 0; ai < 2; ++ai)
#pragma unroll
            for (int m = 0; m < 4; ++m) { bf16_t* rowp = O + (size_t)(row0 + ai * HALF + m * 16) * ldc + col0;
#pragma unroll
                for (int bj = 0; bj < 2; ++bj) { const f32x4 v0 = acc[ai][bj][m][0] * scale, v1 = acc[ai][bj][m][1] * scale;
                    u32x4 w; w.x = cvt_pk_bf16(v0[0], v0[1]); w.y = cvt_pk_bf16(v0[2], v0[3]); w.z = cvt_pk_bf16(v1[0], v1[1]); w.w = cvt_pk_bf16(v1[2], v1[3]);
                    *(u32x4*)(rowp + bj * HALF) = w; } }
    }
};
struct EpiMerge {
    const bf16_t* P; bf16_t* O;
    __device__ __forceinline__ void operator()(const f32x4 (&acc)[2][2][4][2], const Unit& u, int wr, int wc, int fr, int fq) const {
        const int row0 = u.pm * BM + wr * 64 + fr, col0 = u.pn * BM + wc * 32 + 8 * fq; const int b = u.aux;
#pragma unroll
        for (int ai = 0; ai < 2; ++ai)
#pragma unroll
            for (int m = 0; m < 4; ++m) { const size_t row = (size_t)(row0 + ai * HALF + m * 16);
                const bf16_t* gp = P + row * NIN + C_MG + b * D + col0; bf16_t* op = O + row * D + col0;
#pragma unroll
                for (int bj = 0; bj < 2; ++bj) { const u32x4 gt = *(const u32x4*)(gp + bj * HALF);
                    f32x4 v0 = acc[ai][bj][m][0], v1 = acc[ai][bj][m][1];
                    v0[0] *= bf_lo(gt.x); v0[1] *= bf_hi(gt.x); v0[2] *= bf_lo(gt.y); v0[3] *= bf_hi(gt.y);
                    v1[0] *= bf_lo(gt.z); v1[1] *= bf_hi(gt.z); v1[2] *= bf_lo(gt.w); v1[3] *= bf_hi(gt.w);
                    if (b > 0) { const u32x4 pv = *(const u32x4*)(op + bj * HALF);
                        v0[0] += bf_lo(pv.x); v0[1] += bf_hi(pv.x); v0[2] += bf_lo(pv.y); v0[3] += bf_hi(pv.y);
                        v1[0] += bf_lo(pv.z); v1[1] += bf_hi(pv.z); v1[2] += bf_lo(pv.w); v1[3] += bf_hi(pv.w); }
                    u32x4 w; w.x = cvt_pk_bf16(v0[0], v0[1]); w.y = cvt_pk_bf16(v0[2], v0[3]); w.z = cvt_pk_bf16(v1[0], v1[1]); w.w = cvt_pk_bf16(v1[2], v1[3]);
                    *(u32x4*)(op + bj * HALF) = w; } }
    }
};
struct EpiSwiglu {
    unsigned char* O; float scale;
    __device__ __forceinline__ void operator()(const f32x4 (&acc)[2][2][4][2], const Unit& u, int wr, int wc, int fr, int fq) const {
        const int row0 = u.pm * BM + wr * 64 + fr, col0 = u.pn * HALF + wc * 32 + 8 * fq;
#pragma unroll
        for (int ai = 0; ai < 2; ++ai)
#pragma unroll
            for (int m = 0; m < 4; ++m) { unsigned char* rowp = O + (size_t)(row0 + ai * HALF + m * 16) * D + col0;
                f32x4 v0 = acc[ai][0][m][0] * scale, v1 = acc[ai][0][m][1] * scale; const f32x4 g0 = acc[ai][1][m][0] * scale, g1 = acc[ai][1][m][1] * scale;
#pragma unroll
                for (int j = 0; j < 4; ++j) { v0[j] = v0[j] * fast_sigmoid(v0[j]) * g0[j]; v1[j] = v1[j] * fast_sigmoid(v1[j]) * g1[j]; }
                u32x2 w; w.x = pk4_fp8(v0[0], v0[1], v0[2], v0[3]); w.y = pk4_fp8(v1[0], v1[1], v1[2], v1[3]);
                *(u32x2*)rowp = w; }
    }
};
}
namespace attn_body {
using bf16 = __hip_bfloat16;
using s16x4 = __attribute__((ext_vector_type(4))) short;
using f32x16 = __attribute__((ext_vector_type(16))) float;
constexpr int DM = NIN;
constexpr int NW = 8, QBLK = 32, QB = QBLK * NW, KVBLK = 64;
__device__ __forceinline__ int crow(int r, int hi) { return (r & 3) + 8 * (r >> 2) + 4 * hi; }
#define SBAR() __builtin_amdgcn_sched_barrier(0)
constexpr int NSLOT = 3, SLOTB = 8192;
constexpr int LDS_K = 0, LDS_V = NSLOT * SLOTB, LDS_WS = 2 * NSLOT * SLOTB, LDS_OST = LDS_WS + NW * 64 * 4, LDS_BYTES = LDS_OST + NW * 4096;
constexpr float LOG2E = 1.4426950408889634f;
constexpr float C2 = 0.125f * LOG2E;
__device__ __forceinline__ void glds16(const void* gsrc, unsigned lds_dst) { unsigned keep;
    asm volatile("s_mov_b32 %0, m0\n\ts_mov_b32 m0, %2\n\ts_nop 0\n\tglobal_load_lds_dwordx4 %1, off\n\ts_mov_b32 m0, %0" : "=&s"(keep) : "v"(gsrc), "s"(lds_dst) : "memory"); }
__device__ __forceinline__ float max3f(float a, float b, float c) { float r; asm("v_max3_f32 %0, %1, %2, %3" : "=v"(r) : "v"(a), "v"(b), "v"(c)); return r; }
__device__ __forceinline__ float max2f(float a, float b) { float r; asm("v_max_f32_e32 %0, %1, %2" : "=v"(r) : "v"(a), "v"(b)); return r; }
__device__ __forceinline__ float fadd_s(float a, float b) { float r; asm("v_add_f32_e32 %0, %1, %2" : "=v"(r) : "v"(a), "v"(b)); return r; }
__device__ __forceinline__ float fsub_s(float a, float b) { float r; asm("v_sub_f32_e32 %0, %1, %2" : "=v"(r) : "v"(a), "v"(b)); return r; }
typedef float f32x2_t __attribute__((ext_vector_type(2))); typedef __bf16 bf16x2_t __attribute__((ext_vector_type(2)));
__device__ __forceinline__ unsigned cvtpk_s(float lo, float hi) { f32x2_t v = {lo, hi}; bf16x2_t b = __builtin_convertvector(v, bf16x2_t); return __builtin_bit_cast(unsigned, b); }
#define WAIT_BAR(N) asm volatile("s_waitcnt vmcnt(" #N ") lgkmcnt(0)\n\ts_barrier" ::: "memory")

__device__ __forceinline__ void qkt(f32x16& p0, f32x16& p1, const char* Kslot, const bf16x8* qr, const f32x16& negm, int r32, int hi) {
    const char* kb = Kslot + hi * 1024 + r32 * 16;
#pragma unroll
    for (int d0 = 0; d0 < 4; ++d0) {
        const bf16x8 b0 = *reinterpret_cast<const bf16x8*>(kb + d0 * 2048);
        const bf16x8 b1 = *reinterpret_cast<const bf16x8*>(kb + d0 * 2048 + 512);
        if (d0 == 0) { p0 = __builtin_amdgcn_mfma_f32_32x32x16_bf16(b0, qr[0], negm, 0, 0, 0); p1 = __builtin_amdgcn_mfma_f32_32x32x16_bf16(b1, qr[0], negm, 0, 0, 0); }
        else { p0 = __builtin_amdgcn_mfma_f32_32x32x16_bf16(b0, qr[d0], p0, 0, 0, 0); p1 = __builtin_amdgcn_mfma_f32_32x32x16_bf16(b1, qr[d0], p1, 0, 0, 0); } }
}
typedef __attribute__((address_space(3))) const char* lds_cptr;
typedef short v4i16_t __attribute__((ext_vector_type(4)));
__device__ __forceinline__ void kload8(bf16x8* kf, lds_cptr kp) {
    kf[0] = *(const LAS bf16x8*)(kp);        kf[1] = *(const LAS bf16x8*)(kp + 512);
    kf[2] = *(const LAS bf16x8*)(kp + 2048); kf[3] = *(const LAS bf16x8*)(kp + 2560);
    kf[4] = *(const LAS bf16x8*)(kp + 4096); kf[5] = *(const LAS bf16x8*)(kp + 4608);
    kf[6] = *(const LAS bf16x8*)(kp + 6144); kf[7] = *(const LAS bf16x8*)(kp + 6656);
}
__device__ __forceinline__ void kload2(bf16x8* kf, lds_cptr kp, int j) { kf[2 * j] = *(const LAS bf16x8*)(kp + j * 2048); kf[2 * j + 1] = *(const LAS bf16x8*)(kp + j * 2048 + 512); }
__device__ __forceinline__ s16x4 vtr(lds_cptr p) { return __builtin_bit_cast(s16x4, __builtin_amdgcn_ds_read_tr16_b64_v4i16((LAS v4i16_t*)p)); }
__device__ __forceinline__ float rowmax(const f32x16& p0, const f32x16& p1) {
    float a = max3f(p0[0], p0[1], p1[0]), b = max3f(p0[2], p0[3], p1[1]); a = max3f(a, p1[2], p1[3]);
#pragma unroll
    for (int r = 4; r < 16; r += 4) { a = max3f(a, p0[r], p0[r + 1]); b = max3f(b, p0[r + 2], p0[r + 3]); a = max3f(a, p1[r], p1[r + 1]); b = max3f(b, p1[r + 2], p1[r + 3]); }
    const float m = max2f(a, b);
    auto rr = __builtin_amdgcn_permlane32_swap(__float_as_uint(m), __float_as_uint(m), false, false);
    return max2f(__uint_as_float(rr[0]), __uint_as_float(rr[1]));
}
__device__ __forceinline__ void pv(f32x16* o, int vb, bf16x8 pa0, bf16x8 pa1, bf16x8 pa2, bf16x8 pa3) {
#pragma unroll
    for (int d0 = 0; d0 < 2; ++d0) { s16x4 lo[4], hi[4];
#pragma unroll
        for (int ks = 0; ks < 4; ++ks) {
            asm volatile("ds_read_b64_tr_b16 %0,%1 offset:%c2" : "=&v"(lo[ks]) : "v"(vb), "i"(d0 * 4096 + ks * 1024) : "memory");
            asm volatile("ds_read_b64_tr_b16 %0,%1 offset:%c2" : "=&v"(hi[ks]) : "v"(vb), "i"(d0 * 4096 + ks * 1024 + 512) : "memory"); }
        asm volatile("s_waitcnt lgkmcnt(0)" ::: "memory"); SBAR();
#define PK(k) (bf16x8){lo[k][0], lo[k][1], lo[k][2], lo[k][3], hi[k][0], hi[k][1], hi[k][2], hi[k][3]}
        o[d0] = __builtin_amdgcn_mfma_f32_32x32x16_bf16(pa0, PK(0), o[d0], 0, 0, 0);
        o[d0] = __builtin_amdgcn_mfma_f32_32x32x16_bf16(pa1, PK(1), o[d0], 0, 0, 0);
        o[d0] = __builtin_amdgcn_mfma_f32_32x32x16_bf16(pa2, PK(2), o[d0], 0, 0, 0);
        o[d0] = __builtin_amdgcn_mfma_f32_32x32x16_bf16(pa3, PK(3), o[d0], 0, 0, 0);
#undef PK
    }
}
__device__ __forceinline__ void wmask(f32x16& p0, f32x16& p1, int dk0, int hi) {
    const float NEG = -INFINITY; const int kb = dk0 + 4 * hi;
#pragma unroll
    for (int r = 0; r < 16; ++r) { const int d = kb + (r & 3) + 8 * (r >> 2); if (d > 128 || d < -128) p0[r] = NEG; if (d + 32 > 128 || d + 32 < -128) p1[r] = NEG; }
}

struct AttnArgs { bf16* P; const float* qg; const float* ropec; const float* ropes; float sink; bool dry; };

template <int MODE, int THRL> __device__ __forceinline__ void attn_unit(int b, int h, int qb, const AttnArgs& aa, char* shm) {
    constexpr bool LAT = (MODE < 2), WIN = (MODE == 1), SINK = (MODE == 1 || MODE == 3);
    constexpr int NT = (MODE == 0) ? 68 : (MODE == 1 ? 12 : 4);
    constexpr int QCOL = (MODE == 0 || MODE == 2) ? C_GQ : C_WQ, KCOL = (MODE == 0 || MODE == 2) ? C_GK : C_WK, VCOL = (MODE == 0 || MODE == 2) ? C_GV : C_WV;
    int tid_ = threadIdx.x; asm volatile("" : "+v"(tid_));
    const int tid = tid_, lane = tid & 63, r32 = lane & 31, hi = lane >> 5; const int wid = __builtin_amdgcn_readfirstlane(tid >> 6);
    const long rowbase = (long)b * TB; const int q0 = qb * QB;
    const long qrow0 = rowbase + (LAT ? NCTX : 0) + q0 + wid * QBLK;
    const int kvh = h >> 2;
    const bf16* Qw = aa.P + qrow0 * DM + QCOL + h * 64;
    const bf16* Kh = aa.P + rowbase * DM + KCOL + kvh * 64, *Vh = aa.P + rowbase * DM + VCOL + kvh * 64;
    const unsigned lds0 = (unsigned)(uintptr_t)shm;
    float* wsf = (float*)(shm + LDS_WS) + wid * 64;
    const bf16* ksrc = Kh + (long)lane * DM + wid * 8;
    const bf16* vsrc = Vh + (long)(16 * (wid & 3) + (lane >> 2)) * DM + (wid >> 2) * 32 + (lane & 3) * 8;
    const unsigned kdst = lds0 + LDS_K + wid * 1024, vdst = lds0 + LDS_V + wid * 1024;
    int kstart = 0; if (WIN) { kstart = q0 - 128; kstart = kstart < 0 ? 0 : kstart; kstart = kstart > SEQ - 512 ? SEQ - 512 : kstart; }
#define TROW(t) (WIN ? (((t) < 4) ? 64 * (t) : NCTX + kstart + 64 * ((t) - 4)) : 64 * (t))
#define DMA_K(t, slot) glds16(ksrc + (long)TROW(t) * DM, (unsigned)__builtin_amdgcn_readfirstlane(kdst + (slot)))
#define DMA_V(t, slot) glds16(vsrc + (long)TROW(t) * DM, (unsigned)__builtin_amdgcn_readfirstlane(vdst + (slot)))
    const int vb0 = (int)(lds0 + LDS_V) + ((lane >> 4) & 1) * 32 + (lane & 3) * 8 + (4 * hi + ((lane & 15) >> 2)) * 64;
    const char* Kbase = shm + LDS_K; bf16x8 kf[8];
    const lds_cptr shm3 = (lds_cptr)shm; const lds_cptr kp0 = shm3 + LDS_K + hi * 1024 + r32 * 16; const lds_cptr vp0 = shm3 + LDS_V + ((lane >> 4) & 1) * 32 + (lane & 3) * 8 + (4 * hi + ((lane & 15) >> 2)) * 64;
    DMA_K(0, 0); DMA_V(0, 0); DMA_K(1, SLOTB);
    bf16x8 qr[4];
    {
        bf16x8 qraw[4];
#pragma unroll
        for (int d0 = 0; d0 < 4; ++d0) qraw[d0] = *reinterpret_cast<const bf16x8*>(&Qw[(long)r32 * DM + d0 * 16 + hi * 8]);
        float qf[4][8]; float ss = 0.f;
#pragma unroll
        for (int d0 = 0; d0 < 4; ++d0)
#pragma unroll
            for (int j = 0; j < 8; ++j) { qf[d0][j] = __uint_as_float(((unsigned)(unsigned short)qraw[d0][j]) << 16); ss += qf[d0][j] * qf[d0][j]; }
        { auto rr = __builtin_amdgcn_permlane32_swap(__float_as_uint(ss), __float_as_uint(ss), false, false); ss = __uint_as_float(rr[0]) + __uint_as_float(rr[1]); }
        const float rinv = 1.0f / sqrtf(ss * (1.0f / 64.0f) + EPS);
#pragma unroll
        for (int d0 = 0; d0 < 4; ++d0) { const f32x4 g0 = *(const f32x4*)(aa.qg + d0 * 16 + hi * 8), g1 = *(const f32x4*)(aa.qg + d0 * 16 + hi * 8 + 4);
#pragma unroll
            for (int j = 0; j < 4; ++j) { qf[d0][j] *= rinv * g0[j]; qf[d0][4 + j] *= rinv * g1[j]; } }
        if (LAT) {
            const int pos = q0 + wid * QBLK + r32;
#pragma unroll
            for (int pr = 0; pr < 2; ++pr) {
                const float* cp = aa.ropec + (size_t)pos * 32 + pr * 16 + hi * 8; const float* sp = aa.ropes + (size_t)pos * 32 + pr * 16 + hi * 8;
                const f32x4 c0 = *(const f32x4*)cp, c1 = *(const f32x4*)(cp + 4), s0 = *(const f32x4*)sp, s1 = *(const f32x4*)(sp + 4);
#pragma unroll
                for (int j = 0; j < 8; ++j) { const float c = j < 4 ? c0[j & 3] : c1[j & 3], s = j < 4 ? s0[j & 3] : s1[j & 3];
                    const float t1 = qf[pr][j], t2 = qf[pr + 2][j]; qf[pr][j] = t1 * c - t2 * s; qf[pr + 2][j] = t2 * c + t1 * s; } }
        }
#pragma unroll
        for (int d0 = 0; d0 < 4; ++d0) { u32x4 w; w.x = cvtpk_s(qf[d0][0] * C2, qf[d0][1] * C2); w.y = cvtpk_s(qf[d0][2] * C2, qf[d0][3] * C2); w.z = cvtpk_s(qf[d0][4] * C2, qf[d0][5] * C2); w.w = cvtpk_s(qf[d0][6] * C2, qf[d0][7] * C2);
            qr[d0] = __builtin_bit_cast(bf16x8, w); }
    }
    float mhat = 0.f, l_reg = 0.f; f32x16 o[2]; o[0] = f32x16{}; o[1] = f32x16{}; f32x16 negm = f32x16{}; asm volatile("" : "+v"(negm));
    const int dkq = kstart - (q0 + wid * QBLK + r32);
#define CMASK(P0, P1, t) do { if (WIN && (t) >= 4) wmask(P0, P1, dkq + 64 * ((t) - 4), hi); } while (0)
    bool resc = false;
#define START(P0, P1) do { const float rm = rowmax(P0, P1); resc = false; \
    { const float dl = rm; mhat = fadd_s(mhat, dl); \
      _Pragma("unroll") for (int r = 0; r < 16; ++r) { P0[r] = fsub_s(P0[r], dl); P1[r] = fsub_s(P1[r], dl); } \
      _Pragma("unroll") for (int r = 0; r < 16; ++r) negm[r] = -mhat; asm volatile("" : "+v"(negm)); } \
    _Pragma("unroll") for (int r = 0; r < 16; ++r) P0[r] = __builtin_amdgcn_exp2f(P0[r]); } while (0)
#define RESC() do { if (resc) { asm volatile("s_waitcnt lgkmcnt(0)" ::: "memory"); \
      _Pragma("unroll") for (int d_ = 0; d_ < 2; ++d_) _Pragma("unroll") for (int r = 0; r < 16; ++r) o[d_][r] *= wsf[crow(r, hi)]; } } while (0)
    f32x16 pA0, pA1, pB0, pB1;
    int sl_prev = 0, sl_cur = 0, sl_next = SLOTB;
#define ROT() do { sl_prev = sl_cur; sl_cur = sl_next; sl_next = (sl_next == (NSLOT - 1) * SLOTB) ? 0 : sl_next + SLOTB; } while (0)
    DMA_K(2, 2 * SLOTB);
    WAIT_BAR(3);
    qkt(pA0, pA1, Kbase, qr, negm, r32, hi); asm volatile("s_nop 15\n\ts_nop 7" : "+v"(pA0), "+v"(pA1)); CMASK(pA0, pA1, 0);
    START(pA0, pA1);
    _Pragma("unroll") for (int r = 0; r < 16; ++r) pA1[r] = __builtin_amdgcn_exp2f(pA1[r]);
    WAIT_BAR(0);
    DMA_K(3, 0); DMA_V(1, SLOTB);
    ROT();
    kload8(kf, kp0 + sl_cur);
    WAIT_BAR(2);
    s16x4 vlo[8], vhi[8]; u32x4 pw0, pw1, pw2, pw3;
#define PKW(P, B) cvtpk_s(P[B], P[B + 1])
#define PAF(k) __builtin_bit_cast(bf16x8, pw##k)
#define VFR(i) (bf16x8){vlo[i][0], vlo[i][1], vlo[i][2], vlo[i][3], vhi[i][0], vhi[i][1], vhi[i][2], vhi[i][3]}
#define PIN(x) asm volatile("" : "+v"(x))
#define MX3(a, b, c) __builtin_fmaxf(__builtin_fmaxf((a), (b)), (c))
#define GAPA(MF, A0, A1, A2, A3, W0, W1, PW) do { MF; sacc += A0; sacc += A1; sacc += A2; sacc += A3; PIN(sacc); W0; W1; PIN(PW); SBAR(); } while (0)
#define EX(v) __builtin_amdgcn_exp2f(v)
#define GAPB(MF, X, B) do { MF; X[B] = EX(X[B]); X[B + 1] = EX(X[B + 1]); X[B + 2] = EX(X[B + 2]); X[B + 3] = EX(X[B + 3]); PIN(X); SBAR(); } while (0)
#define VRD(i) do { vlo[i] = vtr(vp_ + (((i) >> 2) * 4096 + ((i) & 3) * 1024)); vhi[i] = vtr(vp_ + (((i) >> 2) * 4096 + ((i) & 3) * 1024 + 512)); } while (0)
#define KRD(G, j) do { if (G) { kload2(kf, kp0 + sl_next, j); SBAR(); } } while (0)
#define STEP(C0, C1, P0, P1, t, GK, GV, GL) do { SBAR(); \
    const lds_cptr vp_ = vp0 + sl_prev; \
    VRD(0); SBAR(); float sacc = (P0[0] + P0[1]); \
    GAPA(C0 = __builtin_amdgcn_mfma_f32_32x32x16_bf16(kf[0], qr[0], negm, 0, 0, 0), P0[2], P0[3], P0[4], P0[5],     pw0[0] = PKW(P0, 0), pw0[1] = PKW(P0, 2), pw0); \
    VRD(4); SBAR(); GAPA(C1 = __builtin_amdgcn_mfma_f32_32x32x16_bf16(kf[1], qr[0], negm, 0, 0, 0), P0[6], P0[7], P0[8], P0[9],     pw0[2] = PKW(P0, 4), pw0[3] = PKW(P0, 6), pw0); \
    VRD(1); SBAR(); GAPA(C0 = __builtin_amdgcn_mfma_f32_32x32x16_bf16(kf[2], qr[1], C0, 0, 0, 0),   P0[10], P0[11], P0[12], P0[13], pw1[0] = PKW(P0, 8), pw1[1] = PKW(P0, 10), pw1); \
    VRD(5); SBAR(); GAPA(C1 = __builtin_amdgcn_mfma_f32_32x32x16_bf16(kf[3], qr[1], C1, 0, 0, 0),   P0[14], P0[15], P1[0], P1[1],   pw1[2] = PKW(P0, 12), pw1[3] = PKW(P0, 14), pw1); \
    VRD(2); SBAR(); GAPA(C0 = __builtin_amdgcn_mfma_f32_32x32x16_bf16(kf[4], qr[2], C0, 0, 0, 0),   P1[2], P1[3], P1[4], P1[5],     pw2[0] = PKW(P1, 0), pw2[1] = PKW(P1, 2), pw2); \
    VRD(6); SBAR(); GAPA(C1 = __builtin_amdgcn_mfma_f32_32x32x16_bf16(kf[5], qr[2], C1, 0, 0, 0),   P1[6], P1[7], P1[8], P1[9],     pw2[2] = PKW(P1, 4), pw2[3] = PKW(P1, 6), pw2); \
    VRD(3); SBAR(); GAPA(C0 = __builtin_amdgcn_mfma_f32_32x32x16_bf16(kf[6], qr[3], C0, 0, 0, 0),   P1[10], P1[11], P1[12], P1[13], pw3[0] = PKW(P1, 8), pw3[1] = PKW(P1, 10), pw3); \
    VRD(7); SBAR(); GAPA(C1 = __builtin_amdgcn_mfma_f32_32x32x16_bf16(kf[7], qr[3], C1, 0, 0, 0),   P1[14], P1[15], 0.f, 0.f,       pw3[2] = PKW(P1, 12), pw3[3] = PKW(P1, 14), pw3); \
    l_reg += sacc; \
    if (GK) { DMA_K((t) + 3, sl_cur); } if (GV) { DMA_V((t) + 1, sl_next); } \
    CMASK(C0, C1, t); \
    { float a = MX3(C0[0], C0[1], C1[0]), b = MX3(C0[2], C0[3], C1[1]); a = MX3(a, C1[2], C1[3]); \
      _Pragma("unroll") for (int r = 4; r < 16; r += 4) { a = MX3(a, C0[r], C0[r + 1]); b = MX3(b, C0[r + 2], C0[r + 3]); a = MX3(a, C1[r], C1[r + 1]); b = MX3(b, C1[r + 2], C1[r + 3]); } \
      float rm = __builtin_fmaxf(a, b); { auto rr = __builtin_amdgcn_permlane32_swap(__float_as_uint(rm), __float_as_uint(rm), false, false); rm = __builtin_fmaxf(__uint_as_float(rr[0]), __uint_as_float(rr[1])); } \
      resc = false; \
      if (__builtin_expect(__any(rm > (float)THRL), 0)) { const float dl = __builtin_fmaxf(rm, 0.f); mhat += dl; \
        _Pragma("unroll") for (int r = 0; r < 16; ++r) { C0[r] -= dl; C1[r] -= dl; } \
        _Pragma("unroll") for (int r = 0; r < 16; ++r) negm[r] = -mhat; asm volatile("" : "+v"(negm)); \
        const float f = __builtin_amdgcn_exp2f(-dl); l_reg *= f; if (hi == 0) wsf[r32] = f; resc = true; } } \
    SBAR(); \
    GAPB(o[0] = __builtin_amdgcn_mfma_f32_32x32x16_bf16(PAF(0), VFR(0), o[0], 0, 0, 0), C0, 0); \
    GAPB(o[1] = __builtin_amdgcn_mfma_f32_32x32x16_bf16(PAF(0), VFR(4), o[1], 0, 0, 0), C0, 4); \
    KRD(GL, 0); GAPB(o[0] = __builtin_amdgcn_mfma_f32_32x32x16_bf16(PAF(1), VFR(1), o[0], 0, 0, 0), C0, 8); \
    KRD(GL, 1); GAPB(o[1] = __builtin_amdgcn_mfma_f32_32x32x16_bf16(PAF(1), VFR(5), o[1], 0, 0, 0), C0, 12); \
    KRD(GL, 2); GAPB(o[0] = __builtin_amdgcn_mfma_f32_32x32x16_bf16(PAF(2), VFR(2), o[0], 0, 0, 0), C1, 0); \
    KRD(GL, 3); GAPB(o[1] = __builtin_amdgcn_mfma_f32_32x32x16_bf16(PAF(2), VFR(6), o[1], 0, 0, 0), C1, 4); \
    GAPB(o[0] = __builtin_amdgcn_mfma_f32_32x32x16_bf16(PAF(3), VFR(3), o[0], 0, 0, 0), C1, 8); \
    GAPB(o[1] = __builtin_amdgcn_mfma_f32_32x32x16_bf16(PAF(3), VFR(7), o[1], 0, 0, 0), C1, 12); \
    } while (0)
    int t = 1;
    for (; t + 5 < NT; t += 2) {
        STEP(pB0, pB1, pA0, pA1, t, true, true, true);     WAIT_BAR(2); RESC(); ROT();
        STEP(pA0, pA1, pB0, pB1, t + 1, true, true, true); WAIT_BAR(2); RESC(); ROT();
    }
#define ENDW(tt) do { if ((tt) + 3 < NT) { WAIT_BAR(2); } else if ((tt) + 2 < NT) { WAIT_BAR(1); } else { WAIT_BAR(0); } } while (0)
    for (; t + 1 < NT; t += 2) {
        STEP(pB0, pB1, pA0, pA1, t, (t + 3 < NT), (t + 1 < NT), (t + 1 < NT));         ENDW(t);     RESC(); ROT();
        STEP(pA0, pA1, pB0, pB1, t + 1, (t + 4 < NT), (t + 2 < NT), (t + 2 < NT));     ENDW(t + 1); RESC(); ROT();
    }
    STEP(pB0, pB1, pA0, pA1, NT - 1, false, false, false); RESC();
    { float sacc = pB0[0] + pB0[1]; _Pragma("unroll") for (int r = 2; r < 16; ++r) sacc += pB0[r]; _Pragma("unroll") for (int r = 0; r < 16; ++r) sacc += pB1[r]; l_reg += sacc;
      pw0 = (u32x4){PKW(pB0, 0), PKW(pB0, 2), PKW(pB0, 4), PKW(pB0, 6)}; pw1 = (u32x4){PKW(pB0, 8), PKW(pB0, 10), PKW(pB0, 12), PKW(pB0, 14)}; pw2 = (u32x4){PKW(pB1, 0), PKW(pB1, 2), PKW(pB1, 4), PKW(pB1, 6)}; pw3 = (u32x4){PKW(pB1, 8), PKW(pB1, 10), PKW(pB1, 12), PKW(pB1, 14)};
      SBAR(); pv(o, vb0 + sl_cur, PAF(0), PAF(1), PAF(2), PAF(3)); }
#undef PKW
#undef PAF
#undef VFR
#undef PIN
#undef MX3
#undef GAPA
#undef GAPB
#undef EX
#undef VRD
#undef KRD
#undef STEP
#undef ENDW
    { auto rr = __builtin_amdgcn_permlane32_swap(__float_as_uint(l_reg), __float_as_uint(l_reg), false, false); l_reg = __uint_as_float(rr[0]) + __uint_as_float(rr[1]); }
    if (SINK) l_reg += __builtin_amdgcn_exp2f(aa.sink * LOG2E - mhat);
    if (hi == 0) wsf[32 + r32] = l_reg; asm volatile("s_waitcnt lgkmcnt(0)" ::: "memory");
    float rli[16];
#pragma unroll
    for (int r = 0; r < 16; ++r) rli[r] = __builtin_amdgcn_rcpf(wsf[32 + crow(r, hi)]);
    bf16* Ow = aa.P + qrow0 * DM + QCOL + h * 64;
    { bf16* stg = (bf16*)(shm + LDS_OST) + wid * 2048;
#pragma unroll
      for (int r = 0; r < 16; ++r) { const int orow = crow(r, hi);
#pragma unroll
          for (int d0 = 0; d0 < 2; ++d0) stg[orow * 64 + d0 * 32 + r32] = __float2bfloat16(o[d0][r] * rli[r]); }
      asm volatile("s_waitcnt lgkmcnt(0)" ::: "memory");
#pragma unroll
      for (int i = 0; i < 4; ++i) { const int row = i * 8 + (lane >> 3), ch = lane & 7; const u32x4 v = *(const u32x4*)(stg + row * 64 + ch * 8); if (!aa.dry) *(u32x4*)(Ow + (long)row * DM + ch * 8) = v; } }
    asm volatile("s_waitcnt lgkmcnt(0)\n\ts_barrier" ::: "memory");
#undef DMA_K
#undef DMA_V
#undef TROW
#undef CMASK
#undef START
#undef RESC
#undef ROT
}
#undef SBAR
#undef WAIT_BAR
}
constexpr size_t MiB = 1u << 20;
constexpr size_t WS_CTL = 0, CTL_ZERO_BYTES = 1 * MiB;
constexpr size_t WS_MOD = 1 * MiB;
constexpr size_t WS_ROPE = 2 * MiB;
constexpr size_t WS_ROUTE = 3 * MiB;
constexpr size_t WS_WIN = 6 * MiB;
constexpr size_t WS_WBR = 28 * MiB;
constexpr size_t WS_WOUT = 34 * MiB;
constexpr size_t WS_XC = 38 * MiB;
constexpr size_t WS_A = 54 * MiB;
constexpr size_t WS_PROJ = 190 * MiB;
constexpr size_t WS_YBUF = WS_PROJ;
constexpr size_t WS_HG = WS_PROJ + 420 * MiB;
constexpr size_t WS_H8 = WS_A;
constexpr size_t WS_YP = WS_PROJ;
constexpr size_t WS_HID = WS_PROJ + 280 * MiB;
constexpr size_t WS_W13 = WS_PROJ + 560 * MiB;
constexpr size_t WS_W2 = WS_PROJ + 624 * MiB;
constexpr size_t WS_HIN8 = WS_PROJ + 748 * MiB;
constexpr size_t WS_WIN8 = WS_HIN8 + 68 * MiB;
constexpr size_t WS_END = WS_WIN8 + 11 * MiB;
constexpr int PSPLIT = 4;
static_assert((size_t)T * NIN * 2 == 748 * MiB && (size_t)T * D * 2 == 136 * MiB && (size_t)PMAX * D * 2 == 280 * MiB, "buffer sizes");
static_assert(WS_END <= 1024 * MiB, "workspace map fits 1 GiB");
constexpr int CW_CNT = 64;
constexpr int CW_BAR = 4096;

constexpr int RING_OFF = 0, RING_BYTES = 131072;
constexpr int LDSCTL_OFF = RING_BYTES, MISC_OFF = LDSCTL_OFF + 320;
constexpr int LDS_BYTES = 147456;
constexpr int NWAVES = 8;

typedef GAS unsigned gu32;
#define RLX_AGENT __ATOMIC_RELAXED, __HIP_MEMORY_SCOPE_AGENT
#define LDS_WAIT() asm volatile("s_waitcnt lgkmcnt(0)" ::: "memory")
#define VM_WAIT() asm volatile("s_waitcnt vmcnt(0)" ::: "memory")

#define XB_TMO      128
#define XB_XCNT(j)  (256  + 64 * (j))
#define XB_XSUB(j)  (1280 + 64 * (j))
#define XB_XGEN(j)  (2304 + 64 * (j))
#define XB_TOP      3328
#define XB_TOPGEN   3392
#define XCD_BAR_WORDS 3456
#define XB_SPIN_CAP (1u << 18)
__device__ __forceinline__ unsigned xb_ld(unsigned* p)              { return __hip_atomic_load(p, __ATOMIC_RELAXED, __HIP_MEMORY_SCOPE_AGENT); }
__device__ __forceinline__ unsigned xb_add(unsigned* p, unsigned v) { return __hip_atomic_fetch_add(p, v, __ATOMIC_RELAXED, __HIP_MEMORY_SCOPE_AGENT); }
__device__ __forceinline__ unsigned xb_xcc_id() { return (unsigned)__builtin_amdgcn_s_getreg((3 << 11) | 20) & 0xFu; }
#define XB_SPIN(cond, bar) do { unsigned _sp = 0; while (cond) { __builtin_amdgcn_s_sleep(1); \
    if ((++_sp & 255u) == 0u) { if (xb_ld(&(bar)[XB_TMO])) break; if (_sp > XB_SPIN_CAP) { atomicAdd(&(bar)[XB_TMO], 1u); break; } } } } while (0)
struct XcdBarrier { unsigned* bar; unsigned x; volatile LAS unsigned* st; };
__device__ __forceinline__ XcdBarrier xcd_barrier_post(unsigned* bar, volatile LAS unsigned* st) {
    XcdBarrier b; b.bar = bar; b.x = xb_xcc_id(); b.st = st;
    if (threadIdx.x == 0) (void)xb_add(&bar[XB_XCNT(b.x)], 1u);
    return b;
}
__device__ __forceinline__ void xcd_barrier_complete(unsigned* bar, unsigned x, unsigned& nloc, unsigned& nx) {
    const unsigned G = gridDim.x * gridDim.y * gridDim.z;
    unsigned sum, cnt, mine, sp = 0u;
    for (;;) {
        sum = 0u; cnt = 0u; mine = 0u;
#pragma unroll
        for (unsigned j = 0; j < 16; ++j) { const unsigned c = xb_ld(&bar[XB_XCNT(j)]); sum += c; cnt += (c > 0u) ? 1u : 0u; mine = (j == x) ? c : mine; }
        if (sum == G) break;
        __builtin_amdgcn_s_sleep(1);
        if ((++sp & 255u) == 0u) { if (xb_ld(&bar[XB_TMO])) break; if (sp > XB_SPIN_CAP) { atomicAdd(&bar[XB_TMO], 1u); break; } }
    }
    nloc = mine > 0u ? mine : 1u; nx = cnt > 0u ? cnt : 1u;
}
__device__ __forceinline__ void xcd_barrier(const XcdBarrier& b) {
    asm volatile("s_waitcnt vmcnt(0)" ::: "memory");
    __syncthreads();
    if (threadIdx.x == 0) {
        unsigned* bar = b.bar;
        __builtin_amdgcn_s_waitcnt(0);
        unsigned nloc = b.st[0], nx = b.st[1];
        if (nloc == 0u) { xcd_barrier_complete(bar, b.x, nloc, nx); b.st[0] = nloc; b.st[1] = nx; }
        const unsigned old = xb_add(&bar[XB_XSUB(b.x)], 1u);
        const unsigned gen = old / nloc;
        if (old + 1u == (gen + 1u) * nloc) {
            __builtin_amdgcn_fence(__ATOMIC_RELEASE, "agent");
            asm volatile("s_waitcnt vmcnt(0)" ::: "memory");
            const unsigned og = xb_add(&bar[XB_TOP], 1u);
            const unsigned tg = og / nx;
            if (og + 1u == (tg + 1u) * nx) xb_add(&bar[XB_TOPGEN], 1u);
            else XB_SPIN(xb_ld(&bar[XB_TOPGEN]) == tg, bar);
            __builtin_amdgcn_fence(__ATOMIC_ACQUIRE, "agent");
            xb_add(&bar[XB_XGEN(b.x)], 1u);
            asm volatile("s_waitcnt vmcnt(0)" ::: "memory");
        } else {
            XB_SPIN(xb_ld(&bar[XB_XGEN(b.x)]) == gen, bar);
            __builtin_amdgcn_fence(__ATOMIC_ACQUIRE, "agent");
            asm volatile("s_waitcnt vmcnt(0)" ::: "memory");
        }
    }
    __syncthreads();
}

struct Args { const float* in[27]; float* out; unsigned char* ws; };
struct KArgs { const GAS float* in[27]; GAS float* out; GAS unsigned char* ws; };
typedef const __attribute__((address_space(4))) KArgs* kargs_p;
__device__ __forceinline__ kargs_p kargs() { kargs_p p = (kargs_p)__builtin_amdgcn_kernarg_segment_ptr(); asm volatile("" : "+s"(p)); return p; }
struct Frame {
    LAS unsigned char* lds;
    int tid, lane, wave, vcu, G, gw, NGW, bid;
#define KIN(name, idx) __device__ __forceinline__ const float* name() const { return (const float*)kargs()->in[idx]; }
    KIN(x, 0) KIN(c, 1) KIN(ctx, 2) KIN(c_ctx, 3) KIN(w_mod, 4) KIN(b_mod, 5) KIN(norm1_g, 6) KIN(norm2_g, 7) KIN(w_in, 8) KIN(b_merge, 9) KIN(conv_w, 10) KIN(conv_b, 11)
    KIN(lru_wa, 12) KIN(lru_ba, 13) KIN(lru_wx, 14) KIN(lru_bx, 15) KIN(lru_lambda, 16) KIN(q_norm_g, 17) KIN(k_norm_g, 18) KIN(sink, 19) KIN(w_branch, 20) KIN(w_out, 21)
    KIN(router_w, 22) KIN(router_b, 23) KIN(ew1, 24) KIN(ew3, 25) KIN(ew2, 26)
#undef KIN
    __device__ __forceinline__ float* out() const { return (float*)kargs()->out; }
    __device__ __forceinline__ unsigned char* ws() const { return (unsigned char*)kargs()->ws; }
    __device__ __forceinline__ gu32* ctl() const { return (gu32*)(ws() + WS_CTL); }
#define KWS(type, name, off) __device__ __forceinline__ type* name() const { return (type*)(ws() + (off)); }
    KWS(float, MOD, WS_MOD) KWS(float, ROPEC, WS_ROPE) KWS(float, ROPES, WS_ROPE + (size_t)SEQ * 32 * 4) KWS(float, XC, WS_XC) KWS(float, HT, WS_A) KWS(unsigned, ROUTE, WS_ROUTE)
    KWS(bf16_t, WIN, WS_WIN) KWS(bf16_t, WBR, WS_WBR) KWS(bf16_t, WOUT, WS_WOUT) KWS(bf16_t, A, WS_A) KWS(bf16_t, PROJ, WS_PROJ) KWS(bf16_t, YBUF, WS_YBUF) KWS(unsigned char, HG, WS_HG)
    KWS(bf16_t, YP, WS_YP) KWS(unsigned char, HID, WS_HID) KWS(unsigned char, W13, WS_W13) KWS(unsigned char, W2, WS_W2) KWS(unsigned char, H8, WS_H8) KWS(unsigned char, HIN8, WS_HIN8) KWS(unsigned char, WIN8, WS_WIN8)
#undef KWS
};
__device__ __forceinline__ Frame fresh(const Frame& F0) { Frame F = F0;
    asm volatile("" : "+s"(F.wave), "+s"(F.vcu), "+s"(F.G), "+s"(F.gw), "+s"(F.NGW), "+s"(F.bid), "+v"(F.tid), "+v"(F.lane)); return F; }
__device__ __forceinline__ float wave_sum(float v) {
#pragma unroll
    for (int o = 1; o < 64; o <<= 1) v += __shfl_xor(v, o);
    return v;
}
__device__ __forceinline__ const float* modp(const float* MODb, int l, int sel, int chunk) { return MODb + ((size_t)(l * 17 + sel) * 6 + chunk) * D; }

__device__ __forceinline__ void transpose_item(const float* W, int K, int N, bf16_t* WT, int k0, int n0, int drow0, LAS float* scr, int lane) {
#pragma unroll 8
    for (int i = 0; i < 32; ++i) { const int kk = 2 * i + (lane >> 5); scr[kk * 33 + (lane & 31)] = W[(size_t)(k0 + kk) * N + n0 + (lane & 31)]; }
    LDS_WAIT(); asm volatile("" ::: "memory");
    const int cc = lane & 7;
#pragma unroll
    for (int j = 0; j < 4; ++j) { const int n = (lane >> 3) + 8 * j; const LAS float* s = scr + (8 * cc) * 33 + n;
        u32x4 o; o.x = cvt_pk_bf16(s[0 * 33], s[1 * 33]); o.y = cvt_pk_bf16(s[2 * 33], s[3 * 33]); o.z = cvt_pk_bf16(s[4 * 33], s[5 * 33]); o.w = cvt_pk_bf16(s[6 * 33], s[7 * 33]);
        *(GAS u32x4*)(WT + (size_t)(drow0 + n) * K + k0 + 8 * cc) = o; }
    LDS_WAIT(); asm volatile("" ::: "memory");
}

constexpr float WSCALE = 64.0f;
__device__ __forceinline__ void transpose_item_fp8(const float* W, int K, int N, unsigned char* WT, int k0, int n0, int drow0, float scale, LAS float* scr, int lane) {
#pragma unroll 8
    for (int i = 0; i < 32; ++i) { const int kk = 2 * i + (lane >> 5); scr[kk * 33 + (lane & 31)] = W[(size_t)(k0 + kk) * N + n0 + (lane & 31)]; }
    LDS_WAIT(); asm volatile("" ::: "memory");
    const int cc = lane & 7;
#pragma unroll
    for (int j = 0; j < 4; ++j) { const int n = (lane >> 3) + 8 * j; const LAS float* s = scr + (8 * cc) * 33 + n;
        u32x2 o; o.x = pk4_fp8(s[0 * 33] * scale, s[1 * 33] * scale, s[2 * 33] * scale, s[3 * 33] * scale); o.y = pk4_fp8(s[4 * 33] * scale, s[5 * 33] * scale, s[6 * 33] * scale, s[7 * 33] * scale);
        *(GAS u32x2*)(WT + (size_t)(drow0 + n) * K + k0 + 8 * cc) = o; }
    LDS_WAIT(); asm volatile("" ::: "memory");
}
__device__ __forceinline__ void p0_prologue(Frame& F) {
    LAS float* scr = (LAS float*)(F.lds + RING_OFF + F.wave * 16384);
    constexpr int I_IN = (D / 64) * (NIN / 32), I_BR = (512 / 64) * (D / 32), I_OUT = (D / 64) * (D / 32);
    constexpr int NITEMS = NL * (I_IN + 3 * I_BR + I_OUT);
    for (int it = F.gw; it < NITEMS; it += F.NGW) {
        int r = it; const int l = r / (I_IN + 3 * I_BR + I_OUT); r -= l * (I_IN + 3 * I_BR + I_OUT);
        if (r < I_IN) { const int nb = NIN / 32, kb = r / nb, n0 = 32 * (r % nb);
            if (n0 < 256 * PSPLIT) transpose_item(F.w_in() + (size_t)l * D * NIN, D, NIN, F.WIN() + (size_t)l * NIN * D, 64 * kb, n0, n0, scr, F.lane);
            else transpose_item_fp8(F.w_in() + (size_t)l * D * NIN, D, NIN, F.WIN8() + (size_t)l * NIN * D, 64 * kb, n0, n0, WSCALE, scr, F.lane);
            continue; }
        r -= I_IN;
        if (r < 3 * I_BR) { const int b = r / I_BR; r -= b * I_BR; const int nb = D / 32, kb = r / nb, n0 = 32 * (r % nb);
            transpose_item(F.w_branch() + (size_t)(l * 3 + b) * 512 * D, 512, D, F.WBR() + (size_t)(l * 3 + b) * D * 512, 64 * kb, n0, n0, scr, F.lane); continue; }
        r -= 3 * I_BR;
        { const int nb = D / 32, kb = r / nb, n0 = 32 * (r % nb); transpose_item(F.w_out() + (size_t)l * D * D, D, D, F.WOUT() + (size_t)l * D * D, 64 * kb, n0, n0, scr, F.lane); }
    }
    float* RC = F.ROPEC(); float* RS = F.ROPES();
    for (int i = blockIdx.x * (NWAVES * 64) + F.tid; i < SEQ * 32; i += F.G * NWAVES * 64) {
        const int pos = i >> 5, f = i & 31; const float inv = exp2f(-(float)(f & 15) * (13.287712379549449f / 16.0f));
        const float ang = (float)(f < 16 ? (pos >> 6) : (pos & 63)) * inv;
        const float rev = ang * 0.15915494309189535f; RC[i] = __builtin_amdgcn_cosf(rev); RS[i] = __builtin_amdgcn_sinf(rev);
    }
    __syncthreads();
    {
        LAS float* sc = (LAS float*)(F.lds + RING_OFF);
        LAS float* part = (LAS float*)(F.lds + RING_OFF + 17 * 1024 * 4);
        bool have_sc = false;
        for (int it = blockIdx.x; it < NL * 96; it += F.G) {
            if (!have_sc) { for (int i = F.tid; i < 17 * 1024; i += NWAVES * 64) { const int s = i >> 10, k = i & 1023; const float v = s < 16 ? F.c()[s * D + k] : F.c_ctx()[k]; sc[i] = v * fast_sigmoid(v); }
                have_sc = true; __syncthreads(); }
            const int l = it / 96, cg = it % 96, col = cg * 64 + F.lane;
            const float* wp = F.w_mod() + (size_t)l * D * 6 * D + col;
            float acc[17];
#pragma unroll
            for (int s = 0; s < 17; ++s) acc[s] = 0.f;
            const int kbeg = F.wave * 128;
#pragma unroll 4
            for (int k = kbeg; k < kbeg + 128; ++k) { const float w = wp[(size_t)k * 6 * D];
#pragma unroll
                for (int s = 0; s < 17; ++s) acc[s] += sc[s * 1024 + k] * w; }
#pragma unroll
            for (int s = 0; s < 17; ++s) part[(F.wave * 17 + s) * 64 + F.lane] = acc[s];
            __syncthreads();
            for (int i = F.tid; i < 17 * 64; i += NWAVES * 64) { const int s = i >> 6, cl = i & 63; float v = F.b_mod()[l * 6 * D + cg * 64 + cl];
#pragma unroll
                for (int w = 0; w < 8; ++w) v += part[(w * 17 + s) * 64 + cl];
                F.MOD()[(size_t)(l * 17 + s) * 6 * D + cg * 64 + cl] = v; }
            __syncthreads();
        }
    }
}

__device__ __forceinline__ void convert_experts(Frame& F, int l) {
    LAS float* scr = (LAS float*)(F.lds + RING_OFF + F.wave * 16384);
    constexpr int I_M = (D / 64) * (D / 32);
    for (int it = F.gw; it < NE * 3 * I_M; it += F.NGW) {
        const int e = it / (3 * I_M); int r = it - e * 3 * I_M; const int which = r / I_M; r -= which * I_M;
        const int kb = r / (D / 32), n0 = 32 * (r % (D / 32));
        const size_t eoff = (size_t)(l * NE + e) * D * D;
        if (which == 0) transpose_item_fp8(F.ew1() + eoff, D, D, F.W13() + (size_t)e * 2048 * D, 64 * kb, n0, 256 * (n0 >> 7) + (n0 & 127), WSCALE, scr, F.lane);
        else if (which == 1) transpose_item_fp8(F.ew3() + eoff, D, D, F.W13() + (size_t)e * 2048 * D, 64 * kb, n0, 256 * (n0 >> 7) + 128 + (n0 & 127), WSCALE, scr, F.lane);
        else transpose_item_fp8(F.ew2() + eoff, D, D, F.W2() + (size_t)e * D * D, 64 * kb, n0, n0, WSCALE, scr, F.lane);
    }
}

__device__ __forceinline__ void ld_row_f32(const float* p, int lane, f32x4 (&v)[4]) {
#pragma unroll
    for (int j = 0; j < 4; ++j) v[j] = *((const GAS f32x4*)p + lane + 64 * j);
}
__device__ __forceinline__ void st_row_f32(float* p, int lane, const f32x4 (&v)[4]) {
#pragma unroll
    for (int j = 0; j < 4; ++j) *((GAS f32x4*)p + lane + 64 * j) = v[j];
}
__device__ __forceinline__ void ld_row_bf16(const bf16_t* p, int lane, f32x4 (&v)[4]) {
#pragma unroll
    for (int j = 0; j < 4; ++j) { const u32x2 w = *((const GAS u32x2*)p + lane + 64 * j); v[j] = (f32x4){bf_lo(w.x), bf_hi(w.x), bf_lo(w.y), bf_hi(w.y)}; }
}
__device__ __forceinline__ void st_row_bf16(bf16_t* p, int lane, const f32x4 (&v)[4]) {
#pragma unroll
    for (int j = 0; j < 4; ++j) { u32x2 w; w.x = cvt_pk_bf16(v[j][0], v[j][1]); w.y = cvt_pk_bf16(v[j][2], v[j][3]); *((GAS u32x2*)p + lane + 64 * j) = w; }
}
__device__ __forceinline__ void st_row_fp8(unsigned char* p, int lane, const f32x4 (&v)[4]) {
#pragma unroll
    for (int j = 0; j < 4; ++j) *((GAS unsigned*)p + lane + 64 * j) = pk4_fp8(v[j][0], v[j][1], v[j][2], v[j][3]);
}
__device__ __forceinline__ void norm_mod(const f32x4 (&v)[4], const float* g, const float* shift, const float* scale, int lane, f32x4 (&h)[4]) {
    float ss = 0.f;
#pragma unroll
    for (int j = 0; j < 4; ++j) ss += (v[j][0] * v[j][0] + v[j][1] * v[j][1]) + (v[j][2] * v[j][2] + v[j][3] * v[j][3]);
    const float rinv = 1.0f / sqrtf(wave_sum(ss) * (1.0f / D) + EPS);
#pragma unroll
    for (int j = 0; j < 4; ++j) { const f32x4 gg = *((const GAS f32x4*)g + lane + 64 * j), sh = *((const GAS f32x4*)shift + lane + 64 * j), sc = *((const GAS f32x4*)scale + lane + 64 * j);
        h[j] = (v[j] * rinv) * gg * (sc + 1.0f) + sh; }
}

struct RowRange { int lo, hi; };
__device__ __forceinline__ RowRange wave_rows(const Frame& F, int n) { const int per = (n + F.NGW - 1) / F.NGW; RowRange r; r.lo = F.gw * per; r.hi = r.lo + per; if (r.hi > n) r.hi = n; if (r.lo > n) r.lo = n; return r; }
__device__ __forceinline__ void row_decode(int idx, bool all, int& b, int& p) { if (all) { b = idx / TB; p = idx - b * TB; } else { b = idx / SEQ; p = NCTX + idx - b * SEQ; } }
__device__ __forceinline__ void ld_vec(const float* p, int lane, f32x4 (&v)[4]) {
#pragma unroll
    for (int j = 0; j < 4; ++j) v[j] = *((const GAS f32x4*)p + lane + 64 * j);
}
__device__ __forceinline__ float row_rinv(const f32x4 (&v)[4]) {
    float ss = 0.f;
#pragma unroll
    for (int j = 0; j < 4; ++j) ss += (v[j][0] * v[j][0] + v[j][1] * v[j][1]) + (v[j][2] * v[j][2] + v[j][3] * v[j][3]);
    return 1.0f / sqrtf(wave_sum(ss) * (1.0f / D) + EPS);
}
__device__ __forceinline__ void r1_phase(Frame& F) {
    const float* MODb = F.MOD(); const float* xin = F.x(); const float* cin = F.ctx(); const float* g1n = F.norm1_g(); bf16_t* Ab = F.A(); unsigned char* H8i = F.HIN8();
    const RowRange rr = wave_rows(F, T);
    int cursel = -1; f32x4 gm[4], sh[4], vn[4];
#define R1_SRC(idx_) ({ int b_, p_; row_decode((idx_), true, b_, p_); (p_ < NCTX) ? cin + (size_t)(b_ * NCTX + p_) * D : xin + (size_t)(b_ * SEQ + p_ - NCTX) * D; })
    if (rr.lo < rr.hi) ld_row_f32(R1_SRC(rr.lo), F.lane, vn);
    for (int idx = rr.lo; idx < rr.hi; ++idx) {
        int b, p; row_decode(idx, true, b, p); const int sel = p < NCTX ? 16 : b;
        f32x4 v[4];
#pragma unroll
        for (int j = 0; j < 4; ++j) v[j] = vn[j];
        if (idx + 1 < rr.hi) ld_row_f32(R1_SRC(idx + 1), F.lane, vn);
        if (sel != cursel) { cursel = sel; f32x4 g[4], sc[4]; ld_vec(g1n, F.lane, g); ld_vec(modp(MODb, 0, sel, 1), F.lane, sc); ld_vec(modp(MODb, 0, sel, 0), F.lane, sh);
#pragma unroll
            for (int j = 0; j < 4; ++j) gm[j] = g[j] * (sc[j] + 1.0f); }
        const float rinv = row_rinv(v); f32x4 h[4];
#pragma unroll
        for (int j = 0; j < 4; ++j) h[j] = (v[j] * rinv) * gm[j] + sh[j];
        if (PSPLIT > 0) st_row_bf16(Ab + (size_t)idx * D, F.lane, h);
        st_row_fp8(H8i + (size_t)idx * D, F.lane, h);
    }
#undef R1_SRC
}

__device__ __forceinline__ void kfix_phase(Frame& F, int l, bool dry = false) {
    const int hs = F.lane >> 4, j4 = F.lane & 15, br = hs >> 1;
    const int col = (br ? C_WK : C_GK) + (hs & 1) * 64 + 2 * j4;
    const float* kg = F.k_norm_g() + (size_t)(l * 2 + br) * 64;
    const float g0 = kg[2 * j4], g1 = kg[2 * j4 + 1], g2 = kg[32 + 2 * j4], g3 = kg[32 + 2 * j4 + 1];
    bf16_t* Pb = F.PROJ(); const float* RC = F.ROPEC(); const float* RS = F.ROPES();
    for (int row = F.gw; row < T; row += F.NGW) {
        const int b = row / TB, p = row - b * TB;
        bf16_t* rp = Pb + (size_t)row * NIN + col;
        const unsigned w1 = *(const GAS unsigned*)rp, w2 = *(const GAS unsigned*)(rp + 32);
        float a0 = bf_lo(w1), a1 = bf_hi(w1), b0 = bf_lo(w2), b1 = bf_hi(w2);
        float ss = a0 * a0 + a1 * a1 + b0 * b0 + b1 * b1;
        ss += __shfl_xor(ss, 1); ss += __shfl_xor(ss, 2); ss += __shfl_xor(ss, 4); ss += __shfl_xor(ss, 8);
        const float rinv = 1.0f / sqrtf(ss * (1.0f / 64.0f) + EPS);
        a0 *= rinv * g0; a1 *= rinv * g1; b0 *= rinv * g2; b1 *= rinv * g3;
        if (p >= NCTX) { const int pos = p - NCTX; const f32x2 cs = *(const GAS f32x2*)(RC + (size_t)pos * 32 + 2 * j4), sn = *(const GAS f32x2*)(RS + (size_t)pos * 32 + 2 * j4);
            const float t0 = a0 * cs.x - b0 * sn.x, t1 = a1 * cs.y - b1 * sn.y, u0 = b0 * cs.x + a0 * sn.x, u1 = b1 * cs.y + a1 * sn.y; a0 = t0; a1 = t1; b0 = u0; b1 = u1; }
        if (!dry) { *(GAS unsigned*)rp = cvt_pk_bf16(a0, a1); *(GAS unsigned*)(rp + 32) = cvt_pk_bf16(b0, b1); }
    }
}
constexpr int SC_AOP = 0, SC_AOP_B = 64 * 144, SC_XCV = 2 * SC_AOP_B, SC_XCV_B = 64 * 68 * 4, SC_TOT = SC_XCV + 2 * SC_XCV_B, SC_TOT_B = 4 * 2 * 16 * 8;
__device__ __forceinline__ void scan_unit(Frame& F, int l, int uid, bool last_layer, bool dry = false) {
    const int b = uid >> 4, n = (uid >> 1) & 7, chh = uid & 1;
    const int dir = F.wave >> 2, ht = F.tid & 255, w = F.wave & 3, lane = F.lane, col = lane & 15, quad = lane >> 4;
    LAS unsigned char* aop = F.lds + SC_AOP + dir * SC_AOP_B;
    LAS float* xcv = (LAS float*)(F.lds + SC_XCV + dir * SC_XCV_B);
    LAS f32x2* tot = (LAS f32x2*)(F.lds + SC_TOT + dir * SC_TOT_B);
    bf16x8 Bf[4][2];
    {
        const size_t wbase = ((size_t)((l * 2 + dir) * 8 + n)) * 64 * 64; const float* lwa = F.lru_wa(); const float* lwx = F.lru_wx();
#pragma unroll
        for (int q = 0; q < 4; ++q) { const float* wp = ((q < 2) ? lwa : lwx) + wbase + 32 * chh + 16 * (q & 1) + col;
#pragma unroll
            for (int ks = 0; ks < 2; ++ks) { u32x4 pk;
                const int k0 = 32 * ks + 8 * quad;
                pk.x = cvt_pk_bf16(wp[(size_t)(k0 + 0) * 64], wp[(size_t)(k0 + 1) * 64]); pk.y = cvt_pk_bf16(wp[(size_t)(k0 + 2) * 64], wp[(size_t)(k0 + 3) * 64]);
                pk.z = cvt_pk_bf16(wp[(size_t)(k0 + 4) * 64], wp[(size_t)(k0 + 5) * 64]); pk.w = cvt_pk_bf16(wp[(size_t)(k0 + 6) * 64], wp[(size_t)(k0 + 7) * 64]);
                Bf[q][ks] = __builtin_bit_cast(bf16x8, pk); } }
    }
    float ba[2], bx[2], nla[2]; const float* lba = F.lru_ba(); const float* lbx = F.lru_bx(); const float* llam = F.lru_lambda();
#pragma unroll
    for (int q = 0; q < 2; ++q) { const int gch = 64 * n + 32 * chh + 16 * q + col; const size_t o = (size_t)(l * 2 + dir) * 512 + gch;
        ba[q] = lba[o]; bx[q] = lbx[o]; const float lam = llam[o];
        const float sp = (lam > 15.f) ? __expf(-lam) : log1pf(__expf(-lam));
        nla[q] = -8.0f * sp; }
    const int cg = ht & 7; float cw[4][8], cb[8]; const float* cwp = F.conv_w(); const float* cbp = F.conv_b();
#pragma unroll
    for (int k = 0; k < 4; ++k)
#pragma unroll
        for (int c = 0; c < 8; ++c) cw[k][c] = cwp[(size_t)(l * 4 + k) * 512 + 64 * n + 8 * cg + c];
#pragma unroll
    for (int c = 0; c < 8; ++c) cb[c] = cbp[(size_t)l * 512 + 64 * n + 8 * cg + c];
    float hcar[2] = {0.f, 0.f};
    bf16_t* Pb = F.PROJ(); float* HTb = F.HT();
    const bf16_t* xrb = Pb + C_XR + 64 * n + 8 * cg;

    for (int seg = 0; seg < 2; ++seg) {
        const int nch = seg ? 64 : 4, seglen = nch * 64; const size_t rowseg0 = (size_t)b * TB + (seg ? NCTX : 0);
        const bool want_out = !(seg == 0 && last_layer) && !dry;
        u32x4 raw[2][4];
#define SC_LOAD(i_) do { const int cidx_ = dir ? nch - 1 - (i_) : (i_); const int t0_ = 64 * cidx_; \
        _Pragma("unroll") for (int it = 0; it < 2; ++it) { const int s_ = (it * 256 + ht) >> 3; const int t_ = dir ? t0_ + 63 - s_ : t0_ + s_; \
            _Pragma("unroll") for (int dt = 0; dt < 4; ++dt) { const int tt = t_ + dt - 2; \
                raw[it][dt] = (tt >= 0 && tt < seglen) ? *(const GAS u32x4*)(xrb + (rowseg0 + tt) * NIN) : (u32x4){0u, 0u, 0u, 0u}; } } } while (0)
        SC_LOAD(0);
        for (int i = 0; i < nch; ++i) {
            const int cidx = dir ? nch - 1 - i : i, t0 = 64 * cidx;
#pragma unroll
            for (int it = 0; it < 2; ++it) { const int s = (it * 256 + ht) >> 3; float cv[8];
#pragma unroll
                for (int c2 = 0; c2 < 4; ++c2) { float lo = cb[2 * c2], hi2 = cb[2 * c2 + 1];
#pragma unroll
                    for (int dt = 0; dt < 4; ++dt) { const unsigned wv = raw[it][dt][c2]; lo += cw[dt][2 * c2] * bf_lo(wv); hi2 += cw[dt][2 * c2 + 1] * bf_hi(wv); }
                    cv[2 * c2] = lo; cv[2 * c2 + 1] = hi2; }
                u32x4 pk; pk.x = cvt_pk_bf16(cv[0], cv[1]); pk.y = cvt_pk_bf16(cv[2], cv[3]); pk.z = cvt_pk_bf16(cv[4], cv[5]); pk.w = cvt_pk_bf16(cv[6], cv[7]);
                *(LAS u32x4*)(aop + s * 144 + cg * 16) = pk;
                *(LAS f32x4*)(xcv + s * 68 + cg * 8) = (f32x4){cv[0], cv[1], cv[2], cv[3]}; *(LAS f32x4*)(xcv + s * 68 + cg * 8 + 4) = (f32x4){cv[4], cv[5], cv[6], cv[7]}; }
            if (i + 1 < nch) SC_LOAD(i + 1);
            if (i == nch / 2) VM_WAIT();
            __syncthreads();
            f32x4 gacc[4];
#pragma unroll
            for (int q = 0; q < 4; ++q) gacc[q] = (f32x4){0.f, 0.f, 0.f, 0.f};
#pragma unroll
            for (int ks = 0; ks < 2; ++ks) { const bf16x8 af = *(const LAS bf16x8*)(aop + (16 * w + col) * 144 + ks * 64 + quad * 16);
#pragma unroll
                for (int q = 0; q < 4; ++q) gacc[q] = __builtin_amdgcn_mfma_f32_16x16x32_bf16(af, Bf[q][ks], gacc[q], 0, 0, 0); }
            float av[2][4], bv[2][4], cA[2], cB[2];
#pragma unroll
            for (int q = 0; q < 2; ++q) {
#pragma unroll
                for (int j = 0; j < 4; ++j) { const float r = fast_sigmoid(gacc[q][j] + ba[q]), ig = fast_sigmoid(gacc[q + 2][j] + bx[q]);
                    const float la = nla[q] * r, a = __expf(la), z = 2.0f * la;
                    const float om = (z > -0.1f) ? -z * (1.0f + z * (0.5f + z * (0.16666667f + z * 0.041666668f))) : 1.0f - __expf(z);
                    const float xv = xcv[(16 * w + 4 * quad + j) * 68 + 32 * chh + 16 * q + col];
                    av[q][j] = a; bv[q][j] = sqrtf(om) * ig * xv; }
                cA[q] = av[q][0]; cB[q] = bv[q][0];
#pragma unroll
                for (int j = 1; j < 4; ++j) { cB[q] = av[q][j] * cB[q] + bv[q][j]; cA[q] *= av[q][j]; }
            }
            float iA[2], iB[2], eA[2], eB[2];
#pragma unroll
            for (int q = 0; q < 2; ++q) { iA[q] = cA[q]; iB[q] = cB[q];
                float pA = __shfl_up(iA[q], 16), pB = __shfl_up(iB[q], 16); if (quad >= 1) { iB[q] = iA[q] * pB + iB[q]; iA[q] = iA[q] * pA; }
                pA = __shfl_up(iA[q], 32); pB = __shfl_up(iB[q], 32); if (quad >= 2) { iB[q] = iA[q] * pB + iB[q]; iA[q] = iA[q] * pA; }
                eA[q] = __shfl_up(iA[q], 16); eB[q] = __shfl_up(iB[q], 16); if (quad == 0) { eA[q] = 1.0f; eB[q] = 0.0f; }
                if (quad == 3) tot[(w * 2 + q) * 16 + col] = (f32x2){iA[q], iB[q]}; }
            __syncthreads();
#pragma unroll
            for (int q = 0; q < 2; ++q) { float hin = hcar[q], hall = hcar[q];
#pragma unroll
                for (int ww = 0; ww < 4; ++ww) { const f32x2 tw = tot[(ww * 2 + q) * 16 + col]; hall = tw.x * hall + tw.y; if (ww < w) hin = hall; }
                hcar[q] = hall;
                float hv = eA[q] * hin + eB[q];
                const int gch = 64 * n + 32 * chh + 16 * q + col;
#pragma unroll
                for (int j = 0; j < 4; ++j) { hv = av[q][j] * hv + bv[q][j];
                    if (want_out) { const int s = 16 * w + 4 * quad + j; const int tt = dir ? t0 + 63 - s : t0 + s; const size_t row = rowseg0 + tt;
                        if (i < nch / 2) HTb[row * 512 + gch] = hv;
                        else { const float oth = __hip_atomic_load(HTb + row * 512 + gch, __ATOMIC_RELAXED, __HIP_MEMORY_SCOPE_AGENT);
                            bf16_t* gp = Pb + row * NIN + C_GR + gch; const float gr = __uint_as_float(((unsigned)*gp) << 16);
                            *gp = (bf16_t)(cvt_pk_bf16((hv + oth) * gr, 0.f) & 0xffffu); } } }
            }
        }
#undef SC_LOAD
        __syncthreads();
    }
}

__device__ __forceinline__ void r2_phase(Frame& F, int l, bool dry = false) {
    LAS float* rw = (LAS float*)(F.lds + RING_OFF);
    { const float* rwp = F.router_w(); for (int i = F.tid; i < 16 * 1024; i += NWAVES * 64) { const int e = i >> 10, k = i & 1023; rw[i] = rwp[k * 16 + e]; } }
    __syncthreads();
    float rb[16]; const float* rbp = F.router_b();
#pragma unroll
    for (int e = 0; e < 16; ++e) rb[e] = rbp[e];
    const bool all = (l == 0); const int nrows = all ? T : NB * SEQ;
    const float* MODb = F.MOD(); float* XCb = F.XC(); float* outb = F.out(); const float* xin = F.x(); const float* cin = F.ctx(); const bf16_t* YB = F.YBUF(); unsigned char* H8b = F.H8();
    const float* n2g = F.norm2_g() + (size_t)l * D; unsigned* RT = F.ROUTE(); gu32* cnt = F.ctl() + CW_CNT + l * 64;
    const RowRange rr = wave_rows(F, nrows);
    int cursel = -1; f32x4 g1v[4], gm[4], sh[4], vn[4]; u32x2 yn[4];
    unsigned my_e0 = 0u, my_e1 = 0u; float my_w0 = 0.f, my_w1 = 0.f; int my_row = 0;
#define R2_XI(b_, p_) ((l == 0) ? (((p_) < NCTX) ? cin + (size_t)((b_) * NCTX + (p_)) * D : xin + (size_t)((b_) * SEQ + (p_) - NCTX) * D) : (const float*)(outb + (size_t)((b_) * SEQ + (p_) - NCTX) * D))
#define R2_LOAD(idx_) do { int b_, p_; row_decode((idx_), all, b_, p_); ld_row_f32(R2_XI(b_, p_), F.lane, vn); \
        _Pragma("unroll") for (int j = 0; j < 4; ++j) yn[j] = *((const GAS u32x2*)(YB + (size_t)(b_ * TB + p_) * D) + F.lane + 64 * j); } while (0)
    if (rr.lo < rr.hi) R2_LOAD(rr.lo);
    for (int c0 = rr.lo; c0 < rr.hi; c0 += 64) {
    const int c1 = (c0 + 64 < rr.hi) ? c0 + 64 : rr.hi;
    for (int idx = c0; idx < c1; ++idx) {
        int b, p; row_decode(idx, all, b, p);
        const int row = b * TB + p; const bool isc = p < NCTX; const int sel = isc ? 16 : b;
        float* xo = isc ? XCb + (size_t)(b * NCTX + p) * D : outb + (size_t)(b * SEQ + p - NCTX) * D;
        f32x4 v[4], h[4];
#pragma unroll
        for (int j = 0; j < 4; ++j) { const u32x2 w = yn[j]; v[j] = vn[j]; h[j] = (f32x4){bf_lo(w.x), bf_hi(w.x), bf_lo(w.y), bf_hi(w.y)}; }
        if (idx + 1 < rr.hi) R2_LOAD(idx + 1);
        if (sel != cursel) { cursel = sel; f32x4 g[4], sc[4]; ld_vec(n2g, F.lane, g); ld_vec(modp(MODb, l, sel, 4), F.lane, sc); ld_vec(modp(MODb, l, sel, 3), F.lane, sh); ld_vec(modp(MODb, l, sel, 2), F.lane, g1v);
#pragma unroll
            for (int j = 0; j < 4; ++j) gm[j] = g[j] * (sc[j] + 1.0f); }
#pragma unroll
        for (int j = 0; j < 4; ++j) v[j] = v[j] + g1v[j] * h[j];
        if (!dry) st_row_f32(xo, F.lane, v);
        const float rinv = row_rinv(v);
#pragma unroll
        for (int j = 0; j < 4; ++j) h[j] = (v[j] * rinv) * gm[j] + sh[j];
        if (!dry) st_row_fp8(H8b + (size_t)row * D, F.lane, h);
        float lg[16]; LAS float* rwl = rw; asm volatile("" : "+v"(rwl));
#pragma unroll
        for (int e = 0; e < 16; ++e) { float a = 0.f;
#pragma unroll
            for (int j = 0; j < 4; ++j) { const f32x4 wv = *(const LAS f32x4*)(rwl + e * 1024 + 256 * j + 4 * F.lane); a += (h[j][0] * wv[0] + h[j][1] * wv[1]) + (h[j][2] * wv[2] + h[j][3] * wv[3]); }
            lg[e] = wave_sum(a); }
        float s[16], sl[16];
#pragma unroll
        for (int e = 0; e < 16; ++e) { s[e] = 1.0f / (1.0f + __expf(-lg[e])); sl[e] = s[e] + rb[e]; }
        float bestg = -INFINITY; int gi = 0;
#pragma unroll
        for (int g = 0; g < 4; ++g) { float m1 = -INFINITY, m2 = -INFINITY;
#pragma unroll
            for (int k = 0; k < 4; ++k) { const float t = sl[4 * g + k]; if (t > m1) { m2 = m1; m1 = t; } else if (t > m2) m2 = t; }
            const float gs = m1 + m2; if (gs > bestg) { bestg = gs; gi = g; } }
        float c4[4], s4[4];
#pragma unroll
        for (int k = 0; k < 4; ++k) { c4[k] = gi == 0 ? sl[k] : gi == 1 ? sl[4 + k] : gi == 2 ? sl[8 + k] : sl[12 + k]; s4[k] = gi == 0 ? s[k] : gi == 1 ? s[4 + k] : gi == 2 ? s[8 + k] : s[12 + k]; }
        int i0 = 0; float v0 = c4[0], w0 = s4[0];
#pragma unroll
        for (int k = 1; k < 4; ++k) if (c4[k] > v0) { v0 = c4[k]; i0 = k; w0 = s4[k]; }
        int i1 = -1; float v1 = -INFINITY, w1 = 0.f;
#pragma unroll
        for (int k = 0; k < 4; ++k) if (k != i0 && c4[k] > v1) { v1 = c4[k]; i1 = k; w1 = s4[k]; }
        const float wsum = w0 + w1; w0 /= wsum; w1 /= wsum;
        if (F.lane == idx - c0) { my_e0 = (unsigned)(4 * gi + i0); my_e1 = (unsigned)(4 * gi + i1); my_w0 = w0; my_w1 = w1; my_row = row; }
    }
    if (!dry) {
        const int nmine = c1 - c0; const bool have = F.lane < nmine;
        unsigned r0 = 0u, r1 = 0u, mycnt = 0u;
        const unsigned long long ltm = (1ull << F.lane) - 1ull;
#pragma unroll
        for (int e = 0; e < 16; ++e) { const unsigned long long m0 = __ballot(have && my_e0 == (unsigned)e), m1 = __ballot(have && my_e1 == (unsigned)e);
            const unsigned c0 = (unsigned)__popcll(m0), c1 = (unsigned)__popcll(m1);
            if (my_e0 == (unsigned)e) r0 = (unsigned)__popcll(m0 & ltm);
            if (my_e1 == (unsigned)e) r1 = c0 + (unsigned)__popcll(m1 & ltm);
            if (F.lane == e) mycnt = c0 + c1; }
        unsigned base = 0u; if (F.lane < 16 && mycnt) base = __hip_atomic_fetch_add(cnt + F.lane, mycnt, RLX_AGENT);
        const unsigned b0 = (unsigned)__shfl((int)base, (int)my_e0), b1 = (unsigned)__shfl((int)base, (int)my_e1);
        if (have) { const u32x4 q0 = {my_e0, b0 + r0, my_e1, b1 + r1}; const u32x4 q1 = {__float_as_uint(my_w0), __float_as_uint(my_w1), 0u, 0u};
            *(GAS u32x4*)(RT + (size_t)my_row * 8) = q0; *(GAS u32x4*)(RT + (size_t)my_row * 8 + 4) = q1; }
    }
    }
#undef R2_LOAD
#undef R2_XI
    __syncthreads();
}

__device__ __forceinline__ void build_ptab(Frame& F, int l, LAS int* ptab) {
    if (F.tid == 0) { int acc = 0; gu32* cntb = F.ctl() + CW_CNT + l * 64;
        for (int e = 0; e < NE; ++e) { ptab[e] = acc; const int c = (int)__hip_atomic_load(cntb + e, RLX_AGENT); acc += ((c + 255) >> 8) << 8; }
        ptab[NE] = acc; }
    __syncthreads();
}
__device__ __forceinline__ void gather_phase(Frame& F, int l, LAS int* ptab) {
    const bool all = (l == 0); const int nrows = all ? T : NB * SEQ;
    const unsigned* RT = F.ROUTE(); const unsigned char* Ab = F.H8(); unsigned char* HGb = F.HG();
    const RowRange rr = wave_rows(F, nrows);
    for (int idx = rr.lo; idx < rr.hi; idx += 4) {
        u32x4 a[4]; size_t p0[4], p1[4];
#pragma unroll
        for (int k = 0; k < 4; ++k) if (idx + k < rr.hi) { int b, p; row_decode(idx + k, all, b, p); const int row = b * TB + p;
            const u32x4 r0 = *(const GAS u32x4*)(RT + (size_t)row * 8); p0[k] = (size_t)ptab[r0.x] + r0.y; p1[k] = (size_t)ptab[r0.z] + r0.w;
            a[k] = *((const GAS u32x4*)(Ab + (size_t)row * D) + F.lane); }
#pragma unroll
        for (int k = 0; k < 4; ++k) if (idx + k < rr.hi) { *((GAS u32x4*)(HGb + p0[k] * D) + F.lane) = a[k]; *((GAS u32x4*)(HGb + p1[k] * D) + F.lane) = a[k]; }
    }
}
__device__ __forceinline__ void r3_phase(Frame& F, int l, LAS int* ptab, bool dry = false) {
    const bool all = (l == 0); const int nrows = all ? T : NB * SEQ;
    const float* MODb = F.MOD(); float* XCb = F.XC(); float* outb = F.out(); const bf16_t* YPb = F.YP(); bf16_t* Ab = F.A(); unsigned char* H8i = F.HIN8(); const unsigned* RT = F.ROUTE();
    const float* n1g = F.norm1_g() + (size_t)(l == 0 ? 1 : 0) * D;
    const RowRange rr = wave_rows(F, nrows);
    int cursel = -1; f32x4 g2v[4], gm[4], sh[4], vn[4]; u32x2 y0n[4], y1n[4]; float w0n = 0.f, w1n = 0.f;
    u32x4 ra = {0u, 0u, 0u, 0u}; u32x2 rb2 = {0u, 0u};
#define R3_ROUTE(idx_) do { int b_, p_; row_decode((idx_), all, b_, p_); const int row_ = b_ * TB + p_; ra = *(const GAS u32x4*)(RT + (size_t)row_ * 8); rb2 = *(const GAS u32x2*)(RT + (size_t)row_ * 8 + 4); } while (0)
#define R3_LOAD(idx_) do { int b_, p_; row_decode((idx_), all, b_, p_); const u32x4 r0_ = ra; const u32x2 r1_ = rb2; \
        const size_t q0_ = (size_t)ptab[r0_.x] + r0_.y, q1_ = (size_t)ptab[r0_.z] + r0_.w; w0n = __uint_as_float(r1_.x); w1n = __uint_as_float(r1_.y); \
        ld_row_f32((p_ < NCTX) ? XCb + (size_t)(b_ * NCTX + p_) * D : outb + (size_t)(b_ * SEQ + p_ - NCTX) * D, F.lane, vn); \
        _Pragma("unroll") for (int j = 0; j < 4; ++j) { y0n[j] = *((const GAS u32x2*)(YPb + q0_ * D) + F.lane + 64 * j); y1n[j] = *((const GAS u32x2*)(YPb + q1_ * D) + F.lane + 64 * j); } } while (0)
    if (rr.lo < rr.hi) { R3_ROUTE(rr.lo); R3_LOAD(rr.lo); if (rr.lo + 1 < rr.hi) R3_ROUTE(rr.lo + 1); }
    for (int idx = rr.lo; idx < rr.hi; ++idx) {
        int b, p; row_decode(idx, all, b, p);
        const int row = b * TB + p; const bool isc = p < NCTX; const int sel = isc ? 16 : b;
        float* xo = isc ? XCb + (size_t)(b * NCTX + p) * D : outb + (size_t)(b * SEQ + p - NCTX) * D;
        f32x4 v[4], m[4]; const float w0 = w0n, w1 = w1n;
#pragma unroll
        for (int j = 0; j < 4; ++j) { const u32x2 a = y0n[j], c = y1n[j]; v[j] = vn[j];
            m[j] = (f32x4){bf_lo(a.x) * w0 + bf_lo(c.x) * w1, bf_hi(a.x) * w0 + bf_hi(c.x) * w1, bf_lo(a.y) * w0 + bf_lo(c.y) * w1, bf_hi(a.y) * w0 + bf_hi(c.y) * w1}; }
        if (idx + 1 < rr.hi) { R3_LOAD(idx + 1); if (idx + 2 < rr.hi) R3_ROUTE(idx + 2); }
        if (sel != cursel) { cursel = sel; ld_vec(modp(MODb, l, sel, 5), F.lane, g2v);
            if (l == 0) { f32x4 g[4], sc[4]; ld_vec(n1g, F.lane, g); ld_vec(modp(MODb, l + 1, sel, 1), F.lane, sc); ld_vec(modp(MODb, l + 1, sel, 0), F.lane, sh);
#pragma unroll
                for (int j = 0; j < 4; ++j) gm[j] = g[j] * (sc[j] + 1.0f); } }
#pragma unroll
        for (int j = 0; j < 4; ++j) v[j] = v[j] + g2v[j] * m[j];
        if (!isc && !dry) st_row_f32(xo, F.lane, v);
        if (l == 0) { const float rinv = row_rinv(v); f32x4 h[4];
#pragma unroll
            for (int j = 0; j < 4; ++j) h[j] = (v[j] * rinv) * gm[j] + sh[j];
            if (!dry) { if (PSPLIT > 0) st_row_bf16(Ab + (size_t)row * D, F.lane, h); st_row_fp8(H8i + (size_t)row * D, F.lane, h); } }
    }
#undef R3_LOAD
#undef R3_ROUTE
}

struct SchedProj {
    const char* A; const char* B; int G, c, pn0, npn, rowB;
    __device__ __forceinline__ bool next(int i, pg8::Unit& u) const { int pm, pn; if (!pg8::tile_order((long)i * G + c, T / 256, npn, pm, pn)) return false;
        pn += pn0; u.pm = pm; u.pn = pn; u.aux = 0; u.A = A + (size_t)pm * 256 * rowB; u.B = B + (size_t)pn * 256 * rowB; return true; }
};
__device__ __forceinline__ int lat_tile(int pe) { return (pe >> 4) * 17 + 1 + (pe & 15); }
struct SchedMerge {
    const char* P; const char* B; int G, c, nM; bool lat_only;
    __device__ __forceinline__ bool next(int i, pg8::Unit& u) const { const int rnd = i / 3, br = i - rnd * 3; int pm, pn; if (!pg8::tile_order((long)rnd * G + c, nM, 4, pm, pn)) return false;
        if (lat_only) pm = lat_tile(pm);
        const int acol = br == 0 ? C_GR : (br == 1 ? C_GQ : C_WQ);
        u.pm = pm; u.pn = pn; u.aux = br; u.A = P + ((size_t)pm * 256 * NIN + acol) * 2; u.B = B + ((size_t)br * D + pn * 256) * 512 * 2; return true; }
};
struct SchedOut {
    const char* A; const char* B; int G, c, nM; bool lat_only;
    __device__ __forceinline__ bool next(int i, pg8::Unit& u) const { int pm, pn; if (!pg8::tile_order((long)i * G + c, nM, 4, pm, pn)) return false;
        if (lat_only) pm = lat_tile(pm);
        u.pm = pm; u.pn = pn; u.aux = 0; u.A = A + (size_t)pm * 256 * D * 2; u.B = B + (size_t)pn * 256 * D * 2; return true; }
};
struct SchedMoe {
    const char* A; const char* B; const LAS int* ptab; int G, c, npn;
    __device__ __forceinline__ bool next(int i, pg8::Unit& u) const { const int L = i * G + c; const int ntile = ptab[NE] >> 8; if (L >= ntile * npn) return false;
        const int j = L / npn, pn = L - j * npn; int e = 0;
#pragma unroll
        for (int k = 1; k < NE; ++k) e += (ptab[k] <= j * 256) ? 1 : 0;
        u.pm = j; u.pn = pn; u.aux = e; u.A = A + (size_t)j * 256 * D; u.B = B + ((size_t)e * npn + pn) * 256 * D; return true; }
};

#ifndef PROBE
#define PROBE 0
#endif
static_assert(sizeof(Args) == sizeof(KArgs), "kernarg views");
__global__ void __launch_bounds__(NWAVES * 64, 2) mega_fwd(Args args) {
    extern __shared__ __attribute__((aligned(16))) unsigned char lds[];
    volatile LAS unsigned* MISC = (volatile LAS unsigned*)((LAS unsigned char*)lds + MISC_OFF);
    LAS int* ptab = (LAS int*)((LAS unsigned char*)lds + LDSCTL_OFF);
    Frame F0; {
    Frame& F = F0;
    F.lds = (LAS unsigned char*)lds;
    F.tid = threadIdx.x; F.lane = F.tid & 63; F.wave = __builtin_amdgcn_readfirstlane(F.tid >> 6);
    F.G = gridDim.x; { const int bx = blockIdx.x; F.vcu = (F.G % 8 == 0) ? (bx % 8) * (F.G / 8) + bx / 8 : bx; }
    F.gw = F.vcu * NWAVES + F.wave; F.NGW = F.G * NWAVES; F.bid = blockIdx.x; }
    for (int u = F0.tid; u < (LDS_BYTES - LDSCTL_OFF) / 4; u += NWAVES * 64) ((LAS unsigned*)(F0.lds + LDSCTL_OFF))[u] = 0u;
    __syncthreads();
    XcdBarrier bar = xcd_barrier_post((unsigned*)(F0.ctl() + CW_BAR), MISC + 8);
#define GRID_BAR() do { XcdBarrier b_ = bar; asm volatile("" : "+s"(b_.bar), "+s"(b_.x)); xcd_barrier(b_); } while (0)

    { Frame F = fresh(F0); p0_prologue(F); }
    if (PROBE == 13) { __syncthreads(); Frame F = fresh(F0); p0_prologue(F); }
    GRID_BAR();
    { Frame F = fresh(F0); r1_phase(F); }
    if (PROBE == 17) { Frame F = fresh(F0); r1_phase(F); }
    GRID_BAR();

    for (int l = 0; l < NL; ++l) {
        const bool last = (l == NL - 1);
        if (PSPLIT > 0) { Frame F = fresh(F0);
            pg8::Gemm g{D / 64, D * 2, D * 2}; SchedProj S{(const char*)F.A(), (const char*)(F.WIN() + (size_t)l * NIN * D), F.G, F.bid, 0, PSPLIT, D * 2};
            pg8::EpiProj E{F.PROJ(), F.b_merge() + (size_t)l * 3 * D, 1.0f};
            pg8::gemm_phase(F.lds + RING_OFF, g, S, E);
            if (PROBE == 1) { __syncthreads(); pg8::gemm_phase(F.lds + RING_OFF, g, S, E); }
        }
        { Frame F = fresh(F0);
            pg8::Gemm g{D / 128, D, D}; SchedProj S{(const char*)F.HIN8(), (const char*)(F.WIN8() + (size_t)l * NIN * D), F.G, (F.bid + (3 * F.G) / 4) % F.G, PSPLIT, NIN / 256 - PSPLIT, D};
            pg8::EpiProj E{F.PROJ(), F.b_merge() + (size_t)l * 3 * D, 1.0f / WSCALE};
            pg8::gemm_phase<pg8::EpiProj, SchedProj, true>(F.lds + RING_OFF, g, S, E);
            if (PROBE == 1) { __syncthreads(); pg8::gemm_phase<pg8::EpiProj, SchedProj, true>(F.lds + RING_OFF, g, S, E); }
        }
        GRID_BAR();
        if (PROBE == 14) { Frame F = fresh(F0); kfix_phase(F, l, __hip_atomic_load(F.ctl() + 8, RLX_AGENT) == 0u); }
        { Frame F = fresh(F0); kfix_phase(F, l); }
        GRID_BAR();
        if (PROBE == 4) { Frame F = fresh(F0); const bool dry = __hip_atomic_load(F.ctl() + 8, RLX_AGENT) == 0u; for (int uid = F.vcu; uid < 256; uid += F.G) scan_unit(F, l, uid, last, dry); __syncthreads(); }
        { Frame F = fresh(F0); for (int uid = F.vcu; uid < 256; uid += F.G) scan_unit(F, l, uid, last); }
        __syncthreads();
        { Frame F = fresh(F0);
            const int per = (2048 + F.G - 1) / F.G;
            attn_body::AttnArgs aa; aa.P = (attn_body::bf16*)F.PROJ(); aa.ropec = F.ROPEC(); aa.ropes = F.ROPES(); aa.dry = false;
            aa.qg = F.q_norm_g() + (size_t)(l * 2 + 0) * 64; aa.sink = 0.f;
            if (PROBE == 11) { aa.dry = __hip_atomic_load(F.ctl() + 8, RLX_AGENT) == 0u; for (int gid = F.vcu * per; gid < (F.vcu + 1) * per && gid < 2048; ++gid) { const int pair = gid >> 6, uu = gid & 63; const int b = pair >> 1, h = (pair & 1) * 4 + (uu >> 4), qb = uu & 15;
                attn_body::attn_unit<0, 8>(b, h, qb, aa, (char*)lds + RING_OFF); } aa.dry = false; }
            if (PROBE != 9) for (int gid = F.vcu * per; gid < (F.vcu + 1) * per && gid < 2048; ++gid) { const int pair = gid >> 6, uu = gid & 63; const int b = pair >> 1, h = (pair & 1) * 4 + (uu >> 4), qb = uu & 15;
                attn_body::attn_unit<0, 8>(b, h, qb, aa, (char*)lds + RING_OFF); }
            aa.qg = F.q_norm_g() + (size_t)(l * 2 + 1) * 64;
            if (PROBE == 12) { aa.dry = __hip_atomic_load(F.ctl() + 8, RLX_AGENT) == 0u; for (int gid = F.vcu * per; gid < (F.vcu + 1) * per && gid < 2048; ++gid) { const int pair = gid >> 6, uu = gid & 63; const int b = pair >> 1, h = (pair & 1) * 4 + (uu >> 4), qb = uu & 15;
                aa.sink = 0.f; attn_body::attn_unit<1, 8>(b, h, qb, aa, (char*)lds + RING_OFF); } aa.dry = false; }
            if (PROBE != 10) for (int gid = F.vcu * per; gid < (F.vcu + 1) * per && gid < 2048; ++gid) { const int pair = gid >> 6, uu = gid & 63; const int b = pair >> 1, h = (pair & 1) * 4 + (uu >> 4), qb = uu & 15;
                aa.sink = F.sink()[l * 8 + h];
                attn_body::attn_unit<1, 8>(b, h, qb, aa, (char*)lds + RING_OFF); }
            if (!last) {
                for (int cid = F.vcu; cid < 256; cid += F.G) { const int b = cid >> 4, h = (cid >> 1) & 7;
                    if (cid & 1) { aa.qg = F.q_norm_g() + (size_t)(l * 2 + 1) * 64; aa.sink = F.sink()[l * 8 + h]; attn_body::attn_unit<3, 8>(b, h, 0, aa, (char*)lds + RING_OFF); }
                    else { aa.qg = F.q_norm_g() + (size_t)(l * 2 + 0) * 64; aa.sink = 0.f; attn_body::attn_unit<2, 8>(b, h, 0, aa, (char*)lds + RING_OFF); } }
            }
        }
        GRID_BAR();
        { Frame F = fresh(F0);
            pg8::Gemm g{512 / 64, NIN * 2, 512 * 2}; SchedMerge S{(const char*)F.PROJ(), (const char*)(F.WBR() + (size_t)l * 3 * D * 512), F.G, F.bid, last ? 256 : 272, last};
            pg8::EpiMerge E{F.PROJ(), F.A()};
            pg8::gemm_phase(F.lds + RING_OFF, g, S, E);
            if (PROBE == 2) { __syncthreads(); pg8::gemm_phase(F.lds + RING_OFF, g, S, E); }
        }
        GRID_BAR();
        { Frame F = fresh(F0);
            pg8::Gemm g{D / 64, D * 2, D * 2}; SchedOut S{(const char*)F.A(), (const char*)(F.WOUT() + (size_t)l * D * D), F.G, F.bid, last ? 256 : 272, last};
            pg8::EpiPlain E{F.YBUF(), D, 1.0f};
            pg8::gemm_phase(F.lds + RING_OFF, g, S, E);
            if (PROBE == 3) { __syncthreads(); pg8::gemm_phase(F.lds + RING_OFF, g, S, E); }
        }
        GRID_BAR();
        { Frame F = fresh(F0); convert_experts(F, l); }
        __syncthreads();
        if (PROBE == 7) { Frame F = fresh(F0); convert_experts(F, l); __syncthreads(); }
        if (PROBE == 15) { Frame F = fresh(F0); r2_phase(F, l, __hip_atomic_load(F.ctl() + 8, RLX_AGENT) == 0u); }
        { Frame F = fresh(F0); r2_phase(F, l); }
        GRID_BAR();
        { Frame F = fresh(F0); build_ptab(F, l, ptab); gather_phase(F, l, ptab); if (PROBE == 8) gather_phase(F, l, ptab); }
        GRID_BAR();
        { Frame F = fresh(F0);
            pg8::Gemm g{D / 128, D, D}; SchedMoe S{(const char*)F.HG(), (const char*)F.W13(), ptab, F.G, F.bid, 8};
            pg8::EpiSwiglu E{F.HID(), 1.0f / WSCALE};
            pg8::gemm_phase<pg8::EpiSwiglu, SchedMoe, true>(F.lds + RING_OFF, g, S, E);
            if (PROBE == 5) { __syncthreads(); pg8::gemm_phase<pg8::EpiSwiglu, SchedMoe, true>(F.lds + RING_OFF, g, S, E); }
        }
        GRID_BAR();
        { Frame F = fresh(F0);
            pg8::Gemm g{D / 128, D, D}; SchedMoe S{(const char*)F.HID(), (const char*)F.W2(), ptab, F.G, F.bid, 4};
            pg8::EpiPlain E{F.YP(), D, 1.0f / WSCALE};
            pg8::gemm_phase<pg8::EpiPlain, SchedMoe, true>(F.lds + RING_OFF, g, S, E);
            if (PROBE == 6) { __syncthreads(); pg8::gemm_phase<pg8::EpiPlain, SchedMoe, true>(F.lds + RING_OFF, g, S, E); }
        }
        GRID_BAR();
        if (PROBE == 16) { Frame F = fresh(F0); r3_phase(F, l, ptab, __hip_atomic_load(F.ctl() + 8, RLX_AGENT) == 0u); }
        { Frame F = fresh(F0); r3_phase(F, l, ptab); }
        if (!last) GRID_BAR();
    }
}

extern "C" void kernel_launch(void* const* d_in, const int* in_sizes, int n_in, void* d_out, int out_size, void* d_ws, size_t ws_size, hipStream_t stream) {
    static int grid = 0;
    if (grid == 0) {
        if (n_in != 27 || in_sizes[0] != NB * SEQ * D || out_size != NB * SEQ * D || ws_size < WS_END) { fprintf(stderr, "kernel_launch: unexpected shapes / workspace (n_in %d, ws %zu < %zu)\n", n_in, ws_size, (size_t)WS_END); grid = -1; return; }
        int dev = 0, cus = 0, per_cu = 0;
        if (hipGetDevice(&dev) != hipSuccess || hipDeviceGetAttribute(&cus, hipDeviceAttributeMultiprocessorCount, dev) != hipSuccess) { grid = -1; return; }
        if (hipFuncSetAttribute((const void*)mega_fwd, hipFuncAttributeMaxDynamicSharedMemorySize, LDS_BYTES) != hipSuccess) { fprintf(stderr, "kernel_launch: hipFuncSetAttribute failed\n"); grid = -1; return; }
        if (hipOccupancyMaxActiveBlocksPerMultiprocessor(&per_cu, (const void*)mega_fwd, NWAVES * 64, LDS_BYTES) != hipSuccess || per_cu < 1) { fprintf(stderr, "kernel_launch: occupancy query says %d\n", per_cu); }
        (void)hipGetLastError();
        grid = cus;
    }
    if (grid < 0) return;
    if (hipMemsetAsync((char*)d_ws + WS_CTL, 0, CTL_ZERO_BYTES, stream) != hipSuccess) return;
    Args a{};
    for (int i = 0; i < 27; ++i) a.in[i] = (const float*)d_in[i];
    a.out = (float*)d_out; a.ws = (unsigned char*)d_ws;
    hipLaunchKernelGGL(mega_fwd, dim3(grid), dim3(NWAVES * 64), LDS_BYTES, stream, a);
}
```

```cpp
#define PROBE 0
#include <hip/hip_runtime.h>
#include <hip/hip_bf16.h>
#include <cstdio>
#include <cstdint>
#include <cmath>

#define GAS __attribute__((address_space(1)))
#define LAS __attribute__((address_space(3)))
typedef unsigned short bf16_t;
typedef short bf16x8 __attribute__((ext_vector_type(8)));
typedef float f32x4 __attribute__((ext_vector_type(4)));
typedef float f32x2 __attribute__((ext_vector_type(2)));
typedef unsigned u32x4 __attribute__((ext_vector_type(4)));
typedef unsigned u32x2 __attribute__((ext_vector_type(2)));

constexpr int NB = 16, SEQ = 4096, NCTX = 256, TB = SEQ + NCTX, T = NB * TB;
constexpr int D = 1024, NIN = 5632, NL = 2, NE = 16;
constexpr int C_XR = 0, C_GR = 512, C_GQ = 1024, C_GK = 1536, C_GV = 1664, C_WQ = 1792, C_WK = 2304, C_WV = 2432, C_MG = 2560;
constexpr float EPS = 1e-6f;
constexpr int PMAX = 143360;

__device__ __forceinline__ unsigned cvt_pk_bf16(float lo, float hi) { unsigned r; asm volatile("v_cvt_pk_bf16_f32 %0, %1, %2" : "=v"(r) : "v"(lo), "v"(hi)); return r; }
typedef int i32x8 __attribute__((ext_vector_type(8)));
typedef int i32x4 __attribute__((ext_vector_type(4)));
__device__ __forceinline__ unsigned pk4_fp8(float a, float b, float c, float d) {
    a = __builtin_fminf(__builtin_fmaxf(a, -448.f), 448.f); b = __builtin_fminf(__builtin_fmaxf(b, -448.f), 448.f); c = __builtin_fminf(__builtin_fmaxf(c, -448.f), 448.f); d = __builtin_fminf(__builtin_fmaxf(d, -448.f), 448.f);
    int w = __builtin_amdgcn_cvt_pk_fp8_f32(a, b, 0, false); w = __builtin_amdgcn_cvt_pk_fp8_f32(c, d, w, true); return (unsigned)w; }
__device__ __forceinline__ float bf_lo(unsigned u) { return __uint_as_float(u << 16); }
__device__ __forceinline__ float bf_hi(unsigned u) { return __uint_as_float(u & 0xffff0000u); }
__device__ __forceinline__ float fast_sigmoid(float v) { return __builtin_amdgcn_rcpf(1.0f + __builtin_amdgcn_exp2f(-1.4426950409f * v)); }
__device__ __forceinline__ float gelu_tanh(float v) { return v * __builtin_amdgcn_rcpf(1.0f + __builtin_amdgcn_exp2f(-2.3022082f * v * (1.0f + 0.044715f * v * v))); }

namespace pg8 {
constexpr int BM = 256, BK = 64, HALF = 128, HTB = HALF * BK * 2, STAGE_BYTES = 8 * HTB, NXCD = 8, WGM = 8;
__host__ __device__ __forceinline__ int lds_byte(int r, int c) { const int st = (r >> 4) * 2 + (c >> 5), rr = r & 15, cc = c & 31, ob = rr * 64 + cc * 2; return st * 1024 + (ob ^ (((ob >> 9) & 1) << 5)); }
__host__ __device__ __forceinline__ void stage_rc(int b, int& R, int& C) { const int st = b / 1024, sb = b % 1024, swz = sb ^ (((sb >> 9) & 1) << 5); R = (st >> 1) * 16 + swz / 64; C = (st & 1) * 32 + (swz % 64) / 2; }
__host__ __device__ __forceinline__ int perm32(int rho) { const int n = rho >> 4, i = rho & 15; return 8 * (i >> 2) + 4 * n + (i & 3); }

struct Unit { int pm, pn, aux; const char* A; const char* B; };
struct Gemm { int nt, ldaB, ldbB; };

__device__ __forceinline__ bool tile_order(long L, int nM, int nN, int& pm, int& pn) {
    const int nwg = nM * nN; if (L >= nwg) return false;
    int wgid = (int)L; { const int q = nwg / NXCD, r = nwg % NXCD, xcd = wgid % NXCD, off = wgid / NXCD; wgid = (xcd < r ? xcd * (q + 1) : r * (q + 1) + (xcd - r) * q) + off; }
    const int nig = WGM * nN, gid = wgid / nig, fm = gid * WGM, gsz = (nM - fm) < WGM ? (nM - fm) : WGM;
    pm = fm + ((wgid % nig) % gsz); pn = (wgid % nig) / gsz; return true;
}

template <class Epi, class Sched, bool FP8 = false>
__device__ __forceinline__ void gemm_phase(LAS unsigned char* lds, const Gemm g, const Sched& S, const Epi& E) {
    int tid_ = threadIdx.x; asm volatile("" : "+v"(tid_));
    const int tid = tid_, wid = __builtin_amdgcn_readfirstlane(tid >> 6), lane = tid & 63, wr = wid >> 2, wc = wid & 3, fr = lane & 15, fq = lane >> 4;
    int nt_ = g.nt; asm volatile("" : "+s"(nt_)); const int nt = nt_;
    unsigned voffA[2], voffB[2];
#pragma unroll
    for (int i = 0; i < 2; ++i) { int R, C; stage_rc(tid * 16 + i * 8192, R, C); const int Rb = (R & ~31) + perm32(R & 31);
        voffA[i] = (unsigned)(R * g.ldaB + C * 2); voffB[i] = (unsigned)(Rb * g.ldbB + C * 2); }
    const size_t kstep = (size_t)(BK * 2);
    const size_t hstepA = (size_t)HALF * g.ldaB, hstepB = (size_t)HALF * g.ldbB;
    const unsigned ldsw = (unsigned)wid * 1024u;
    const int aoff = lds_byte(wr * 64 + fr, fq * 8), boff = lds_byte(wc * 32 + fr, fq * 8);
#define PG8_SA(b, h) (((b) * 2 + (h)) * HTB)
#define PG8_SB(b, h) ((4 + (b) * 2 + (h)) * HTB)
#define PG8_STAGE(bufoff, gbase, voff) do { _Pragma("unroll") for (int _i = 0; _i < 2; ++_i) \
        __builtin_amdgcn_global_load_lds((const unsigned*)((const char*)(gbase) + (voff)[_i]), (LAS unsigned*)(lds + (bufoff) + ldsw + _i * 8192), 16, 0, 0); } while (0)
#define PG8_LDA(dst, b, h) do { _Pragma("unroll") for (int m = 0; m < 4; ++m) _Pragma("unroll") for (int k = 0; k < 2; ++k) dst[m][k] = *(const LAS bf16x8*)(lds + PG8_SA(b, h) + aoff + m * 2048 + k * 1024); } while (0)
#define PG8_LDB(dst, b, h) do { _Pragma("unroll") for (int n = 0; n < 2; ++n) _Pragma("unroll") for (int k = 0; k < 2; ++k) dst[n][k] = *(const LAS bf16x8*)(lds + PG8_SB(b, h) + boff + n * 2048 + k * 1024); } while (0)
#define PG8_CAT(x) __builtin_shufflevector(__builtin_bit_cast(i32x4, x[0]), __builtin_bit_cast(i32x4, x[1]), 0, 1, 2, 3, 4, 5, 6, 7)
#define PG8_MMA(ai, bj, At, Bt) do { __builtin_amdgcn_s_setprio(1); \
        if constexpr (FP8) { _Pragma("unroll") for (int m = 0; m < 4; ++m) _Pragma("unroll") for (int n = 0; n < 2; ++n) \
            asm volatile("v_mfma_scale_f32_16x16x128_f8f6f4 %0, %1, %2, %0, %3, %3 op_sel_hi:[0,0,0]" : "+v"(acc[ai][bj][m][n]) : "v"(PG8_CAT(Bt[n])), "v"(PG8_CAT(At[m])), "v"(scl1)); } \
        else { _Pragma("unroll") for (int m = 0; m < 4; ++m) _Pragma("unroll") for (int n = 0; n < 2; ++n) _Pragma("unroll") for (int k = 0; k < 2; ++k) \
            acc[ai][bj][m][n] = __builtin_amdgcn_mfma_f32_16x16x32_bf16(Bt[n][k], At[m][k], acc[ai][bj][m][n], 0, 0, 0); } \
        __builtin_amdgcn_s_setprio(0); } while (0)
#define PG8_WAIT_V(n) asm volatile("s_waitcnt vmcnt(" #n ")" ::: "memory")
#define PG8_WAIT_L(n) asm volatile("s_waitcnt lgkmcnt(" #n ")" ::: "memory")
#define PG8_BAR __builtin_amdgcn_s_barrier()
#define PG8_SCHED __builtin_amdgcn_sched_barrier(0)
    int scl1 = 0x7F7F7F7F; asm volatile("" : "+v"(scl1));
    Unit cur, nxt; int ui = 0;
    if (!S.next(0, cur)) return;
    f32x4 acc[2][2][4][2];
#pragma unroll
    for (int a = 0; a < 2; ++a)
#pragma unroll
        for (int b = 0; b < 2; ++b)
#pragma unroll
            for (int m = 0; m < 4; ++m)
#pragma unroll
                for (int n = 0; n < 2; ++n) acc[a][b][m][n] = (f32x4){0.f, 0.f, 0.f, 0.f};
    bf16x8 At[4][2], B0[2][2], B1[2][2];
    const char* cA = cur.A; const char* cB = cur.B;
    PG8_STAGE(PG8_SB(0, 0), cB, voffB); PG8_STAGE(PG8_SB(0, 1), cB + hstepB, voffB); PG8_STAGE(PG8_SA(0, 0), cA, voffA); PG8_STAGE(PG8_SA(0, 1), cA + hstepA, voffA);
    if (wr == 1) PG8_BAR;
    PG8_WAIT_V(2); PG8_BAR;
    PG8_STAGE(PG8_SB(1, 0), cB + kstep, voffB); PG8_STAGE(PG8_SA(1, 0), cA + kstep, voffA); PG8_STAGE(PG8_SB(1, 1), cB + hstepB + kstep, voffB);
    PG8_WAIT_V(6); PG8_BAR;
    for (;;) {
        const bool has_next = S.next(ui + 1, nxt);
        const char* nA = has_next ? nxt.A : cA; const char* nB = has_next ? nxt.B : cB;
        for (int t = 0; t < nt; t += 2) {
            const bool last = (t == nt - 2);
            const char* a1 = cA + (size_t)(t + 1) * kstep;
            const char* a2 = last ? nA : cA + (size_t)(t + 2) * kstep; const char* b2 = last ? nB : cB + (size_t)(t + 2) * kstep;
            const char* a3 = a2 + kstep; const char* b3 = b2 + kstep;
            PG8_LDB(B0, 0, 0); PG8_LDB(B1, 0, 1); PG8_SCHED; PG8_LDA(At, 0, 0); PG8_STAGE(PG8_SA(1, 1), a1 + hstepA, voffA);
            PG8_WAIT_V(8); PG8_WAIT_L(0); PG8_BAR; PG8_MMA(0, 0, At, B0); PG8_MMA(0, 1, At, B1); PG8_BAR; PG8_SCHED;
            PG8_LDA(At, 0, 1); PG8_STAGE(PG8_SB(0, 0), b2, voffB); PG8_STAGE(PG8_SB(0, 1), b2 + hstepB, voffB); PG8_STAGE(PG8_SA(0, 0), a2, voffA);
            PG8_WAIT_V(8); PG8_WAIT_L(0); PG8_BAR; PG8_MMA(1, 0, At, B0); PG8_MMA(1, 1, At, B1); PG8_BAR; PG8_SCHED;
            PG8_LDB(B0, 1, 0); PG8_LDB(B1, 1, 1); PG8_SCHED; PG8_LDA(At, 1, 0); PG8_STAGE(PG8_SA(0, 1), a2 + hstepA, voffA);
            PG8_WAIT_V(8); PG8_WAIT_L(0); PG8_BAR; PG8_MMA(0, 0, At, B0); PG8_MMA(0, 1, At, B1); PG8_BAR; PG8_SCHED;
            PG8_LDA(At, 1, 1); PG8_STAGE(PG8_SB(1, 0), b3, voffB); PG8_STAGE(PG8_SB(1, 1), b3 + hstepB, voffB); PG8_STAGE(PG8_SA(1, 0), a3, voffA);
            PG8_WAIT_V(8); PG8_WAIT_L(0); PG8_BAR; PG8_MMA(1, 0, At, B0); PG8_MMA(1, 1, At, B1); PG8_BAR; PG8_SCHED;
        }
        if (wr == 0) PG8_BAR;
        if constexpr (FP8) asm volatile("s_nop 15\n\ts_nop 15" ::: "memory");
        E(acc, cur, wr, wc, fr, fq);
        if (!has_next) break;
#pragma unroll
        for (int a = 0; a < 2; ++a)
#pragma unroll
            for (int b = 0; b < 2; ++b)
#pragma unroll
                for (int m = 0; m < 4; ++m)
#pragma unroll
                    for (int n = 0; n < 2; ++n) acc[a][b][m][n] = (f32x4){0.f, 0.f, 0.f, 0.f};
        cur = nxt; cA = nA; cB = nB; ++ui;
        if (wr == 1) PG8_BAR;
    }
    PG8_WAIT_V(0);
    PG8_BAR;
#undef PG8_SA
#undef PG8_SB
#undef PG8_STAGE
#undef PG8_LDA
#undef PG8_LDB
#undef PG8_MMA
#undef PG8_CAT
#undef PG8_WAIT_V
#undef PG8_WAIT_L
#undef PG8_BAR
#undef PG8_SCHED
}

struct EpiProj {
    bf16_t* O; const float* bmerge; float scale;
    __device__ __forceinline__ void operator()(const f32x4 (&acc)[2][2][4][2], const Unit& u, int wr, int wc, int fr, int fq) const {
        const int row0 = u.pm * BM + wr * 64 + fr, col0 = u.pn * BM + wc * 32 + 8 * fq;
        const int mode = (u.pn == 2 || u.pn == 3) ? 1 : (u.pn >= 10 ? 2 : 0);
        f32x4 bv[2][2];
#pragma unroll
        for (int bj = 0; bj < 2; ++bj)
#pragma unroll
            for (int n = 0; n < 2; ++n) bv[bj][n] = (mode == 2) ? *(const f32x4*)(bmerge + (col0 - C_MG) + bj * HALF + 4 * n) : (f32x4){0.f, 0.f, 0.f, 0.f};
#pragma unroll
        for (int ai = 0; ai < 2; ++ai)
#pragma unroll
            for (int m = 0; m < 4; ++m) { bf16_t* rowp = O + (size_t)(row0 + ai * HALF + m * 16) * NIN + col0;
#pragma unroll
                for (int bj = 0; bj < 2; ++bj) { f32x4 v0 = acc[ai][bj][m][0] * scale + bv[bj][0], v1 = acc[ai][bj][m][1] * scale + bv[bj][1];
                    if (mode == 1) {
#pragma unroll
                        for (int j = 0; j < 4; ++j) { v0[j] = gelu_tanh(v0[j]); v1[j] = gelu_tanh(v1[j]); } }
                    else if (mode == 2) {
#pragma unroll
                        for (int j = 0; j < 4; ++j) { v0[j] = fast_sigmoid(v0[j]); v1[j] = fast_sigmoid(v1[j]); } }
                    u32x4 w; w.x = cvt_pk_bf16(v0[0], v0[1]); w.y = cvt_pk_bf16(v0[2], v0[3]); w.z = cvt_pk_bf16(v1[0], v1[1]); w.w = cvt_pk_bf16(v1[2], v1[3]);
                    *(u32x4*)(rowp + bj * HALF) = w; } }
    }
};
struct EpiPlain {
    bf16_t* O; int ldc; float scale;
    __device__ __forceinline__ void operator()(const f32x4 (&acc)[2][2][4][2], const Unit& u, int wr, int wc, int fr, int fq) const {
        const int row0 = u.pm * BM + wr * 64 + fr, col0 = u.pn * BM + wc * 32 + 8 * fq;
#pragma unroll
        for (int ai = 0; ai < 2; ++ai)
#pragma unroll
            for (int m = 0; m < 4; ++m) { bf16_t* rowp = O + (size_t)(row0 + ai * HALF + m * 16) * ldc + col0;
#pragma unroll
                for (int bj = 0; bj < 2; ++bj) { const f32x4 v0 = acc[ai][bj][m][0] * scale, v1 = acc[ai][bj][m][1] * scale;
                    u32x4 w; w.x = cvt_pk_bf16(v0[0], v0[1]); w.y = cvt_pk_bf16(v0[2], v0[3]); w.z = cvt_pk_bf16(v1[0], v1[1]); w.w = cvt_pk_bf16(v1[2], v1[3]);
                    *(u32x4*)(rowp + bj * HALF) = w; } }
    }
};
struct EpiMerge {
    const bf16_t* P; bf16_t* O;
    __device__ __forceinline__ void operator()(const f32x4 (&acc)[2][2][4][2], const Unit& u, int wr, int wc, int fr, int fq) const {
        const int row0 = u.pm * BM + wr * 64 + fr, col0 = u.pn * BM + wc * 32 + 8 * fq; const int b = u.aux;
#pragma unroll
        for (int ai = 0; ai < 2; ++ai)
#pragma unroll
            for (int m = 0; m < 4; ++m) { const size_t row = (size_t)(row0 + ai * HALF + m * 16);
                const bf16_t* gp = P + row * NIN + C_MG + b * D + col0; bf16_t* op = O + row * D + col0;
#pragma unroll
                for (int bj = 0; bj < 2; ++bj) { const u32x4 gt = *(const u32x4*)(gp + bj * HALF);
                    f32x4 v0 = acc[ai][bj][m][0], v1 = acc[ai][bj][m][1];
                    v0[0] *= bf_lo(gt.x); v0[1] *= bf_hi(gt.x); v0[2] *= bf_lo(gt.y); v0[3] *= bf_hi(gt.y);
                    v1[0] *= bf_lo(gt.z); v1[1] *= bf_hi(gt.z); v1[2] *= bf_lo(gt.w); v1[3] *= bf_hi(gt.w);
                    if (b > 0) { const u32x4 pv = *(const u32x4*)(op + bj * HALF);
                        v0[0] += bf_lo(pv.x); v0[1] += bf_hi(pv.x); v0[2] += bf_lo(pv.y); v0[3] += bf_hi(pv.y);
                        v1[0] += bf_lo(pv.z); v1[1] += bf_hi(pv.z); v1[2] += bf_lo(pv.w); v1[3] += bf_hi(pv.w); }
                    u32x4 w; w.x = cvt_pk_bf16(v0[0], v0[1]); w.y = cvt_pk_bf16(v0[2], v0[3]); w.z = cvt_pk_bf16(v1[0], v1[1]); w.w = cvt_pk_bf16(v1[2], v1[3]);
                    *(u32x4*)(op + bj * HALF) = w; } }
    }
};
struct EpiSwiglu {
    unsigned char* O; float scale;
    __device__ __forceinline__ void operator()(const f32x4 (&acc)[2][2][4][2], const Unit& u, int wr, int wc, int fr, int fq) const {
        const int row0 = u.pm * BM + wr * 64 + fr, col0 = u.pn * HALF + wc * 32 + 8 * fq;
#pragma unroll
        for (int ai = 0; ai < 2; ++ai)
#pragma unroll
            for (int m = 0; m < 4; ++m) { unsigned char* rowp = O + (size_t)(row0 + ai * HALF + m * 16) * D + col0;
                f32x4 v0 = acc[ai][0][m][0] * scale, v1 = acc[ai][0][m][1] * scale; const f32x4 g0 = acc[ai][1][m][0] * scale, g1 = acc[ai][1][m][1] * scale;
#pragma unroll
                for (int j = 0; j < 4; ++j) { v0[j] = v0[j] * fast_sigmoid(v0[j]) * g0[j]; v1[j] = v1[j] * fast_sigmoid(v1[j]) * g1[j]; }
                u32x2 w; w.x = pk4_fp8(v0[0], v0[1], v0[2], v0[3]); w.y = pk4_fp8(v1[0], v1[1], v1[2], v1[3]);
                *(u32x2*)rowp = w; }
    }
};
}
namespace attn_body {
using bf16 = __hip_bfloat16;
using s16x4 = __attribute__((ext_vector_type(4))) short;
using f32x16 = __attribute__((ext_vector_type(16))) float;
constexpr int DM = NIN;
constexpr int NW = 8, QBLK = 32, QB = QBLK * NW, KVBLK = 64;
__device__ __forceinline__ int crow(int r, int hi) { return (r & 3) + 8 * (r >> 2) + 4 * hi; }
#define SBAR() __builtin_amdgcn_sched_barrier(0)
constexpr int NSLOT = 3, SLOTB = 8192;
constexpr int LDS_K = 0, LDS_V = NSLOT * SLOTB, LDS_WS = 2 * NSLOT * SLOTB, LDS_OST = LDS_WS + NW * 64 * 4, LDS_BYTES = LDS_OST + NW * 4096;
constexpr float LOG2E = 1.4426950408889634f;
constexpr float C2 = 0.125f * LOG2E;
__device__ __forceinline__ void glds16(const void* gsrc, unsigned lds_dst) { unsigned keep;
    asm volatile("s_mov_b32 %0, m0\n\ts_mov_b32 m0, %2\n\ts_nop 0\n\tglobal_load_lds_dwordx4 %1, off\n\ts_mov_b32 m0, %0" : "=&s"(keep) : "v"(gsrc), "s"(lds_dst) : "memory"); }
__device__ __forceinline__ float max3f(float a, float b, float c) { float r; asm("v_max3_f32 %0, %1, %2, %3" : "=v"(r) : "v"(a), "v"(b), "v"(c)); return r; }
__device__ __forceinline__ float max2f(float a, float b) { float r; asm("v_max_f32_e32 %0, %1, %2" : "=v"(r) : "v"(a), "v"(b)); return r; }
__device__ __forceinline__ float fadd_s(float a, float b) { float r; asm("v_add_f32_e32 %0, %1, %2" : "=v"(r) : "v"(a), "v"(b)); return r; }
__device__ __forceinline__ float fsub_s(float a, float b) { float r; asm("v_sub_f32_e32 %0, %1, %2" : "=v"(r) : "v"(a), "v"(b)); return r; }
typedef float f32x2_t __attribute__((ext_vector_type(2))); typedef __bf16 bf16x2_t __attribute__((ext_vector_type(2)));
__device__ __forceinline__ unsigned cvtpk_s(float lo, float hi) { f32x2_t v = {lo, hi}; bf16x2_t b = __builtin_convertvector(v, bf16x2_t); return __builtin_bit_cast(unsigned, b); }
#define WAIT_BAR(N) asm volatile("s_waitcnt vmcnt(" #N ") lgkmcnt(0)\n\ts_barrier" ::: "memory")

__device__ __forceinline__ void qkt(f32x16& p0, f32x16& p1, const char* Kslot, const bf16x8* qr, const f32x16& negm, int r32, int hi) {
    const char* kb = Kslot + hi * 1024 + r32 * 16;
#pragma unroll
    for (int d0 = 0; d0 < 4; ++d0) {
        const bf16x8 b0 = *reinterpret_cast<const bf16x8*>(kb + d0 * 2048);
        const bf16x8 b1 = *reinterpret_cast<const bf16x8*>(kb + d0 * 2048 + 512);
        if (d0 == 0) { p0 = __builtin_amdgcn_mfma_f32_32x32x16_bf16(b0, qr[0], negm, 0, 0, 0); p1 = __builtin_amdgcn_mfma_f32_32x32x16_bf16(b1, qr[0], negm, 0, 0, 0); }
        else { p0 = __builtin_amdgcn_mfma_f32_32x32x16_bf16(b0, qr[d0], p0, 0, 0, 0); p1 = __builtin_amdgcn_mfma_f32_32x32x16_bf16(b1, qr[d0], p1, 0, 0, 0); } }
}
typedef __attribute__((address_space(3))) const char* lds_cptr;
typedef short v4i16_t __attribute__((ext_vector_type(4)));
__device__ __forceinline__ void kload8(bf16x8* kf, lds_cptr kp) {
    kf[0] = *(const LAS bf16x8*)(kp);        kf[1] = *(const LAS bf16x8*)(kp + 512);
    kf[2] = *(const LAS bf16x8*)(kp + 2048); kf[3] = *(const LAS bf16x8*)(kp + 2560);
    kf[4] = *(const LAS bf16x8*)(kp + 4096); kf[5] = *(const LAS bf16x8*)(kp + 4608);
    kf[6] = *(const LAS bf16x8*)(kp + 6144); kf[7] = *(const LAS bf16x8*)(kp + 6656);
}
__device__ __forceinline__ void kload2(bf16x8* kf, lds_cptr kp, int j) { kf[2 * j] = *(const LAS bf16x8*)(kp + j * 2048); kf[2 * j + 1] = *(const LAS bf16x8*)(kp + j * 2048 + 512); }
__device__ __forceinline__ s16x4 vtr(lds_cptr p) { return __builtin_bit_cast(s16x4, __builtin_amdgcn_ds_read_tr16_b64_v4i16((LAS v4i16_t*)p)); }
__device__ __forceinline__ float rowmax(const f32x16& p0, const f32x16& p1) {
    float a = max3f(p0[0], p0[1], p1[0]), b = max3f(p0[2], p0[3], p1[1]); a = max3f(a, p1[2], p1[3]);
#pragma unroll
    for (int r = 4; r < 16; r += 4) { a = max3f(a, p0[r], p0[r + 1]); b = max3f(b, p0[r + 2], p0[r + 3]); a = max3f(a, p1[r], p1[r + 1]); b = max3f(b, p1[r + 2], p1[r + 3]); }
    const float m = max2f(a, b);
    auto rr = __builtin_amdgcn_permlane32_swap(__float_as_uint(m), __float_as_uint(m), false, false);
    return max2f(__uint_as_float(rr[0]), __uint_as_float(rr[1]));
}
__device__ __forceinline__ void pv(f32x16* o, int vb, bf16x8 pa0, bf16x8 pa1, bf16x8 pa2, bf16x8 pa3) {
#pragma unroll
    for (int d0 = 0; d0 < 2; ++d0) { s16x4 lo[4], hi[4];
#pragma unroll
        for (int ks = 0; ks < 4; ++ks) {
            asm volatile("ds_read_b64_tr_b16 %0,%1 offset:%c2" : "=&v"(lo[ks]) : "v"(vb), "i"(d0 * 4096 + ks * 1024) : "memory");
            asm volatile("ds_read_b64_tr_b16 %0,%1 offset:%c2" : "=&v"(hi[ks]) : "v"(vb), "i"(d0 * 4096 + ks * 1024 + 512) : "memory"); }
        asm volatile("s_waitcnt lgkmcnt(0)" ::: "memory"); SBAR();
#define PK(k) (bf16x8){lo[k][0], lo[k][1], lo[k][2], lo[k][3], hi[k][0], hi[k][1], hi[k][2], hi[k][3]}
        o[d0] = __builtin_amdgcn_mfma_f32_32x32x16_bf16(pa0, PK(0), o[d0], 0, 0, 0);
        o[d0] = __builtin_amdgcn_mfma_f32_32x32x16_bf16(pa1, PK(1), o[d0], 0, 0, 0);
        o[d0] = __builtin_amdgcn_mfma_f32_32x32x16_bf16(pa2, PK(2), o[d0], 0, 0, 0);
        o[d0] = __builtin_amdgcn_mfma_f32_32x32x16_bf16(pa3, PK(3), o[d0], 0, 0, 0);
#undef PK
    }
}
__device__ __forceinline__ void wmask(f32x16& p0, f32x16& p1, int dk0, int hi) {
    const float NEG = -INFINITY; const int kb = dk0 + 4 * hi;
#pragma unroll
    for (int r = 0; r < 16; ++r) { const int d = kb + (r & 3) + 8 * (r >> 2); if (d > 128 || d < -128) p0[r] = NEG; if (d + 32 > 128 || d + 32 < -128) p1[r] = NEG; }
}

struct AttnArgs { bf16* P; const float* qg; const float* ropec; const float* ropes; float sink; bool dry; };

template <int MODE, int THRL> __device__ __forceinline__ void attn_unit(int b, int h, int qb, const AttnArgs& aa, char* shm) {
    constexpr bool LAT = (MODE < 2), WIN = (MODE == 1), SINK = (MODE == 1 || MODE == 3);
    constexpr int NT = (MODE == 0) ? 68 : (MODE == 1 ? 12 : 4);
    constexpr int QCOL = (MODE == 0 || MODE == 2) ? C_GQ : C_WQ, KCOL = (MODE == 0 || MODE == 2) ? C_GK : C_WK, VCOL = (MODE == 0 || MODE == 2) ? C_GV : C_WV;
    int tid_ = threadIdx.x; asm volatile("" : "+v"(tid_));
    const int tid = tid_, lane = tid & 63, r32 = lane & 31, hi = lane >> 5; const int wid = __builtin_amdgcn_readfirstlane(tid >> 6);
    const long rowbase = (long)b * TB; const int q0 = qb * QB;
    const long qrow0 = rowbase + (LAT ? NCTX : 0) + q0 + wid * QBLK;
    const int kvh = h >> 2;
    const bf16* Qw = aa.P + qrow0 * DM + QCOL + h * 64;
    const bf16* Kh = aa.P + rowbase * DM + KCOL + kvh * 64, *Vh = aa.P + rowbase * DM + VCOL + kvh * 64;
    const unsigned lds0 = (unsigned)(uintptr_t)shm;
    float* wsf = (float*)(shm + LDS_WS) + wid * 64;
    const bf16* ksrc = Kh + (long)lane * DM + wid * 8;
    const bf16* vsrc = Vh + (long)(16 * (wid & 3) + (lane >> 2)) * DM + (wid >> 2) * 32 + (lane & 3) * 8;
    const unsigned kdst = lds0 + LDS_K + wid * 1024, vdst = lds0 + LDS_V + wid * 1024;
    int kstart = 0; if (WIN) { kstart = q0 - 128; kstart = kstart < 0 ? 0 : kstart; kstart = kstart > SEQ - 512 ? SEQ - 512 : kstart; }
#define TROW(t) (WIN ? (((t) < 4) ? 64 * (t) : NCTX + kstart + 64 * ((t) - 4)) : 64 * (t))
#define DMA_K(t, slot) glds16(ksrc + (long)TROW(t) * DM, (unsigned)__builtin_amdgcn_readfirstlane(kdst + (slot)))
#define DMA_V(t, slot) glds16(vsrc + (long)TROW(t) * DM, (unsigned)__builtin_amdgcn_readfirstlane(vdst + (slot)))
    const int vb0 = (int)(lds0 + LDS_V) + ((lane >> 4) & 1) * 32 + (lane & 3) * 8 + (4 * hi + ((lane & 15) >> 2)) * 64;
    const char* Kbase = shm + LDS_K; bf16x8 kf[8];
    const lds_cptr shm3 = (lds_cptr)shm; const lds_cptr kp0 = shm3 + LDS_K + hi * 1024 + r32 * 16; const lds_cptr vp0 = shm3 + LDS_V + ((lane >> 4) & 1) * 32 + (lane & 3) * 8 + (4 * hi + ((lane & 15) >> 2)) * 64;
    DMA_K(0, 0); DMA_V(0, 0); DMA_K(1, SLOTB);
    bf16x8 qr[4];
    {
        bf16x8 qraw[4];
#pragma unroll
        for (int d0 = 0; d0 < 4; ++d0) qraw[d0] = *reinterpret_cast<const bf16x8*>(&Qw[(long)r32 * DM + d0 * 16 + hi * 8]);
        float qf[4][8]; float ss = 0.f;
#pragma unroll
        for (int d0 = 0; d0 < 4; ++d0)
#pragma unroll
            for (int j = 0; j < 8; ++j) { qf[d0][j] = __uint_as_float(((unsigned)(unsigned short)qraw[d0][j]) << 16); ss += qf[d0][j] * qf[d0][j]; }
        { auto rr = __builtin_amdgcn_permlane32_swap(__float_as_uint(ss), __float_as_uint(ss), false, false); ss = __uint_as_float(rr[0]) + __uint_as_float(rr[1]); }
        const float rinv = 1.0f / sqrtf(ss * (1.0f / 64.0f) + EPS);
#pragma unroll
        for (int d0 = 0; d0 < 4; ++d0) { const f32x4 g0 = *(const f32x4*)(aa.qg + d0 * 16 + hi * 8), g1 = *(const f32x4*)(aa.qg + d0 * 16 + hi * 8 + 4);
#pragma unroll
            for (int j = 0; j < 4; ++j) { qf[d0][j] *= rinv * g0[j]; qf[d0][4 + j] *= rinv * g1[j]; } }
        if (LAT) {
            const int pos = q0 + wid * QBLK + r32;
#pragma unroll
            for (int pr = 0; pr < 2; ++pr) {
                const float* cp = aa.ropec + (size_t)pos * 32 + pr * 16 + hi * 8; const float* sp = aa.ropes + (size_t)pos * 32 + pr * 16 + hi * 8;
                const f32x4 c0 = *(const f32x4*)cp, c1 = *(const f32x4*)(cp + 4), s0 = *(const f32x4*)sp, s1 = *(const f32x4*)(sp + 4);
#pragma unroll
                for (int j = 0; j < 8; ++j) { const float c = j < 4 ? c0[j & 3] : c1[j & 3], s = j < 4 ? s0[j & 3] : s1[j & 3];
                    const float t1 = qf[pr][j], t2 = qf[pr + 2][j]; qf[pr][j] = t1 * c - t2 * s; qf[pr + 2][j] = t2 * c + t1 * s; } }
        }
#pragma unroll
        for (int d0 = 0; d0 < 4; ++d0) { u32x4 w; w.x = cvtpk_s(qf[d0][0] * C2, qf[d0][1] * C2); w.y = cvtpk_s(qf[d0][2] * C2, qf[d0][3] * C2); w.z = cvtpk_s(qf[d0][4] * C2, qf[d0][5] * C2); w.w = cvtpk_s(qf[d0][6] * C2, qf[d0][7] * C2);
            qr[d0] = __builtin_bit_cast(bf16x8, w); }
    }
    float mhat = 0.f, l_reg = 0.f; f32x16 o[2]; o[0] = f32x16{}; o[1] = f32x16{}; f32x16 negm = f32x16{}; asm volatile("" : "+v"(negm));
    const int dkq = kstart - (q0 + wid * QBLK + r32);
#define CMASK(P0, P1, t) do { if (WIN && (t) >= 4) wmask(P0, P1, dkq + 64 * ((t) - 4), hi); } while (0)
    bool resc = false;
#define START(P0, P1) do { const float rm = rowmax(P0, P1); resc = false; \
    { const float dl = rm; mhat = fadd_s(mhat, dl); \
      _Pragma("unroll") for (int r = 0; r < 16; ++r) { P0[r] = fsub_s(P0[r], dl); P1[r] = fsub_s(P1[r], dl); } \
      _Pragma("unroll") for (int r = 0; r < 16; ++r) negm[r] = -mhat; asm volatile("" : "+v"(negm)); } \
    _Pragma("unroll") for (int r = 0; r < 16; ++r) P0[r] = __builtin_amdgcn_exp2f(P0[r]); } while (0)
#define RESC() do { if (resc) { asm volatile("s_waitcnt lgkmcnt(0)" ::: "memory"); \
      _Pragma("unroll") for (int d_ = 0; d_ < 2; ++d_) _Pragma("unroll") for (int r = 0; r < 16; ++r) o[d_][r] *= wsf[crow(r, hi)]; } } while (0)
    f32x16 pA0, pA1, pB0, pB1;
    int sl_prev = 0, sl_cur = 0, sl_next = SLOTB;
#define ROT() do { sl_prev = sl_cur; sl_cur = sl_next; sl_next = (sl_next == (NSLOT - 1) * SLOTB) ? 0 : sl_next + SLOTB; } while (0)
    DMA_K(2, 2 * SLOTB);
    WAIT_BAR(3);
    qkt(pA0, pA1, Kbase, qr, negm, r32, hi); asm volatile("s_nop 15\n\ts_nop 7" : "+v"(pA0), "+v"(pA1)); CMASK(pA0, pA1, 0);
    START(pA0, pA1);
    _Pragma("unroll") for (int r = 0; r < 16; ++r) pA1[r] = __builtin_amdgcn_exp2f(pA1[r]);
    WAIT_BAR(0);
    DMA_K(3, 0); DMA_V(1, SLOTB);
    ROT();
    kload8(kf, kp0 + sl_cur);
    WAIT_BAR(2);
    s16x4 vlo[8], vhi[8]; u32x4 pw0, pw1, pw2, pw3;
#define PKW(P, B) cvtpk_s(P[B], P[B + 1])
#define PAF(k) __builtin_bit_cast(bf16x8, pw##k)
#define VFR(i) (bf16x8){vlo[i][0], vlo[i][1], vlo[i][2], vlo[i][3], vhi[i][0], vhi[i][1], vhi[i][2], vhi[i][3]}
#define PIN(x) asm volatile("" : "+v"(x))
#define MX3(a, b, c) __builtin_fmaxf(__builtin_fmaxf((a), (b)), (c))
#define GAPA(MF, A0, A1, A2, A3, W0, W1, PW) do { MF; sacc += A0; sacc += A1; sacc += A2; sacc += A3; PIN(sacc); W0; W1; PIN(PW); SBAR(); } while (0)
#define EX(v) __builtin_amdgcn_exp2f(v)
#define GAPB(MF, X, B) do { MF; X[B] = EX(X[B]); X[B + 1] = EX(X[B + 1]); X[B + 2] = EX(X[B + 2]); X[B + 3] = EX(X[B + 3]); PIN(X); SBAR(); } while (0)
#define VRD(i) do { vlo[i] = vtr(vp_ + (((i) >> 2) * 4096 + ((i) & 3) * 1024)); vhi[i] = vtr(vp_ + (((i) >> 2) * 4096 + ((i) & 3) * 1024 + 512)); } while (0)
#define KRD(G, j) do { if (G) { kload2(kf, kp0 + sl_next, j); SBAR(); } } while (0)
#define STEP(C0, C1, P0, P1, t, GK, GV, GL) do { SBAR(); \
    const lds_cptr vp_ = vp0 + sl_prev; \
    VRD(0); SBAR(); float sacc = (P0[0] + P0[1]); \
    GAPA(C0 = __builtin_amdgcn_mfma_f32_32x32x16_bf16(kf[0], qr[0], negm, 0, 0, 0), P0[2], P0[3], P0[4], P0[5],     pw0[0] = PKW(P0, 0), pw0[1] = PKW(P0, 2), pw0); \
    VRD(4); SBAR(); GAPA(C1 = __builtin_amdgcn_mfma_f32_32x32x16_bf16(kf[1], qr[0], negm, 0, 0, 0), P0[6], P0[7], P0[8], P0[9],     pw0[2] = PKW(P0, 4), pw0[3] = PKW(P0, 6), pw0); \
    VRD(1); SBAR(); GAPA(C0 = __builtin_amdgcn_mfma_f32_32x32x16_bf16(kf[2], qr[1], C0, 0, 0, 0),   P0[10], P0[11], P0[12], P0[13], pw1[0] = PKW(P0, 8), pw1[1] = PKW(P0, 10), pw1); \
    VRD(5); SBAR(); GAPA(C1 = __builtin_amdgcn_mfma_f32_32x32x16_bf16(kf[3], qr[1], C1, 0, 0, 0),   P0[14], P0[15], P1[0], P1[1],   pw1[2] = PKW(P0, 12), pw1[3] = PKW(P0, 14), pw1); \
    VRD(2); SBAR(); GAPA(C0 = __builtin_amdgcn_mfma_f32_32x32x16_bf16(kf[4], qr[2], C0, 0, 0, 0),   P1[2], P1[3], P1[4], P1[5],     pw2[0] = PKW(P1, 0), pw2[1] = PKW(P1, 2), pw2); \
    VRD(6); SBAR(); GAPA(C1 = __builtin_amdgcn_mfma_f32_32x32x16_bf16(kf[5], qr[2], C1, 0, 0, 0),   P1[6], P1[7], P1[8], P1[9],     pw2[2] = PKW(P1, 4), pw2[3] = PKW(P1, 6), pw2); \
    VRD(3); SBAR(); GAPA(C0 = __builtin_amdgcn_mfma_f32_32x32x16_bf16(kf[6], qr[3], C0, 0, 0, 0),   P1[10], P1[11], P1[12], P1[13], pw3[0] = PKW(P1, 8), pw3[1] = PKW(P1, 10), pw3); \
    VRD(7); SBAR(); GAPA(C1 = __builtin_amdgcn_mfma_f32_32x32x16_bf16(kf[7], qr[3], C1, 0, 0, 0),   P1[14], P1[15], 0.f, 0.f,       pw3[2] = PKW(P1, 12), pw3[3] = PKW(P1, 14), pw3); \
    l_reg += sacc; \
    if (GK) { DMA_K((t) + 3, sl_cur); } if (GV) { DMA_V((t) + 1, sl_next); } \
    CMASK(C0, C1, t); \
    { float a = MX3(C0[0], C0[1], C1[0]), b = MX3(C0[2], C0[3], C1[1]); a = MX3(a, C1[2], C1[3]); \
      _Pragma("unroll") for (int r = 4; r < 16; r += 4) { a = MX3(a, C0[r], C0[r + 1]); b = MX3(b, C0[r + 2], C0[r + 3]); a = MX3(a, C1[r], C1[r + 1]); b = MX3(b, C1[r + 2], C1[r + 3]); } \
      float rm = __builtin_fmaxf(a, b); { auto rr = __builtin_amdgcn_permlane32_swap(__float_as_uint(rm), __float_as_uint(rm), false, false); rm = __builtin_fmaxf(__uint_as_float(rr[0]), __uint_as_float(rr[1])); } \
      resc = false; \
      if (__builtin_expect(__any(rm > (float)THRL), 0)) { const float dl = __builtin_fmaxf(rm, 0.f); mhat += dl; \
        _Pragma("unroll") for (int r = 0; r < 16; ++r) { C0[r] -= dl; C1[r] -= dl; } \
        _Pragma("unroll") for (int r = 0; r < 16; ++r) negm[r] = -mhat; asm volatile("" : "+v"(negm)); \
        const float f = __builtin_amdgcn_exp2f(-dl); l_reg *= f; if (hi == 0) wsf[r32] = f; resc = true; } } \
    SBAR(); \
    GAPB(o[0] = __builtin_amdgcn_mfma_f32_32x32x16_bf16(PAF(0), VFR(0), o[0], 0, 0, 0), C0, 0); \
    GAPB(o[1] = __builtin_amdgcn_mfma_f32_32x32x16_bf16(PAF(0), VFR(4), o[1], 0, 0, 0), C0, 4); \
    KRD(GL, 0); GAPB(o[0] = __builtin_amdgcn_mfma_f32_32x32x16_bf16(PAF(1), VFR(1), o[0], 0, 0, 0), C0, 8); \
    KRD(GL, 1); GAPB(o[1] = __builtin_amdgcn_mfma_f32_32x32x16_bf16(PAF(1), VFR(5), o[1], 0, 0, 0), C0, 12); \
    KRD(GL, 2); GAPB(o[0] = __builtin_amdgcn_mfma_f32_32x32x16_bf16(PAF(2), VFR(2), o[0], 0, 0, 0), C1, 0); \
    KRD(GL, 3); GAPB(o[1] = __builtin_amdgcn_mfma_f32_32x32x16_bf16(PAF(2), VFR(6), o[1], 0, 0, 0), C1, 4); \
    GAPB(o[0] = __builtin_amdgcn_mfma_f32_32x32x16_bf16(PAF(3), VFR(3), o[0], 0, 0, 0), C1, 8); \
    GAPB(o[1] = __builtin_amdgcn_mfma_f32_32x32x16_bf16(PAF(3), VFR(7), o[1], 0, 0, 0), C1, 12); \
    } while (0)
    int t = 1;
    for (; t + 5 < NT; t += 2) {
        STEP(pB0, pB1, pA0, pA1, t, true, true, true);     WAIT_BAR(2); RESC(); ROT();
        STEP(pA0, pA1, pB0, pB1, t + 1, true, true, true); WAIT_BAR(2); RESC(); ROT();
    }
#define ENDW(tt) do { if ((tt) + 3 < NT) { WAIT_BAR(2); } else if ((tt) + 2 < NT) { WAIT_BAR(1); } else { WAIT_BAR(0); } } while (0)
    for (; t + 1 < NT; t += 2) {
        STEP(pB0, pB1, pA0, pA1, t, (t + 3 < NT), (t + 1 < NT), (t + 1 < NT));         ENDW(t);     RESC(); ROT();
        STEP(pA0, pA1, pB0, pB1, t + 1, (t + 4 < NT), (t + 2 < NT), (t + 2 < NT));     ENDW(t + 1); RESC(); ROT();
    }
    STEP(pB0, pB1, pA0, pA1, NT - 1, false, false, false); RESC();
    { float sacc = pB0[0] + pB0[1]; _Pragma("unroll") for (int r = 2; r < 16; ++r) sacc += pB0[r]; _Pragma("unroll") for (int r = 0; r < 16; ++r) sacc += pB1[r]; l_reg += sacc;
      pw0 = (u32x4){PKW(pB0, 0), PKW(pB0, 2), PKW(pB0, 4), PKW(pB0, 6)}; pw1 = (u32x4){PKW(pB0, 8), PKW(pB0, 10), PKW(pB0, 12), PKW(pB0, 14)}; pw2 = (u32x4){PKW(pB1, 0), PKW(pB1, 2), PKW(pB1, 4), PKW(pB1, 6)}; pw3 = (u32x4){PKW(pB1, 8), PKW(pB1, 10), PKW(pB1, 12), PKW(pB1, 14)};
      SBAR(); pv(o, vb0 + sl_cur, PAF(0), PAF(1), PAF(2), PAF(3)); }
#undef PKW
#undef PAF
#undef VFR
#undef PIN
#undef MX3
#undef GAPA
#undef GAPB
#undef EX
#undef VRD
#undef KRD
#undef STEP
#undef ENDW
    { auto rr = __builtin_amdgcn_permlane32_swap(__float_as_uint(l_reg), __float_as_uint(l_reg), false, false); l_reg = __uint_as_float(rr[0]) + __uint_as_float(rr[1]); }
    if (SINK) l_reg += __builtin_amdgcn_exp2f(aa.sink * LOG2E - mhat);
    if (hi == 0) wsf[32 + r32] = l_reg; asm volatile("s_waitcnt lgkmcnt(0)" ::: "memory");
    float rli[16];
#pragma unroll
    for (int r = 0; r < 16; ++r) rli[r] = __builtin_amdgcn_rcpf(wsf[32 + crow(r, hi)]);
    bf16* Ow = aa.P + qrow0 * DM + QCOL + h * 64;
    { bf16* stg = (bf16*)(shm + LDS_OST) + wid * 2048;
#pragma unroll
      for (int r = 0; r < 16; ++r) { const int orow = crow(r, hi);
#pragma unroll
          for (int d0 = 0; d0 < 2; ++d0) stg[orow * 64 + d0 * 32 + r32] = __float2bfloat16(o[d0][r] * rli[r]); }
      asm volatile("s_waitcnt lgkmcnt(0)" ::: "memory");
#pragma unroll
      for (int i = 0; i < 4; ++i) { const int row = i * 8 + (lane >> 3), ch = lane & 7; const u32x4 v = *(const u32x4*)(stg + row * 64 + ch * 8); if (!aa.dry) *(u32x4*)(Ow + (long)row * DM + ch * 8) = v; } }
    asm volatile("s_waitcnt lgkmcnt(0)\n\ts_barrier" ::: "memory");
#undef DMA_K
#undef DMA_V
#undef TROW
#undef CMASK
#undef START
#undef RESC
#undef ROT
}
#undef SBAR
#undef WAIT_BAR
}
constexpr size_t MiB = 1u << 20;
constexpr size_t WS_CTL = 0, CTL_ZERO_BYTES = 1 * MiB;
constexpr size_t WS_MOD = 1 * MiB;
constexpr size_t WS_ROPE = 2 * MiB;
constexpr size_t WS_ROUTE = 3 * MiB;
constexpr size_t WS_WIN = 6 * MiB;
constexpr size_t WS_WBR = 28 * MiB;
constexpr size_t WS_WOUT = 34 * MiB;
constexpr size_t WS_XC = 38 * MiB;
constexpr size_t WS_A = 54 * MiB;
constexpr size_t WS_PROJ = 190 * MiB;
constexpr size_t WS_YBUF = WS_PROJ;
constexpr size_t WS_HG = WS_PROJ + 420 * MiB;
constexpr size_t WS_H8 = WS_A;
constexpr size_t WS_YP = WS_PROJ;
constexpr size_t WS_HID = WS_PROJ + 280 * MiB;
constexpr size_t WS_W13 = WS_PROJ + 560 * MiB;
constexpr size_t WS_W2 = WS_PROJ + 624 * MiB;
constexpr size_t WS_HIN8 = WS_PROJ + 748 * MiB;
constexpr size_t WS_WIN8 = WS_HIN8 + 68 * MiB;
constexpr size_t WS_END = WS_WIN8 + 11 * MiB;
constexpr int PSPLIT = 4;
static_assert((size_t)T * NIN * 2 == 748 * MiB && (size_t)T * D * 2 == 136 * MiB && (size_t)PMAX * D * 2 == 280 * MiB, "buffer sizes");
static_assert(WS_END <= 1024 * MiB, "workspace map fits 1 GiB");
constexpr int CW_CNT = 64;
constexpr int CW_BAR = 4096;

constexpr int RING_OFF = 0, RING_BYTES = 131072;
constexpr int LDSCTL_OFF = RING_BYTES, MISC_OFF = LDSCTL_OFF + 320;
constexpr int LDS_BYTES = 147456;
constexpr int NWAVES = 8;

typedef GAS unsigned gu32;
#define RLX_AGENT __ATOMIC_RELAXED, __HIP_MEMORY_SCOPE_AGENT
#define LDS_WAIT() asm volatile("s_waitcnt lgkmcnt(0)" ::: "memory")
#define VM_WAIT() asm volatile("s_waitcnt vmcnt(0)" ::: "memory")

#define XB_TMO      128
#define XB_XCNT(j)  (256  + 64 * (j))
#define XB_XSUB(j)  (1280 + 64 * (j))
#define XB_XGEN(j)  (2304 + 64 * (j))
#define XB_TOP      3328
#define XB_TOPGEN   3392
#define XCD_BAR_WORDS 3456
#define XB_SPIN_CAP (1u << 18)
__device__ __forceinline__ unsigned xb_ld(unsigned* p)              { return __hip_atomic_load(p, __ATOMIC_RELAXED, __HIP_MEMORY_SCOPE_AGENT); }
__device__ __forceinline__ unsigned xb_add(unsigned* p, unsigned v) { return __hip_atomic_fetch_add(p, v, __ATOMIC_RELAXED, __HIP_MEMORY_SCOPE_AGENT); }
__device__ __forceinline__ unsigned xb_xcc_id() { return (unsigned)__builtin_amdgcn_s_getreg((3 << 11) | 20) & 0xFu; }
#define XB_SPIN(cond, bar) do { unsigned _sp = 0; while (cond) { __builtin_amdgcn_s_sleep(1); \
    if ((++_sp & 255u) == 0u) { if (xb_ld(&(bar)[XB_TMO])) break; if (_sp > XB_SPIN_CAP) { atomicAdd(&(bar)[XB_TMO], 1u); break; } } } } while (0)
struct XcdBarrier { unsigned* bar; unsigned x; volatile LAS unsigned* st; };
__device__ __forceinline__ XcdBarrier xcd_barrier_post(unsigned* bar, volatile LAS unsigned* st) {
    XcdBarrier b; b.bar = bar; b.x = xb_xcc_id(); b.st = st;
    if (threadIdx.x == 0) (void)xb_add(&bar[XB_XCNT(b.x)], 1u);
    return b;
}
__device__ __forceinline__ void xcd_barrier_complete(unsigned* bar, unsigned x, unsigned& nloc, unsigned& nx) {
    const unsigned G = gridDim.x * gridDim.y * gridDim.z;
    unsigned sum, cnt, mine, sp = 0u;
    for (;;) {
        sum = 0u; cnt = 0u; mine = 0u;
#pragma unroll
        for (unsigned j = 0; j < 16; ++j) { const unsigned c = xb_ld(&bar[XB_XCNT(j)]); sum += c; cnt += (c > 0u) ? 1u : 0u; mine = (j == x) ? c : mine; }
        if (sum == G) break;
        __builtin_amdgcn_s_sleep(1);
        if ((++sp & 255u) == 0u) { if (xb_ld(&bar[XB_TMO])) break; if (sp > XB_SPIN_CAP) { atomicAdd(&bar[XB_TMO], 1u); break; } }
    }
    nloc = mine > 0u ? mine : 1u; nx = cnt > 0u ? cnt : 1u;
}
__device__ __forceinline__ void xcd_barrier(const XcdBarrier& b) {
    asm volatile("s_waitcnt vmcnt(0)" ::: "memory");
    __syncthreads();
    if (threadIdx.x == 0) {
        unsigned* bar = b.bar;
        __builtin_amdgcn_s_waitcnt(0);
        unsigned nloc = b.st[0], nx = b.st[1];
        if (nloc == 0u) { xcd_barrier_complete(bar, b.x, nloc, nx); b.st[0] = nloc; b.st[1] = nx; }
        const unsigned old = xb_add(&bar[XB_XSUB(b.x)], 1u);
        const unsigned gen = old / nloc;
        if (old + 1u == (gen + 1u) * nloc) {
            __builtin_amdgcn_fence(__ATOMIC_RELEASE, "agent");
            asm volatile("s_waitcnt vmcnt(0)" ::: "memory");
            const unsigned og = xb_add(&bar[XB_TOP], 1u);
            const unsigned tg = og / nx;
            if (og + 1u == (tg + 1u) * nx) xb_add(&bar[XB_TOPGEN], 1u);
            else XB_SPIN(xb_ld(&bar[XB_TOPGEN]) == tg, bar);
            __builtin_amdgcn_fence(__ATOMIC_ACQUIRE, "agent");
            xb_add(&bar[XB_XGEN(b.x)], 1u);
            asm volatile("s_waitcnt vmcnt(0)" ::: "memory");
        } else {
            XB_SPIN(xb_ld(&bar[XB_XGEN(b.x)]) == gen, bar);
            __builtin_amdgcn_fence(__ATOMIC_ACQUIRE, "agent");
            asm volatile("s_waitcnt vmcnt(0)" ::: "memory");
        }
    }
    __syncthreads();
}

struct Args { const float* in[27]; float* out; unsigned char* ws; };
struct KArgs { const GAS float* in[27]; GAS float* out; GAS unsigned char* ws; };
typedef const __attribute__((address_space(4))) KArgs* kargs_p;
__device__ __forceinline__ kargs_p kargs() { kargs_p p = (kargs_p)__builtin_amdgcn_kernarg_segment_ptr(); asm volatile("" : "+s"(p)); return p; }
struct Frame {
    LAS unsigned char* lds;
    int tid, lane, wave, vcu, G, gw, NGW, bid;
#define KIN(name, idx) __device__ __forceinline__ const float* name() const { return (const float*)kargs()->in[idx]; }
    KIN(x, 0) KIN(c, 1) KIN(ctx, 2) KIN(c_ctx, 3) KIN(w_mod, 4) KIN(b_mod, 5) KIN(norm1_g, 6) KIN(norm2_g, 7) KIN(w_in, 8) KIN(b_merge, 9) KIN(conv_w, 10) KIN(conv_b, 11)
    KIN(lru_wa, 12) KIN(lru_ba, 13) KIN(lru_wx, 14) KIN(lru_bx, 15) KIN(lru_lambda, 16) KIN(q_norm_g, 17) KIN(k_norm_g, 18) KIN(sink, 19) KIN(w_branch, 20) KIN(w_out, 21)
    KIN(router_w, 22) KIN(router_b, 23) KIN(ew1, 24) KIN(ew3, 25) KIN(ew2, 26)
#undef KIN
    __device__ __forceinline__ float* out() const { return (float*)kargs()->out; }
    __device__ __forceinline__ unsigned char* ws() const { return (unsigned char*)kargs()->ws; }
    __device__ __forceinline__ gu32* ctl() const { return (gu32*)(ws() + WS_CTL); }
#define KWS(type, name, off) __device__ __forceinline__ type* name() const { return (type*)(ws() + (off)); }
    KWS(float, MOD, WS_MOD) KWS(float, ROPEC, WS_ROPE) KWS(float, ROPES, WS_ROPE + (size_t)SEQ * 32 * 4) KWS(float, XC, WS_XC) KWS(float, HT, WS_A) KWS(unsigned, ROUTE, WS_ROUTE)
    KWS(bf16_t, WIN, WS_WIN) KWS(bf16_t, WBR, WS_WBR) KWS(bf16_t, WOUT, WS_WOUT) KWS(bf16_t, A, WS_A) KWS(bf16_t, PROJ, WS_PROJ) KWS(bf16_t, YBUF, WS_YBUF) KWS(unsigned char, HG, WS_HG)
    KWS(bf16_t, YP, WS_YP) KWS(unsigned char, HID, WS_HID) KWS(unsigned char, W13, WS_W13) KWS(unsigned char, W2, WS_W2) KWS(unsigned char, H8, WS_H8) KWS(unsigned char, HIN8, WS_HIN8) KWS(unsigned char, WIN8, WS_WIN8)
#undef KWS
};
__device__ __forceinline__ Frame fresh(const Frame& F0) { Frame F = F0;
    asm volatile("" : "+s"(F.wave), "+s"(F.vcu), "+s"(F.G), "+s"(F.gw), "+s"(F.NGW), "+s"(F.bid), "+v"(F.tid), "+v"(F.lane)); return F; }
__device__ __forceinline__ float wave_sum(float v) {
#pragma unroll
    for (int o = 1; o < 64; o <<= 1) v += __shfl_xor(v, o);
    return v;
}
__device__ __forceinline__ const float* modp(const float* MODb, int l, int sel, int chunk) { return MODb + ((size_t)(l * 17 + sel) * 6 + chunk) * D; }

constexpr float WSCALE = 64.0f;
struct CvtTile { const float* W; void* WT; int N, k0, n0, Kd, drow0, fp8; };
__device__ __forceinline__ void cvt_load(const CvtTile& t, int tid, f32x4 (&r)[8]) {
#pragma unroll
    for (int i = 0; i < 8; ++i) r[i] = *(const GAS f32x4*)(t.W + (size_t)(t.k0 + 16 * i + (tid >> 5)) * t.N + t.n0 + 4 * (tid & 31));
}
__device__ __forceinline__ void cvt_to_lds(LAS float* Tl, int tid, const f32x4 (&r)[8]) {
#pragma unroll
    for (int i = 0; i < 8; ++i) { LAS float* p = Tl + (16 * i + (tid >> 5)) * 129 + 4 * (tid & 31); p[0] = r[i][0]; p[1] = r[i][1]; p[2] = r[i][2]; p[3] = r[i][3]; }
}
__device__ __forceinline__ void cvt_emit(const CvtTile& t, LAS float* Tl, int tid) {
#pragma unroll
    for (int p = 0; p < 4; ++p) { const int idx = tid + 512 * p, n = idx >> 4, kg = idx & 15; const LAS float* s = Tl + (8 * kg) * 129 + n; float v[8];
#pragma unroll
        for (int j = 0; j < 8; ++j) v[j] = s[j * 129];
        if (t.fp8) { u32x2 o; o.x = pk4_fp8(v[0] * WSCALE, v[1] * WSCALE, v[2] * WSCALE, v[3] * WSCALE); o.y = pk4_fp8(v[4] * WSCALE, v[5] * WSCALE, v[6] * WSCALE, v[7] * WSCALE);
            *(GAS u32x2*)((unsigned char*)t.WT + (size_t)(t.drow0 + n) * t.Kd + t.k0 + 8 * kg) = o; }
        else { u32x4 o; o.x = cvt_pk_bf16(v[0], v[1]); o.y = cvt_pk_bf16(v[2], v[3]); o.z = cvt_pk_bf16(v[4], v[5]); o.w = cvt_pk_bf16(v[6], v[7]);
            *(GAS u32x4*)((bf16_t*)t.WT + (size_t)(t.drow0 + n) * t.Kd + t.k0 + 8 * kg) = o; } }
}
template <class Get> __device__ __forceinline__ void cvt_run(const Frame& F, int first, int step, int count, const Get& get) {
    LAS float* Tl = (LAS float*)(F.lds + RING_OFF);
    if (first >= count) return;
    f32x4 r[8]; CvtTile cur = get(first); cvt_load(cur, F.tid, r);
    for (int it = first; it < count; it += step) {
        cvt_to_lds(Tl, F.tid, r);
        CvtTile nxt = cur; const bool more = it + step < count;
        if (more) { nxt = get(it + step); cvt_load(nxt, F.tid, r); }
        __syncthreads();
        cvt_emit(cur, Tl, F.tid);
        __syncthreads();
        cur = nxt;
    }
}
struct GetSmall {
    const float* win; const float* wbr; const float* wout; bf16_t* WINb; unsigned char* WIN8b; bf16_t* WBRb; bf16_t* WOUTb;
    static constexpr int T_IN = (D / 128) * (NIN / 128), T_BR = (512 / 128) * (D / 128), T_OUT = (D / 128) * (D / 128), T_L = T_IN + 3 * T_BR + T_OUT;
    __device__ __forceinline__ CvtTile operator()(int it) const { CvtTile t; const int l = it / T_L; int r = it - l * T_L;
        if (r < T_IN) { const int nb = NIN / 128, kb = r / nb, n0 = 128 * (r % nb); const bool f8 = n0 >= 256 * PSPLIT;
            t.W = win + (size_t)l * D * NIN; t.N = NIN; t.k0 = 128 * kb; t.n0 = n0; t.WT = f8 ? (void*)(WIN8b + (size_t)l * NIN * D) : (void*)(WINb + (size_t)l * NIN * D); t.Kd = D; t.drow0 = n0; t.fp8 = f8; return t; }
        r -= T_IN;
        if (r < 3 * T_BR) { const int b = r / T_BR; r -= b * T_BR; const int nb = D / 128, kb = r / nb, n0 = 128 * (r % nb);
            t.W = wbr + (size_t)(l * 3 + b) * 512 * D; t.N = D; t.k0 = 128 * kb; t.n0 = n0; t.WT = (void*)(WBRb + (size_t)(l * 3 + b) * D * 512); t.Kd = 512; t.drow0 = n0; t.fp8 = false; return t; }
        r -= 3 * T_BR;
        const int nb = D / 128, kb = r / nb, n0 = 128 * (r % nb);
        t.W = wout + (size_t)l * D * D; t.N = D; t.k0 = 128 * kb; t.n0 = n0; t.WT = (void*)(WOUTb + (size_t)l * D * D); t.Kd = D; t.drow0 = n0; t.fp8 = false; return t; }
};
struct GetExperts {
    const float* e1; const float* e3; const float* e2; unsigned char* W13b; unsigned char* W2b; int l;
    static constexpr int T_M = (D / 128) * (D / 128);
    __device__ __forceinline__ CvtTile operator()(int it) const { CvtTile t; const int e = it / (3 * T_M); int r = it - e * 3 * T_M; const int which = r / T_M; r -= which * T_M;
        const int kb = r / (D / 128), n0 = 128 * (r % (D / 128)); const size_t eoff = (size_t)(l * NE + e) * D * D;
        t.N = D; t.k0 = 128 * kb; t.n0 = n0; t.Kd = D; t.fp8 = true;
        if (which == 0) { t.W = e1 + eoff; t.WT = (void*)(W13b + (size_t)e * 2048 * D); t.drow0 = 2 * n0; }
        else if (which == 1) { t.W = e3 + eoff; t.WT = (void*)(W13b + (size_t)e * 2048 * D); t.drow0 = 2 * n0 + 128; }
        else { t.W = e2 + eoff; t.WT = (void*)(W2b + (size_t)e * D * D); t.drow0 = n0; }
        return t; }
};
__device__ __forceinline__ void p0_prologue(Frame& F) {
    { GetSmall get{F.w_in(), F.w_branch(), F.w_out(), F.WIN(), F.WIN8(), F.WBR(), F.WOUT()}; cvt_run(F, (int)blockIdx.x, F.G, NL * GetSmall::T_L, get); }
    float* RC = F.ROPEC(); float* RS = F.ROPES();
    for (int i = blockIdx.x * (NWAVES * 64) + F.tid; i < SEQ * 32; i += F.G * NWAVES * 64) {
        const int pos = i >> 5, f = i & 31; const float inv = exp2f(-(float)(f & 15) * (13.287712379549449f / 16.0f));
        const float ang = (float)(f < 16 ? (pos >> 6) : (pos & 63)) * inv;
        const float rev = ang * 0.15915494309189535f; RC[i] = __builtin_amdgcn_cosf(rev); RS[i] = __builtin_amdgcn_sinf(rev);
    }
    __syncthreads();
    {
        LAS float* sc = (LAS float*)(F.lds + RING_OFF);
        LAS float* part = (LAS float*)(F.lds + RING_OFF + 17 * 1024 * 4);
        bool have_sc = false;
        for (int it = blockIdx.x; it < NL * 96; it += F.G) {
            if (!have_sc) { for (int i = F.tid; i < 17 * 1024; i += NWAVES * 64) { const int s = i >> 10, k = i & 1023; const float v = s < 16 ? F.c()[s * D + k] : F.c_ctx()[k]; sc[i] = v * fast_sigmoid(v); }
                have_sc = true; __syncthreads(); }
            const int l = it / 96, cg = it % 96, col = cg * 64 + F.lane;
            const float* wp = F.w_mod() + (size_t)l * D * 6 * D + col;
            float acc[17];
#pragma unroll
            for (int s = 0; s < 17; ++s) acc[s] = 0.f;
            const int kbeg = F.wave * 128;
#pragma unroll 4
            for (int k = kbeg; k < kbeg + 128; ++k) { const float w = wp[(size_t)k * 6 * D];
#pragma unroll
                for (int s = 0; s < 17; ++s) acc[s] += sc[s * 1024 + k] * w; }
#pragma unroll
            for (int s = 0; s < 17; ++s) part[(F.wave * 17 + s) * 64 + F.lane] = acc[s];
            __syncthreads();
            for (int i = F.tid; i < 17 * 64; i += NWAVES * 64) { const int s = i >> 6, cl = i & 63; float v = F.b_mod()[l * 6 * D + cg * 64 + cl];
#pragma unroll
                for (int w = 0; w < 8; ++w) v += part[(w * 17 + s) * 64 + cl];
                F.MOD()[(size_t)(l * 17 + s) * 6 * D + cg * 64 + cl] = v; }
            __syncthreads();
        }
    }
}

__device__ __forceinline__ void convert_experts(Frame& F, int l) {
    GetExperts get{F.ew1(), F.ew3(), F.ew2(), F.W13(), F.W2(), l}; cvt_run(F, (int)blockIdx.x, F.G, NE * 3 * GetExperts::T_M, get);
}

__device__ __forceinline__ void ld_row_f32(const float* p, int lane, f32x4 (&v)[4]) {
#pragma unroll
    for (int j = 0; j < 4; ++j) v[j] = *((const GAS f32x4*)p + lane + 64 * j);
}
__device__ __forceinline__ void st_row_f32(float* p, int lane, const f32x4 (&v)[4]) {
#pragma unroll
    for (int j = 0; j < 4; ++j) *((GAS f32x4*)p + lane + 64 * j) = v[j];
}
__device__ __forceinline__ void ld_row_bf16(const bf16_t* p, int lane, f32x4 (&v)[4]) {
#pragma unroll
    for (int j = 0; j < 4; ++j) { const u32x2 w = *((const GAS u32x2*)p + lane + 64 * j); v[j] = (f32x4){bf_lo(w.x), bf_hi(w.x), bf_lo(w.y), bf_hi(w.y)}; }
}
__device__ __forceinline__ void st_row_bf16(bf16_t* p, int lane, const f32x4 (&v)[4]) {
#pragma unroll
    for (int j = 0; j < 4; ++j) { u32x2 w; w.x = cvt_pk_bf16(v[j][0], v[j][1]); w.y = cvt_pk_bf16(v[j][2], v[j][3]); *((GAS u32x2*)p + lane + 64 * j) = w; }
}
__device__ __forceinline__ void st_row_fp8(unsigned char* p, int lane, const f32x4 (&v)[4]) {
#pragma unroll
    for (int j = 0; j < 4; ++j) *((GAS unsigned*)p + lane + 64 * j) = pk4_fp8(v[j][0], v[j][1], v[j][2], v[j][3]);
}
__device__ __forceinline__ void norm_mod(const f32x4 (&v)[4], const float* g, const float* shift, const float* scale, int lane, f32x4 (&h)[4]) {
    float ss = 0.f;
#pragma unroll
    for (int j = 0; j < 4; ++j) ss += (v[j][0] * v[j][0] + v[j][1] * v[j][1]) + (v[j][2] * v[j][2] + v[j][3] * v[j][3]);
    const float rinv = 1.0f / sqrtf(wave_sum(ss) * (1.0f / D) + EPS);
#pragma unroll
    for (int j = 0; j < 4; ++j) { const f32x4 gg = *((const GAS f32x4*)g + lane + 64 * j), sh = *((const GAS f32x4*)shift + lane + 64 * j), sc = *((const GAS f32x4*)scale + lane + 64 * j);
        h[j] = (v[j] * rinv) * gg * (sc + 1.0f) + sh; }
}

struct RowRange { int lo, hi; };
__device__ __forceinline__ RowRange wave_rows(const Frame& F, int n) { const int per = (n + F.NGW - 1) / F.NGW; RowRange r; r.lo = F.gw * per; r.hi = r.lo + per; if (r.hi > n) r.hi = n; if (r.lo > n) r.lo = n; return r; }
__device__ __forceinline__ void row_decode(int idx, bool all, int& b, int& p) { if (all) { b = idx / TB; p = idx - b * TB; } else { b = idx / SEQ; p = NCTX + idx - b * SEQ; } }
__device__ __forceinline__ void ld_vec(const float* p, int lane, f32x4 (&v)[4]) {
#pragma unroll
    for (int j = 0; j < 4; ++j) v[j] = *((const GAS f32x4*)p + lane + 64 * j);
}
__device__ __forceinline__ float row_rinv(const f32x4 (&v)[4]) {
    float ss = 0.f;
#pragma unroll
    for (int j = 0; j < 4; ++j) ss += (v[j][0] * v[j][0] + v[j][1] * v[j][1]) + (v[j][2] * v[j][2] + v[j][3] * v[j][3]);
    return 1.0f / sqrtf(wave_sum(ss) * (1.0f / D) + EPS);
}
__device__ __forceinline__ void r1_phase(Frame& F) {
    const float* MODb = F.MOD(); const float* xin = F.x(); const float* cin = F.ctx(); const float* g1n = F.norm1_g(); bf16_t* Ab = F.A(); unsigned char* H8i = F.HIN8();
    const RowRange rr = wave_rows(F, T);
    int cursel = -1; f32x4 gm[4], sh[4], vn[4];
#define R1_SRC(idx_) ({ int b_, p_; row_decode((idx_), true, b_, p_); (p_ < NCTX) ? cin + (size_t)(b_ * NCTX + p_) * D : xin + (size_t)(b_ * SEQ + p_ - NCTX) * D; })
    if (rr.lo < rr.hi) ld_row_f32(R1_SRC(rr.lo), F.lane, vn);
    for (int idx = rr.lo; idx < rr.hi; ++idx) {
        int b, p; row_decode(idx, true, b, p); const int sel = p < NCTX ? 16 : b;
        f32x4 v[4];
#pragma unroll
        for (int j = 0; j < 4; ++j) v[j] = vn[j];
        if (idx + 1 < rr.hi) ld_row_f32(R1_SRC(idx + 1), F.lane, vn);
        if (sel != cursel) { cursel = sel; f32x4 g[4], sc[4]; ld_vec(g1n, F.lane, g); ld_vec(modp(MODb, 0, sel, 1), F.lane, sc); ld_vec(modp(MODb, 0, sel, 0), F.lane, sh);
#pragma unroll
            for (int j = 0; j < 4; ++j) gm[j] = g[j] * (sc[j] + 1.0f); }
        const float rinv = row_rinv(v); f32x4 h[4];
#pragma unroll
        for (int j = 0; j < 4; ++j) h[j] = (v[j] * rinv) * gm[j] + sh[j];
        if (PSPLIT > 0) st_row_bf16(Ab + (size_t)idx * D, F.lane, h);
        st_row_fp8(H8i + (size_t)idx * D, F.lane, h);
    }
#undef R1_SRC
}

__device__ __forceinline__ void kfix_phase(Frame& F, int l, bool dry = false) {
    const int hs = F.lane >> 4, j4 = F.lane & 15, br = hs >> 1;
    const int col = (br ? C_WK : C_GK) + (hs & 1) * 64 + 2 * j4;
    const float* kg = F.k_norm_g() + (size_t)(l * 2 + br) * 64;
    const float g0 = kg[2 * j4], g1 = kg[2 * j4 + 1], g2 = kg[32 + 2 * j4], g3 = kg[32 + 2 * j4 + 1];
    bf16_t* Pb = F.PROJ(); const float* RC = F.ROPEC(); const float* RS = F.ROPES();
    const RowRange rr = wave_rows(F, T);
    for (int r0 = rr.lo; r0 < rr.hi; r0 += 4) {
        unsigned w1[4], w2[4]; f32x2 cs[4], sn[4];
#pragma unroll
        for (int k = 0; k < 4; ++k) { const int row = (r0 + k < rr.hi) ? r0 + k : rr.hi - 1; const int p = row % TB; const int pos = p >= NCTX ? p - NCTX : 0;
            const bf16_t* rp = Pb + (size_t)row * NIN + col; w1[k] = *(const GAS unsigned*)rp; w2[k] = *(const GAS unsigned*)(rp + 32);
            cs[k] = *(const GAS f32x2*)(RC + (size_t)pos * 32 + 2 * j4); sn[k] = *(const GAS f32x2*)(RS + (size_t)pos * 32 + 2 * j4); }
#pragma unroll
        for (int k = 0; k < 4; ++k) { const int row = r0 + k; if (row >= rr.hi) break; const int p = row % TB;
            float a0 = bf_lo(w1[k]), a1 = bf_hi(w1[k]), b0 = bf_lo(w2[k]), b1 = bf_hi(w2[k]);
            float ss = a0 * a0 + a1 * a1 + b0 * b0 + b1 * b1;
            ss += __shfl_xor(ss, 1); ss += __shfl_xor(ss, 2); ss += __shfl_xor(ss, 4); ss += __shfl_xor(ss, 8);
            const float rinv = 1.0f / sqrtf(ss * (1.0f / 64.0f) + EPS);
            a0 *= rinv * g0; a1 *= rinv * g1; b0 *= rinv * g2; b1 *= rinv * g3;
            if (p >= NCTX) { const float t0 = a0 * cs[k].x - b0 * sn[k].x, t1 = a1 * cs[k].y - b1 * sn[k].y, u0 = b0 * cs[k].x + a0 * sn[k].x, u1 = b1 * cs[k].y + a1 * sn[k].y; a0 = t0; a1 = t1; b0 = u0; b1 = u1; }
            bf16_t* rp = Pb + (size_t)row * NIN + col;
            if (!dry) { *(GAS unsigned*)rp = cvt_pk_bf16(a0, a1); *(GAS unsigned*)(rp + 32) = cvt_pk_bf16(b0, b1); } }
    }
}
constexpr int SC_AOP = 0, SC_AOP_B = 64 * 144, SC_XCV = 2 * SC_AOP_B, SC_XCV_B = 64 * 68 * 4, SC_TOT = SC_XCV + 2 * SC_XCV_B, SC_TOT_B = 4 * 2 * 16 * 8;
__device__ __forceinline__ void scan_unit(Frame& F, int l, int uid, bool last_layer, bool dry = false) {
    const int b = uid >> 4, n = (uid >> 1) & 7, chh = uid & 1;
    const int dir = F.wave >> 2, ht = F.tid & 255, w = F.wave & 3, lane = F.lane, col = lane & 15, quad = lane >> 4;
    LAS unsigned char* aop = F.lds + SC_AOP + dir * SC_AOP_B;
    LAS float* xcv = (LAS float*)(F.lds + SC_XCV + dir * SC_XCV_B);
    LAS f32x2* tot = (LAS f32x2*)(F.lds + SC_TOT + dir * SC_TOT_B);
    bf16x8 Bf[4][2];
    {
        const size_t wbase = ((size_t)((l * 2 + dir) * 8 + n)) * 64 * 64; const float* lwa = F.lru_wa(); const float* lwx = F.lru_wx();
#pragma unroll
        for (int q = 0; q < 4; ++q) { const float* wp = ((q < 2) ? lwa : lwx) + wbase + 32 * chh + 16 * (q & 1) + col;
#pragma unroll
            for (int ks = 0; ks < 2; ++ks) { u32x4 pk;
                const int k0 = 32 * ks + 8 * quad;
                pk.x = cvt_pk_bf16(wp[(size_t)(k0 + 0) * 64], wp[(size_t)(k0 + 1) * 64]); pk.y = cvt_pk_bf16(wp[(size_t)(k0 + 2) * 64], wp[(size_t)(k0 + 3) * 64]);
                pk.z = cvt_pk_bf16(wp[(size_t)(k0 + 4) * 64], wp[(size_t)(k0 + 5) * 64]); pk.w = cvt_pk_bf16(wp[(size_t)(k0 + 6) * 64], wp[(size_t)(k0 + 7) * 64]);
                Bf[q][ks] = __builtin_bit_cast(bf16x8, pk); } }
    }
    float ba[2], bx[2], nla[2]; const float* lba = F.lru_ba(); const float* lbx = F.lru_bx(); const float* llam = F.lru_lambda();
#pragma unroll
    for (int q = 0; q < 2; ++q) { const int gch = 64 * n + 32 * chh + 16 * q + col; const size_t o = (size_t)(l * 2 + dir) * 512 + gch;
        ba[q] = lba[o]; bx[q] = lbx[o]; const float lam = llam[o];
        const float sp = (lam > 15.f) ? __expf(-lam) : log1pf(__expf(-lam));
        nla[q] = -8.0f * sp; }
    const int cg = ht & 7; float cw[4][8], cb[8]; const float* cwp = F.conv_w(); const float* cbp = F.conv_b();
#pragma unroll
    for (int k = 0; k < 4; ++k)
#pragma unroll
        for (int c = 0; c < 8; ++c) cw[k][c] = cwp[(size_t)(l * 4 + k) * 512 + 64 * n + 8 * cg + c];
#pragma unroll
    for (int c = 0; c < 8; ++c) cb[c] = cbp[(size_t)l * 512 + 64 * n + 8 * cg + c];
    float hcar[2] = {0.f, 0.f};
    bf16_t* Pb = F.PROJ(); float* HTb = F.HT();
    const bf16_t* xrb = Pb + C_XR + 64 * n + 8 * cg;

    for (int seg = 0; seg < 2; ++seg) {
        const int nch = seg ? 64 : 4, seglen = nch * 64; const size_t rowseg0 = (size_t)b * TB + (seg ? NCTX : 0);
        const bool want_out = !(seg == 0 && last_layer) && !dry;
        u32x4 raw[2][4];
#define SC_LOAD(i_) do { const int cidx_ = dir ? nch - 1 - (i_) : (i_); const int t0_ = 64 * cidx_; \
        _Pragma("unroll") for (int it = 0; it < 2; ++it) { const int s_ = (it * 256 + ht) >> 3; const int t_ = dir ? t0_ + 63 - s_ : t0_ + s_; \
            _Pragma("unroll") for (int dt = 0; dt < 4; ++dt) { const int tt = t_ + dt - 2; \
                raw[it][dt] = (tt >= 0 && tt < seglen) ? *(const GAS u32x4*)(xrb + (rowseg0 + tt) * NIN) : (u32x4){0u, 0u, 0u, 0u}; } } } while (0)
        SC_LOAD(0);
        for (int i = 0; i < nch; ++i) {
            const int cidx = dir ? nch - 1 - i : i, t0 = 64 * cidx;
#pragma unroll
            for (int it = 0; it < 2; ++it) { const int s = (it * 256 + ht) >> 3; float cv[8];
#pragma unroll
                for (int c2 = 0; c2 < 4; ++c2) { float lo = cb[2 * c2], hi2 = cb[2 * c2 + 1];
#pragma unroll
                    for (int dt = 0; dt < 4; ++dt) { const unsigned wv = raw[it][dt][c2]; lo += cw[dt][2 * c2] * bf_lo(wv); hi2 += cw[dt][2 * c2 + 1] * bf_hi(wv); }
                    cv[2 * c2] = lo; cv[2 * c2 + 1] = hi2; }
                u32x4 pk; pk.x = cvt_pk_bf16(cv[0], cv[1]); pk.y = cvt_pk_bf16(cv[2], cv[3]); pk.z = cvt_pk_bf16(cv[4], cv[5]); pk.w = cvt_pk_bf16(cv[6], cv[7]);
                *(LAS u32x4*)(aop + s * 144 + cg * 16) = pk;
                *(LAS f32x4*)(xcv + s * 68 + cg * 8) = (f32x4){cv[0], cv[1], cv[2], cv[3]}; *(LAS f32x4*)(xcv + s * 68 + cg * 8 + 4) = (f32x4){cv[4], cv[5], cv[6], cv[7]}; }
            if (i + 1 < nch) SC_LOAD(i + 1);
            if (i == nch / 2) VM_WAIT();
            __syncthreads();
            float othv[2][4]; unsigned grv[2][4]; const bool fin = want_out && i >= nch / 2;
            if (fin) {
#pragma unroll
                for (int q = 0; q < 2; ++q) { const int gch = 64 * n + 32 * chh + 16 * q + col;
#pragma unroll
                    for (int j = 0; j < 4; ++j) { const int s = 16 * w + 4 * quad + j; const int tt = dir ? t0 + 63 - s : t0 + s; const size_t row = rowseg0 + tt;
                        othv[q][j] = __hip_atomic_load(HTb + row * 512 + gch, __ATOMIC_RELAXED, __HIP_MEMORY_SCOPE_AGENT); grv[q][j] = *(const GAS bf16_t*)(Pb + row * NIN + C_GR + gch); } } }
            f32x4 gacc[4];
#pragma unroll
            for (int q = 0; q < 4; ++q) gacc[q] = (f32x4){0.f, 0.f, 0.f, 0.f};
#pragma unroll
            for (int ks = 0; ks < 2; ++ks) { const bf16x8 af = *(const LAS bf16x8*)(aop + (16 * w + col) * 144 + ks * 64 + quad * 16);
#pragma unroll
                for (int q = 0; q < 4; ++q) gacc[q] = __builtin_amdgcn_mfma_f32_16x16x32_bf16(af, Bf[q][ks], gacc[q], 0, 0, 0); }
            float av[2][4], bv[2][4], cA[2], cB[2];
#pragma unroll
            for (int q = 0; q < 2; ++q) {
#pragma unroll
                for (int j = 0; j < 4; ++j) { const float r = fast_sigmoid(gacc[q][j] + ba[q]), ig = fast_sigmoid(gacc[q + 2][j] + bx[q]);
                    const float la = nla[q] * r, a = __expf(la), z = 2.0f * la;
                    const float om = (z > -0.1f) ? -z * (1.0f + z * (0.5f + z * (0.16666667f + z * 0.041666668f))) : 1.0f - __expf(z);
                    const float xv = xcv[(16 * w + 4 * quad + j) * 68 + 32 * chh + 16 * q + col];
                    av[q][j] = a; bv[q][j] = sqrtf(om) * ig * xv; }
                cA[q] = av[q][0]; cB[q] = bv[q][0];
#pragma unroll
                for (int j = 1; j < 4; ++j) { cB[q] = av[q][j] * cB[q] + bv[q][j]; cA[q] *= av[q][j]; }
            }
            float iA[2], iB[2], eA[2], eB[2];
#pragma unroll
            for (int q = 0; q < 2; ++q) { iA[q] = cA[q]; iB[q] = cB[q];
                float pA = __shfl_up(iA[q], 16), pB = __shfl_up(iB[q], 16); if (quad >= 1) { iB[q] = iA[q] * pB + iB[q]; iA[q] = iA[q] * pA; }
                pA = __shfl_up(iA[q], 32); pB = __shfl_up(iB[q], 32); if (quad >= 2) { iB[q] = iA[q] * pB + iB[q]; iA[q] = iA[q] * pA; }
                eA[q] = __shfl_up(iA[q], 16); eB[q] = __shfl_up(iB[q], 16); if (quad == 0) { eA[q] = 1.0f; eB[q] = 0.0f; }
                if (quad == 3) tot[(w * 2 + q) * 16 + col] = (f32x2){iA[q], iB[q]}; }
            __syncthreads();
#pragma unroll
            for (int q = 0; q < 2; ++q) { float hin = hcar[q], hall = hcar[q];
#pragma unroll
                for (int ww = 0; ww < 4; ++ww) { const f32x2 tw = tot[(ww * 2 + q) * 16 + col]; hall = tw.x * hall + tw.y; if (ww < w) hin = hall; }
                hcar[q] = hall;
                float hv = eA[q] * hin + eB[q];
                const int gch = 64 * n + 32 * chh + 16 * q + col;
#pragma unroll
                for (int j = 0; j < 4; ++j) { hv = av[q][j] * hv + bv[q][j];
                    if (want_out) { const int s = 16 * w + 4 * quad + j; const int tt = dir ? t0 + 63 - s : t0 + s; const size_t row = rowseg0 + tt;
                        if (!fin) HTb[row * 512 + gch] = hv;
                        else { bf16_t* gp = Pb + row * NIN + C_GR + gch; const float gr = __uint_as_float(grv[q][j] << 16);
                            *gp = (bf16_t)(cvt_pk_bf16((hv + othv[q][j]) * gr, 0.f) & 0xffffu); } } }
            }
        }
#undef SC_LOAD
        __syncthreads();
    }
}

__device__ __forceinline__ void r2_phase(Frame& F, int l, bool dry = false) {
    LAS float* rw = (LAS float*)(F.lds + RING_OFF);
    { const float* rwp = F.router_w(); for (int i = F.tid; i < 16 * 1024; i += NWAVES * 64) { const int e = i >> 10, k = i & 1023; rw[i] = rwp[k * 16 + e]; } }
    __syncthreads();
    float rb[16]; const float* rbp = F.router_b();
#pragma unroll
    for (int e = 0; e < 16; ++e) rb[e] = rbp[e];
    const bool all = (l == 0); const int nrows = all ? T : NB * SEQ;
    const float* MODb = F.MOD(); float* XCb = F.XC(); float* outb = F.out(); const float* xin = F.x(); const float* cin = F.ctx(); const bf16_t* YB = F.YBUF(); unsigned char* H8b = F.H8();
    const float* n2g = F.norm2_g() + (size_t)l * D; unsigned* RT = F.ROUTE(); gu32* cnt = F.ctl() + CW_CNT + l * 64;
    const RowRange rr = wave_rows(F, nrows);
    int cursel = -1; f32x4 g1v[4], gm[4], sh[4], vn[4]; u32x2 yn[4];
    unsigned my_e0 = 0u, my_e1 = 0u; float my_w0 = 0.f, my_w1 = 0.f; int my_row = 0;
#define R2_XI(b_, p_) ((l == 0) ? (((p_) < NCTX) ? cin + (size_t)((b_) * NCTX + (p_)) * D : xin + (size_t)((b_) * SEQ + (p_) - NCTX) * D) : (const float*)(outb + (size_t)((b_) * SEQ + (p_) - NCTX) * D))
#define R2_LOAD(idx_) do { int b_, p_; row_decode((idx_), all, b_, p_); ld_row_f32(R2_XI(b_, p_), F.lane, vn); \
        _Pragma("unroll") for (int j = 0; j < 4; ++j) yn[j] = *((const GAS u32x2*)(YB + (size_t)(b_ * TB + p_) * D) + F.lane + 64 * j); } while (0)
    if (rr.lo < rr.hi) R2_LOAD(rr.lo);
    for (int c0 = rr.lo; c0 < rr.hi; c0 += 64) {
    const int c1 = (c0 + 64 < rr.hi) ? c0 + 64 : rr.hi;
    for (int idx = c0; idx < c1; ++idx) {
        int b, p; row_decode(idx, all, b, p);
        const int row = b * TB + p; const bool isc = p < NCTX; const int sel = isc ? 16 : b;
        float* xo = isc ? XCb + (size_t)(b * NCTX + p) * D : outb + (size_t)(b * SEQ + p - NCTX) * D;
        f32x4 v[4], h[4];
#pragma unroll
        for (int j = 0; j < 4; ++j) { const u32x2 w = yn[j]; v[j] = vn[j]; h[j] = (f32x4){bf_lo(w.x), bf_hi(w.x), bf_lo(w.y), bf_hi(w.y)}; }
        if (idx + 1 < rr.hi) R2_LOAD(idx + 1);
        if (sel != cursel) { cursel = sel; f32x4 g[4], sc[4]; ld_vec(n2g, F.lane, g); ld_vec(modp(MODb, l, sel, 4), F.lane, sc); ld_vec(modp(MODb, l, sel, 3), F.lane, sh); ld_vec(modp(MODb, l, sel, 2), F.lane, g1v);
#pragma unroll
            for (int j = 0; j < 4; ++j) gm[j] = g[j] * (sc[j] + 1.0f); }
#pragma unroll
        for (int j = 0; j < 4; ++j) v[j] = v[j] + g1v[j] * h[j];
        if (!dry) st_row_f32(xo, F.lane, v);
        const float rinv = row_rinv(v);
#pragma unroll
        for (int j = 0; j < 4; ++j) h[j] = (v[j] * rinv) * gm[j] + sh[j];
        if (!dry) st_row_fp8(H8b + (size_t)row * D, F.lane, h);
        float lg[16]; LAS float* rwl = rw; asm volatile("" : "+v"(rwl));
#pragma unroll
        for (int e = 0; e < 16; ++e) { float a = 0.f;
#pragma unroll
            for (int j = 0; j < 4; ++j) { const f32x4 wv = *(const LAS f32x4*)(rwl + e * 1024 + 256 * j + 4 * F.lane); a += (h[j][0] * wv[0] + h[j][1] * wv[1]) + (h[j][2] * wv[2] + h[j][3] * wv[3]); }
            lg[e] = wave_sum(a); }
        float s[16], sl[16];
#pragma unroll
        for (int e = 0; e < 16; ++e) { s[e] = 1.0f / (1.0f + __expf(-lg[e])); sl[e] = s[e] + rb[e]; }
        float bestg = -INFINITY; int gi = 0;
#pragma unroll
        for (int g = 0; g < 4; ++g) { float m1 = -INFINITY, m2 = -INFINITY;
#pragma unroll
            for (int k = 0; k < 4; ++k) { const float t = sl[4 * g + k]; if (t > m1) { m2 = m1; m1 = t; } else if (t > m2) m2 = t; }
            const float gs = m1 + m2; if (gs > bestg) { bestg = gs; gi = g; } }
        float c4[4], s4[4];
#pragma unroll
        for (int k = 0; k < 4; ++k) { c4[k] = gi == 0 ? sl[k] : gi == 1 ? sl[4 + k] : gi == 2 ? sl[8 + k] : sl[12 + k]; s4[k] = gi == 0 ? s[k] : gi == 1 ? s[4 + k] : gi == 2 ? s[8 + k] : s[12 + k]; }
        int i0 = 0; float v0 = c4[0], w0 = s4[0];
#pragma unroll
        for (int k = 1; k < 4; ++k) if (c4[k] > v0) { v0 = c4[k]; i0 = k; w0 = s4[k]; }
        int i1 = -1; float v1 = -INFINITY, w1 = 0.f;
#pragma unroll
        for (int k = 0; k < 4; ++k) if (k != i0 && c4[k] > v1) { v1 = c4[k]; i1 = k; w1 = s4[k]; }
        const float wsum = w0 + w1; w0 /= wsum; w1 /= wsum;
        if (F.lane == idx - c0) { my_e0 = (unsigned)(4 * gi + i0); my_e1 = (unsigned)(4 * gi + i1); my_w0 = w0; my_w1 = w1; my_row = row; }
    }
    if (!dry) {
        const int nmine = c1 - c0; const bool have = F.lane < nmine;
        unsigned r0 = 0u, r1 = 0u, mycnt = 0u;
        const unsigned long long ltm = (1ull << F.lane) - 1ull;
#pragma unroll
        for (int e = 0; e < 16; ++e) { const unsigned long long m0 = __ballot(have && my_e0 == (unsigned)e), m1 = __ballot(have && my_e1 == (unsigned)e);
            const unsigned c0 = (unsigned)__popcll(m0), c1 = (unsigned)__popcll(m1);
            if (my_e0 == (unsigned)e) r0 = (unsigned)__popcll(m0 & ltm);
            if (my_e1 == (unsigned)e) r1 = c0 + (unsigned)__popcll(m1 & ltm);
            if (F.lane == e) mycnt = c0 + c1; }
        unsigned base = 0u; if (F.lane < 16 && mycnt) base = __hip_atomic_fetch_add(cnt + F.lane, mycnt, RLX_AGENT);
        const unsigned b0 = (unsigned)__shfl((int)base, (int)my_e0), b1 = (unsigned)__shfl((int)base, (int)my_e1);
        if (have) { const u32x4 q0 = {my_e0, b0 + r0, my_e1, b1 + r1}; const u32x4 q1 = {__float_as_uint(my_w0), __float_as_uint(my_w1), 0u, 0u};
            *(GAS u32x4*)(RT + (size_t)my_row * 8) = q0; *(GAS u32x4*)(RT + (size_t)my_row * 8 + 4) = q1; }
    }
    }
#undef R2_LOAD
#undef R2_XI
    __syncthreads();
}

__device__ __forceinline__ void build_ptab(Frame& F, int l, LAS int* ptab) {
    if (F.tid == 0) { int acc = 0; gu32* cntb = F.ctl() + CW_CNT + l * 64;
        for (int e = 0; e < NE; ++e) { ptab[e] = acc; const int c = (int)__hip_atomic_load(cntb + e, RLX_AGENT); acc += ((c + 255) >> 8) << 8; }
        ptab[NE] = acc; }
    __syncthreads();
}
__device__ __forceinline__ void gather_phase(Frame& F, int l, LAS int* ptab) {
    const bool all = (l == 0); const int nrows = all ? T : NB * SEQ;
    const unsigned* RT = F.ROUTE(); const unsigned char* Ab = F.H8(); unsigned char* HGb = F.HG();
    const RowRange rr = wave_rows(F, nrows);
    for (int idx = rr.lo; idx < rr.hi; idx += 4) {
        u32x4 a[4]; size_t p0[4], p1[4];
#pragma unroll
        for (int k = 0; k < 4; ++k) if (idx + k < rr.hi) { int b, p; row_decode(idx + k, all, b, p); const int row = b * TB + p;
            const u32x4 r0 = *(const GAS u32x4*)(RT + (size_t)row * 8); p0[k] = (size_t)ptab[r0.x] + r0.y; p1[k] = (size_t)ptab[r0.z] + r0.w;
            a[k] = *((const GAS u32x4*)(Ab + (size_t)row * D) + F.lane); }
#pragma unroll
        for (int k = 0; k < 4; ++k) if (idx + k < rr.hi) { *((GAS u32x4*)(HGb + p0[k] * D) + F.lane) = a[k]; *((GAS u32x4*)(HGb + p1[k] * D) + F.lane) = a[k]; }
    }
}
__device__ __forceinline__ void r3_phase(Frame& F, int l, LAS int* ptab, bool dry = false) {
    const bool all = (l == 0); const int nrows = all ? T : NB * SEQ;
    const float* MODb = F.MOD(); float* XCb = F.XC(); float* outb = F.out(); const bf16_t* YPb = F.YP(); bf16_t* Ab = F.A(); unsigned char* H8i = F.HIN8(); const unsigned* RT = F.ROUTE();
    const float* n1g = F.norm1_g() + (size_t)(l == 0 ? 1 : 0) * D;
    const RowRange rr = wave_rows(F, nrows);
    int cursel = -1; f32x4 g2v[4], gm[4], sh[4], vn[4]; u32x2 y0n[4], y1n[4]; float w0n = 0.f, w1n = 0.f;
    u32x4 ra = {0u, 0u, 0u, 0u}; u32x2 rb2 = {0u, 0u};
#define R3_ROUTE(idx_) do { int b_, p_; row_decode((idx_), all, b_, p_); const int row_ = b_ * TB + p_; ra = *(const GAS u32x4*)(RT + (size_t)row_ * 8); rb2 = *(const GAS u32x2*)(RT + (size_t)row_ * 8 + 4); } while (0)
#define R3_LOAD(idx_) do { int b_, p_; row_decode((idx_), all, b_, p_); const u32x4 r0_ = ra; const u32x2 r1_ = rb2; \
        const size_t q0_ = (size_t)ptab[r0_.x] + r0_.y, q1_ = (size_t)ptab[r0_.z] + r0_.w; w0n = __uint_as_float(r1_.x); w1n = __uint_as_float(r1_.y); \
        ld_row_f32((p_ < NCTX) ? XCb + (size_t)(b_ * NCTX + p_) * D : outb + (size_t)(b_ * SEQ + p_ - NCTX) * D, F.lane, vn); \
        _Pragma("unroll") for (int j = 0; j < 4; ++j) { y0n[j] = *((const GAS u32x2*)(YPb + q0_ * D) + F.lane + 64 * j); y1n[j] = *((const GAS u32x2*)(YPb + q1_ * D) + F.lane + 64 * j); } } while (0)
    if (rr.lo < rr.hi) { R3_ROUTE(rr.lo); R3_LOAD(rr.lo); if (rr.lo + 1 < rr.hi) R3_ROUTE(rr.lo + 1); }
    for (int idx = rr.lo; idx < rr.hi; ++idx) {
        int b, p; row_decode(idx, all, b, p);
        const int row = b * TB + p; const bool isc = p < NCTX; const int sel = isc ? 16 : b;
        float* xo = isc ? XCb + (size_t)(b * NCTX + p) * D : outb + (size_t)(b * SEQ + p - NCTX) * D;
        f32x4 v[4], m[4]; const float w0 = w0n, w1 = w1n;
#pragma unroll
        for (int j = 0; j < 4; ++j) { const u32x2 a = y0n[j], c = y1n[j]; v[j] = vn[j];
            m[j] = (f32x4){bf_lo(a.x) * w0 + bf_lo(c.x) * w1, bf_hi(a.x) * w0 + bf_hi(c.x) * w1, bf_lo(a.y) * w0 + bf_lo(c.y) * w1, bf_hi(a.y) * w0 + bf_hi(c.y) * w1}; }
        if (idx + 1 < rr.hi) { R3_LOAD(idx + 1); if (idx + 2 < rr.hi) R3_ROUTE(idx + 2); }
        if (sel != cursel) { cursel = sel; ld_vec(modp(MODb, l, sel, 5), F.lane, g2v);
            if (l == 0) { f32x4 g[4], sc[4]; ld_vec(n1g, F.lane, g); ld_vec(modp(MODb, l + 1, sel, 1), F.lane, sc); ld_vec(modp(MODb, l + 1, sel, 0), F.lane, sh);
#pragma unroll
                for (int j = 0; j < 4; ++j) gm[j] = g[j] * (sc[j] + 1.0f); } }
#pragma unroll
        for (int j = 0; j < 4; ++j) v[j] = v[j] + g2v[j] * m[j];
        if (!isc && !dry) st_row_f32(xo, F.lane, v);
        if (l == 0) { const float rinv = row_rinv(v); f32x4 h[4];
#pragma unroll
            for (int j = 0; j < 4; ++j) h[j] = (v[j] * rinv) * gm[j] + sh[j];
            if (!dry) { if (PSPLIT > 0) st_row_bf16(Ab + (size_t)row * D, F.lane, h); st_row_fp8(H8i + (size_t)row * D, F.lane, h); } }
    }
#undef R3_LOAD
#undef R3_ROUTE
}

struct SchedProj {
    const char* A; const char* B; int G, c, pn0, npn, rowB;
    __device__ __forceinline__ bool next(int i, pg8::Unit& u) const { int pm, pn; if (!pg8::tile_order((long)i * G + c, T / 256, npn, pm, pn)) return false;
        pn += pn0; u.pm = pm; u.pn = pn; u.aux = 0; u.A = A + (size_t)pm * 256 * rowB; u.B = B + (size_t)pn * 256 * rowB; return true; }
};
__device__ __forceinline__ int lat_tile(int pe) { return (pe >> 4) * 17 + 1 + (pe & 15); }
struct SchedMerge {
    const char* P; const char* B; int G, c, nM; bool lat_only;
    __device__ __forceinline__ bool next(int i, pg8::Unit& u) const { const int rnd = i / 3, br = i - rnd * 3; int pm, pn; if (!pg8::tile_order((long)rnd * G + c, nM, 4, pm, pn)) return false;
        if (lat_only) pm = lat_tile(pm);
        const int acol = br == 0 ? C_GR : (br == 1 ? C_GQ : C_WQ);
        u.pm = pm; u.pn = pn; u.aux = br; u.A = P + ((size_t)pm * 256 * NIN + acol) * 2; u.B = B + ((size_t)br * D + pn * 256) * 512 * 2; return true; }
};
struct SchedOut {
    const char* A; const char* B; int G, c, nM; bool lat_only;
    __device__ __forceinline__ bool next(int i, pg8::Unit& u) const { int pm, pn; if (!pg8::tile_order((long)i * G + c, nM, 4, pm, pn)) return false;
        if (lat_only) pm = lat_tile(pm);
        u.pm = pm; u.pn = pn; u.aux = 0; u.A = A + (size_t)pm * 256 * D * 2; u.B = B + (size_t)pn * 256 * D * 2; return true; }
};
struct SchedMoe {
    const char* A; const char* B; const LAS int* ptab; int G, c, npn;
    __device__ __forceinline__ bool next(int i, pg8::Unit& u) const { const int L = i * G + c; const int ntile = ptab[NE] >> 8; if (L >= ntile * npn) return false;
        const int j = L / npn, pn = L - j * npn; int e = 0;
#pragma unroll
        for (int k = 1; k < NE; ++k) e += (ptab[k] <= j * 256) ? 1 : 0;
        u.pm = j; u.pn = pn; u.aux = e; u.A = A + (size_t)j * 256 * D; u.B = B + ((size_t)e * npn + pn) * 256 * D; return true; }
};

#ifndef PROBE
#define PROBE 0
#endif
static_assert(sizeof(Args) == sizeof(KArgs), "kernarg views");
__global__ void __launch_bounds__(NWAVES * 64, 2) mega_fwd(Args args) {
    extern __shared__ __attribute__((aligned(16))) unsigned char lds[];
    volatile LAS unsigned* MISC = (volatile LAS unsigned*)((LAS unsigned char*)lds + MISC_OFF);
    LAS int* ptab = (LAS int*)((LAS unsigned char*)lds + LDSCTL_OFF);
    Frame F0; {
    Frame& F = F0;
    F.lds = (LAS unsigned char*)lds;
    F.tid = threadIdx.x; F.lane = F.tid & 63; F.wave = __builtin_amdgcn_readfirstlane(F.tid >> 6);
    F.G = gridDim.x; { const int bx = blockIdx.x; F.vcu = (F.G % 8 == 0) ? (bx % 8) * (F.G / 8) + bx / 8 : bx; }
    F.gw = F.vcu * NWAVES + F.wave; F.NGW = F.G * NWAVES; F.bid = blockIdx.x; }
    for (int u = F0.tid; u < (LDS_BYTES - LDSCTL_OFF) / 4; u += NWAVES * 64) ((LAS unsigned*)(F0.lds + LDSCTL_OFF))[u] = 0u;
    __syncthreads();
    XcdBarrier bar = xcd_barrier_post((unsigned*)(F0.ctl() + CW_BAR), MISC + 8);
#define GRID_BAR() do { XcdBarrier b_ = bar; asm volatile("" : "+s"(b_.bar), "+s"(b_.x)); xcd_barrier(b_); } while (0)

    { Frame F = fresh(F0); p0_prologue(F); }
    if (PROBE == 13) { __syncthreads(); Frame F = fresh(F0); p0_prologue(F); }
    GRID_BAR();
    { Frame F = fresh(F0); r1_phase(F); }
    if (PROBE == 17) { Frame F = fresh(F0); r1_phase(F); }
    GRID_BAR();

    for (int l = 0; l < NL; ++l) {
        const bool last = (l == NL - 1);
        if (PSPLIT > 0) { Frame F = fresh(F0);
            pg8::Gemm g{D / 64, D * 2, D * 2}; SchedProj S{(const char*)F.A(), (const char*)(F.WIN() + (size_t)l * NIN * D), F.G, F.bid, 0, PSPLIT, D * 2};
            pg8::EpiProj E{F.PROJ(), F.b_merge() + (size_t)l * 3 * D, 1.0f};
            pg8::gemm_phase(F.lds + RING_OFF, g, S, E);
            if (PROBE == 1) { __syncthreads(); pg8::gemm_phase(F.lds + RING_OFF, g, S, E); }
        }
        { Frame F = fresh(F0);
            pg8::Gemm g{D / 128, D, D}; SchedProj S{(const char*)F.HIN8(), (const char*)(F.WIN8() + (size_t)l * NIN * D), F.G, (F.bid + (3 * F.G) / 4) % F.G, PSPLIT, NIN / 256 - PSPLIT, D};
            pg8::EpiProj E{F.PROJ(), F.b_merge() + (size_t)l * 3 * D, 1.0f / WSCALE};
            pg8::gemm_phase<pg8::EpiProj, SchedProj, true>(F.lds + RING_OFF, g, S, E);
            if (PROBE == 1) { __syncthreads(); pg8::gemm_phase<pg8::EpiProj, SchedProj, true>(F.lds + RING_OFF, g, S, E); }
        }
        GRID_BAR();
        if (PROBE == 14) { Frame F = fresh(F0); kfix_phase(F, l, __hip_atomic_load(F.ctl() + 8, RLX_AGENT) == 0u); }
        { Frame F = fresh(F0); kfix_phase(F, l); }
        GRID_BAR();
        if (PROBE == 4) { Frame F = fresh(F0); const bool dry = __hip_atomic_load(F.ctl() + 8, RLX_AGENT) == 0u; for (int uid = F.vcu; uid < 256; uid += F.G) scan_unit(F, l, uid, last, dry); __syncthreads(); }
        { Frame F = fresh(F0); for (int uid = F.vcu; uid < 256; uid += F.G) scan_unit(F, l, uid, last); }
        __syncthreads();
        { Frame F = fresh(F0);
            const int per = (2048 + F.G - 1) / F.G;
            attn_body::AttnArgs aa; aa.P = (attn_body::bf16*)F.PROJ(); aa.ropec = F.ROPEC(); aa.ropes = F.ROPES(); aa.dry = false;
            aa.qg = F.q_norm_g() + (size_t)(l * 2 + 0) * 64; aa.sink = 0.f;
            if (PROBE == 11) { aa.dry = __hip_atomic_load(F.ctl() + 8, RLX_AGENT) == 0u; for (int gid = F.vcu * per; gid < (F.vcu + 1) * per && gid < 2048; ++gid) { const int pair = gid >> 6, uu = gid & 63; const int b = pair >> 1, h = (pair & 1) * 4 + (uu >> 4), qb = uu & 15;
                attn_body::attn_unit<0, 8>(b, h, qb, aa, (char*)lds + RING_OFF); } aa.dry = false; }
            if (PROBE != 9) for (int gid = F.vcu * per; gid < (F.vcu + 1) * per && gid < 2048; ++gid) { const int pair = gid >> 6, uu = gid & 63; const int b = pair >> 1, h = (pair & 1) * 4 + (uu >> 4), qb = uu & 15;
                attn_body::attn_unit<0, 8>(b, h, qb, aa, (char*)lds + RING_OFF); }
            aa.qg = F.q_norm_g() + (size_t)(l * 2 + 1) * 64;
            if (PROBE == 12) { aa.dry = __hip_atomic_load(F.ctl() + 8, RLX_AGENT) == 0u; for (int gid = F.vcu * per; gid < (F.vcu + 1) * per && gid < 2048; ++gid) { const int pair = gid >> 6, uu = gid & 63; const int b = pair >> 1, h = (pair & 1) * 4 + (uu >> 4), qb = uu & 15;
                aa.sink = 0.f; attn_body::attn_unit<1, 8>(b, h, qb, aa, (char*)lds + RING_OFF); } aa.dry = false; }
            if (PROBE != 10) for (int gid = F.vcu * per; gid < (F.vcu + 1) * per && gid < 2048; ++gid) { const int pair = gid >> 6, uu = gid & 63; const int b = pair >> 1, h = (pair & 1) * 4 + (uu >> 4), qb = uu & 15;
                aa.sink = F.sink()[l * 8 + h];
                attn_body::attn_unit<1, 8>(b, h, qb, aa, (char*)lds + RING_OFF); }
            if (!last) {
                for (int cid = F.vcu; cid < 256; cid += F.G) { const int b = cid >> 4, h = (cid >> 1) & 7;
                    if (cid & 1) { aa.qg = F.q_norm_g() + (size_t)(l * 2 + 1) * 64; aa.sink = F.sink()[l * 8 + h]; attn_body::attn_unit<3, 8>(b, h, 0, aa, (char*)lds + RING_OFF); }
                    else { aa.qg = F.q_norm_g() + (size_t)(l * 2 + 0) * 64; aa.sink = 0.f; attn_body::attn_unit<2, 8>(b, h, 0, aa, (char*)lds + RING_OFF); } }
            }
        }
        GRID_BAR();
        { Frame F = fresh(F0);
            pg8::Gemm g{512 / 64, NIN * 2, 512 * 2}; SchedMerge S{(const char*)F.PROJ(), (const char*)(F.WBR() + (size_t)l * 3 * D * 512), F.G, F.bid, last ? 256 : 272, last};
            pg8::EpiMerge E{F.PROJ(), F.A()};
            pg8::gemm_phase(F.lds + RING_OFF, g, S, E);
            if (PROBE == 2) { __syncthreads(); pg8::gemm_phase(F.lds + RING_OFF, g, S, E); }
        }
        GRID_BAR();
        { Frame F = fresh(F0);
            pg8::Gemm g{D / 64, D * 2, D * 2}; SchedOut S{(const char*)F.A(), (const char*)(F.WOUT() + (size_t)l * D * D), F.G, F.bid, last ? 256 : 272, last};
            pg8::EpiPlain E{F.YBUF(), D, 1.0f};
            pg8::gemm_phase(F.lds + RING_OFF, g, S, E);
            if (PROBE == 3) { __syncthreads(); pg8::gemm_phase(F.lds + RING_OFF, g, S, E); }
        }
        GRID_BAR();
        { Frame F = fresh(F0); convert_experts(F, l); }
        __syncthreads();
        if (PROBE == 7) { Frame F = fresh(F0); convert_experts(F, l); __syncthreads(); }
        if (PROBE == 15) { Frame F = fresh(F0); r2_phase(F, l, __hip_atomic_load(F.ctl() + 8, RLX_AGENT) == 0u); }
        { Frame F = fresh(F0); r2_phase(F, l); }
        GRID_BAR();
        { Frame F = fresh(F0); build_ptab(F, l, ptab); gather_phase(F, l, ptab); if (PROBE == 8) gather_phase(F, l, ptab); }
        GRID_BAR();
        { Frame F = fresh(F0);
            pg8::Gemm g{D / 128, D, D}; SchedMoe S{(const char*)F.HG(), (const char*)F.W13(), ptab, F.G, F.bid, 8};
            pg8::EpiSwiglu E{F.HID(), 1.0f / WSCALE};
            pg8::gemm_phase<pg8::EpiSwiglu, SchedMoe, true>(F.lds + RING_OFF, g, S, E);
            if (PROBE == 5) { __syncthreads(); pg8::gemm_phase<pg8::EpiSwiglu, SchedMoe, true>(F.lds + RING_OFF, g, S, E); }
        }
        GRID_BAR();
        { Frame F = fresh(F0);
            pg8::Gemm g{D / 128, D, D}; SchedMoe S{(const char*)F.HID(), (const char*)F.W2(), ptab, F.G, F.bid, 4};
            pg8::EpiPlain E{F.YP(), D, 1.0f / WSCALE};
            pg8::gemm_phase<pg8::EpiPlain, SchedMoe, true>(F.lds + RING_OFF, g, S, E);
            if (PROBE == 6) { __syncthreads(); pg8::gemm_phase<pg8::EpiPlain, SchedMoe, true>(F.lds + RING_OFF, g, S, E); }
        }
        GRID_BAR();
        if (PROBE == 16) { Frame F = fresh(F0); r3_phase(F, l, ptab, __hip_atomic_load(F.ctl() + 8, RLX_AGENT) == 0u); }
        { Frame F = fresh(F0); r3_phase(F, l, ptab); }
        if (!last) GRID_BAR();
    }
}

extern "C" void kernel_launch(void* const* d_in, const int* in_sizes, int n_in, void* d_out, int out_size, void* d_ws, size_t ws_size, hipStream_t stream) {
    static int grid = 0;
    if (grid == 0) {
        if (n_in != 27 || in_sizes[0] != NB * SEQ * D || out_size != NB * SEQ * D || ws_size < WS_END) { fprintf(stderr, "kernel_launch: unexpected shapes / workspace (n_in %d, ws %zu < %zu)\n", n_in, ws_size, (size_t)WS_END); grid = -1; return; }
        int dev = 0, cus = 0, per_cu = 0;
        if (hipGetDevice(&dev) != hipSuccess || hipDeviceGetAttribute(&cus, hipDeviceAttributeMultiprocessorCount, dev) != hipSuccess) { grid = -1; return; }
        if (hipFuncSetAttribute((const void*)mega_fwd, hipFuncAttributeMaxDynamicSharedMemorySize, LDS_BYTES) != hipSuccess) { fprintf(stderr, "kernel_launch: hipFuncSetAttribute failed\n"); grid = -1; return; }
        if (hipOccupancyMaxActiveBlocksPerMultiprocessor(&per_cu, (const void*)mega_fwd, NWAVES * 64, LDS_BYTES) != hipSuccess || per_cu < 1) { fprintf(stderr, "kernel_launch: occupancy query says %d\n", per_cu); }
        (void)hipGetLastError();
        grid = cus;
    }
    if (grid < 0) return;
    if (hipMemsetAsync((char*)d_ws + WS_CTL, 0, CTL_ZERO_BYTES, stream) != hipSuccess) return;
    Args a{};
    for (int i = 0; i < 27; ++i) a.in[i] = (const float*)d_in[i];
    a.out = (float*)d_out; a.ws = (unsigned char*)d_ws;
    hipLaunchKernelGGL(mega_fwd, dim3(grid), dim3(NWAVES * 64), LDS_BYTES, stream, a);
}
```

```cpp
#define PROBE 0
#include <hip/hip_runtime.h>
#include <hip/hip_bf16.h>
#include <cstdio>
#include <cstdint>
#include <cmath>

#define GAS __attribute__((address_space(1)))
#define LAS __attribute__((address_space(3)))
typedef unsigned short bf16_t;
typedef short bf16x8 __attribute__((ext_vector_type(8)));
typedef float f32x4 __attribute__((ext_vector_type(4)));
typedef float f32x2 __attribute__((ext_vector_type(2)));
typedef unsigned u32x4 __attribute__((ext_vector_type(4)));
typedef unsigned u32x2 __attribute__((ext_vector_type(2)));

constexpr int NB = 16, SEQ = 4096, NCTX = 256, TB = SEQ + NCTX, T = NB * TB;
constexpr int D = 1024, NIN = 5632, NL = 2, NE = 16;
constexpr int C_XR = 0, C_GR = 512, C_GQ = 1024, C_GK = 1536, C_GV = 1664, C_WQ = 1792, C_WK = 2304, C_WV = 2432, C_MG = 2560;
constexpr float EPS = 1e-6f;
constexpr int PMAX = 143360;

__device__ __forceinline__ unsigned cvt_pk_bf16(float lo, float hi) { unsigned r; asm volatile("v_cvt_pk_bf16_f32 %0, %1, %2" : "=v"(r) : "v"(lo), "v"(hi)); return r; }
typedef int i32x8 __attribute__((ext_vector_type(8)));
typedef int i32x4 __attribute__((ext_vector_type(4)));
__device__ __forceinline__ unsigned pk4_fp8(float a, float b, float c, float d) {
    a = __builtin_amdgcn_fmed3f(a, -448.f, 448.f); b = __builtin_amdgcn_fmed3f(b, -448.f, 448.f); c = __builtin_amdgcn_fmed3f(c, -448.f, 448.f); d = __builtin_amdgcn_fmed3f(d, -448.f, 448.f);
    int w = __builtin_amdgcn_cvt_pk_fp8_f32(a, b, 0, false); w = __builtin_amdgcn_cvt_pk_fp8_f32(c, d, w, true); return (unsigned)w; }
__device__ __forceinline__ float bf_lo(unsigned u) { return __uint_as_float(u << 16); }
__device__ __forceinline__ float bf_hi(unsigned u) { return __uint_as_float(u & 0xffff0000u); }
__device__ __forceinline__ float fast_sigmoid(float v) { return __builtin_amdgcn_rcpf(1.0f + __builtin_amdgcn_exp2f(-1.4426950409f * v)); }
__device__ __forceinline__ float gelu_tanh(float v) { return v * __builtin_amdgcn_rcpf(1.0f + __builtin_amdgcn_exp2f(-2.3022082f * v * (1.0f + 0.044715f * v * v))); }

namespace pg8 {
constexpr int BM = 256, BK = 64, HALF = 128, HTB = HALF * BK * 2, STAGE_BYTES = 8 * HTB, NXCD = 8, WGM = 6;
__host__ __device__ __forceinline__ int lds_byte(int r, int c) { const int st = (r >> 4) * 2 + (c >> 5), rr = r & 15, cc = c & 31, ob = rr * 64 + cc * 2; return st * 1024 + (ob ^ (((ob >> 9) & 1) << 5)); }
__host__ __device__ __forceinline__ void stage_rc(int b, int& R, int& C) { const int st = b / 1024, sb = b % 1024, swz = sb ^ (((sb >> 9) & 1) << 5); R = (st >> 1) * 16 + swz / 64; C = (st & 1) * 32 + (swz % 64) / 2; }
__host__ __device__ __forceinline__ int perm32(int rho) { const int n = rho >> 4, i = rho & 15; return 8 * (i >> 2) + 4 * n + (i & 3); }

struct Unit { int pm, pn, aux; const char* A; const char* B; const int* gl; int nvalid; };
struct Gemm { int nt, ldaB, ldbB, stagger; };

__device__ __forceinline__ bool tile_order(long L, int nM, int nN, int& pm, int& pn) {
    const int nwg = nM * nN; if (L >= nwg) return false;
    int wgid = (int)L; { const int q = nwg / NXCD, r = nwg % NXCD, xcd = wgid % NXCD, off = wgid / NXCD; wgid = (xcd < r ? xcd * (q + 1) : r * (q + 1) + (xcd - r) * q) + off; }
    const int nig = WGM * nN, gid = wgid / nig, fm = gid * WGM, gsz = (nM - fm) < WGM ? (nM - fm) : WGM;
    pm = fm + ((wgid % nig) % gsz); pn = (wgid % nig) / gsz; return true;
}

template <class Epi, class Sched, bool FP8 = false, bool GATHER = false>
__device__ __forceinline__ void gemm_phase(int tid0, LAS unsigned char* lds, const Gemm g, const Sched& S, const Epi& E, LAS int* idxbuf = nullptr) {
    int tid_ = tid0; asm volatile("" : "+v"(tid_));
    const int tid = tid_, wid = __builtin_amdgcn_readfirstlane(tid >> 6), lane = tid & 63, wr = wid >> 2, wc = wid & 3, fr = lane & 15, fq = lane >> 4;
    int nt_ = g.nt; asm volatile("" : "+s"(nt_)); const int nt = nt_;
    unsigned voffA[2], voffB[2];
#pragma unroll
    for (int i = 0; i < 2; ++i) { int R, C; stage_rc(tid * 16 + i * 8192, R, C); const int Rb = (R & ~31) + perm32(R & 31);
        voffA[i] = (unsigned)(R * g.ldaB + C * 2); voffB[i] = (unsigned)(Rb * g.ldbB + C * 2); }
    const size_t kstep = (size_t)(BK * 2);
    const size_t hstepA = GATHER ? 0 : (size_t)HALF * g.ldaB, hstepB = (size_t)HALF * g.ldbB;
#define PG8_GOFF(dst, bufp, nv, h) do { _Pragma("unroll") for (int i_ = 0; i_ < 2; ++i_) { int R_, C_; stage_rc(tid * 16 + i_ * 8192, R_, C_); const int pos_ = R_ + HALF * (h); \
        const int ix_ = (bufp)[pos_]; dst[i_] = (unsigned)((pos_ < (nv)) ? ix_ : 0) * (unsigned)g.ldaB + (unsigned)(C_ * 2); } } while (0)
#define PG8_GDMA(bufp, glp) __builtin_amdgcn_global_load_lds((const unsigned*)((glp) + lane * 4), (LAS unsigned*)(bufp), 16, 0, 0)
    const unsigned ldsw = (unsigned)wid * 1024u;
    const int aoff = lds_byte(wr * 64 + fr, fq * 8), boff = lds_byte(wc * 32 + fr, fq * 8);
#define PG8_SA(b, h) (((b) * 2 + (h)) * HTB)
#define PG8_SB(b, h) ((4 + (b) * 2 + (h)) * HTB)
#define PG8_STAGE(bufoff, gbase, voff) do { _Pragma("unroll") for (int _i = 0; _i < 2; ++_i) \
        __builtin_amdgcn_global_load_lds((const unsigned*)((const char*)(gbase) + (voff)[_i]), (LAS unsigned*)(lds + (bufoff) + ldsw + _i * 8192), 16, 0, 0); } while (0)
#define PG8_LDA(dst, b, h) do { _Pragma("unroll") for (int m = 0; m < 4; ++m) _Pragma("unroll") for (int k = 0; k < 2; ++k) dst[m][k] = *(const LAS bf16x8*)(lds + PG8_SA(b, h) + aoff + m * 2048 + k * 1024); } while (0)
#define PG8_LDB(dst, b, h) do { _Pragma("unroll") for (int n = 0; n < 2; ++n) _Pragma("unroll") for (int k = 0; k < 2; ++k) dst[n][k] = *(const LAS bf16x8*)(lds + PG8_SB(b, h) + boff + n * 2048 + k * 1024); } while (0)
#define PG8_CAT(x) __builtin_shufflevector(__builtin_bit_cast(i32x4, x[0]), __builtin_bit_cast(i32x4, x[1]), 0, 1, 2, 3, 4, 5, 6, 7)
#define PG8_MMA(ai, bj, At, Bt) do { __builtin_amdgcn_s_setprio(1); \
        if constexpr (FP8) { _Pragma("unroll") for (int m = 0; m < 4; ++m) _Pragma("unroll") for (int n = 0; n < 2; ++n) \
            asm volatile("v_mfma_scale_f32_16x16x128_f8f6f4 %0, %1, %2, %0, %3, %3 op_sel_hi:[0,0,0]" : "+v"(acc[ai][bj][m][n]) : "v"(PG8_CAT(Bt[n])), "v"(PG8_CAT(At[m])), "v"(scl1)); } \
        else { _Pragma("unroll") for (int m = 0; m < 4; ++m) _Pragma("unroll") for (int n = 0; n < 2; ++n) _Pragma("unroll") for (int k = 0; k < 2; ++k) \
            acc[ai][bj][m][n] = __builtin_amdgcn_mfma_f32_16x16x32_bf16(Bt[n][k], At[m][k], acc[ai][bj][m][n], 0, 0, 0); } \
        __builtin_amdgcn_s_setprio(0); } while (0)
#define PG8_WAIT_V(n) asm volatile("s_waitcnt vmcnt(" #n ")" ::: "memory")
#define PG8_WAIT_L(n) asm volatile("s_waitcnt lgkmcnt(" #n ")" ::: "memory")
#define PG8_BAR __builtin_amdgcn_s_barrier()
#define PG8_SCHED __builtin_amdgcn_sched_barrier(0)
    int scl1 = 0x7F7F7F7F; asm volatile("" : "+v"(scl1));
#define PG8_STAGEA(bufoff, gbase, h, offs) do { if constexpr (GATHER) { unsigned go_[2]; PG8_GOFF(go_, idxbuf + 256 * (ui & 1), cur.nvalid, h); PG8_STAGE(bufoff, gbase, go_); } else { PG8_STAGE(bufoff, (gbase) + (h) * hstepA, voffA); } } while (0)
    Unit cur, nxt; int ui = 0;
    if (!S.next(0, cur)) return;
    u32x2 gcar[Epi::CHAIN ? 2 : 1][Epi::CHAIN ? 4 : 1][Epi::CHAIN ? 2 : 1];
    if constexpr (Epi::CHAIN) { _Pragma("unroll") for (int a_ = 0; a_ < 2; ++a_) _Pragma("unroll") for (int m_ = 0; m_ < 4; ++m_) _Pragma("unroll") for (int b_ = 0; b_ < 2; ++b_) gcar[a_][m_][b_] = (u32x2){0u, 0u}; }
    if constexpr (GATHER) { if (wid == 0) PG8_GDMA(idxbuf, cur.gl); asm volatile("s_waitcnt vmcnt(0)" ::: "memory"); __builtin_amdgcn_s_barrier(); }
    if (g.stagger > 0) { const unsigned long long t0 = __builtin_amdgcn_s_memrealtime(), dl = (unsigned long long)((blockIdx.x >> 3) & 3) * (unsigned)g.stagger;
        while (__builtin_amdgcn_s_memrealtime() - t0 < dl) __builtin_amdgcn_s_sleep(8); }
    f32x4 acc[2][2][4][2];
#pragma unroll
    for (int a = 0; a < 2; ++a)
#pragma unroll
        for (int b = 0; b < 2; ++b)
#pragma unroll
            for (int m = 0; m < 4; ++m)
#pragma unroll
                for (int n = 0; n < 2; ++n) acc[a][b][m][n] = (f32x4){0.f, 0.f, 0.f, 0.f};
    bf16x8 At[4][2], B0[2][2], B1[2][2];
    const char* cA = cur.A; const char* cB = cur.B;
    PG8_STAGE(PG8_SB(0, 0), cB, voffB); PG8_STAGE(PG8_SB(0, 1), cB + hstepB, voffB); PG8_STAGEA(PG8_SA(0, 0), cA, 0, co); PG8_STAGEA(PG8_SA(0, 1), cA, 1, co);
    if (wr == 1) PG8_BAR;
    PG8_WAIT_V(2); PG8_BAR;
    PG8_STAGE(PG8_SB(1, 0), cB + kstep, voffB); PG8_STAGEA(PG8_SA(1, 0), cA + kstep, 0, co); PG8_STAGE(PG8_SB(1, 1), cB + hstepB + kstep, voffB);
    PG8_WAIT_V(6); PG8_BAR;
    for (;;) {
        const bool has_next = S.next(ui + 1, nxt);
        const char* nA = has_next ? nxt.A : cA; const char* nB = has_next ? nxt.B : cB;
        if constexpr (GATHER) { if (has_next && wid == 0) PG8_GDMA(idxbuf + 256 * ((ui + 1) & 1), nxt.gl); }
        unsigned warm0 = 0u, warm1 = 0u;
        if constexpr (Epi::WARM) E.warm(cur, tid, warm0, warm1);
        for (int t = 0; t < nt; t += 2) {
            const bool last = (t == nt - 2);
            const char* a1 = cA + (size_t)(t + 1) * kstep;
            const char* a2 = last ? nA : cA + (size_t)(t + 2) * kstep; const char* b2 = last ? nB : cB + (size_t)(t + 2) * kstep;
            const char* a3 = a2 + kstep; const char* b3 = b2 + kstep;
#define PG8_STAGEX(bufoff, gbase, h) do { if constexpr (GATHER) { unsigned go_[2]; const bool nx_ = last && has_next;   \
        PG8_GOFF(go_, idxbuf + 256 * ((nx_ ? ui + 1 : ui) & 1), (nx_ ? nxt.nvalid : cur.nvalid), h); PG8_STAGE(bufoff, gbase, go_); } else { PG8_STAGE(bufoff, (gbase) + (h) * hstepA, voffA); } } while (0)
            PG8_LDB(B0, 0, 0); PG8_LDB(B1, 0, 1); PG8_SCHED; PG8_LDA(At, 0, 0); PG8_STAGEA(PG8_SA(1, 1), a1, 1, co);
            PG8_WAIT_V(8); PG8_WAIT_L(0); PG8_BAR; PG8_MMA(0, 0, At, B0); PG8_MMA(0, 1, At, B1); PG8_BAR; PG8_SCHED;
            PG8_LDA(At, 0, 1); PG8_STAGE(PG8_SB(0, 0), b2, voffB); PG8_STAGE(PG8_SB(0, 1), b2 + hstepB, voffB); PG8_STAGEX(PG8_SA(0, 0), a2, 0);
            PG8_WAIT_V(8); PG8_WAIT_L(0); PG8_BAR; PG8_MMA(1, 0, At, B0); PG8_MMA(1, 1, At, B1); PG8_BAR; PG8_SCHED;
            PG8_LDB(B0, 1, 0); PG8_LDB(B1, 1, 1); PG8_SCHED; PG8_LDA(At, 1, 0); PG8_STAGEX(PG8_SA(0, 1), a2, 1);
            PG8_WAIT_V(8); PG8_WAIT_L(0); PG8_BAR; PG8_MMA(0, 0, At, B0); PG8_MMA(0, 1, At, B1); PG8_BAR; PG8_SCHED;
            PG8_LDA(At, 1, 1); PG8_STAGE(PG8_SB(1, 0), b3, voffB); PG8_STAGE(PG8_SB(1, 1), b3 + hstepB, voffB); PG8_STAGEX(PG8_SA(1, 0), a3, 0);
            PG8_WAIT_V(8); PG8_WAIT_L(0); PG8_BAR; PG8_MMA(1, 0, At, B0); PG8_MMA(1, 1, At, B1); PG8_BAR; PG8_SCHED;
        }
        if (wr == 0) PG8_BAR;
        if constexpr (Epi::WARM) asm volatile("s_waitcnt vmcnt(0)" : "+v"(warm0), "+v"(warm1) :: "memory");
        if constexpr (FP8) asm volatile("s_nop 15\n\ts_nop 15" ::: "memory");
        bool keep = false;
        { unsigned ones_ = ~0u; asm volatile("" : "+s"(ones_)); int t2 = (int)__builtin_amdgcn_mbcnt_hi(ones_, __builtin_amdgcn_mbcnt_lo(ones_, 0u)); asm volatile("" : "+v"(t2));
          if constexpr (Epi::CHAIN) keep = E.chain(acc, gcar, cur, wr, wc, (t2 & 63) & 15, (t2 & 63) >> 4);
          else E(acc, cur, wr, wc, (t2 & 63) & 15, (t2 & 63) >> 4); }
        if (!has_next) break;
        if (!keep) {
#pragma unroll
        for (int a = 0; a < 2; ++a)
#pragma unroll
            for (int b = 0; b < 2; ++b)
#pragma unroll
                for (int m = 0; m < 4; ++m)
#pragma unroll
                    for (int n = 0; n < 2; ++n) acc[a][b][m][n] = (f32x4){0.f, 0.f, 0.f, 0.f};
        }
        cur = nxt; cA = nA; cB = nB; ++ui;
        if (wr == 1) PG8_BAR;
    }
    PG8_WAIT_V(0);
    PG8_BAR;
#undef PG8_SA
#undef PG8_SB
#undef PG8_STAGE
#undef PG8_STAGEA
#undef PG8_STAGEX
#undef PG8_GOFF
#undef PG8_GDMA
#undef PG8_LDA
#undef PG8_LDB
#undef PG8_MMA
#undef PG8_CAT
#undef PG8_WAIT_V
#undef PG8_WAIT_L
#undef PG8_BAR
#undef PG8_SCHED
}

struct EpiProj {
    static constexpr bool WARM = false, CHAIN = false;
    bf16_t* O; const LAS float* bmerge; float scale; int dry, pad_;
    __device__ __forceinline__ void operator()(const f32x4 (&acc)[2][2][4][2], const Unit& u, int wr, int wc, int fr, int fq) const {
        const int row0 = u.pm * BM + wr * 64 + fr, col0 = u.pn * BM + wc * 32 + 8 * fq;
        const int mode = (u.pn == 2 || u.pn == 3) ? 1 : (u.pn >= 10 ? 2 : 0);
        f32x4 bv[2][2];
#pragma unroll
        for (int bj = 0; bj < 2; ++bj)
#pragma unroll
            for (int n = 0; n < 2; ++n) bv[bj][n] = (mode == 2) ? *(const LAS f32x4*)(bmerge + (col0 - C_MG) + bj * HALF + 4 * n) : (f32x4){0.f, 0.f, 0.f, 0.f};
#pragma unroll
        for (int ai = 0; ai < 2; ++ai)
#pragma unroll
            for (int m = 0; m < 4; ++m) { bf16_t* rowp = O + (size_t)(row0 + ai * HALF + m * 16) * NIN + col0;
#pragma unroll
                for (int bj = 0; bj < 2; ++bj) {
                    if (mode == 2) {
                        const float ns = -1.4426950409f * scale; unsigned lo = 0u, hi = 0u;
#pragma unroll
                        for (int j = 0; j < 4; ++j) { const float e0 = __builtin_amdgcn_exp2f(acc[ai][bj][m][0][j] * ns + bv[bj][0][j]), e1 = __builtin_amdgcn_exp2f(acc[ai][bj][m][1][j] * ns + bv[bj][1][j]);
                            lo = __builtin_amdgcn_cvt_pk_u8_f32(__builtin_amdgcn_rcpf(__builtin_amdgcn_fmed3f(e0 * (1.0f / 255.0f) + (1.0f / 255.0f), 0.0f, 1.0f)), j, lo); hi = __builtin_amdgcn_cvt_pk_u8_f32(__builtin_amdgcn_rcpf(__builtin_amdgcn_fmed3f(e1 * (1.0f / 255.0f) + (1.0f / 255.0f), 0.0f, 1.0f)), j, hi); }
                        u32x2 w8; w8.x = lo; w8.y = hi;
                        if (!dry) *(u32x2*)((unsigned char*)(O + (size_t)(row0 + ai * HALF + m * 16) * NIN + C_MG) + (col0 - C_MG) + bj * HALF) = w8; continue; }
                    f32x4 v0 = acc[ai][bj][m][0] * scale + bv[bj][0], v1 = acc[ai][bj][m][1] * scale + bv[bj][1];
                    if (mode == 1) {
#pragma unroll
                        for (int j = 0; j < 4; ++j) { v0[j] = gelu_tanh(v0[j]); v1[j] = gelu_tanh(v1[j]); } }
                    u32x4 w; w.x = cvt_pk_bf16(v0[0], v0[1]); w.y = cvt_pk_bf16(v0[2], v0[3]); w.z = cvt_pk_bf16(v1[0], v1[1]); w.w = cvt_pk_bf16(v1[2], v1[3]);
                    if (!dry) *(u32x4*)(rowp + bj * HALF) = w; } }
    }
};
struct EpiPlain {
    static constexpr bool WARM = false, CHAIN = false;
    bf16_t* O; int ldc; float scale; bool dry = false;
    __device__ __forceinline__ void operator()(const f32x4 (&acc)[2][2][4][2], const Unit& u, int wr, int wc, int fr, int fq) const {
        const int row0 = u.pm * BM + wr * 64 + fr, col0 = u.pn * BM + wc * 32 + 8 * fq;
#pragma unroll
        for (int ai = 0; ai < 2; ++ai)
#pragma unroll
            for (int m = 0; m < 4; ++m) { bf16_t* rowp = O + (size_t)(row0 + ai * HALF + m * 16) * ldc + col0;
#pragma unroll
                for (int bj = 0; bj < 2; ++bj) { const f32x4 v0 = acc[ai][bj][m][0] * scale, v1 = acc[ai][bj][m][1] * scale;
                    u32x4 w; w.x = cvt_pk_bf16(v0[0], v0[1]); w.y = cvt_pk_bf16(v0[2], v0[3]); w.z = cvt_pk_bf16(v1[0], v1[1]); w.w = cvt_pk_bf16(v1[2], v1[3]);
                    if (!dry) *(u32x4*)(rowp + bj * HALF) = w; } }
    }
};
struct EpiPlain8 {
    static constexpr bool WARM = false, CHAIN = false;
    unsigned char* O; int ldc; float scale;
    __device__ __forceinline__ void operator()(const f32x4 (&acc)[2][2][4][2], const Unit& u, int wr, int wc, int fr, int fq) const {
        const int row0 = u.pm * BM + wr * 64 + fr, col0 = u.pn * BM + wc * 32 + 8 * fq;
#pragma unroll
        for (int ai = 0; ai < 2; ++ai)
#pragma unroll
            for (int m = 0; m < 4; ++m) { unsigned char* rowp = O + (size_t)(row0 + ai * HALF + m * 16) * ldc + col0;
#pragma unroll
                for (int bj = 0; bj < 2; ++bj) { const f32x4 v0 = acc[ai][bj][m][0] * scale, v1 = acc[ai][bj][m][1] * scale;
                    u32x2 w; w.x = pk4_fp8(v0[0], v0[1], v0[2], v0[3]); w.y = pk4_fp8(v1[0], v1[1], v1[2], v1[3]);
                    *(u32x2*)(rowp + bj * HALF) = w; } }
    }
};
struct EpiMerge {
    static constexpr bool WARM = false, CHAIN = true;
    const bf16_t* P; bf16_t* O;
    __device__ __forceinline__ bool chain(f32x4 (&acc)[2][2][4][2], u32x2 (&gcar)[2][4][2], const Unit& u, int wr, int wc, int fr, int fq) const {
        const int row0 = u.pm * BM + wr * 64 + fr, col0 = u.pn * BM + wc * 32 + 8 * fq; const int b = u.aux;
        u32x2 gt[2][4][2], gn[2][4][2];
        const unsigned char* gp0 = (const unsigned char*)(P + (size_t)row0 * NIN + C_MG) + b * D + col0;
#define EM_LOADS(arr, off) _Pragma("unroll") for (int ai = 0; ai < 2; ++ai) _Pragma("unroll") for (int m = 0; m < 4; ++m) _Pragma("unroll") for (int bj = 0; bj < 2; ++bj) \
            arr[ai][m][bj] = *(const u32x2*)(gp0 + (size_t)(ai * HALF + m * 16) * (NIN * 2) + (off) + bj * HALF)
#define EM_COPY(dst, src) _Pragma("unroll") for (int ai = 0; ai < 2; ++ai) _Pragma("unroll") for (int m = 0; m < 4; ++m) _Pragma("unroll") for (int bj = 0; bj < 2; ++bj) dst[ai][m][bj] = src[ai][m][bj]
#define EM_PIN(arr) _Pragma("unroll") for (int ai = 0; ai < 2; ++ai) \
            asm volatile("" : "+v"(arr[ai][0][0]), "+v"(arr[ai][0][1]), "+v"(arr[ai][1][0]), "+v"(arr[ai][1][1]), "+v"(arr[ai][2][0]), "+v"(arr[ai][2][1]), "+v"(arr[ai][3][0]), "+v"(arr[ai][3][1]))
        if (b == 0) { EM_LOADS(gt, 0); EM_LOADS(gn, D); EM_PIN(gt); EM_PIN(gn); }
        else if (b == 1) { EM_COPY(gt, gcar); EM_LOADS(gn, D); EM_PIN(gn); }
        else { EM_COPY(gt, gcar); EM_COPY(gn, gcar); }
        EM_COPY(gcar, gn);
#undef EM_LOADS
#undef EM_COPY
#undef EM_PIN
#pragma unroll
        for (int ai = 0; ai < 2; ++ai)
#pragma unroll
            for (int m = 0; m < 4; ++m) { const size_t row = (size_t)(row0 + ai * HALF + m * 16); bf16_t* op = O + row * D + col0;
#pragma unroll
                for (int bj = 0; bj < 2; ++bj) { const u32x2 gt_ = gt[ai][m][bj];
                    float gv[8];
#pragma unroll
                    for (int j = 0; j < 4; ++j) { gv[j] = (float)((gt_.x >> (8 * j)) & 0xffu); gv[4 + j] = (float)((gt_.y >> (8 * j)) & 0xffu); }
                    if (b < 2) { const u32x2 gn_ = gn[ai][m][bj];
#pragma unroll
                        for (int j = 0; j < 4; ++j) { gv[j] *= __builtin_amdgcn_rcpf((float)((gn_.x >> (8 * j)) & 0xffu)); gv[4 + j] *= __builtin_amdgcn_rcpf((float)((gn_.y >> (8 * j)) & 0xffu)); } }
                    f32x4 v0 = acc[ai][bj][m][0], v1 = acc[ai][bj][m][1];
#pragma unroll
                    for (int j = 0; j < 4; ++j) { v0[j] *= gv[j]; v1[j] *= gv[4 + j]; }
                    if (b < 2) { acc[ai][bj][m][0] = v0; acc[ai][bj][m][1] = v1; }
                    else { u32x4 w; w.x = cvt_pk_bf16(v0[0], v0[1]); w.y = cvt_pk_bf16(v0[2], v0[3]); w.z = cvt_pk_bf16(v1[0], v1[1]); w.w = cvt_pk_bf16(v1[2], v1[3]);
                        *(u32x4*)(op + bj * HALF) = w; } } }
        return b < 2;
    }
};
struct EpiSwiglu {
    static constexpr bool WARM = false, CHAIN = false;
    unsigned char* O; float scale;
    __device__ __forceinline__ void operator()(const f32x4 (&acc)[2][2][4][2], const Unit& u, int wr, int wc, int fr, int fq) const {
        const int row0 = u.pm * BM + wr * 64 + fr, col0 = u.pn * HALF + wc * 32 + 8 * fq;
#pragma unroll
        for (int ai = 0; ai < 2; ++ai)
#pragma unroll
            for (int m = 0; m < 4; ++m) { unsigned char* rowp = O + (size_t)(row0 + ai * HALF + m * 16) * D + col0;
                f32x4 v0 = acc[ai][0][m][0], v1 = acc[ai][0][m][1]; const f32x4 g0 = acc[ai][1][m][0], g1 = acc[ai][1][m][1];
                const float ns = -1.4426950409f * scale, is2 = 1.0f / (scale * scale);
#pragma unroll
                for (int j = 0; j < 4; ++j) { v0[j] = (v0[j] * g0[j]) * __builtin_amdgcn_rcpf(__builtin_fmaf(__builtin_amdgcn_exp2f(v0[j] * ns), is2, is2)); v1[j] = (v1[j] * g1[j]) * __builtin_amdgcn_rcpf(__builtin_fmaf(__builtin_amdgcn_exp2f(v1[j] * ns), is2, is2)); }
                u32x2 w; w.x = pk4_fp8(v0[0], v0[1], v0[2], v0[3]); w.y = pk4_fp8(v1[0], v1[1], v1[2], v1[3]);
                *(u32x2*)rowp = w; }
    }
};
}
namespace attn_body {
using bf16 = __hip_bfloat16;
using s16x4 = __attribute__((ext_vector_type(4))) short;
using f32x16 = __attribute__((ext_vector_type(16))) float;
constexpr int DM = NIN;
constexpr int NW = 8, QBLK = 32, QB = QBLK * NW, KVBLK = 64;
__device__ __forceinline__ int crow(int r, int hi) { return (r & 3) + 8 * (r >> 2) + 4 * hi; }
#define SBAR() __builtin_amdgcn_sched_barrier(0)
constexpr int NSLOT = 3, SLOTB = 8192;
constexpr int LDS_K = 0, LDS_V = NSLOT * SLOTB, LDS_WS = 2 * NSLOT * SLOTB, LDS_OST = LDS_WS + NW * 64 * 4, LDS_BYTES = LDS_OST + NW * 4096;
constexpr float LOG2E = 1.4426950408889634f;
constexpr float C2 = 0.125f * LOG2E;
__device__ __forceinline__ void glds16(const void* gsrc, unsigned lds_dst) { unsigned keep;
    asm volatile("s_mov_b32 %0, m0\n\ts_mov_b32 m0, %2\n\ts_nop 0\n\tglobal_load_lds_dwordx4 %1, off\n\ts_mov_b32 m0, %0" : "=&s"(keep) : "v"(gsrc), "s"(lds_dst) : "memory"); }
__device__ __forceinline__ float max3f(float a, float b, float c) { float r; asm("v_max3_f32 %0, %1, %2, %3" : "=v"(r) : "v"(a), "v"(b), "v"(c)); return r; }
__device__ __forceinline__ float max2f(float a, float b) { float r; asm("v_max_f32_e32 %0, %1, %2" : "=v"(r) : "v"(a), "v"(b)); return r; }
__device__ __forceinline__ float fadd_s(float a, float b) { float r; asm("v_add_f32_e32 %0, %1, %2" : "=v"(r) : "v"(a), "v"(b)); return r; }
__device__ __forceinline__ float fsub_s(float a, float b) { float r; asm("v_sub_f32_e32 %0, %1, %2" : "=v"(r) : "v"(a), "v"(b)); return r; }
typedef float f32x2_t __attribute__((ext_vector_type(2))); typedef __bf16 bf16x2_t __attribute__((ext_vector_type(2)));
__device__ __forceinline__ unsigned cvtpk_s(float lo, float hi) { f32x2_t v = {lo, hi}; bf16x2_t b = __builtin_convertvector(v, bf16x2_t); return __builtin_bit_cast(unsigned, b); }
#define WAIT_BAR(N) asm volatile("s_waitcnt vmcnt(" #N ") lgkmcnt(0)\n\ts_barrier" ::: "memory")

__device__ __forceinline__ void qkt(f32x16& p0, f32x16& p1, const char* Kslot, const bf16x8* qr, const f32x16& negm, int r32, int hi) {
    const char* kb = Kslot + hi * 1024 + r32 * 16;
#pragma unroll
    for (int d0 = 0; d0 < 4; ++d0) {
        const bf16x8 b0 = *reinterpret_cast<const bf16x8*>(kb + d0 * 2048);
        const bf16x8 b1 = *reinterpret_cast<const bf16x8*>(kb + d0 * 2048 + 512);
        if (d0 == 0) { p0 = __builtin_amdgcn_mfma_f32_32x32x16_bf16(b0, qr[0], negm, 0, 0, 0); p1 = __builtin_amdgcn_mfma_f32_32x32x16_bf16(b1, qr[0], negm, 0, 0, 0); }
        else { p0 = __builtin_amdgcn_mfma_f32_32x32x16_bf16(b0, qr[d0], p0, 0, 0, 0); p1 = __builtin_amdgcn_mfma_f32_32x32x16_bf16(b1, qr[d0], p1, 0, 0, 0); } }
}
typedef __attribute__((address_space(3))) const char* lds_cptr;
typedef short v4i16_t __attribute__((ext_vector_type(4)));
__device__ __forceinline__ void kload8(bf16x8* kf, lds_cptr kp) {
    kf[0] = *(const LAS bf16x8*)(kp);        kf[1] = *(const LAS bf16x8*)(kp + 512);
    kf[2] = *(const LAS bf16x8*)(kp + 2048); kf[3] = *(const LAS bf16x8*)(kp + 2560);
    kf[4] = *(const LAS bf16x8*)(kp + 4096); kf[5] = *(const LAS bf16x8*)(kp + 4608);
    kf[6] = *(const LAS bf16x8*)(kp + 6144); kf[7] = *(const LAS bf16x8*)(kp + 6656);
}
__device__ __forceinline__ void kload2(bf16x8* kf, lds_cptr kp, int j) { kf[2 * j] = *(const LAS bf16x8*)(kp + j * 2048); kf[2 * j + 1] = *(const LAS bf16x8*)(kp + j * 2048 + 512); }
__device__ __forceinline__ s16x4 vtr(lds_cptr p) { return __builtin_bit_cast(s16x4, __builtin_amdgcn_ds_read_tr16_b64_v4i16((LAS v4i16_t*)p)); }
__device__ __forceinline__ float rowmax(const f32x16& p0, const f32x16& p1) {
    float a = max3f(p0[0], p0[1], p1[0]), b = max3f(p0[2], p0[3], p1[1]); a = max3f(a, p1[2], p1[3]);
#pragma unroll
    for (int r = 4; r < 16; r += 4) { a = max3f(a, p0[r], p0[r + 1]); b = max3f(b, p0[r + 2], p0[r + 3]); a = max3f(a, p1[r], p1[r + 1]); b = max3f(b, p1[r + 2], p1[r + 3]); }
    const float m = max2f(a, b);
    auto rr = __builtin_amdgcn_permlane32_swap(__float_as_uint(m), __float_as_uint(m), false, false);
    return max2f(__uint_as_float(rr[0]), __uint_as_float(rr[1]));
}
__device__ __forceinline__ void pv(f32x16* o, int vb, bf16x8 pa0, bf16x8 pa1, bf16x8 pa2, bf16x8 pa3) {
#pragma unroll
    for (int d0 = 0; d0 < 2; ++d0) { s16x4 lo[4], hi[4];
#pragma unroll
        for (int ks = 0; ks < 4; ++ks) {
            asm volatile("ds_read_b64_tr_b16 %0,%1 offset:%c2" : "=&v"(lo[ks]) : "v"(vb), "i"(d0 * 4096 + ks * 1024) : "memory");
            asm volatile("ds_read_b64_tr_b16 %0,%1 offset:%c2" : "=&v"(hi[ks]) : "v"(vb), "i"(d0 * 4096 + ks * 1024 + 512) : "memory"); }
        asm volatile("s_waitcnt lgkmcnt(0)" ::: "memory"); SBAR();
#define PK(k) (bf16x8){lo[k][0], lo[k][1], lo[k][2], lo[k][3], hi[k][0], hi[k][1], hi[k][2], hi[k][3]}
        o[d0] = __builtin_amdgcn_mfma_f32_32x32x16_bf16(pa0, PK(0), o[d0], 0, 0, 0);
        o[d0] = __builtin_amdgcn_mfma_f32_32x32x16_bf16(pa1, PK(1), o[d0], 0, 0, 0);
        o[d0] = __builtin_amdgcn_mfma_f32_32x32x16_bf16(pa2, PK(2), o[d0], 0, 0, 0);
        o[d0] = __builtin_amdgcn_mfma_f32_32x32x16_bf16(pa3, PK(3), o[d0], 0, 0, 0);
#undef PK
    }
}
__device__ __forceinline__ void wmask(f32x16& p0, f32x16& p1, int dk0, int hi) {
    const float NEG = -INFINITY; const int kb = dk0 + 4 * hi;
#pragma unroll
    for (int r = 0; r < 16; ++r) { const int d = kb + (r & 3) + 8 * (r >> 2); if (d > 128 || d < -128) p0[r] = NEG; if (d + 32 > 128 || d + 32 < -128) p1[r] = NEG; }
}

struct AttnArgs { bf16* P; const float* qg; const float* ropec; const float* ropes; const float* sinkp; float sink; bool dry; };

constexpr int LDS_QST = LDS_BYTES;
template <int MODE> __device__ __forceinline__ const bf16* q_wave_ptr(const AttnArgs& aa, int wid, int b, int h, int qb) {
    constexpr bool LAT = (MODE < 2), WIN = (MODE == 1); constexpr int QCOL = (MODE == 0 || MODE == 2) ? C_GQ : C_WQ;
    const int wq = WIN ? (wid & 3) : wid, hh = WIN ? 2 * h + (wid >> 2) : h;
    const long qrow0 = (long)b * TB + (LAT ? NCTX : 0) + qb * (WIN ? QB / 2 : QB) + wq * QBLK;
    return aa.P + qrow0 * DM + QCOL + hh * 64;
}
template <int MODE, int THRL, bool NOMAX> __device__ __forceinline__ void attn_unit(int tid0, int b, int h, int qb, const AttnArgs& aa, char* shm, bool staged = false, bool has_next = false, const bf16* Qnext = nullptr) {
    constexpr bool LAT = (MODE < 2), WIN = (MODE == 1), SINK = (MODE == 1 || MODE == 3);
    constexpr int NT = (MODE == 0) ? 68 : (MODE == 1 ? 10 : 4);
    constexpr int QCOL = (MODE == 0 || MODE == 2) ? C_GQ : C_WQ, KCOL = (MODE == 0 || MODE == 2) ? C_GK : C_WK, VCOL = (MODE == 0 || MODE == 2) ? C_GV : C_WV;
    int tid_ = tid0; asm volatile("" : "+v"(tid_));
    const int tid = tid_, lane = tid & 63, r32 = lane & 31, hi = lane >> 5; const int wid = __builtin_amdgcn_readfirstlane(tid >> 6);
    const int wq = WIN ? (wid & 3) : wid, hh = WIN ? 2 * h + (wid >> 2) : h;
    const long rowbase = (long)b * TB; const int q0 = qb * (WIN ? QB / 2 : QB);
    const long qrow0 = rowbase + (LAT ? NCTX : 0) + q0 + wq * QBLK;
    const int kvh = hh >> 2;
    const bf16* Qw = q_wave_ptr<MODE>(aa, wid, b, h, qb);
    const float sinkv = SINK ? (WIN ? *(const __attribute__((address_space(4))) float*)(aa.sinkp + hh) : aa.sink) : 0.f;
    const bf16* Kh = aa.P + rowbase * DM + KCOL + kvh * 64, *Vh = aa.P + rowbase * DM + VCOL + kvh * 64;
    const unsigned lds0 = (unsigned)(uintptr_t)shm;
    float* wsf = (float*)(shm + LDS_WS) + wid * 64;
    const bf16* ksrc = Kh + (long)lane * DM + wid * 8;
    const bf16* vsrc = Vh + (long)(16 * (wid & 3) + (lane >> 2)) * DM + (wid >> 2) * 32 + (lane & 3) * 8;
    const unsigned kdst = lds0 + LDS_K + wid * 1024, vdst = lds0 + LDS_V + wid * 1024;
    int kstart = 0; if (WIN) { kstart = q0 - 128; kstart = kstart < 0 ? 0 : kstart; kstart = kstart > SEQ - 384 ? SEQ - 384 : kstart; }
#define TROW(t) (WIN ? (((t) < 4) ? 64 * (t) : NCTX + kstart + 64 * ((t) - 4)) : 64 * (t))
#define DMA_K(t, slot) glds16(ksrc + (long)TROW(t) * DM, (unsigned)__builtin_amdgcn_readfirstlane(kdst + (slot)))
#define DMA_V(t, slot) glds16(vsrc + (long)TROW(t) * DM, (unsigned)__builtin_amdgcn_readfirstlane(vdst + (slot)))
    const int vb0 = (int)(lds0 + LDS_V) + ((lane >> 4) & 1) * 32 + (lane & 3) * 8 + (4 * hi + ((lane & 15) >> 2)) * 64;
    const char* Kbase = shm + LDS_K; bf16x8 kf[8];
    const lds_cptr shm3 = (lds_cptr)shm; const lds_cptr kp0 = shm3 + LDS_K + hi * 1024 + r32 * 16; const lds_cptr vp0 = shm3 + LDS_V + ((lane >> 4) & 1) * 32 + (lane & 3) * 8 + (4 * hi + ((lane & 15) >> 2)) * 64;
    DMA_K(0, 0); DMA_V(0, 0); DMA_K(1, SLOTB); DMA_K(2, 2 * SLOTB); DMA_V(1, SLOTB);
    bf16x8 qr[4];
    {
        bf16x8 qraw[4];
        if (staged) { const lds_cptr qs = shm3 + LDS_QST + wid * 4096 + r32 * 128 + hi * 16;
#pragma unroll
            for (int d0 = 0; d0 < 4; ++d0) qraw[d0] = *(const LAS bf16x8*)(qs + d0 * 32);
            asm volatile("s_waitcnt lgkmcnt(0)" ::: "memory"); }
        else {
#pragma unroll
            for (int d0 = 0; d0 < 4; ++d0) qraw[d0] = *reinterpret_cast<const bf16x8*>(&Qw[(long)r32 * DM + d0 * 16 + hi * 8]); }
        if (has_next) {
#pragma unroll
            for (int i = 0; i < 4; ++i) glds16(Qnext + (long)(8 * i + (lane >> 3)) * DM + (lane & 7) * 8, (unsigned)__builtin_amdgcn_readfirstlane(lds0 + LDS_QST + wid * 4096 + i * 1024)); }
        float qf[4][8]; float ss = 0.f;
#pragma unroll
        for (int d0 = 0; d0 < 4; ++d0)
#pragma unroll
            for (int j = 0; j < 8; ++j) { qf[d0][j] = __uint_as_float(((unsigned)(unsigned short)qraw[d0][j]) << 16); ss += qf[d0][j] * qf[d0][j]; }
        { auto rr = __builtin_amdgcn_permlane32_swap(__float_as_uint(ss), __float_as_uint(ss), false, false); ss = __uint_as_float(rr[0]) + __uint_as_float(rr[1]); }
        const float rinv = 1.0f / sqrtf(ss * (1.0f / 64.0f) + EPS);
#pragma unroll
        for (int d0 = 0; d0 < 4; ++d0) { const f32x4 g0 = *(const f32x4*)(aa.qg + d0 * 16 + hi * 8), g1 = *(const f32x4*)(aa.qg + d0 * 16 + hi * 8 + 4);
#pragma unroll
            for (int j = 0; j < 4; ++j) { qf[d0][j] *= rinv * g0[j]; qf[d0][4 + j] *= rinv * g1[j]; } }
        if (LAT) {
            const int pos = q0 + wq * QBLK + r32;
#pragma unroll
            for (int pr = 0; pr < 2; ++pr) {
                const float* cp = aa.ropec + (size_t)pos * 32 + pr * 16 + hi * 8; const float* sp = aa.ropes + (size_t)pos * 32 + pr * 16 + hi * 8;
                const f32x4 c0 = *(const f32x4*)cp, c1 = *(const f32x4*)(cp + 4), s0 = *(const f32x4*)sp, s1 = *(const f32x4*)(sp + 4);
#pragma unroll
                for (int j = 0; j < 8; ++j) { const float c = j < 4 ? c0[j & 3] : c1[j & 3], s = j < 4 ? s0[j & 3] : s1[j & 3];
                    const float t1 = qf[pr][j], t2 = qf[pr + 2][j]; qf[pr][j] = t1 * c - t2 * s; qf[pr + 2][j] = t2 * c + t1 * s; } }
        }
#pragma unroll
        for (int d0 = 0; d0 < 4; ++d0) { u32x4 w; w.x = cvtpk_s(qf[d0][0] * C2, qf[d0][1] * C2); w.y = cvtpk_s(qf[d0][2] * C2, qf[d0][3] * C2); w.z = cvtpk_s(qf[d0][4] * C2, qf[d0][5] * C2); w.w = cvtpk_s(qf[d0][6] * C2, qf[d0][7] * C2);
            qr[d0] = __builtin_bit_cast(bf16x8, w); }
    }
    float zf = 0.f; asm volatile("" : "+v"(zf));
    float mhat = 0.f, l_reg = 0.f; f32x16 o[2], negm;
#pragma unroll
    for (int r = 0; r < 16; ++r) { o[0][r] = zf; o[1][r] = zf; negm[r] = zf; }
    if constexpr (!NOMAX) asm volatile("" : "+v"(negm));
    const f32x16 zero16 = f32x16{};
#define CINIT (NOMAX ? zero16 : negm)
    const int dkq = kstart - (q0 + wq * QBLK + r32);
#define CMASK(P0, P1, t) do { if (WIN && (t) >= 4) wmask(P0, P1, dkq + 64 * ((t) - 4), hi); } while (0)
    bool resc = false;
#define START(P0, P1) do { resc = false; if constexpr (!NOMAX) { const float rm = rowmax(P0, P1); \
    { const float dl = rm; mhat = fadd_s(mhat, dl); \
      _Pragma("unroll") for (int r = 0; r < 16; ++r) { P0[r] = fsub_s(P0[r], dl); P1[r] = fsub_s(P1[r], dl); } \
      _Pragma("unroll") for (int r = 0; r < 16; ++r) negm[r] = -mhat; asm volatile("" : "+v"(negm)); } } \
    _Pragma("unroll") for (int r = 0; r < 16; ++r) P0[r] = __builtin_amdgcn_exp2f(P0[r]); } while (0)
#define RESC() do { if constexpr (!NOMAX) if (resc) { asm volatile("s_waitcnt lgkmcnt(0)" ::: "memory"); \
      _Pragma("unroll") for (int d_ = 0; d_ < 2; ++d_) _Pragma("unroll") for (int r = 0; r < 16; ++r) o[d_][r] *= wsf[crow(r, hi)]; } } while (0)
    f32x16 pA0, pA1, pB0, pB1;
    int sl_prev = 0, sl_cur = 0, sl_next = SLOTB;
#define ROT() do { sl_prev = sl_cur; sl_cur = sl_next; sl_next = (sl_next == (NSLOT - 1) * SLOTB) ? 0 : sl_next + SLOTB; } while (0)
    if (has_next) { WAIT_BAR(4); } else { WAIT_BAR(0); }
    qkt(pA0, pA1, Kbase, qr, CINIT, r32, hi); asm volatile("s_nop 15\n\ts_nop 7" : "+v"(pA0), "+v"(pA1)); CMASK(pA0, pA1, 0);
    START(pA0, pA1);
    _Pragma("unroll") for (int r = 0; r < 16; ++r) pA1[r] = __builtin_amdgcn_exp2f(pA1[r]);
    if (has_next) { WAIT_BAR(4); } else { WAIT_BAR(0); }
    DMA_K(3, 0);
    ROT();
    kload8(kf, kp0 + sl_cur);
    if (has_next) { WAIT_BAR(5); } else { WAIT_BAR(2); }
    s16x4 vlo[8], vhi[8]; u32x4 pw0, pw1, pw2, pw3;
#define PKW(P, B) cvtpk_s(P[B], P[B + 1])
#define PAF(k) __builtin_bit_cast(bf16x8, pw##k)
#define VFR(i) (bf16x8){vlo[i][0], vlo[i][1], vlo[i][2], vlo[i][3], vhi[i][0], vhi[i][1], vhi[i][2], vhi[i][3]}
#define PIN(x) asm volatile("" : "+v"(x))
#define MX3(a, b, c) __builtin_fmaxf(__builtin_fmaxf((a), (b)), (c))
#define GAPA(MF, A0, A1, A2, A3, W0, W1, PW) do { MF; sacc += A0; sacc += A1; sacc += A2; sacc += A3; PIN(sacc); W0; W1; PIN(PW); SBAR(); } while (0)
#define EX(v) __builtin_amdgcn_exp2f(v)
#define GAPB(MF, X, B) do { MF; X[B] = EX(X[B]); X[B + 1] = EX(X[B + 1]); X[B + 2] = EX(X[B + 2]); X[B + 3] = EX(X[B + 3]); PIN(X); SBAR(); } while (0)
#define VRD(i) do { vlo[i] = vtr(vp_ + (((i) >> 2) * 4096 + ((i) & 3) * 1024)); vhi[i] = vtr(vp_ + (((i) >> 2) * 4096 + ((i) & 3) * 1024 + 512)); } while (0)
#define KRD(G, j) do { if (G) { kload2(kf, kp0 + sl_next, j); SBAR(); } } while (0)
#define STEP(C0, C1, P0, P1, t, GK, GV, GL) do { SBAR(); \
    const lds_cptr vp_ = vp0 + sl_prev; \
    VRD(0); SBAR(); float sacc = (P0[0] + P0[1]); \
    GAPA(C0 = __builtin_amdgcn_mfma_f32_32x32x16_bf16(kf[0], qr[0], CINIT, 0, 0, 0), P0[2], P0[3], P0[4], P0[5],     pw0[0] = PKW(P0, 0), pw0[1] = PKW(P0, 2), pw0); \
    VRD(4); SBAR(); GAPA(C1 = __builtin_amdgcn_mfma_f32_32x32x16_bf16(kf[1], qr[0], CINIT, 0, 0, 0), P0[6], P0[7], P0[8], P0[9],     pw0[2] = PKW(P0, 4), pw0[3] = PKW(P0, 6), pw0); \
    VRD(1); SBAR(); GAPA(C0 = __builtin_amdgcn_mfma_f32_32x32x16_bf16(kf[2], qr[1], C0, 0, 0, 0),   P0[10], P0[11], P0[12], P0[13], pw1[0] = PKW(P0, 8), pw1[1] = PKW(P0, 10), pw1); \
    VRD(5); SBAR(); GAPA(C1 = __builtin_amdgcn_mfma_f32_32x32x16_bf16(kf[3], qr[1], C1, 0, 0, 0),   P0[14], P0[15], P1[0], P1[1],   pw1[2] = PKW(P0, 12), pw1[3] = PKW(P0, 14), pw1); \
    VRD(2); SBAR(); GAPA(C0 = __builtin_amdgcn_mfma_f32_32x32x16_bf16(kf[4], qr[2], C0, 0, 0, 0),   P1[2], P1[3], P1[4], P1[5],     pw2[0] = PKW(P1, 0), pw2[1] = PKW(P1, 2), pw2); \
    VRD(6); SBAR(); GAPA(C1 = __builtin_amdgcn_mfma_f32_32x32x16_bf16(kf[5], qr[2], C1, 0, 0, 0),   P1[6], P1[7], P1[8], P1[9],     pw2[2] = PKW(P1, 4), pw2[3] = PKW(P1, 6), pw2); \
    VRD(3); SBAR(); GAPA(C0 = __builtin_amdgcn_mfma_f32_32x32x16_bf16(kf[6], qr[3], C0, 0, 0, 0),   P1[10], P1[11], P1[12], P1[13], pw3[0] = PKW(P1, 8), pw3[1] = PKW(P1, 10), pw3); \
    VRD(7); SBAR(); GAPA(C1 = __builtin_amdgcn_mfma_f32_32x32x16_bf16(kf[7], qr[3], C1, 0, 0, 0),   P1[14], P1[15], 0.f, 0.f,       pw3[2] = PKW(P1, 12), pw3[3] = PKW(P1, 14), pw3); \
    l_reg += sacc; \
    if (GK) { DMA_K((t) + 3, sl_cur); } if (GV) { DMA_V((t) + 1, sl_next); } \
    CMASK(C0, C1, t); \
    if constexpr (!NOMAX) { float a = MX3(C0[0], C0[1], C1[0]), b = MX3(C0[2], C0[3], C1[1]); a = MX3(a, C1[2], C1[3]); \
      _Pragma("unroll") for (int r = 4; r < 16; r += 4) { a = MX3(a, C0[r], C0[r + 1]); b = MX3(b, C0[r + 2], C0[r + 3]); a = MX3(a, C1[r], C1[r + 1]); b = MX3(b, C1[r + 2], C1[r + 3]); } \
      float rm = __builtin_fmaxf(a, b); { auto rr = __builtin_amdgcn_permlane32_swap(__float_as_uint(rm), __float_as_uint(rm), false, false); rm = __builtin_fmaxf(__uint_as_float(rr[0]), __uint_as_float(rr[1])); } \
      resc = false; \
      if (__builtin_expect(__any(rm > (float)THRL), 0)) { const float dl = __builtin_fmaxf(rm, 0.f); mhat += dl; \
        _Pragma("unroll") for (int r = 0; r < 16; ++r) { C0[r] -= dl; C1[r] -= dl; } \
        _Pragma("unroll") for (int r = 0; r < 16; ++r) negm[r] = -mhat; asm volatile("" : "+v"(negm)); \
        const float f = __builtin_amdgcn_exp2f(-dl); l_reg *= f; if (hi == 0) wsf[r32] = f; resc = true; } } \
    SBAR(); \
    GAPB(o[0] = __builtin_amdgcn_mfma_f32_32x32x16_bf16(PAF(0), VFR(0), o[0], 0, 0, 0), C0, 0); \
    GAPB(o[1] = __builtin_amdgcn_mfma_f32_32x32x16_bf16(PAF(0), VFR(4), o[1], 0, 0, 0), C0, 4); \
    KRD(GL, 0); GAPB(o[0] = __builtin_amdgcn_mfma_f32_32x32x16_bf16(PAF(1), VFR(1), o[0], 0, 0, 0), C0, 8); \
    KRD(GL, 1); GAPB(o[1] = __builtin_amdgcn_mfma_f32_32x32x16_bf16(PAF(1), VFR(5), o[1], 0, 0, 0), C0, 12); \
    KRD(GL, 2); GAPB(o[0] = __builtin_amdgcn_mfma_f32_32x32x16_bf16(PAF(2), VFR(2), o[0], 0, 0, 0), C1, 0); \
    KRD(GL, 3); GAPB(o[1] = __builtin_amdgcn_mfma_f32_32x32x16_bf16(PAF(2), VFR(6), o[1], 0, 0, 0), C1, 4); \
    GAPB(o[0] = __builtin_amdgcn_mfma_f32_32x32x16_bf16(PAF(3), VFR(3), o[0], 0, 0, 0), C1, 8); \
    GAPB(o[1] = __builtin_amdgcn_mfma_f32_32x32x16_bf16(PAF(3), VFR(7), o[1], 0, 0, 0), C1, 12); \
    } while (0)
    int t = 1;
    for (; t + 5 < NT; t += 2) {
        STEP(pB0, pB1, pA0, pA1, t, true, true, true);     WAIT_BAR(2); RESC(); ROT();
        STEP(pA0, pA1, pB0, pB1, t + 1, true, true, true); WAIT_BAR(2); RESC(); ROT();
    }
#define ENDW(tt) do { if ((tt) + 3 < NT) { WAIT_BAR(2); } else if ((tt) + 2 < NT) { WAIT_BAR(1); } else { WAIT_BAR(0); } } while (0)
    for (; t + 1 < NT; t += 2) {
        STEP(pB0, pB1, pA0, pA1, t, (t + 3 < NT), (t + 1 < NT), (t + 1 < NT));         ENDW(t);     RESC(); ROT();
        STEP(pA0, pA1, pB0, pB1, t + 1, (t + 4 < NT), (t + 2 < NT), (t + 2 < NT));     ENDW(t + 1); RESC(); ROT();
    }
    STEP(pB0, pB1, pA0, pA1, NT - 1, false, false, false); RESC();
    { float sacc = pB0[0] + pB0[1]; _Pragma("unroll") for (int r = 2; r < 16; ++r) sacc += pB0[r]; _Pragma("unroll") for (int r = 0; r < 16; ++r) sacc += pB1[r]; l_reg += sacc;
      pw0 = (u32x4){PKW(pB0, 0), PKW(pB0, 2), PKW(pB0, 4), PKW(pB0, 6)}; pw1 = (u32x4){PKW(pB0, 8), PKW(pB0, 10), PKW(pB0, 12), PKW(pB0, 14)}; pw2 = (u32x4){PKW(pB1, 0), PKW(pB1, 2), PKW(pB1, 4), PKW(pB1, 6)}; pw3 = (u32x4){PKW(pB1, 8), PKW(pB1, 10), PKW(pB1, 12), PKW(pB1, 14)};
      SBAR(); pv(o, vb0 + sl_cur, PAF(0), PAF(1), PAF(2), PAF(3)); }
#undef PKW
#undef PAF
#undef VFR
#undef PIN
#undef MX3
#undef GAPA
#undef GAPB
#undef EX
#undef VRD
#undef KRD
#undef STEP
#undef ENDW
    { auto rr = __builtin_amdgcn_permlane32_swap(__float_as_uint(l_reg), __float_as_uint(l_reg), false, false); l_reg = __uint_as_float(rr[0]) + __uint_as_float(rr[1]); }
    if (SINK) l_reg += __builtin_amdgcn_exp2f(sinkv * LOG2E - mhat);
    if (hi == 0) wsf[32 + r32] = l_reg; asm volatile("s_waitcnt lgkmcnt(0)" ::: "memory");
    float rli[16];
#pragma unroll
    for (int r = 0; r < 16; ++r) rli[r] = __builtin_amdgcn_rcpf(wsf[32 + crow(r, hi)]);
    bf16* Ow = aa.P + qrow0 * DM + QCOL + hh * 64;
    { bf16* stg = (bf16*)(shm + LDS_OST) + wid * 2048;
#pragma unroll
      for (int r = 0; r < 16; ++r) { const int orow = crow(r, hi);
#pragma unroll
          for (int d0 = 0; d0 < 2; ++d0) stg[orow * 64 + d0 * 32 + r32] = __float2bfloat16(o[d0][r] * rli[r]); }
      asm volatile("s_waitcnt lgkmcnt(0)" ::: "memory");
#pragma unroll
      for (int i = 0; i < 4; ++i) { const int row = i * 8 + (lane >> 3), ch = lane & 7; const u32x4 v = *(const u32x4*)(stg + row * 64 + ch * 8); if (!aa.dry) *(u32x4*)(Ow + (long)row * DM + ch * 8) = v; } }
    asm volatile("s_waitcnt lgkmcnt(0)\n\ts_barrier" ::: "memory");
#undef DMA_K
#undef DMA_V
#undef TROW
#undef CMASK
#undef START
#undef CINIT
#undef RESC
#undef ROT
}
#undef SBAR
#undef WAIT_BAR
}
constexpr size_t MiB = 1u << 20;
constexpr size_t WS_CTL = 0, CTL_ZERO_BYTES = 64 * 1024;
constexpr size_t WS_MOD = 1 * MiB;
constexpr size_t WS_ROPE = 2 * MiB;
constexpr size_t WS_ROUTE = 3 * MiB;
constexpr size_t WS_WIN = 6 * MiB;
constexpr size_t WS_WBR = 28 * MiB;
constexpr size_t WS_WOUT = 34 * MiB;
constexpr size_t WS_XC = 38 * MiB;
constexpr size_t WS_A = 54 * MiB;
constexpr size_t WS_PROJ = 190 * MiB;
constexpr size_t WS_YBUF = WS_PROJ;
constexpr size_t WS_HG = WS_PROJ + 420 * MiB;
constexpr size_t WS_H8 = WS_A;
constexpr size_t WS_YP = WS_PROJ;
constexpr size_t WS_X1 = WS_PROJ + 140 * MiB;
constexpr size_t WS_HID = WS_PROJ + 280 * MiB;
constexpr size_t WS_W13 = WS_PROJ + 560 * MiB;
constexpr size_t WS_W2 = WS_PROJ + 624 * MiB;
constexpr size_t WS_HIN8 = WS_PROJ + 748 * MiB;
constexpr size_t WS_WIN8 = WS_HIN8 + 68 * MiB;
constexpr size_t WS_PL = WS_WIN8 + 11 * MiB;
constexpr size_t WS_END = WS_PL + (size_t)NE * T * 4;
constexpr int PSPLIT = 4;
static_assert((size_t)T * NIN * 2 == 748 * MiB && (size_t)T * D * 2 == 136 * MiB && (size_t)PMAX * D * 2 == 280 * MiB, "buffer sizes");
static_assert(WS_END <= 1024 * MiB, "workspace map fits 1 GiB");
constexpr int CW_CNT = 64;
constexpr int CW_BAR = 4096;

constexpr int RING_OFF = 0, RING_BYTES = 131072;
constexpr int LDSCTL_OFF = RING_BYTES, MISC_OFF = LDSCTL_OFF + 320, BIAS_OFF = LDSCTL_OFF + 4096;
constexpr int LDS_BYTES = 147456;
constexpr int NWAVES = 8;

typedef GAS unsigned gu32;
#define RLX_AGENT __ATOMIC_RELAXED, __HIP_MEMORY_SCOPE_AGENT
#define LDS_WAIT() asm volatile("s_waitcnt lgkmcnt(0)" ::: "memory")
#define VM_WAIT() asm volatile("s_waitcnt vmcnt(0)" ::: "memory")

#define XB_TMO      128
#define XB_XCNT(j)  (256  + 64 * (j))
#define XB_XSUB(j)  (1280 + 64 * (j))
#define XB_XGEN(j)  (2304 + 64 * (j))
#define XB_TOP      3328
#define XB_TOPGEN   3392
#define XCD_BAR_WORDS 3456
#define XB_SPIN_CAP (1u << 18)
__device__ __forceinline__ unsigned xb_ld(unsigned* p)              { return __hip_atomic_load(p, __ATOMIC_RELAXED, __HIP_MEMORY_SCOPE_AGENT); }
__device__ __forceinline__ unsigned xb_add(unsigned* p, unsigned v) { return __hip_atomic_fetch_add(p, v, __ATOMIC_RELAXED, __HIP_MEMORY_SCOPE_AGENT); }
__device__ __forceinline__ unsigned xb_xcc_id() { return (unsigned)__builtin_amdgcn_s_getreg((3 << 11) | 20) & 0xFu; }
#define XB_SPIN(cond, bar) do { unsigned _sp = 0; while (cond) { __builtin_amdgcn_s_sleep(1); \
    if ((++_sp & 255u) == 0u) { if (xb_ld(&(bar)[XB_TMO])) break; if (_sp > XB_SPIN_CAP) { atomicAdd(&(bar)[XB_TMO], 1u); break; } } } } while (0)
struct XcdBarrier { unsigned* bar; unsigned x; volatile LAS unsigned* st; };
__device__ __forceinline__ XcdBarrier xcd_barrier_post(unsigned* bar, volatile LAS unsigned* st) {
    XcdBarrier b; b.bar = bar; b.x = xb_xcc_id(); b.st = st;
    if (threadIdx.x == 0) (void)xb_add(&bar[XB_XCNT(b.x)], 1u);
    return b;
}
__device__ __forceinline__ void xcd_barrier_complete(unsigned* bar, unsigned x, unsigned& nloc, unsigned& nx) {
    const unsigned G = gridDim.x * gridDim.y * gridDim.z;
    unsigned sum, cnt, mine, sp = 0u;
    for (;;) {
        sum = 0u; cnt = 0u; mine = 0u;
#pragma unroll
        for (unsigned j = 0; j < 16; ++j) { const unsigned c = xb_ld(&bar[XB_XCNT(j)]); sum += c; cnt += (c > 0u) ? 1u : 0u; mine = (j == x) ? c : mine; }
        if (sum == G) break;
        __builtin_amdgcn_s_sleep(1);
        if ((++sp & 255u) == 0u) { if (xb_ld(&bar[XB_TMO])) break; if (sp > XB_SPIN_CAP) { atomicAdd(&bar[XB_TMO], 1u); break; } }
    }
    nloc = mine > 0u ? mine : 1u; nx = cnt > 0u ? cnt : 1u;
}
__device__ __forceinline__ void xcd_barrier(const XcdBarrier& b, bool leader) {
    asm volatile("s_waitcnt vmcnt(0)" ::: "memory");
    __syncthreads();
    if (leader) {
        unsigned* bar = b.bar;
        __builtin_amdgcn_s_waitcnt(0);
        unsigned nloc = b.st[0], nx = b.st[1];
        if (nloc == 0u) { xcd_barrier_complete(bar, b.x, nloc, nx); b.st[0] = nloc; b.st[1] = nx; }
        const unsigned old = xb_add(&bar[XB_XSUB(b.x)], 1u);
        const unsigned gen = old / nloc;
        if (old + 1u == (gen + 1u) * nloc) {
            __builtin_amdgcn_fence(__ATOMIC_RELEASE, "agent");
            asm volatile("s_waitcnt vmcnt(0)" ::: "memory");
            const unsigned og = xb_add(&bar[XB_TOP], 1u);
            const unsigned tg = og / nx;
            if (og + 1u == (tg + 1u) * nx) xb_add(&bar[XB_TOPGEN], 1u);
            else XB_SPIN(xb_ld(&bar[XB_TOPGEN]) == tg, bar);
            __builtin_amdgcn_fence(__ATOMIC_ACQUIRE, "agent");
            xb_add(&bar[XB_XGEN(b.x)], 1u);
            asm volatile("s_waitcnt vmcnt(0)" ::: "memory");
        } else {
            XB_SPIN(xb_ld(&bar[XB_XGEN(b.x)]) == gen, bar);
            __builtin_amdgcn_fence(__ATOMIC_ACQUIRE, "agent");
            asm volatile("s_waitcnt vmcnt(0)" ::: "memory");
        }
    }
    __syncthreads();
}

struct Args { const float* in[27]; float* out; unsigned char* ws; };
struct KArgs { const GAS float* in[27]; GAS float* out; GAS unsigned char* ws; };
typedef const __attribute__((address_space(4))) KArgs* kargs_p;
__device__ __forceinline__ kargs_p kargs() { kargs_p p = (kargs_p)__builtin_amdgcn_kernarg_segment_ptr(); asm volatile("" : "+s"(p)); return p; }
struct Frame {
    LAS unsigned char* lds;
    int tid, lane, wave, vcu, G, gw, NGW, bid;
#define KIN(name, idx) __device__ __forceinline__ const float* name() const { return (const float*)kargs()->in[idx]; }
    KIN(x, 0) KIN(c, 1) KIN(ctx, 2) KIN(c_ctx, 3) KIN(w_mod, 4) KIN(b_mod, 5) KIN(norm1_g, 6) KIN(norm2_g, 7) KIN(w_in, 8) KIN(b_merge, 9) KIN(conv_w, 10) KIN(conv_b, 11)
    KIN(lru_wa, 12) KIN(lru_ba, 13) KIN(lru_wx, 14) KIN(lru_bx, 15) KIN(lru_lambda, 16) KIN(q_norm_g, 17) KIN(k_norm_g, 18) KIN(sink, 19) KIN(w_branch, 20) KIN(w_out, 21)
    KIN(router_w, 22) KIN(router_b, 23) KIN(ew1, 24) KIN(ew3, 25) KIN(ew2, 26)
#undef KIN
    __device__ __forceinline__ float* out() const { return (float*)kargs()->out; }
    __device__ __forceinline__ unsigned char* ws() const { return (unsigned char*)kargs()->ws; }
    __device__ __forceinline__ gu32* ctl() const { return (gu32*)(ws() + WS_CTL); }
#define KWS(type, name, off) __device__ __forceinline__ type* name() const { return (type*)(ws() + (off)); }
    KWS(float, MOD, WS_MOD) KWS(float, ROPEC, WS_ROPE) KWS(float, ROPES, WS_ROPE + (size_t)SEQ * 32 * 4) KWS(bf16_t, XC, WS_XC) KWS(bf16_t, X1, WS_X1) KWS(float, HT, WS_A) KWS(unsigned, ROUTE, WS_ROUTE)
    KWS(bf16_t, WIN, WS_WIN) KWS(bf16_t, WBR, WS_WBR) KWS(bf16_t, WOUT, WS_WOUT) KWS(bf16_t, A, WS_A) KWS(bf16_t, PROJ, WS_PROJ) KWS(bf16_t, YBUF, WS_YBUF) KWS(unsigned char, HG, WS_HG)
    KWS(unsigned char, YP, WS_YP) KWS(unsigned char, HID, WS_HID) KWS(unsigned char, W13, WS_W13) KWS(unsigned char, W2, WS_W2) KWS(unsigned char, H8, WS_H8) KWS(unsigned char, HIN8, WS_HIN8) KWS(unsigned char, WIN8, WS_WIN8) KWS(int, PL, WS_PL)
#undef KWS
};
__device__ __forceinline__ Frame fresh(const Frame& F0) { Frame F = F0; unsigned ones_ = ~0u; asm volatile("" : "+s"(ones_)); F.lane = (int)__builtin_amdgcn_mbcnt_hi(ones_, __builtin_amdgcn_mbcnt_lo(ones_, 0u)); F.tid = F.wave * 64 + F.lane;
    asm volatile("" : "+s"(F.wave), "+s"(F.vcu), "+s"(F.G), "+s"(F.gw), "+s"(F.NGW), "+s"(F.bid), "+v"(F.tid), "+v"(F.lane)); return F; }
__device__ __forceinline__ float dpp_f(float v, int ctrl) { return __builtin_bit_cast(float, ctrl == 0xB1 ? __builtin_amdgcn_mov_dpp(__builtin_bit_cast(int, v), 0xB1, 0xf, 0xf, true) :
    ctrl == 0x4E ? __builtin_amdgcn_mov_dpp(__builtin_bit_cast(int, v), 0x4E, 0xf, 0xf, true) : ctrl == 0x141 ? __builtin_amdgcn_mov_dpp(__builtin_bit_cast(int, v), 0x141, 0xf, 0xf, true) :
    __builtin_amdgcn_mov_dpp(__builtin_bit_cast(int, v), 0x140, 0xf, 0xf, true)); }
__device__ __forceinline__ float row16_sum(float v) {
    v += dpp_f(v, 0xB1); v += dpp_f(v, 0x4E); v += dpp_f(v, 0x141); v += dpp_f(v, 0x140); return v; }
__device__ __forceinline__ float wave_sum(float v) {
    v = row16_sum(v);
    v += __builtin_bit_cast(float, __builtin_amdgcn_ds_swizzle(__builtin_bit_cast(int, v), 0x401F));
    { auto rr = __builtin_amdgcn_permlane32_swap(__float_as_uint(v), __float_as_uint(v), false, false); v = __uint_as_float(rr[0]) + __uint_as_float(rr[1]); }
    return v;
}
__device__ __forceinline__ float wave_max(float v) {
    v = fmaxf(v, dpp_f(v, 0xB1)); v = fmaxf(v, dpp_f(v, 0x4E)); v = fmaxf(v, dpp_f(v, 0x141)); v = fmaxf(v, dpp_f(v, 0x140));
    v = fmaxf(v, __builtin_bit_cast(float, __builtin_amdgcn_ds_swizzle(__builtin_bit_cast(int, v), 0x401F)));
    { auto rr = __builtin_amdgcn_permlane32_swap(__float_as_uint(v), __float_as_uint(v), false, false); v = fmaxf(__uint_as_float(rr[0]), __uint_as_float(rr[1])); }
    return v;
}
__device__ __forceinline__ const float* modp(const float* MODb, int l, int sel, int chunk) { return MODb + ((size_t)(l * 17 + sel) * 6 + chunk) * D; }

constexpr float WSCALE = 64.0f;
struct CvtTile { const float* W; void* WT; int N, k0, n0, Kd, drow0, fp8; float bscale; int pad_; };
__device__ __forceinline__ void cvt_load(const CvtTile& t, int tid, f32x4 (&r)[8]) {
#pragma unroll
    for (int i = 0; i < 8; ++i) r[i] = *(const GAS f32x4*)(t.W + (size_t)(t.k0 + 16 * i + (tid >> 5)) * t.N + t.n0 + 4 * (tid & 31));
}
__device__ __forceinline__ void cvt_to_lds(LAS float* Tl, int tid, const f32x4 (&r)[8]) {
#pragma unroll
    for (int i = 0; i < 8; ++i) { LAS float* p = Tl + (16 * i + (tid >> 5)) * 129 + 4 * (tid & 31); p[0] = r[i][0]; p[1] = r[i][1]; p[2] = r[i][2]; p[3] = r[i][3]; }
}
__device__ __forceinline__ void cvt_emit(const CvtTile& t, LAS float* Tl, int tid) {
#pragma unroll
    for (int p = 0; p < 4; ++p) { const int idx = tid + 512 * p, n = idx >> 4, kg = idx & 15; const LAS float* s = Tl + (8 * kg) * 129 + n; float v[8];
#pragma unroll
        for (int j = 0; j < 8; ++j) v[j] = s[j * 129];
        if (t.fp8) { u32x2 o; o.x = pk4_fp8(v[0] * WSCALE, v[1] * WSCALE, v[2] * WSCALE, v[3] * WSCALE); o.y = pk4_fp8(v[4] * WSCALE, v[5] * WSCALE, v[6] * WSCALE, v[7] * WSCALE);
            *(GAS u32x2*)((unsigned char*)t.WT + (size_t)(t.drow0 + n) * t.Kd + t.k0 + 8 * kg) = o; }
        else { const float bs = t.bscale; u32x4 o; o.x = cvt_pk_bf16(v[0] * bs, v[1] * bs); o.y = cvt_pk_bf16(v[2] * bs, v[3] * bs); o.z = cvt_pk_bf16(v[4] * bs, v[5] * bs); o.w = cvt_pk_bf16(v[6] * bs, v[7] * bs);
            *(GAS u32x4*)((bf16_t*)t.WT + (size_t)(t.drow0 + n) * t.Kd + t.k0 + 8 * kg) = o; } }
}
template <class Get> __device__ __forceinline__ void cvt_run(const Frame& F, int first, int step, int count, const Get& get) {
    LAS float* Tl = (LAS float*)(F.lds + RING_OFF);
    if (first >= count) return;
    f32x4 r[8]; CvtTile cur = get(first); cvt_load(cur, F.tid, r);
    for (int it = first; it < count; it += step) {
        cvt_to_lds(Tl, F.tid, r);
        CvtTile nxt = cur; const bool more = it + step < count;
        if (more) { nxt = get(it + step); cvt_load(nxt, F.tid, r); }
        __syncthreads();
        cvt_emit(cur, Tl, F.tid);
        __syncthreads();
        cur = nxt;
    }
}
struct GetSmall {
    const float* win; const float* wbr; const float* wout; bf16_t* WINb; unsigned char* WIN8b; bf16_t* WBRb; bf16_t* WOUTb;
    static constexpr int T_IN = (D / 128) * (NIN / 128), T_BR = (512 / 128) * (D / 128), T_OUT = (D / 128) * (D / 128), T_L = T_IN + 3 * T_BR + T_OUT;
    __device__ __forceinline__ CvtTile operator()(int it) const { CvtTile t; t.bscale = 1.0f; t.pad_ = 0; const int l = it / T_L; int r = it - l * T_L;
        if (r < T_IN) { const int nb = NIN / 128, kb = r / nb, n0 = 128 * (r % nb); const bool f8 = n0 >= 256 * PSPLIT;
            t.W = win + (size_t)l * D * NIN; t.N = NIN; t.k0 = 128 * kb; t.n0 = n0; t.WT = f8 ? (void*)(WIN8b + (size_t)l * NIN * D) : (void*)(WINb + (size_t)l * NIN * D); t.Kd = D; t.drow0 = n0; t.fp8 = f8; return t; }
        r -= T_IN;
        if (r < 3 * T_BR) { const int b = r / T_BR; r -= b * T_BR; const int nb = D / 128, kb = r / nb, n0 = 128 * (r % nb);
            t.W = wbr + (size_t)(l * 3 + b) * 512 * D; t.N = D; t.k0 = 128 * kb; t.n0 = n0; t.WT = (void*)(WBRb + (size_t)(l * 3 + b) * D * 512); t.Kd = 512; t.drow0 = n0; t.fp8 = false; t.bscale = 1.0f / 255.0f; return t; }
        r -= 3 * T_BR;
        const int nb = D / 128, kb = r / nb, n0 = 128 * (r % nb);
        t.W = wout + (size_t)l * D * D; t.N = D; t.k0 = 128 * kb; t.n0 = n0; t.WT = (void*)(WOUTb + (size_t)l * D * D); t.Kd = D; t.drow0 = n0; t.fp8 = false; return t; }
};
struct GetExperts {
    const float* e1; const float* e3; const float* e2; unsigned char* W13b; unsigned char* W2b; int l;
    static constexpr int T_M = (D / 128) * (D / 128);
    __device__ __forceinline__ CvtTile operator()(int it) const { CvtTile t; t.bscale = 1.0f; t.pad_ = 0; const int e = it / (3 * T_M); int r = it - e * 3 * T_M; const int which = r / T_M; r -= which * T_M;
        const int kb = r / (D / 128), n0 = 128 * (r % (D / 128)); const size_t eoff = (size_t)(l * NE + e) * D * D;
        t.N = D; t.k0 = 128 * kb; t.n0 = n0; t.Kd = D; t.fp8 = true;
        if (which == 0) { t.W = e1 + eoff; t.WT = (void*)(W13b + (size_t)e * 2048 * D); t.drow0 = 2 * n0; }
        else if (which == 1) { t.W = e3 + eoff; t.WT = (void*)(W13b + (size_t)e * 2048 * D); t.drow0 = 2 * n0 + 128; }
        else { t.W = e2 + eoff; t.WT = (void*)(W2b + (size_t)e * D * D); t.drow0 = n0; }
        return t; }
};
__device__ __forceinline__ void convert_small(Frame& F) {
    GetSmall get{F.w_in(), F.w_branch(), F.w_out(), F.WIN(), F.WIN8(), F.WBR(), F.WOUT()}; cvt_run(F, (int)blockIdx.x, F.G, NL * GetSmall::T_L, get);
}
__device__ __forceinline__ void p0_prologue(Frame& F) {
    float* RC = F.ROPEC(); float* RS = F.ROPES();
    for (int i = blockIdx.x * (NWAVES * 64) + F.tid; i < SEQ * 32; i += F.G * NWAVES * 64) {
        const int pos = i >> 5, f = i & 31; const float inv = exp2f(-(float)(f & 15) * (13.287712379549449f / 16.0f));
        const float ang = (float)(f < 16 ? (pos >> 6) : (pos & 63)) * inv;
        const float rev = ang * 0.15915494309189535f; RC[i] = __builtin_amdgcn_cosf(rev); RS[i] = __builtin_amdgcn_sinf(rev);
    }
    __syncthreads();
    {
        LAS float* sc = (LAS float*)(F.lds + RING_OFF);
        LAS float* part = (LAS float*)(F.lds + RING_OFF + 17 * 1024 * 4);
        bool have_sc = false;
        for (int it = blockIdx.x; it < NL * 96; it += F.G) {
            if (!have_sc) { const float* cp = F.c(); const float* ccp = F.c_ctx(); float cv[34];
#pragma unroll
                for (int q = 0; q < 34; ++q) { const int i = F.tid + NWAVES * 64 * q, s = i >> 10, k = i & 1023; cv[q] = s < 16 ? cp[s * D + k] : ccp[k]; }
                asm volatile("" ::: "memory");
#pragma unroll
                for (int q = 0; q < 34; ++q) { const int i = F.tid + NWAVES * 64 * q; sc[i] = cv[q] * fast_sigmoid(cv[q]); }
                have_sc = true; __syncthreads(); }
            const int l = it / 96, cg = it % 96, col = cg * 64 + F.lane;
            const float* wp = F.w_mod() + (size_t)l * D * 6 * D + col;
            float acc[17];
#pragma unroll
            for (int s = 0; s < 17; ++s) acc[s] = 0.f;
            const int kbeg = F.wave * 128;
#pragma unroll 4
            for (int k = kbeg; k < kbeg + 128; ++k) { const float w = wp[(size_t)k * 6 * D];
#pragma unroll
                for (int s = 0; s < 17; ++s) acc[s] += sc[s * 1024 + k] * w; }
#pragma unroll
            for (int s = 0; s < 17; ++s) part[(F.wave * 17 + s) * 64 + F.lane] = acc[s];
            __syncthreads();
            for (int i = F.tid; i < 17 * 64; i += NWAVES * 64) { const int s = i >> 6, cl = i & 63; float v = F.b_mod()[l * 6 * D + cg * 64 + cl];
#pragma unroll
                for (int w = 0; w < 8; ++w) v += part[(w * 17 + s) * 64 + cl];
                F.MOD()[(size_t)(l * 17 + s) * 6 * D + cg * 64 + cl] = v; }
            __syncthreads();
        }
    }
}

__device__ __forceinline__ void convert_experts(Frame& F, int l) {
    GetExperts get{F.ew1(), F.ew3(), F.ew2(), F.W13(), F.W2(), l}; cvt_run(F, (int)blockIdx.x, F.G, NE * 3 * GetExperts::T_M, get);
}

__device__ __forceinline__ void ld_row_f32(const float* p, int lane, f32x4 (&v)[4]) {
#pragma unroll
    for (int j = 0; j < 4; ++j) v[j] = *((const GAS f32x4*)p + lane + 64 * j);
}
__device__ __forceinline__ void st_row_f32(float* p, int lane, const f32x4 (&v)[4]) {
#pragma unroll
    for (int j = 0; j < 4; ++j) *((GAS f32x4*)p + lane + 64 * j) = v[j];
}
__device__ __forceinline__ void ld_row_bf16(const bf16_t* p, int lane, f32x4 (&v)[4]) {
#pragma unroll
    for (int j = 0; j < 4; ++j) { const u32x2 w = *((const GAS u32x2*)p + lane + 64 * j); v[j] = (f32x4){bf_lo(w.x), bf_hi(w.x), bf_lo(w.y), bf_hi(w.y)}; }
}
__device__ __forceinline__ void st_row_bf16(bf16_t* p, int lane, const f32x4 (&v)[4]) {
#pragma unroll
    for (int j = 0; j < 4; ++j) { u32x2 w; w.x = cvt_pk_bf16(v[j][0], v[j][1]); w.y = cvt_pk_bf16(v[j][2], v[j][3]); *((GAS u32x2*)p + lane + 64 * j) = w; }
}
__device__ __forceinline__ void st_row_fp8(unsigned char* p, int lane, const f32x4 (&v)[4]) {
#pragma unroll
    for (int j = 0; j < 4; ++j) *((GAS unsigned*)p + lane + 64 * j) = pk4_fp8(v[j][0], v[j][1], v[j][2], v[j][3]);
}
__device__ __forceinline__ void norm_mod(const f32x4 (&v)[4], const float* g, const float* shift, const float* scale, int lane, f32x4 (&h)[4]) {
    float ss = 0.f;
#pragma unroll
    for (int j = 0; j < 4; ++j) ss += (v[j][0] * v[j][0] + v[j][1] * v[j][1]) + (v[j][2] * v[j][2] + v[j][3] * v[j][3]);
    const float rinv = 1.0f / sqrtf(wave_sum(ss) * (1.0f / D) + EPS);
#pragma unroll
    for (int j = 0; j < 4; ++j) { const f32x4 gg = *((const GAS f32x4*)g + lane + 64 * j), sh = *((const GAS f32x4*)shift + lane + 64 * j), sc = *((const GAS f32x4*)scale + lane + 64 * j);
        h[j] = (v[j] * rinv) * gg * (sc + 1.0f) + sh; }
}

struct RowRange { int lo, hi; };
__device__ __forceinline__ RowRange wave_rows(const Frame& F, int n) { const int per = (n + F.NGW - 1) / F.NGW; RowRange r; r.lo = F.gw * per; r.hi = r.lo + per; if (r.hi > n) r.hi = n; if (r.lo > n) r.lo = n; return r; }
__device__ __forceinline__ void row_decode(int idx, bool all, int& b, int& p) { if (all) { b = idx / TB; p = idx - b * TB; } else { b = idx / SEQ; p = NCTX + idx - b * SEQ; } }
__device__ __forceinline__ void ld_vec(const float* p, int lane, f32x4 (&v)[4]) {
#pragma unroll
    for (int j = 0; j < 4; ++j) v[j] = *((const GAS f32x4*)p + lane + 64 * j);
}
__device__ __forceinline__ float row_rinv(const f32x4 (&v)[4]) {
    float ss = 0.f;
#pragma unroll
    for (int j = 0; j < 4; ++j) ss += (v[j][0] * v[j][0] + v[j][1] * v[j][1]) + (v[j][2] * v[j][2] + v[j][3] * v[j][3]);
    return 1.0f / sqrtf(wave_sum(ss) * (1.0f / D) + EPS);
}
__device__ __forceinline__ void r1_phase(Frame& F) {
    const float* MODb = F.MOD(); const float* xin = F.x(); const float* cin = F.ctx(); const float* g1n = F.norm1_g(); bf16_t* Ab = F.A(); unsigned char* H8i = F.HIN8();
    const RowRange rr = wave_rows(F, T);
    int cursel = -1; f32x4 gm[4], sh[4], vn[4];
#define R1_SRC(idx_) ({ int b_, p_; row_decode((idx_), true, b_, p_); (p_ < NCTX) ? cin + (size_t)(b_ * NCTX + p_) * D : xin + (size_t)(b_ * SEQ + p_ - NCTX) * D; })
    if (rr.lo < rr.hi) ld_row_f32(R1_SRC(rr.lo), F.lane, vn);
    for (int idx = rr.lo; idx < rr.hi; ++idx) {
        int b, p; row_decode(idx, true, b, p); const int sel = p < NCTX ? 16 : b;
        f32x4 v[4];
#pragma unroll
        for (int j = 0; j < 4; ++j) v[j] = vn[j];
        if (idx + 1 < rr.hi) ld_row_f32(R1_SRC(idx + 1), F.lane, vn);
        if (sel != cursel) { cursel = sel; f32x4 g[4], sc[4]; ld_vec(g1n, F.lane, g); ld_vec(modp(MODb, 0, sel, 1), F.lane, sc); ld_vec(modp(MODb, 0, sel, 0), F.lane, sh);
#pragma unroll
            for (int j = 0; j < 4; ++j) gm[j] = g[j] * (sc[j] + 1.0f); }
        const float rinv = row_rinv(v); f32x4 h[4];
#pragma unroll
        for (int j = 0; j < 4; ++j) h[j] = (v[j] * rinv) * gm[j] + sh[j];
        if (PSPLIT > 0) st_row_bf16(Ab + (size_t)idx * D, F.lane, h);
        st_row_fp8(H8i + (size_t)idx * D, F.lane, h);
    }
#undef R1_SRC
}

__device__ __forceinline__ void kfix_phase(Frame& F, int l, bool dry = false) {
    const int hs = F.lane >> 4, j4 = F.lane & 15, br = hs >> 1;
    const int col = (br ? C_WK : C_GK) + (hs & 1) * 64 + 2 * j4;
    const float* kg = F.k_norm_g() + (size_t)(l * 2 + br) * 64;
    const float g0 = kg[2 * j4], g1 = kg[2 * j4 + 1], g2 = kg[32 + 2 * j4], g3 = kg[32 + 2 * j4 + 1];
    bf16_t* Pb = F.PROJ(); const float* RC = F.ROPEC(); const float* RS = F.ROPES();
    const RowRange rr = wave_rows(F, T);
    unsigned w1n[4], w2n[4]; f32x2 csn[4], snn[4];
#define KF_LOAD(r0_) do { _Pragma("unroll") for (int k = 0; k < 4; ++k) { const int row = ((r0_) + k < rr.hi) ? (r0_) + k : rr.hi - 1; const int p = row % TB; const int pos = p >= NCTX ? p - NCTX : 0; \
            const bf16_t* rp = Pb + (size_t)row * NIN + col; w1n[k] = *(const GAS unsigned*)rp; w2n[k] = *(const GAS unsigned*)(rp + 32); \
            csn[k] = *(const GAS f32x2*)(RC + (size_t)pos * 32 + 2 * j4); snn[k] = *(const GAS f32x2*)(RS + (size_t)pos * 32 + 2 * j4); } } while (0)
    if (rr.lo < rr.hi) KF_LOAD(rr.lo);
    for (int r0 = rr.lo; r0 < rr.hi; r0 += 4) {
        unsigned w1[4], w2[4]; f32x2 cs[4], sn[4];
#pragma unroll
        for (int k = 0; k < 4; ++k) { w1[k] = w1n[k]; w2[k] = w2n[k]; cs[k] = csn[k]; sn[k] = snn[k]; }
        if (r0 + 4 < rr.hi) KF_LOAD(r0 + 4);
        asm volatile("" ::: "memory");
#pragma unroll
        for (int k = 0; k < 4; ++k) { const int row = r0 + k; if (row >= rr.hi) break; const int p = row % TB;
            float a0 = bf_lo(w1[k]), a1 = bf_hi(w1[k]), b0 = bf_lo(w2[k]), b1 = bf_hi(w2[k]);
            float ss = a0 * a0 + a1 * a1 + b0 * b0 + b1 * b1;
            ss = row16_sum(ss);
            const float rinv = 1.0f / sqrtf(ss * (1.0f / 64.0f) + EPS);
            a0 *= rinv * g0; a1 *= rinv * g1; b0 *= rinv * g2; b1 *= rinv * g3;
            if (p >= NCTX) { const float t0 = a0 * cs[k].x - b0 * sn[k].x, t1 = a1 * cs[k].y - b1 * sn[k].y, u0 = b0 * cs[k].x + a0 * sn[k].x, u1 = b1 * cs[k].y + a1 * sn[k].y; a0 = t0; a1 = t1; b0 = u0; b1 = u1; }
            bf16_t* rp = Pb + (size_t)row * NIN + col;
            if (!dry) { *(GAS unsigned*)rp = cvt_pk_bf16(a0, a1); *(GAS unsigned*)(rp + 32) = cvt_pk_bf16(b0, b1); } }
    }
#undef KF_LOAD
}
constexpr int SC_AOP = 0, SC_AOP_B = 64 * 144, SC_XCV = 2 * SC_AOP_B, SC_XCV_B = 64 * 68 * 4, SC_TOT = SC_XCV + 2 * SC_XCV_B, SC_TOT_B = 4 * 2 * 16 * 8;
__device__ __forceinline__ void scan_unit(Frame& F, int l, int uid, bool last_layer, bool dry = false) {
    const int b = uid >> 4, n = (uid >> 1) & 7, chh = uid & 1;
    const int dir = F.wave >> 2, ht = F.tid & 255, w = F.wave & 3, lane = F.lane, col = lane & 15, quad = lane >> 4;
    LAS unsigned char* aop = F.lds + SC_AOP + dir * SC_AOP_B;
    LAS float* xcv = (LAS float*)(F.lds + SC_XCV + dir * SC_XCV_B);
    LAS f32x2* tot = (LAS f32x2*)(F.lds + SC_TOT + dir * SC_TOT_B);
    bf16x8 Bf[4][2];
    {
        const size_t wbase = ((size_t)((l * 2 + dir) * 8 + n)) * 64 * 64; const float* lwa = F.lru_wa(); const float* lwx = F.lru_wx();
        float wv[4][2][8];
#pragma unroll
        for (int q = 0; q < 4; ++q) { const float* wp = ((q < 2) ? lwa : lwx) + wbase + 32 * chh + 16 * (q & 1) + col;
#pragma unroll
            for (int ks = 0; ks < 2; ++ks)
#pragma unroll
                for (int j = 0; j < 8; ++j) wv[q][ks][j] = wp[(size_t)(32 * ks + 8 * quad + j) * 64]; }
        asm volatile("" ::: "memory");
#pragma unroll
        for (int q = 0; q < 4; ++q)
#pragma unroll
            for (int ks = 0; ks < 2; ++ks) { u32x4 pk;
                pk.x = cvt_pk_bf16(wv[q][ks][0], wv[q][ks][1]); pk.y = cvt_pk_bf16(wv[q][ks][2], wv[q][ks][3]);
                pk.z = cvt_pk_bf16(wv[q][ks][4], wv[q][ks][5]); pk.w = cvt_pk_bf16(wv[q][ks][6], wv[q][ks][7]);
                Bf[q][ks] = __builtin_bit_cast(bf16x8, pk); }
    }
    float ba[2], bx[2], nla[2]; const float* lba = F.lru_ba(); const float* lbx = F.lru_bx(); const float* llam = F.lru_lambda();
#pragma unroll
    for (int q = 0; q < 2; ++q) { const int gch = 64 * n + 32 * chh + 16 * q + col; const size_t o = (size_t)(l * 2 + dir) * 512 + gch;
        ba[q] = lba[o] * -1.4426950409f; bx[q] = lbx[o] * -1.4426950409f; const float lam = llam[o];
        const float ex = __expf(-lam);
        const float sp = (ex < 0.05f) ? ex * (1.0f - ex * (0.5f - ex * (0.33333334f - ex * 0.25f))) : __logf(1.0f + ex);
        nla[q] = -8.0f * sp * 1.4426950409f; }
    const int cg = ht & 7; float cw[4][8], cb[8]; const float* cwp = F.conv_w(); const float* cbp = F.conv_b();
#pragma unroll
    for (int k = 0; k < 4; ++k)
#pragma unroll
        for (int c = 0; c < 8; ++c) cw[k][c] = cwp[(size_t)(l * 4 + k) * 512 + 64 * n + 8 * cg + c];
#pragma unroll
    for (int c = 0; c < 8; ++c) cb[c] = cbp[(size_t)l * 512 + 64 * n + 8 * cg + c];
    float hcar[2] = {0.f, 0.f};
    const int up16 = (lane >= 16 ? lane - 16 : lane) * 4, up32 = (lane >= 32 ? lane - 32 : lane) * 4;
#define SHUP(x, a) __builtin_bit_cast(float, __builtin_amdgcn_ds_bpermute((a), __builtin_bit_cast(int, (x))))
    bf16_t* Pb = F.PROJ(); float* HTb = F.HT();
    const bf16_t* xrb = Pb + C_XR + 64 * n + 8 * cg;

    for (int seg = 0; seg < 2; ++seg) {
        const int nch = seg ? 64 : 4, seglen = nch * 64; const size_t rowseg0 = (size_t)b * TB + (seg ? NCTX : 0);
        const bool want_out = !(seg == 0 && last_layer) && !dry;
        const int sbase = 16 * w + 4 * quad, gch0 = 64 * n + 32 * chh + col;
        const int tlo0 = dir ? 64 * (nch - 1) + 60 - sbase : sbase;
        char* htc = (char*)HTb + ((rowseg0 + tlo0) * 512 + gch0) * 4; char* grc = (char*)Pb + ((rowseg0 + tlo0) * NIN + C_GR + gch0) * 2;
        const ptrdiff_t hstep = (ptrdiff_t)(dir ? -64 : 64) * 2048, gstep = (ptrdiff_t)(dir ? -64 : 64) * NIN * 2;
        u32x4 raw[5];
#define SC_LOAD(i_) do { const int cidx_ = dir ? nch - 1 - (i_) : (i_); const int s0_ = (ht >> 3) << 1; const int tl_ = 64 * cidx_ + (dir ? 62 - s0_ : s0_); \
        const bf16_t* rp_ = xrb + (rowseg0 + tl_) * NIN; \
        if (cidx_ == 0 || cidx_ == nch - 1) { _Pragma("unroll") for (int dt = 0; dt < 5; ++dt) { const int tt = tl_ + dt - 2; \
                raw[dt] = (tt >= 0 && tt < seglen) ? *(const GAS u32x4*)(rp_ + (ptrdiff_t)(dt - 2) * NIN) : (u32x4){0u, 0u, 0u, 0u}; } } \
        else { _Pragma("unroll") for (int dt = 0; dt < 5; ++dt) raw[dt] = *(const GAS u32x4*)(rp_ + (ptrdiff_t)(dt - 2) * NIN); } } while (0)
        SC_LOAD(0);
        for (int i = 0; i < nch; ++i) {
            const int cidx = dir ? nch - 1 - i : i, t0 = 64 * cidx;
            { const int s0 = (ht >> 3) << 1; float xl[5][8];
#pragma unroll
                for (int dt = 0; dt < 5; ++dt)
#pragma unroll
                    for (int c2 = 0; c2 < 4; ++c2) { const unsigned wv = raw[dt][c2]; xl[dt][2 * c2] = bf_lo(wv); xl[dt][2 * c2 + 1] = bf_hi(wv); }
#pragma unroll
                for (int it = 0; it < 2; ++it) { const int s = dir ? s0 + 1 - it : s0 + it; float cv[8];
#pragma unroll
                    for (int c = 0; c < 8; ++c) { float a = cb[c];
#pragma unroll
                        for (int dt = 0; dt < 4; ++dt) a += cw[dt][c] * xl[it + dt][c];
                        cv[c] = a; }
                    u32x4 pk; pk.x = cvt_pk_bf16(cv[0], cv[1]); pk.y = cvt_pk_bf16(cv[2], cv[3]); pk.z = cvt_pk_bf16(cv[4], cv[5]); pk.w = cvt_pk_bf16(cv[6], cv[7]);
                    *(LAS u32x4*)(aop + s * 144 + cg * 16) = pk;
                    *(LAS f32x4*)(xcv + s * 68 + cg * 8) = (f32x4){cv[0], cv[1], cv[2], cv[3]}; *(LAS f32x4*)(xcv + s * 68 + cg * 8 + 4) = (f32x4){cv[4], cv[5], cv[6], cv[7]}; } }
            if (i + 1 < nch) SC_LOAD(i + 1);
            if (i == nch / 2) VM_WAIT();
            __syncthreads();
            float othv[2][4]; unsigned grv[2][4]; const bool fin = want_out && i >= nch / 2;
            if (fin) {
#pragma unroll
                for (int q = 0; q < 2; ++q)
#pragma unroll
                    for (int k = 0; k < 4; ++k) { othv[q][k] = __hip_atomic_load((const float*)(htc + k * 2048 + q * 64), __ATOMIC_RELAXED, __HIP_MEMORY_SCOPE_AGENT); grv[q][k] = *(const GAS bf16_t*)(grc + (ptrdiff_t)k * NIN * 2 + q * 32); } }
            f32x4 gacc[4];
#pragma unroll
            for (int q = 0; q < 4; ++q) gacc[q] = (f32x4){0.f, 0.f, 0.f, 0.f};
#pragma unroll
            for (int ks = 0; ks < 2; ++ks) { const bf16x8 af = *(const LAS bf16x8*)(aop + (16 * w + col) * 144 + ks * 64 + quad * 16);
#pragma unroll
                for (int q = 0; q < 4; ++q) gacc[q] = __builtin_amdgcn_mfma_f32_16x16x32_bf16(af, Bf[q][ks], gacc[q], 0, 0, 0); }
            float av[2][4], bv[2][4], cA[2], cB[2];
#pragma unroll
            for (int q = 0; q < 2; ++q) {
#pragma unroll
                for (int j = 0; j < 4; ++j) { const float r = __builtin_amdgcn_rcpf(1.0f + __builtin_amdgcn_exp2f(__builtin_fmaf(gacc[q][j], -1.4426950409f, ba[q]))),
                                                            ig = __builtin_amdgcn_rcpf(1.0f + __builtin_amdgcn_exp2f(__builtin_fmaf(gacc[q + 2][j], -1.4426950409f, bx[q])));
                    const float a = __builtin_amdgcn_exp2f(nla[q] * r);
                    const float om = __builtin_fmaf(-a, a, 1.0f);
                    const float xv = xcv[(16 * w + 4 * quad + j) * 68 + 32 * chh + 16 * q + col];
                    av[q][j] = a; bv[q][j] = __builtin_amdgcn_sqrtf(om) * ig * xv; }
                cA[q] = av[q][0]; cB[q] = bv[q][0];
#pragma unroll
                for (int j = 1; j < 4; ++j) { cB[q] = av[q][j] * cB[q] + bv[q][j]; cA[q] *= av[q][j]; }
            }
            float iA[2], iB[2], eA[2], eB[2];
#pragma unroll
            for (int q = 0; q < 2; ++q) { iA[q] = cA[q]; iB[q] = cB[q];
                float pA = SHUP(iA[q], up16), pB = SHUP(iB[q], up16); if (quad >= 1) { iB[q] = iA[q] * pB + iB[q]; iA[q] = iA[q] * pA; }
                pA = SHUP(iA[q], up32); pB = SHUP(iB[q], up32); if (quad >= 2) { iB[q] = iA[q] * pB + iB[q]; iA[q] = iA[q] * pA; }
                eA[q] = SHUP(iA[q], up16); eB[q] = SHUP(iB[q], up16); if (quad == 0) { eA[q] = 1.0f; eB[q] = 0.0f; }
                if (quad == 3) tot[(w * 2 + q) * 16 + col] = (f32x2){iA[q], iB[q]}; }
            __syncthreads();
            float hvs[2][4];
#pragma unroll
            for (int q = 0; q < 2; ++q) { float hin = hcar[q], hall = hcar[q];
#pragma unroll
                for (int ww = 0; ww < 4; ++ww) { const f32x2 tw = tot[(ww * 2 + q) * 16 + col]; hall = tw.x * hall + tw.y; if (ww < w) hin = hall; }
                hcar[q] = hall;
                float hv = eA[q] * hin + eB[q];
#pragma unroll
                for (int j = 0; j < 4; ++j) { hv = av[q][j] * hv + bv[q][j]; hvs[q][j] = hv; } }
            if (want_out) {
#pragma unroll
                for (int q = 0; q < 2; ++q)
#pragma unroll
                    for (int k = 0; k < 4; ++k) { const float hv = dir ? hvs[q][3 - k] : hvs[q][k];
                        if (!fin) *(GAS float*)(htc + k * 2048 + q * 64) = hv;
                        else { const float gr = __uint_as_float(grv[q][k] << 16); *(GAS bf16_t*)(grc + (ptrdiff_t)k * NIN * 2 + q * 32) = (bf16_t)(cvt_pk_bf16((hv + othv[q][k]) * gr, 0.f) & 0xffffu); } }
            }
            htc += hstep; grc += gstep;
        }
#undef SC_LOAD
        __syncthreads();
    }
}

__device__ __forceinline__ void r2_phase(Frame& F, int l, bool dry = false) {
    LAS float* rw = (LAS float*)(F.lds + RING_OFF);
    LAS float* tt = (LAS float*)(F.lds + RING_OFF + 65536);
    LAS float* part = (LAS float*)(F.lds + LDSCTL_OFF + 8192);
    { const float* rwp = F.router_w(); for (int i = F.tid; i < 16 * 1024 / 4; i += NWAVES * 64) *((LAS f32x4*)rw + i) = *((const GAS f32x4*)rwp + i); }
    __syncthreads();
    float rb[16]; const float* rbp = F.router_b();
#pragma unroll
    for (int e = 0; e < 16; ++e) rb[e] = rbp[e];
    const bool all = (l == 0); const int nrows = all ? T : NB * SEQ;
    const float* MODb = F.MOD(); bf16_t* XCb = F.XC(); bf16_t* X1b = F.X1(); const bf16_t* X2b = (const bf16_t*)F.out(); const float* xin = F.x(); const float* cin = F.ctx(); const bf16_t* YB = F.YBUF(); unsigned char* H8b = F.H8();
    const float* n2g = F.norm2_g() + (size_t)l * D; unsigned* RT = F.ROUTE(); gu32* cnt = F.ctl() + CW_CNT + l * 64; int* PLb = F.PL();
    const int perwg = (((nrows + F.G - 1) / F.G) + 15) & ~15, wg0 = F.vcu * perwg, ngroups = perwg / 16;
    int cursel = -1; f32x4 g1v[4], gm[4], sh[4], vn[4]; u32x2 yn[4];
    unsigned my_e0 = 0u, my_e1 = 0u; float my_w0 = 0.f, my_w1 = 0.f; int my_row = -1;
#define R2_XI(b_, p_) (((p_) < NCTX) ? cin + (size_t)((b_) * NCTX + (p_)) * D : xin + (size_t)((b_) * SEQ + (p_) - NCTX) * D)
#define R2_LOAD(idx_) do { if ((idx_) < nrows) { int b_, p_; row_decode((idx_), all, b_, p_); \
        if (l == 0) ld_row_f32(R2_XI(b_, p_), F.lane, vn); \
        else { const bf16_t* s_ = X2b + (size_t)(b_ * SEQ + p_ - NCTX) * D; _Pragma("unroll") for (int j = 0; j < 4; ++j) { const u32x2 w_ = *((const GAS u32x2*)s_ + F.lane + 64 * j); vn[j][0] = __uint_as_float(w_.x); vn[j][1] = __uint_as_float(w_.y); } } \
        _Pragma("unroll") for (int j = 0; j < 4; ++j) yn[j] = *((const GAS u32x2*)(YB + (size_t)(b_ * TB + p_) * D) + F.lane + 64 * j); } } while (0)
    R2_LOAD(wg0 + 2 * F.wave);
    for (int gI = 0; gI < ngroups; ++gI) {
#pragma unroll
        for (int rr = 0; rr < 2; ++rr) {
            const int idx = wg0 + 16 * gI + 2 * F.wave + rr; const int trow = 2 * F.wave + rr;
            f32x4 v[4], h[4];
#pragma unroll
            for (int j = 0; j < 4; ++j) { const u32x2 w = yn[j]; h[j] = (f32x4){bf_lo(w.x), bf_hi(w.x), bf_lo(w.y), bf_hi(w.y)};
                if (l == 0) v[j] = vn[j]; else { const unsigned xa = __float_as_uint(vn[j][0]), xb = __float_as_uint(vn[j][1]); v[j] = (f32x4){bf_lo(xa), bf_hi(xa), bf_lo(xb), bf_hi(xb)}; } }
            const int nidx = rr == 0 ? idx + 1 : idx + 15;
            if (rr == 0 || gI + 1 < ngroups) R2_LOAD(nidx);
            if (idx < nrows) {
                int b, p; row_decode(idx, all, b, p);
                const int row = b * TB + p; const bool isc = p < NCTX; const int sel = isc ? 16 : b;
                bf16_t* xo = isc ? XCb + (size_t)(b * NCTX + p) * D : X1b + (size_t)(b * SEQ + p - NCTX) * D;
                if (sel != cursel) { cursel = sel; f32x4 g[4], sc[4]; ld_vec(n2g, F.lane, g); ld_vec(modp(MODb, l, sel, 4), F.lane, sc); ld_vec(modp(MODb, l, sel, 3), F.lane, sh); ld_vec(modp(MODb, l, sel, 2), F.lane, g1v);
#pragma unroll
                    for (int j = 0; j < 4; ++j) gm[j] = g[j] * (sc[j] + 1.0f); }
#pragma unroll
                for (int j = 0; j < 4; ++j) v[j] = v[j] + g1v[j] * h[j];
                if (!dry) st_row_bf16(xo, F.lane, v);
                const float rinv = row_rinv(v);
#pragma unroll
                for (int j = 0; j < 4; ++j) h[j] = (v[j] * rinv) * gm[j] + sh[j];
                if (!dry) st_row_fp8(H8b + (size_t)row * D, F.lane, h);
#pragma unroll
                for (int j = 0; j < 4; ++j) *(LAS f32x4*)(tt + trow * 1024 + ((256 * j + 4 * F.lane) ^ (4 * trow))) = h[j];
                if (F.lane == 2 * gI + rr) my_row = row;
            }
        }
        __syncthreads();
        {
            f32x4 acc = {0.f, 0.f, 0.f, 0.f}; const int r16 = F.lane & 15, quad = F.lane >> 4;
#pragma unroll 8
            for (int i = 0; i < 32; ++i) { const int k = 128 * F.wave + 4 * i + quad;
                const float a = tt[r16 * 1024 + (k ^ (4 * r16))], bq = rw[k * 16 + r16];
                acc = __builtin_amdgcn_mfma_f32_16x16x4f32(a, bq, acc, 0, 0, 0); }
#pragma unroll
            for (int j = 0; j < 4; ++j) part[F.wave * 256 + (4 * quad + j) * 16 + r16] = acc[j];
        }
        __syncthreads();
#pragma unroll
        for (int rr = 0; rr < 2; ++rr) {
            const int trow = 2 * F.wave + rr; float lgl = 0.f;
#pragma unroll
            for (int w = 0; w < 8; ++w) lgl += part[w * 256 + trow * 16 + (F.lane & 15)];
            float lg[16];
#pragma unroll
            for (int e = 0; e < 16; ++e) lg[e] = __builtin_bit_cast(float, __builtin_amdgcn_readlane(__builtin_bit_cast(int, lgl), e));
            float s[16], sl[16];
#pragma unroll
            for (int e = 0; e < 16; ++e) { s[e] = __builtin_amdgcn_rcpf(1.0f + __builtin_amdgcn_exp2f(-1.4426950409f * lg[e])); sl[e] = s[e] + rb[e]; }
            float bestg = -INFINITY; int gi = 0;
#pragma unroll
            for (int g = 0; g < 4; ++g) { float m1 = -INFINITY, m2 = -INFINITY;
#pragma unroll
                for (int k = 0; k < 4; ++k) { const float t = sl[4 * g + k]; if (t > m1) { m2 = m1; m1 = t; } else if (t > m2) m2 = t; }
                const float gs = m1 + m2; if (gs > bestg) { bestg = gs; gi = g; } }
            float c4[4], s4[4];
#pragma unroll
            for (int k = 0; k < 4; ++k) { c4[k] = gi == 0 ? sl[k] : gi == 1 ? sl[4 + k] : gi == 2 ? sl[8 + k] : sl[12 + k]; s4[k] = gi == 0 ? s[k] : gi == 1 ? s[4 + k] : gi == 2 ? s[8 + k] : s[12 + k]; }
            int i0 = 0; float v0 = c4[0], w0 = s4[0];
#pragma unroll
            for (int k = 1; k < 4; ++k) if (c4[k] > v0) { v0 = c4[k]; i0 = k; w0 = s4[k]; }
            int i1 = -1; float v1 = -INFINITY, w1 = 0.f;
#pragma unroll
            for (int k = 0; k < 4; ++k) if (k != i0 && c4[k] > v1) { v1 = c4[k]; i1 = k; w1 = s4[k]; }
            const float rws = __builtin_amdgcn_rcpf(w0 + w1); w0 *= rws; w1 *= rws;
            if (F.lane == 2 * gI + rr) { my_e0 = (unsigned)(4 * gi + i0); my_e1 = (unsigned)(4 * gi + i1); my_w0 = w0; my_w1 = w1; }
        }
    }
#undef R2_LOAD
#undef R2_XI
    if (!dry) {
        const bool have = my_row >= 0;
        unsigned r0 = 0u, r1 = 0u, mycnt = 0u;
        const unsigned long long ltm = (1ull << F.lane) - 1ull;
#pragma unroll
        for (int e = 0; e < 16; ++e) { const unsigned long long m0 = __ballot(have && my_e0 == (unsigned)e), m1 = __ballot(have && my_e1 == (unsigned)e);
            const unsigned c0 = (unsigned)__popcll(m0), c1 = (unsigned)__popcll(m1);
            if (my_e0 == (unsigned)e) r0 = (unsigned)__popcll(m0 & ltm);
            if (my_e1 == (unsigned)e) r1 = c0 + (unsigned)__popcll(m1 & ltm);
            if (F.lane == e) mycnt = c0 + c1; }
        unsigned base = 0u; if (F.lane < 16 && mycnt) base = __hip_atomic_fetch_add(cnt + F.lane, mycnt, RLX_AGENT);
        const unsigned b0 = (unsigned)__builtin_amdgcn_ds_bpermute((int)(my_e0 * 4u), (int)base), b1 = (unsigned)__builtin_amdgcn_ds_bpermute((int)(my_e1 * 4u), (int)base);
        if (have) { const u32x4 q0 = {my_e0, b0 + r0, my_e1, b1 + r1}; const u32x4 q1 = {__float_as_uint(my_w0), __float_as_uint(my_w1), 0u, 0u};
            *(GAS u32x4*)(RT + (size_t)my_row * 8) = q0; *(GAS u32x4*)(RT + (size_t)my_row * 8 + 4) = q1;
            PLb[(size_t)my_e0 * T + b0 + r0] = my_row; PLb[(size_t)my_e1 * T + b1 + r1] = my_row; }
    }
    __syncthreads();
}

constexpr int ETAB_OFF = 256, IDXBUF_OFF = 1024;
__device__ __forceinline__ void build_ptab(Frame& F, int l, LAS int* ptab) {
    gu32* cntb = F.ctl() + CW_CNT + l * 64; const int e = F.tid & 15;
    const int c = (int)__hip_atomic_load(cntb + e, RLX_AGENT);
    if (F.tid < 16) { ptab[32 + e] = c; ptab[48 + e] = (c + 255) >> 8; }
    __syncthreads();
    int tl[16], tot = 0, mys = 0;
#pragma unroll
    for (int k = 0; k < 16; ++k) { tl[k] = ptab[48 + k]; if (k < e) mys += tl[k]; tot += tl[k]; }
    if (F.tid < 16) ptab[e] = mys << 8;
    if (F.tid == 16) ptab[NE] = tot << 8;
    for (int j = F.tid; j < tot; j += NWAVES * 64) { int ee = 0, acc = 0;
#pragma unroll
        for (int k = 0; k < 15; ++k) { acc += tl[k]; ee += (j >= acc) ? 1 : 0; }
        ptab[ETAB_OFF + j] = ee; }
    __syncthreads();
}
__device__ __forceinline__ void gather_phase(Frame& F, int l, LAS int* ptab) {
    const bool all = (l == 0); const int nrows = all ? T : NB * SEQ;
    const unsigned* RT = F.ROUTE(); const unsigned char* Ab = F.H8(); unsigned char* HGb = F.HG();
    const RowRange rr = wave_rows(F, nrows);
    for (int idx = rr.lo; idx < rr.hi; idx += 4) {
        u32x4 a[4]; size_t p0[4], p1[4];
#pragma unroll
        for (int k = 0; k < 4; ++k) if (idx + k < rr.hi) { int b, p; row_decode(idx + k, all, b, p); const int row = b * TB + p;
            const u32x4 r0 = *(const GAS u32x4*)(RT + (size_t)row * 8); p0[k] = (size_t)ptab[r0.x] + r0.y; p1[k] = (size_t)ptab[r0.z] + r0.w;
            a[k] = *((const GAS u32x4*)(Ab + (size_t)row * D) + F.lane); }
#pragma unroll
        for (int k = 0; k < 4; ++k) if (idx + k < rr.hi) { *((GAS u32x4*)(HGb + p0[k] * D) + F.lane) = a[k]; *((GAS u32x4*)(HGb + p1[k] * D) + F.lane) = a[k]; }
    }
}
__device__ __forceinline__ void r3_phase(Frame& F, int l, LAS int* ptab, bool dry = false) {
    const bool all = (l == 0); const int nrows = all ? T : NB * SEQ;
    const float* MODb = F.MOD(); const bf16_t* XCb = F.XC(); const bf16_t* X1b = F.X1(); float* outb = F.out(); const unsigned char* YPb = F.YP(); bf16_t* Ab = F.A(); unsigned char* H8i = F.HIN8(); const unsigned* RT = F.ROUTE();
    const float* n1g = F.norm1_g() + (size_t)(l == 0 ? 1 : 0) * D;
    const RowRange rr = wave_rows(F, nrows);
    int cursel = -1; f32x4 g2v[4], gm[4], sh[4]; u32x2 xn[4]; unsigned y0n[4], y1n[4]; float w0n = 0.f, w1n = 0.f;
    u32x4 ra = {0u, 0u, 0u, 0u}; u32x2 rb2 = {0u, 0u};
#define R3_ROUTE(idx_) do { int b_, p_; row_decode((idx_), all, b_, p_); const int row_ = b_ * TB + p_; ra = *(const GAS u32x4*)(RT + (size_t)row_ * 8); rb2 = *(const GAS u32x2*)(RT + (size_t)row_ * 8 + 4); } while (0)
#define R3_LOAD(idx_) do { int b_, p_; row_decode((idx_), all, b_, p_); const u32x4 r0_ = ra; const u32x2 r1_ = rb2; \
        const size_t q0_ = (size_t)ptab[r0_.x] + r0_.y, q1_ = (size_t)ptab[r0_.z] + r0_.w; w0n = __uint_as_float(r1_.x); w1n = __uint_as_float(r1_.y); \
        { const bf16_t* s_ = (p_ < NCTX) ? XCb + (size_t)(b_ * NCTX + p_) * D : X1b + (size_t)(b_ * SEQ + p_ - NCTX) * D; _Pragma("unroll") for (int j = 0; j < 4; ++j) xn[j] = *((const GAS u32x2*)s_ + F.lane + 64 * j); } \
        _Pragma("unroll") for (int j = 0; j < 4; ++j) { y0n[j] = *((const GAS unsigned*)(YPb + q0_ * D) + F.lane + 64 * j); y1n[j] = *((const GAS unsigned*)(YPb + q1_ * D) + F.lane + 64 * j); } } while (0)
    if (rr.lo < rr.hi) { R3_ROUTE(rr.lo); R3_LOAD(rr.lo); if (rr.lo + 1 < rr.hi) R3_ROUTE(rr.lo + 1); }
    for (int idx = rr.lo; idx < rr.hi; ++idx) {
        int b, p; row_decode(idx, all, b, p);
        const int row = b * TB + p; const bool isc = p < NCTX; const int sel = isc ? 16 : b;
        const size_t lrow = (size_t)(b * SEQ + p - NCTX);
        f32x4 v[4], m[4]; const float w0 = w0n, w1 = w1n;
#pragma unroll
        for (int j = 0; j < 4; ++j) { const f32x2 a0 = __builtin_amdgcn_cvt_pk_f32_fp8((int)y0n[j], false), a1 = __builtin_amdgcn_cvt_pk_f32_fp8((int)y0n[j], true),
                c0 = __builtin_amdgcn_cvt_pk_f32_fp8((int)y1n[j], false), c1 = __builtin_amdgcn_cvt_pk_f32_fp8((int)y1n[j], true); v[j] = (f32x4){bf_lo(xn[j].x), bf_hi(xn[j].x), bf_lo(xn[j].y), bf_hi(xn[j].y)};
            m[j] = (f32x4){a0.x * w0 + c0.x * w1, a0.y * w0 + c0.y * w1, a1.x * w0 + c1.x * w1, a1.y * w0 + c1.y * w1}; }
        if (idx + 1 < rr.hi) { R3_LOAD(idx + 1); if (idx + 2 < rr.hi) R3_ROUTE(idx + 2); }
        if (sel != cursel) { cursel = sel; ld_vec(modp(MODb, l, sel, 5), F.lane, g2v);
            if (l == 0) { f32x4 g[4], sc[4]; ld_vec(n1g, F.lane, g); ld_vec(modp(MODb, l + 1, sel, 1), F.lane, sc); ld_vec(modp(MODb, l + 1, sel, 0), F.lane, sh);
#pragma unroll
                for (int j = 0; j < 4; ++j) gm[j] = g[j] * (sc[j] + 1.0f); } }
#pragma unroll
        for (int j = 0; j < 4; ++j) v[j] = v[j] + g2v[j] * m[j];
        if (!isc && !dry) { if (l == 0) st_row_bf16((bf16_t*)outb + lrow * D, F.lane, v); else st_row_f32(outb + lrow * D, F.lane, v); }
        if (l == 0) { const float rinv = row_rinv(v); f32x4 h[4];
#pragma unroll
            for (int j = 0; j < 4; ++j) h[j] = (v[j] * rinv) * gm[j] + sh[j];
            if (!dry) { if (PSPLIT > 0) st_row_bf16(Ab + (size_t)row * D, F.lane, h); st_row_fp8(H8i + (size_t)row * D, F.lane, h); } }
    }
#undef R3_LOAD
#undef R3_ROUTE
}

__device__ __forceinline__ int lat_tile(int pe) { return (pe >> 4) * 17 + 1 + (pe & 15); }
struct SchedProj {
    const char* A; const char* B; int G, c, pn0, npn, rowB, kv_ctx;
    __device__ __forceinline__ bool next(int i, pg8::Unit& u) const { int pm, pn; const long L = (long)i * G + c;
        if (!kv_ctx) { if (!pg8::tile_order(L, T / 256, npn, pm, pn)) return false; pn += pn0; }
        else if (L < (long)(NB * SEQ / 256) * npn) { pg8::tile_order(L, NB * SEQ / 256, npn, pm, pn); pm = lat_tile(pm); pn += pn0; }
        else { const int r = (int)(L - (long)(NB * SEQ / 256) * npn); if (r >= 2 * NB) return false; pm = (r >> 1) * 17; pn = (r & 1) ? C_WK / 256 : C_GK / 256; }
        u.pm = pm; u.pn = pn; u.aux = 0; u.A = A + (size_t)pm * 256 * rowB; u.B = B + (size_t)pn * 256 * rowB; return true; }
};
struct SchedMerge {
    const char* P; const char* B; int G, c, nM; bool lat_only;
    __device__ __forceinline__ bool next(int i, pg8::Unit& u) const { const int rnd = i / 3, br = i - rnd * 3; int pm, pn; if (!pg8::tile_order((long)rnd * G + c, nM, 4, pm, pn)) return false;
        if (lat_only) pm = lat_tile(pm);
        const int acol = br == 0 ? C_GR : (br == 1 ? C_GQ : C_WQ);
        u.pm = pm; u.pn = pn; u.aux = br; u.A = P + ((size_t)pm * 256 * NIN + acol) * 2; u.B = B + ((size_t)br * D + pn * 256) * 512 * 2; return true; }
};
struct SchedOut {
    const char* A; const char* B; int G, c, nM; bool lat_only;
    __device__ __forceinline__ bool next(int i, pg8::Unit& u) const { int pm, pn; if (!pg8::tile_order((long)i * G + c, nM, 4, pm, pn)) return false;
        if (lat_only) pm = lat_tile(pm);
        u.pm = pm; u.pn = pn; u.aux = 0; u.A = A + (size_t)pm * 256 * D * 2; u.B = B + (size_t)pn * 256 * D * 2; return true; }
};
struct SchedMoe {
    const char* A; const char* B; const LAS int* ptab; const int* PLb; int G, c, npn;
    __device__ __forceinline__ bool next(int i, pg8::Unit& u) const { const int L = i * G + c; const int ntile = __builtin_amdgcn_readfirstlane(ptab[NE]) >> 8; if (L >= ntile * npn) return false;
        const int j = L / npn, pn = L - j * npn; const int e = __builtin_amdgcn_readfirstlane(ptab[ETAB_OFF + j]); const int tin = j - (__builtin_amdgcn_readfirstlane(ptab[e]) >> 8); const int left = __builtin_amdgcn_readfirstlane(ptab[32 + e]) - tin * 256;
        u.pm = j; u.pn = pn; u.aux = e; u.B = B + ((size_t)e * npn + pn) * 256 * D;
        if (PLb) { u.A = A; u.gl = PLb + (size_t)e * T + tin * 256; u.nvalid = left < 256 ? left : 256; } else { u.A = A + (size_t)j * 256 * D; u.gl = nullptr; u.nvalid = 256; }
        return true; }
};

#ifndef PROBE
#define PROBE 0
#endif
#ifndef STAGGER
#define STAGGER 0
#endif
static_assert(sizeof(Args) == sizeof(KArgs), "kernarg views");
__global__ void __launch_bounds__(NWAVES * 64, 2) mega_fwd(Args args) {
    extern __shared__ __attribute__((aligned(16))) unsigned char lds[];
    volatile LAS unsigned* MISC = (volatile LAS unsigned*)((LAS unsigned char*)lds + MISC_OFF);
    LAS int* ptab = (LAS int*)((LAS unsigned char*)lds + LDSCTL_OFF);
    Frame F0; {
    Frame& F = F0;
    F.lds = (LAS unsigned char*)lds;
    F.tid = threadIdx.x; F.lane = F.tid & 63; F.wave = __builtin_amdgcn_readfirstlane(F.tid >> 6);
    F.G = gridDim.x; { const int bx = blockIdx.x; F.vcu = (F.G % 8 == 0) ? (bx % 8) * (F.G / 8) + bx / 8 : bx; }
    F.gw = F.vcu * NWAVES + F.wave; F.NGW = F.G * NWAVES; F.bid = blockIdx.x; }
    for (int u = F0.tid; u < (LDS_BYTES - LDSCTL_OFF) / 4; u += NWAVES * 64) ((LAS unsigned*)(F0.lds + LDSCTL_OFF))[u] = 0u;
    __syncthreads();
    XcdBarrier bar = xcd_barrier_post((unsigned*)(F0.ctl() + CW_BAR), MISC + 8);
#define GRID_BAR() do { XcdBarrier b_ = bar; asm volatile("" : "+s"(b_.bar), "+s"(b_.x)); int w_ = F0.wave; asm volatile("" : "+s"(w_)); \
        unsigned o_ = ~0u; asm volatile("" : "+s"(o_)); xcd_barrier(b_, w_ == 0 && __builtin_amdgcn_mbcnt_hi(o_, __builtin_amdgcn_mbcnt_lo(o_, 0u)) == 0u); } while (0)

    { Frame F = fresh(F0); p0_prologue(F); }
    if (PROBE == 13) { __syncthreads(); Frame F = fresh(F0); p0_prologue(F); }
    GRID_BAR();
    { Frame F = fresh(F0); convert_small(F); }
    { Frame F = fresh(F0); r1_phase(F); }
    if (PROBE == 17) { Frame F = fresh(F0); r1_phase(F); }
    GRID_BAR();

    for (int l = 0; l < NL; ++l) {
        const bool last = (l == NL - 1);
        if (PSPLIT > 0) { Frame F = fresh(F0);
            pg8::Gemm g{D / 64, D * 2, D * 2, STAGGER}; SchedProj S{(const char*)F.A(), (const char*)(F.WIN() + (size_t)l * NIN * D), F.G, F.bid, 0, PSPLIT, D * 2, 0};
            pg8::EpiProj E{F.PROJ(), (const LAS float*)(F.lds + BIAS_OFF), 1.0f, 0, 0};
            pg8::gemm_phase(F.tid, F.lds + RING_OFF, g, S, E);
            if (PROBE == 1) { __syncthreads(); pg8::gemm_phase(F.tid, F.lds + RING_OFF, g, S, E); }
        }
        { Frame F = fresh(F0);
            pg8::Gemm g{D / 128, D, D, STAGGER}; SchedProj S{(const char*)F.HIN8(), (const char*)(F.WIN8() + (size_t)l * NIN * D), F.G, (F.bid + (3 * F.G) / 4) % F.G, PSPLIT, NIN / 256 - PSPLIT, D, last ? 1 : 0};
            { LAS float* bl = (LAS float*)(F.lds + BIAS_OFF); const float* bm = F.b_merge() + (size_t)l * 3 * D;
              for (int i = F.tid; i < 3 * D / 4; i += NWAVES * 64) *((LAS f32x4*)bl + i) = *((const GAS f32x4*)bm + i) * -1.4426950409f; }
            __syncthreads();
            pg8::EpiProj E{F.PROJ(), (const LAS float*)(F.lds + BIAS_OFF), 1.0f / WSCALE, 0, 0};
            if (PROBE == 52) { pg8::EpiProj E2 = E; E2.dry = __builtin_amdgcn_readfirstlane((int)(__hip_atomic_load(F.ctl() + 8, RLX_AGENT) == 0u)); pg8::gemm_phase<pg8::EpiProj, SchedProj, true>(F.tid, F.lds + RING_OFF, g, S, E2); __syncthreads(); }
            if (PROBE == 50 || PROBE == 51) { pg8::Gemm g2{PROBE == 51 ? D / 64 : D / 128, D, D, STAGGER}; pg8::gemm_phase<pg8::EpiProj, SchedProj, true>(F.tid, F.lds + RING_OFF, g2, S, E); __syncthreads(); }
            pg8::gemm_phase<pg8::EpiProj, SchedProj, true>(F.tid, F.lds + RING_OFF, g, S, E);
            if (PROBE == 1) { __syncthreads(); pg8::gemm_phase<pg8::EpiProj, SchedProj, true>(F.tid, F.lds + RING_OFF, g, S, E); }
        }
        GRID_BAR();
        if (PROBE == 14) { Frame F = fresh(F0); kfix_phase(F, l, __hip_atomic_load(F.ctl() + 8, RLX_AGENT) == 0u); }
        { Frame F = fresh(F0); kfix_phase(F, l); }
        GRID_BAR();
        if (PROBE == 4) { Frame F = fresh(F0); const bool dry = __hip_atomic_load(F.ctl() + 8, RLX_AGENT) == 0u; for (int uid = F.vcu; uid < 256; uid += F.G) scan_unit(F, l, uid, last, dry); __syncthreads(); }
        { Frame F = fresh(F0); for (int uid = F.vcu; uid < 256; uid += F.G) scan_unit(F, l, uid, last); }
        __syncthreads();
        { Frame F = fresh(F0);
            const int per = (2048 + F.G - 1) / F.G;
            bool nomax0, nomax1;
            { const float* qgp = F.q_norm_g() + (size_t)l * 128; const float* kgp = F.k_norm_g() + (size_t)l * 128;
              const float mq0 = wave_max(fabsf(qgp[F.lane])), mk0 = wave_max(fabsf(kgp[F.lane])), mq1 = wave_max(fabsf(qgp[64 + F.lane])), mk1 = wave_max(fabsf(kgp[64 + F.lane]));
              nomax0 = __builtin_amdgcn_readfirstlane((int)(8.0f * 1.4426950409f * mq0 * mk0 < 100.0f)) != 0; nomax1 = __builtin_amdgcn_readfirstlane((int)(8.0f * 1.4426950409f * mq1 * mk1 < 100.0f)) != 0; }
            attn_body::AttnArgs aa; aa.P = (attn_body::bf16*)F.PROJ(); aa.ropec = F.ROPEC(); aa.ropes = F.ROPES(); aa.dry = false; aa.sinkp = F.sink() + l * 8;
            aa.qg = F.q_norm_g() + (size_t)(l * 2 + 0) * 64; aa.sink = 0.f;
            if (PROBE == 11) { aa.dry = __hip_atomic_load(F.ctl() + 8, RLX_AGENT) == 0u; for (int gid = F.vcu * per; gid < (F.vcu + 1) * per && gid < 2048; ++gid) { const int pair = gid >> 6, uu = gid & 63; const int b = pair >> 1, h = (pair & 1) * 4 + (uu >> 4), qb = uu & 15;
                if (nomax0) attn_body::attn_unit<0, 8, true>(F.tid, b, h, qb, aa, (char*)lds + RING_OFF); else attn_body::attn_unit<0, 8, false>(F.tid, b, h, qb, aa, (char*)lds + RING_OFF); } aa.dry = false; }
            const int gid0 = F.vcu * per, gid1 = ((F.vcu + 1) * per < 2048) ? (F.vcu + 1) * per : 2048;
            if (PROBE != 9) for (int gid = gid0; gid < gid1; ++gid) { const int pair = gid >> 6, uu = gid & 63; const int b = pair >> 1, h = (pair & 1) * 4 + (uu >> 4), qb = uu & 15;
                const int gn = gid + 1, pn_ = gn >> 6, un_ = gn & 63; const bool st = gid > gid0, hn = gn < gid1;
                const attn_body::bf16* qn = attn_body::q_wave_ptr<0>(aa, F.wave, pn_ >> 1, (pn_ & 1) * 4 + (un_ >> 4), un_ & 15);
                if (nomax0) attn_body::attn_unit<0, 8, true>(F.tid, b, h, qb, aa, (char*)lds + RING_OFF, st, hn, qn); else attn_body::attn_unit<0, 8, false>(F.tid, b, h, qb, aa, (char*)lds + RING_OFF, st, hn, qn); }
            aa.qg = F.q_norm_g() + (size_t)(l * 2 + 1) * 64;
            if (PROBE == 12) { aa.dry = __hip_atomic_load(F.ctl() + 8, RLX_AGENT) == 0u; for (int gid = F.vcu * per; gid < (F.vcu + 1) * per && gid < 2048; ++gid) { const int pair = gid >> 6, uu = gid & 63; const int b = pair >> 1, h = (pair & 1) * 4 + (uu >> 4), qb = uu & 15;
                aa.sink = 0.f; if (nomax1) attn_body::attn_unit<1, 8, true>(F.tid, b, h, qb, aa, (char*)lds + RING_OFF); else attn_body::attn_unit<1, 8, false>(F.tid, b, h, qb, aa, (char*)lds + RING_OFF); } aa.dry = false; }
            aa.sinkp = F.sink() + l * 8;
            if (PROBE != 10) for (int gid = gid0; gid < gid1; ++gid) { const int b = gid >> 7, h = (gid >> 5) & 3, qb = gid & 31;
                aa.sink = 0.f;
                const int gn = gid + 1; const bool st = gid > gid0, hn = gn < gid1;
                const attn_body::bf16* qn = attn_body::q_wave_ptr<1>(aa, F.wave, gn >> 7, (gn >> 5) & 3, gn & 31);
                if (nomax1) attn_body::attn_unit<1, 8, true>(F.tid, b, h, qb, aa, (char*)lds + RING_OFF, st, hn, qn); else attn_body::attn_unit<1, 8, false>(F.tid, b, h, qb, aa, (char*)lds + RING_OFF, st, hn, qn); }
            if (!last) {
                for (int cid = F.vcu; cid < 256; cid += F.G) { const int b = cid >> 4, h = (cid >> 1) & 7;
                    if (cid & 1) { aa.qg = F.q_norm_g() + (size_t)(l * 2 + 1) * 64; aa.sink = F.sink()[l * 8 + h]; if (nomax1) attn_body::attn_unit<3, 8, true>(F.tid, b, h, 0, aa, (char*)lds + RING_OFF); else attn_body::attn_unit<3, 8, false>(F.tid, b, h, 0, aa, (char*)lds + RING_OFF); }
                    else { aa.qg = F.q_norm_g() + (size_t)(l * 2 + 0) * 64; aa.sink = 0.f; if (nomax0) attn_body::attn_unit<2, 8, true>(F.tid, b, h, 0, aa, (char*)lds + RING_OFF); else attn_body::attn_unit<2, 8, false>(F.tid, b, h, 0, aa, (char*)lds + RING_OFF); } }
            }
        }
        GRID_BAR();
        { Frame F = fresh(F0);
            pg8::Gemm g{512 / 64, NIN * 2, 512 * 2, STAGGER}; SchedMerge S{(const char*)F.PROJ(), (const char*)(F.WBR() + (size_t)l * 3 * D * 512), F.G, F.bid, last ? 256 : 272, last};
            pg8::EpiMerge E{F.PROJ(), F.A()};
            pg8::gemm_phase(F.tid, F.lds + RING_OFF, g, S, E);
            if (PROBE == 2) { __syncthreads(); pg8::gemm_phase(F.tid, F.lds + RING_OFF, g, S, E); }
        }
        GRID_BAR();
        if (PROBE == 30) { for (int k = 0; k < 10; ++k) GRID_BAR(); }
        { Frame F = fresh(F0);
            pg8::Gemm g{D / 64, D * 2, D * 2, STAGGER}; SchedOut S{(const char*)F.A(), (const char*)(F.WOUT() + (size_t)l * D * D), F.G, F.bid, last ? 256 : 272, last};
            pg8::EpiPlain E{F.YBUF(), D, 1.0f};
            pg8::gemm_phase(F.tid, F.lds + RING_OFF, g, S, E);
            if (PROBE == 3) { __syncthreads(); pg8::gemm_phase(F.tid, F.lds + RING_OFF, g, S, E); }
        }
        GRID_BAR();
        { Frame F = fresh(F0); convert_experts(F, l); }
        __syncthreads();
        if (PROBE == 7) { Frame F = fresh(F0); convert_experts(F, l); __syncthreads(); }
        if (PROBE == 15) { Frame F = fresh(F0); r2_phase(F, l, __hip_atomic_load(F.ctl() + 8, RLX_AGENT) == 0u); }
        { Frame F = fresh(F0); r2_phase(F, l); }
        GRID_BAR();
        { Frame F = fresh(F0); LAS int* pt = ptab; asm volatile("" : "+v"(pt)); build_ptab(F, l, pt); }
        { Frame F = fresh(F0);
            pg8::Gemm g{D / 128, D, D, STAGGER}; LAS int* pt = ptab; asm volatile("" : "+v"(pt)); SchedMoe S{(const char*)F.H8(), (const char*)F.W13(), pt, F.PL(), F.G, F.bid, 8};
            pg8::EpiSwiglu E{F.HID(), 1.0f / WSCALE};
            pg8::gemm_phase<pg8::EpiSwiglu, SchedMoe, true, true>(F.tid, F.lds + RING_OFF, g, S, E, pt + IDXBUF_OFF);
        }
        GRID_BAR();
        { Frame F = fresh(F0);
            pg8::Gemm g{D / 128, D, D, STAGGER}; LAS int* pt = ptab; asm volatile("" : "+v"(pt)); SchedMoe S{(const char*)F.HID(), (const char*)F.W2(), pt, nullptr, F.G, F.bid, 4};
            pg8::EpiPlain8 E{F.YP(), D, 1.0f / WSCALE};
            pg8::gemm_phase<pg8::EpiPlain8, SchedMoe, true>(F.tid, F.lds + RING_OFF, g, S, E);
        }
        GRID_BAR();
        if (PROBE == 16) { Frame F = fresh(F0); LAS int* pt = ptab; asm volatile("" : "+v"(pt)); r3_phase(F, l, pt, __hip_atomic_load(F.ctl() + 8, RLX_AGENT) == 0u); }
        { Frame F = fresh(F0); LAS int* pt = ptab; asm volatile("" : "+v"(pt)); r3_phase(F, l, pt); }
        if (!last) GRID_BAR();
    }
}

extern "C" void kernel_launch(void* const* d_in, const int* in_sizes, int n_in, void* d_out, int out_size, void* d_ws, size_t ws_size, hipStream_t stream) {
    static int grid = 0;
    if (grid == 0) {
        if (n_in != 27 || in_sizes[0] != NB * SEQ * D || out_size != NB * SEQ * D || ws_size < WS_END) { fprintf(stderr, "kernel_launch: unexpected shapes / workspace (n_in %d, ws %zu < %zu)\n", n_in, ws_size, (size_t)WS_END); grid = -1; return; }
        int dev = 0, cus = 0, per_cu = 0;
        if (hipGetDevice(&dev) != hipSuccess || hipDeviceGetAttribute(&cus, hipDeviceAttributeMultiprocessorCount, dev) != hipSuccess) { grid = -1; return; }
        if (hipFuncSetAttribute((const void*)mega_fwd, hipFuncAttributeMaxDynamicSharedMemorySize, LDS_BYTES) != hipSuccess) { fprintf(stderr, "kernel_launch: hipFuncSetAttribute failed\n"); grid = -1; return; }
        if (hipOccupancyMaxActiveBlocksPerMultiprocessor(&per_cu, (const void*)mega_fwd, NWAVES * 64, LDS_BYTES) != hipSuccess || per_cu < 1) { fprintf(stderr, "kernel_launch: occupancy query says %d\n", per_cu); }
        (void)hipGetLastError();
        if (cus < 137) { fprintf(stderr, "kernel_launch: built for >= 137 CUs (the router pass keeps at most 64 rows per wave), device has %d\n", cus); grid = -1; return; }
        grid = cus;
    }
    if (grid < 0) return;
    if (hipMemsetAsync((char*)d_ws + WS_CTL, 0, CTL_ZERO_BYTES, stream) != hipSuccess) return;
    Args a{};
    for (int i = 0; i < 27; ++i) a.in[i] = (const float*)d_in[i];
    a.out = (float*)d_out; a.ws = (unsigned char*)d_ws;
    hipLaunchKernelGGL(mega_fwd, dim3(grid), dim3(NWAVES * 64), LDS_BYTES, stream, a);
}
```

```cpp
#define PROBE 0
#include <hip/hip_runtime.h>
#include <hip/hip_bf16.h>
#include <cstdio>
#include <cstdint>
#include <cmath>

#define GAS __attribute__((address_space(1)))
#define LAS __attribute__((address_space(3)))
typedef unsigned short bf16_t;
typedef short bf16x8 __attribute__((ext_vector_type(8)));
typedef float f32x4 __attribute__((ext_vector_type(4)));
typedef float f32x2 __attribute__((ext_vector_type(2)));
typedef unsigned u32x4 __attribute__((ext_vector_type(4)));
typedef unsigned u32x2 __attribute__((ext_vector_type(2)));

constexpr int NB = 16, SEQ = 4096, NCTX = 256, TB = SEQ + NCTX, T = NB * TB;
constexpr int D = 1024, NIN = 5632, NL = 2, NE = 16;
constexpr int C_XR = 0, C_GR = 512, C_GQ = 1024, C_GK = 1536, C_GV = 1664, C_WQ = 1792, C_WK = 2304, C_WV = 2432, C_MG = 2560;
constexpr float EPS = 1e-6f;
constexpr int PMAX = 143360;

__device__ __forceinline__ unsigned cvt_pk_bf16(float lo, float hi) { unsigned r; asm volatile("v_cvt_pk_bf16_f32 %0, %1, %2" : "=v"(r) : "v"(lo), "v"(hi)); return r; }
typedef int i32x8 __attribute__((ext_vector_type(8)));
typedef int i32x4 __attribute__((ext_vector_type(4)));
__device__ __forceinline__ unsigned pk4_fp8(float a, float b, float c, float d) {
    a = __builtin_amdgcn_fmed3f(a, -448.f, 448.f); b = __builtin_amdgcn_fmed3f(b, -448.f, 448.f); c = __builtin_amdgcn_fmed3f(c, -448.f, 448.f); d = __builtin_amdgcn_fmed3f(d, -448.f, 448.f);
    int w = __builtin_amdgcn_cvt_pk_fp8_f32(a, b, 0, false); w = __builtin_amdgcn_cvt_pk_fp8_f32(c, d, w, true); return (unsigned)w; }
__device__ __forceinline__ float bf_lo(unsigned u) { return __uint_as_float(u << 16); }
__device__ __forceinline__ float bf_hi(unsigned u) { return __uint_as_float(u & 0xffff0000u); }
__device__ __forceinline__ float fast_sigmoid(float v) { return __builtin_amdgcn_rcpf(1.0f + __builtin_amdgcn_exp2f(-1.4426950409f * v)); }
__device__ __forceinline__ float gelu_tanh(float v) { return v * __builtin_amdgcn_rcpf(1.0f + __builtin_amdgcn_exp2f(-2.3022082f * v * (1.0f + 0.044715f * v * v))); }

namespace pg8 {
constexpr int BM = 256, BK = 64, HALF = 128, HTB = HALF * BK * 2, STAGE_BYTES = 8 * HTB, NXCD = 8, WGM = 4;
__host__ __device__ __forceinline__ int lds_byte(int r, int c) { const int st = (r >> 4) * 2 + (c >> 5), rr = r & 15, cc = c & 31, ob = rr * 64 + cc * 2; return st * 1024 + (ob ^ (((ob >> 9) & 1) << 5)); }
__host__ __device__ __forceinline__ void stage_rc(int b, int& R, int& C) { const int st = b / 1024, sb = b % 1024, swz = sb ^ (((sb >> 9) & 1) << 5); R = (st >> 1) * 16 + swz / 64; C = (st & 1) * 32 + (swz % 64) / 2; }
__host__ __device__ __forceinline__ int perm32(int rho) { const int n = rho >> 4, i = rho & 15; return 8 * (i >> 2) + 4 * n + (i & 3); }

struct Unit { int pm, pn, aux; const char* A; const char* B; const int* gl; int nvalid; };
struct Gemm { int nt, ldaB, ldbB, stagger; };

__device__ __forceinline__ bool tile_order(long L, int nM, int nN, int& pm, int& pn) {
    const int nwg = nM * nN; if (L >= nwg) return false;
    int wgid = (int)L; { const int q = nwg / NXCD, r = nwg % NXCD, xcd = wgid % NXCD, off = wgid / NXCD; wgid = (xcd < r ? xcd * (q + 1) : r * (q + 1) + (xcd - r) * q) + off; }
    const int nig = WGM * nN, gid = wgid / nig, fm = gid * WGM, gsz = (nM - fm) < WGM ? (nM - fm) : WGM;
    pm = fm + ((wgid % nig) % gsz); pn = (wgid % nig) / gsz; return true;
}

template <class Epi, class Sched, bool FP8 = false, bool GATHER = false>
__device__ __forceinline__ void gemm_phase(int tid0, LAS unsigned char* lds, const Gemm g, const Sched& S, const Epi& E, LAS int* idxbuf = nullptr) {
    int tid_ = tid0; asm volatile("" : "+v"(tid_));
    const int tid = tid_, wid = __builtin_amdgcn_readfirstlane(tid >> 6), lane = tid & 63, wr = wid >> 2, wc = wid & 3, fr = lane & 15, fq = lane >> 4;
    int nt_ = g.nt; asm volatile("" : "+s"(nt_)); const int nt = nt_;
    unsigned voffA[2], voffB[2];
#pragma unroll
    for (int i = 0; i < 2; ++i) { int R, C; stage_rc(tid * 16 + i * 8192, R, C); const int Rb = (R & ~31) + perm32(R & 31);
        voffA[i] = (unsigned)(R * g.ldaB + C * 2); voffB[i] = (unsigned)(Rb * g.ldbB + C * 2); }
    const size_t kstep = (size_t)(BK * 2);
    const size_t hstepA = GATHER ? 0 : (size_t)HALF * g.ldaB, hstepB = (size_t)HALF * g.ldbB;
#define PG8_GOFF(dst, bufp, nv, h) do { _Pragma("unroll") for (int i_ = 0; i_ < 2; ++i_) { int R_, C_; stage_rc(tid * 16 + i_ * 8192, R_, C_); const int pos_ = R_ + HALF * (h); \
        const int ix_ = (bufp)[pos_]; dst[i_] = (unsigned)((pos_ < (nv)) ? ix_ : 0) * (unsigned)g.ldaB + (unsigned)(C_ * 2); } } while (0)
#define PG8_GDMA(bufp, glp) __builtin_amdgcn_global_load_lds((const unsigned*)((glp) + lane * 4), (LAS unsigned*)(bufp), 16, 0, 0)
    const unsigned ldsw = (unsigned)wid * 1024u;
    const int aoff = lds_byte(wr * 64 + fr, fq * 8), boff = lds_byte(wc * 32 + fr, fq * 8);
#define PG8_SA(b, h) (((b) * 2 + (h)) * HTB)
#define PG8_SB(b, h) ((4 + (b) * 2 + (h)) * HTB)
#define PG8_STAGE(bufoff, gbase, voff) do { _Pragma("unroll") for (int _i = 0; _i < 2; ++_i) \
        __builtin_amdgcn_global_load_lds((const unsigned*)((const char*)(gbase) + (voff)[_i]), (LAS unsigned*)(lds + (bufoff) + ldsw + _i * 8192), 16, 0, 0); } while (0)
#define PG8_LDA(dst, b, h) do { _Pragma("unroll") for (int m = 0; m < 4; ++m) _Pragma("unroll") for (int k = 0; k < 2; ++k) dst[m][k] = *(const LAS bf16x8*)(lds + PG8_SA(b, h) + aoff + m * 2048 + k * 1024); } while (0)
#define PG8_LDB(dst, b, h) do { _Pragma("unroll") for (int n = 0; n < 2; ++n) _Pragma("unroll") for (int k = 0; k < 2; ++k) dst[n][k] = *(const LAS bf16x8*)(lds + PG8_SB(b, h) + boff + n * 2048 + k * 1024); } while (0)
#define PG8_CAT(x) __builtin_shufflevector(__builtin_bit_cast(i32x4, x[0]), __builtin_bit_cast(i32x4, x[1]), 0, 1, 2, 3, 4, 5, 6, 7)
#define PG8_MMA(ai, bj, At, Bt) do { __builtin_amdgcn_s_setprio(1); \
        if constexpr (FP8) { _Pragma("unroll") for (int m = 0; m < 4; ++m) _Pragma("unroll") for (int n = 0; n < 2; ++n) \
            asm volatile("v_mfma_scale_f32_16x16x128_f8f6f4 %0, %1, %2, %0, %3, %3 op_sel_hi:[0,0,0]" : "+v"(acc[ai][bj][m][n]) : "v"(PG8_CAT(Bt[n])), "v"(PG8_CAT(At[m])), "v"(scl1)); } \
        else { _Pragma("unroll") for (int m = 0; m < 4; ++m) _Pragma("unroll") for (int n = 0; n < 2; ++n) _Pragma("unroll") for (int k = 0; k < 2; ++k) \
            acc[ai][bj][m][n] = __builtin_amdgcn_mfma_f32_16x16x32_bf16(Bt[n][k], At[m][k], acc[ai][bj][m][n], 0, 0, 0); } \
        __builtin_amdgcn_s_setprio(0); } while (0)
#define PG8_WAIT_V(n) asm volatile("s_waitcnt vmcnt(" #n ")" ::: "memory")
#define PG8_WAIT_L(n) asm volatile("s_waitcnt lgkmcnt(" #n ")" ::: "memory")
#define PG8_BAR __builtin_amdgcn_s_barrier()
#define PG8_SCHED __builtin_amdgcn_sched_barrier(0)
    int scl1 = 0x7F7F7F7F; asm volatile("" : "+v"(scl1));
#define PG8_STAGEA(bufoff, gbase, h, offs) do { if constexpr (GATHER) { unsigned go_[2]; PG8_GOFF(go_, idxbuf + 256 * (ui & 1), cur.nvalid, h); PG8_STAGE(bufoff, gbase, go_); } else { PG8_STAGE(bufoff, (gbase) + (h) * hstepA, voffA); } } while (0)
    Unit cur, nxt; int ui = 0;
    if (!S.next(0, cur)) return;
    u32x2 gcar[Epi::CHAIN ? 2 : 1][Epi::CHAIN ? 4 : 1][Epi::CHAIN ? 2 : 1];
    if constexpr (Epi::CHAIN) { _Pragma("unroll") for (int a_ = 0; a_ < 2; ++a_) _Pragma("unroll") for (int m_ = 0; m_ < 4; ++m_) _Pragma("unroll") for (int b_ = 0; b_ < 2; ++b_) gcar[a_][m_][b_] = (u32x2){0u, 0u}; }
    if constexpr (GATHER) { if (wid == 0) PG8_GDMA(idxbuf, cur.gl); asm volatile("s_waitcnt vmcnt(0)" ::: "memory"); __builtin_amdgcn_s_barrier(); }
    if (g.stagger > 0) { const unsigned long long t0 = __builtin_amdgcn_s_memrealtime(), dl = (unsigned long long)((blockIdx.x >> 3) & 3) * (unsigned)g.stagger;
        while (__builtin_amdgcn_s_memrealtime() - t0 < dl) __builtin_amdgcn_s_sleep(8); }
    f32x4 acc[2][2][4][2];
#pragma unroll
    for (int a = 0; a < 2; ++a)
#pragma unroll
        for (int b = 0; b < 2; ++b)
#pragma unroll
            for (int m = 0; m < 4; ++m)
#pragma unroll
                for (int n = 0; n < 2; ++n) acc[a][b][m][n] = (f32x4){0.f, 0.f, 0.f, 0.f};
    bf16x8 At[4][2], B0[2][2], B1[2][2];
    const char* cA = cur.A; const char* cB = cur.B;
    PG8_STAGE(PG8_SB(0, 0), cB, voffB); PG8_STAGE(PG8_SB(0, 1), cB + hstepB, voffB); PG8_STAGEA(PG8_SA(0, 0), cA, 0, co); PG8_STAGEA(PG8_SA(0, 1), cA, 1, co);
    if (wr == 1) PG8_BAR;
    PG8_WAIT_V(2); PG8_BAR;
    PG8_STAGE(PG8_SB(1, 0), cB + kstep, voffB); PG8_STAGEA(PG8_SA(1, 0), cA + kstep, 0, co); PG8_STAGE(PG8_SB(1, 1), cB + hstepB + kstep, voffB);
    PG8_WAIT_V(6); PG8_BAR;
    for (;;) {
        const bool has_next = S.next(ui + 1, nxt);
        const char* nA = has_next ? nxt.A : cA; const char* nB = has_next ? nxt.B : cB;
        if constexpr (GATHER) { if (has_next && wid == 0) PG8_GDMA(idxbuf + 256 * ((ui + 1) & 1), nxt.gl); }
        unsigned warm0 = 0u, warm1 = 0u;
        if constexpr (Epi::WARM) E.warm(cur, tid, warm0, warm1);
        for (int t = 0; t < nt; t += 2) {
            const bool last = (t == nt - 2);
            const char* a1 = cA + (size_t)(t + 1) * kstep;
            const char* a2 = last ? nA : cA + (size_t)(t + 2) * kstep; const char* b2 = last ? nB : cB + (size_t)(t + 2) * kstep;
            const char* a3 = a2 + kstep; const char* b3 = b2 + kstep;
#define PG8_STAGEX(bufoff, gbase, h) do { if constexpr (GATHER) { unsigned go_[2]; const bool nx_ = last && has_next;   \
        PG8_GOFF(go_, idxbuf + 256 * ((nx_ ? ui + 1 : ui) & 1), (nx_ ? nxt.nvalid : cur.nvalid), h); PG8_STAGE(bufoff, gbase, go_); } else { PG8_STAGE(bufoff, (gbase) + (h) * hstepA, voffA); } } while (0)
            PG8_LDB(B0, 0, 0); PG8_LDB(B1, 0, 1); PG8_SCHED; PG8_LDA(At, 0, 0); PG8_STAGEA(PG8_SA(1, 1), a1, 1, co);
            PG8_WAIT_V(8); PG8_WAIT_L(0); PG8_BAR; PG8_MMA(0, 0, At, B0); PG8_MMA(0, 1, At, B1); PG8_BAR; PG8_SCHED;
            PG8_LDA(At, 0, 1); PG8_STAGE(PG8_SB(0, 0), b2, voffB); PG8_STAGE(PG8_SB(0, 1), b2 + hstepB, voffB); PG8_STAGEX(PG8_SA(0, 0), a2, 0);
            PG8_WAIT_V(8); PG8_WAIT_L(0); PG8_BAR; PG8_MMA(1, 0, At, B0); PG8_MMA(1, 1, At, B1); PG8_BAR; PG8_SCHED;
            PG8_LDB(B0, 1, 0); PG8_LDB(B1, 1, 1); PG8_SCHED; PG8_LDA(At, 1, 0); PG8_STAGEX(PG8_SA(0, 1), a2, 1);
            PG8_WAIT_V(8); PG8_WAIT_L(0); PG8_BAR; PG8_MMA(0, 0, At, B0); PG8_MMA(0, 1, At, B1); PG8_BAR; PG8_SCHED;
            PG8_LDA(At, 1, 1); PG8_STAGE(PG8_SB(1, 0), b3, voffB); PG8_STAGE(PG8_SB(1, 1), b3 + hstepB, voffB); PG8_STAGEX(PG8_SA(1, 0), a3, 0);
            PG8_WAIT_V(8); PG8_WAIT_L(0); PG8_BAR; PG8_MMA(1, 0, At, B0); PG8_MMA(1, 1, At, B1); PG8_BAR; PG8_SCHED;
        }
        if (wr == 0) PG8_BAR;
        if constexpr (Epi::WARM) asm volatile("s_waitcnt vmcnt(0)" : "+v"(warm0), "+v"(warm1) :: "memory");
        if constexpr (FP8) asm volatile("s_nop 15\n\ts_nop 15" ::: "memory");
        bool keep = false;
        { unsigned ones_ = ~0u; asm volatile("" : "+s"(ones_)); int t2 = (int)__builtin_amdgcn_mbcnt_hi(ones_, __builtin_amdgcn_mbcnt_lo(ones_, 0u)); asm volatile("" : "+v"(t2));
          if constexpr (Epi::CHAIN) keep = E.chain(acc, gcar, cur, wr, wc, (t2 & 63) & 15, (t2 & 63) >> 4);
          else E(acc, cur, wr, wc, (t2 & 63) & 15, (t2 & 63) >> 4); }
        if (!has_next) break;
        if (!keep) {
#pragma unroll
        for (int a = 0; a < 2; ++a)
#pragma unroll
            for (int b = 0; b < 2; ++b)
#pragma unroll
                for (int m = 0; m < 4; ++m)
#pragma unroll
                    for (int n = 0; n < 2; ++n) acc[a][b][m][n] = (f32x4){0.f, 0.f, 0.f, 0.f};
        }
        cur = nxt; cA = nA; cB = nB; ++ui;
        if (wr == 1) PG8_BAR;
    }
    PG8_WAIT_V(0);
    PG8_BAR;
#undef PG8_SA
#undef PG8_SB
#undef PG8_STAGE
#undef PG8_STAGEA
#undef PG8_STAGEX
#undef PG8_GOFF
#undef PG8_GDMA
#undef PG8_LDA
#undef PG8_LDB
#undef PG8_MMA
#undef PG8_CAT
#undef PG8_WAIT_V
#undef PG8_WAIT_L
#undef PG8_BAR
#undef PG8_SCHED
}

struct EpiProj {
    static constexpr bool WARM = false, CHAIN = false;
    bf16_t* O; const LAS float* bmerge; float scale; int dry, pad_;
    template <int MODE> __device__ __forceinline__ void body(const f32x4 (&acc)[2][2][4][2], int row0, int col0) const {
        f32x4 bv[2][2];
#pragma unroll
        for (int bj = 0; bj < 2; ++bj)
#pragma unroll
            for (int n = 0; n < 2; ++n) bv[bj][n] = (MODE == 2) ? *(const LAS f32x4*)(bmerge + (col0 - C_MG) + bj * HALF + 4 * n) : (f32x4){0.f, 0.f, 0.f, 0.f};
#pragma unroll
        for (int ai = 0; ai < 2; ++ai)
#pragma unroll
            for (int m = 0; m < 4; ++m) { bf16_t* rowp = O + (size_t)(row0 + ai * HALF + m * 16) * NIN + col0;
#pragma unroll
                for (int bj = 0; bj < 2; ++bj) {
                    if constexpr (MODE == 2) {
                        const float ns = -1.4426950409f * scale; unsigned lo = 0u, hi = 0u;
#pragma unroll
                        for (int j = 0; j < 4; ++j) { const float e0 = __builtin_amdgcn_exp2f(acc[ai][bj][m][0][j] * ns + bv[bj][0][j]), e1 = __builtin_amdgcn_exp2f(acc[ai][bj][m][1][j] * ns + bv[bj][1][j]);
                            lo = __builtin_amdgcn_cvt_pk_u8_f32(__builtin_amdgcn_rcpf(__builtin_amdgcn_fmed3f(e0 * (1.0f / 255.0f) + (1.0f / 255.0f), 0.0f, 1.0f)), j, lo); hi = __builtin_amdgcn_cvt_pk_u8_f32(__builtin_amdgcn_rcpf(__builtin_amdgcn_fmed3f(e1 * (1.0f / 255.0f) + (1.0f / 255.0f), 0.0f, 1.0f)), j, hi); }
                        u32x2 w8; w8.x = lo; w8.y = hi;
                        if (!dry) *(u32x2*)((unsigned char*)(O + (size_t)(row0 + ai * HALF + m * 16) * NIN + C_MG) + (col0 - C_MG) + bj * HALF) = w8; }
                    else {
                        f32x4 v0 = acc[ai][bj][m][0] * scale, v1 = acc[ai][bj][m][1] * scale;
                        if constexpr (MODE == 1) {
#pragma unroll
                            for (int j = 0; j < 4; ++j) { v0[j] = gelu_tanh(v0[j]); v1[j] = gelu_tanh(v1[j]); } }
                        u32x4 w; w.x = cvt_pk_bf16(v0[0], v0[1]); w.y = cvt_pk_bf16(v0[2], v0[3]); w.z = cvt_pk_bf16(v1[0], v1[1]); w.w = cvt_pk_bf16(v1[2], v1[3]);
                        if (!dry) *(u32x4*)(rowp + bj * HALF) = w; } } }
    }
    __device__ __forceinline__ void operator()(const f32x4 (&acc)[2][2][4][2], const Unit& u, int wr, int wc, int fr, int fq) const {
        const int row0 = u.pm * BM + wr * 64 + fr, col0 = u.pn * BM + wc * 32 + 8 * fq;
        if (u.pn >= 10) body<2>(acc, row0, col0); else if (u.pn == 2 || u.pn == 3) body<1>(acc, row0, col0); else body<0>(acc, row0, col0);
    }
};
struct EpiPlain {
    static constexpr bool WARM = false, CHAIN = false;
    bf16_t* O; int ldc; float scale; bool dry = false;
    __device__ __forceinline__ void operator()(const f32x4 (&acc)[2][2][4][2], const Unit& u, int wr, int wc, int fr, int fq) const {
        const int row0 = u.pm * BM + wr * 64 + fr, col0 = u.pn * BM + wc * 32 + 8 * fq;
#pragma unroll
        for (int ai = 0; ai < 2; ++ai)
#pragma unroll
            for (int m = 0; m < 4; ++m) { bf16_t* rowp = O + (size_t)(row0 + ai * HALF + m * 16) * ldc + col0;
#pragma unroll
                for (int bj = 0; bj < 2; ++bj) { const f32x4 v0 = acc[ai][bj][m][0] * scale, v1 = acc[ai][bj][m][1] * scale;
                    u32x4 w; w.x = cvt_pk_bf16(v0[0], v0[1]); w.y = cvt_pk_bf16(v0[2], v0[3]); w.z = cvt_pk_bf16(v1[0], v1[1]); w.w = cvt_pk_bf16(v1[2], v1[3]);
                    if (!dry) *(u32x4*)(rowp + bj * HALF) = w; } }
    }
};
struct EpiPlain8 {
    static constexpr bool WARM = false, CHAIN = false;
    unsigned char* O; int ldc; float scale;
    __device__ __forceinline__ void operator()(const f32x4 (&acc)[2][2][4][2], const Unit& u, int wr, int wc, int fr, int fq) const {
        const int row0 = u.pm * BM + wr * 64 + fr, col0 = u.pn * BM + wc * 32 + 8 * fq;
#pragma unroll
        for (int ai = 0; ai < 2; ++ai)
#pragma unroll
            for (int m = 0; m < 4; ++m) { unsigned char* rowp = O + (size_t)(row0 + ai * HALF + m * 16) * ldc + col0;
#pragma unroll
                for (int bj = 0; bj < 2; ++bj) { const f32x4 v0 = acc[ai][bj][m][0] * scale, v1 = acc[ai][bj][m][1] * scale;
                    u32x2 w; w.x = pk4_fp8(v0[0], v0[1], v0[2], v0[3]); w.y = pk4_fp8(v1[0], v1[1], v1[2], v1[3]);
                    *(u32x2*)(rowp + bj * HALF) = w; } }
    }
};
struct EpiMerge {
    static constexpr bool WARM = false, CHAIN = true;
    const bf16_t* P; bf16_t* O;
    __device__ __forceinline__ bool chain(f32x4 (&acc)[2][2][4][2], u32x2 (&gcar)[2][4][2], const Unit& u, int wr, int wc, int fr, int fq) const {
        const int row0 = u.pm * BM + wr * 64 + fr, col0 = u.pn * BM + wc * 32 + 8 * fq; const int b = u.aux;
        u32x2 gt[2][4][2], gn[2][4][2];
        const unsigned char* gp0 = (const unsigned char*)(P + (size_t)row0 * NIN + C_MG) + b * D + col0;
#define EM_LOADS(arr, off) _Pragma("unroll") for (int ai = 0; ai < 2; ++ai) _Pragma("unroll") for (int m = 0; m < 4; ++m) _Pragma("unroll") for (int bj = 0; bj < 2; ++bj) \
            arr[ai][m][bj] = *(const u32x2*)(gp0 + (size_t)(ai * HALF + m * 16) * (NIN * 2) + (off) + bj * HALF)
#define EM_COPY(dst, src) _Pragma("unroll") for (int ai = 0; ai < 2; ++ai) _Pragma("unroll") for (int m = 0; m < 4; ++m) _Pragma("unroll") for (int bj = 0; bj < 2; ++bj) dst[ai][m][bj] = src[ai][m][bj]
#define EM_PIN(arr) _Pragma("unroll") for (int ai = 0; ai < 2; ++ai) \
            asm volatile("" : "+v"(arr[ai][0][0]), "+v"(arr[ai][0][1]), "+v"(arr[ai][1][0]), "+v"(arr[ai][1][1]), "+v"(arr[ai][2][0]), "+v"(arr[ai][2][1]), "+v"(arr[ai][3][0]), "+v"(arr[ai][3][1]))
        if (b == 0) { EM_LOADS(gt, 0); EM_LOADS(gn, D); EM_PIN(gt); EM_PIN(gn); }
        else if (b == 1) { EM_COPY(gt, gcar); EM_LOADS(gn, D); EM_PIN(gn); }
        else { EM_COPY(gt, gcar); EM_COPY(gn, gcar); }
        EM_COPY(gcar, gn);
#undef EM_LOADS
#undef EM_COPY
#undef EM_PIN
#pragma unroll
        for (int ai = 0; ai < 2; ++ai)
#pragma unroll
            for (int m = 0; m < 4; ++m) { const size_t row = (size_t)(row0 + ai * HALF + m * 16); bf16_t* op = O + row * D + col0;
#pragma unroll
                for (int bj = 0; bj < 2; ++bj) { const u32x2 gt_ = gt[ai][m][bj];
                    float gv[8];
#pragma unroll
                    for (int j = 0; j < 4; ++j) { gv[j] = (float)((gt_.x >> (8 * j)) & 0xffu); gv[4 + j] = (float)((gt_.y >> (8 * j)) & 0xffu); }
                    if (b < 2) { const u32x2 gn_ = gn[ai][m][bj];
#pragma unroll
                        for (int j = 0; j < 4; ++j) { gv[j] *= __builtin_amdgcn_rcpf((float)((gn_.x >> (8 * j)) & 0xffu)); gv[4 + j] *= __builtin_amdgcn_rcpf((float)((gn_.y >> (8 * j)) & 0xffu)); } }
                    f32x4 v0 = acc[ai][bj][m][0], v1 = acc[ai][bj][m][1];
#pragma unroll
                    for (int j = 0; j < 4; ++j) { v0[j] *= gv[j]; v1[j] *= gv[4 + j]; }
                    if (b < 2) { acc[ai][bj][m][0] = v0; acc[ai][bj][m][1] = v1; }
                    else { u32x4 w; w.x = cvt_pk_bf16(v0[0], v0[1]); w.y = cvt_pk_bf16(v0[2], v0[3]); w.z = cvt_pk_bf16(v1[0], v1[1]); w.w = cvt_pk_bf16(v1[2], v1[3]);
                        *(u32x4*)(op + bj * HALF) = w; } } }
        return b < 2;
    }
};
struct EpiSwiglu {
    static constexpr bool WARM = false, CHAIN = false;
    unsigned char* O; float scale;
    __device__ __forceinline__ void operator()(const f32x4 (&acc)[2][2][4][2], const Unit& u, int wr, int wc, int fr, int fq) const {
        const int row0 = u.pm * BM + wr * 64 + fr, col0 = u.pn * HALF + wc * 32 + 8 * fq;
#pragma unroll
        for (int ai = 0; ai < 2; ++ai)
#pragma unroll
            for (int m = 0; m < 4; ++m) { unsigned char* rowp = O + (size_t)(row0 + ai * HALF + m * 16) * D + col0;
                f32x4 v0 = acc[ai][0][m][0], v1 = acc[ai][0][m][1]; const f32x4 g0 = acc[ai][1][m][0], g1 = acc[ai][1][m][1];
                const float ns = -1.4426950409f * scale, is2 = 1.0f / (scale * scale);
#pragma unroll
                for (int j = 0; j < 4; ++j) { v0[j] = (v0[j] * g0[j]) * __builtin_amdgcn_rcpf(__builtin_fmaf(__builtin_amdgcn_exp2f(v0[j] * ns), is2, is2)); v1[j] = (v1[j] * g1[j]) * __builtin_amdgcn_rcpf(__builtin_fmaf(__builtin_amdgcn_exp2f(v1[j] * ns), is2, is2)); }
                u32x2 w; w.x = pk4_fp8(v0[0], v0[1], v0[2], v0[3]); w.y = pk4_fp8(v1[0], v1[1], v1[2], v1[3]);
                *(u32x2*)rowp = w; }
    }
};
}
namespace attn_body {
using bf16 = __hip_bfloat16;
using s16x4 = __attribute__((ext_vector_type(4))) short;
using f32x16 = __attribute__((ext_vector_type(16))) float;
constexpr int DM = NIN;
constexpr int NW = 8, QBLK = 32, QB = QBLK * NW, KVBLK = 64;
__device__ __forceinline__ int crow(int r, int hi) { return (r & 3) + 8 * (r >> 2) + 4 * hi; }
#define SBAR() __builtin_amdgcn_sched_barrier(0)
constexpr int NSLOT = 3, SLOTB = 8192;
constexpr int LDS_K = 0, LDS_V = NSLOT * SLOTB, LDS_WS = 2 * NSLOT * SLOTB, LDS_OST = LDS_WS + NW * 64 * 4, LDS_BYTES = LDS_OST + NW * 4096;
constexpr float LOG2E = 1.4426950408889634f;
constexpr float C2 = 0.125f * LOG2E;
__device__ __forceinline__ void glds16(const void* gsrc, unsigned lds_dst) { unsigned keep;
    asm volatile("s_mov_b32 %0, m0\n\ts_mov_b32 m0, %2\n\ts_nop 0\n\tglobal_load_lds_dwordx4 %1, off\n\ts_mov_b32 m0, %0" : "=&s"(keep) : "v"(gsrc), "s"(lds_dst) : "memory"); }
__device__ __forceinline__ float max3f(float a, float b, float c) { float r; asm("v_max3_f32 %0, %1, %2, %3" : "=v"(r) : "v"(a), "v"(b), "v"(c)); return r; }
__device__ __forceinline__ float max2f(float a, float b) { float r; asm("v_max_f32_e32 %0, %1, %2" : "=v"(r) : "v"(a), "v"(b)); return r; }
__device__ __forceinline__ float fadd_s(float a, float b) { float r; asm("v_add_f32_e32 %0, %1, %2" : "=v"(r) : "v"(a), "v"(b)); return r; }
__device__ __forceinline__ float fsub_s(float a, float b) { float r; asm("v_sub_f32_e32 %0, %1, %2" : "=v"(r) : "v"(a), "v"(b)); return r; }
typedef float f32x2_t __attribute__((ext_vector_type(2))); typedef __bf16 bf16x2_t __attribute__((ext_vector_type(2)));
__device__ __forceinline__ unsigned cvtpk_s(float lo, float hi) { f32x2_t v = {lo, hi}; bf16x2_t b = __builtin_convertvector(v, bf16x2_t); return __builtin_bit_cast(unsigned, b); }
#define WAIT_BAR(N) asm volatile("s_waitcnt vmcnt(" #N ") lgkmcnt(0)\n\ts_barrier" ::: "memory")

__device__ __forceinline__ void qkt(f32x16& p0, f32x16& p1, const char* Kslot, const bf16x8* qr, const f32x16& negm, int r32, int hi) {
    const char* kb = Kslot + hi * 1024 + r32 * 16;
#pragma unroll
    for (int d0 = 0; d0 < 4; ++d0) {
        const bf16x8 b0 = *reinterpret_cast<const bf16x8*>(kb + d0 * 2048);
        const bf16x8 b1 = *reinterpret_cast<const bf16x8*>(kb + d0 * 2048 + 512);
        if (d0 == 0) { p0 = __builtin_amdgcn_mfma_f32_32x32x16_bf16(b0, qr[0], negm, 0, 0, 0); p1 = __builtin_amdgcn_mfma_f32_32x32x16_bf16(b1, qr[0], negm, 0, 0, 0); }
        else { p0 = __builtin_amdgcn_mfma_f32_32x32x16_bf16(b0, qr[d0], p0, 0, 0, 0); p1 = __builtin_amdgcn_mfma_f32_32x32x16_bf16(b1, qr[d0], p1, 0, 0, 0); } }
}
typedef __attribute__((address_space(3))) const char* lds_cptr;
typedef short v4i16_t __attribute__((ext_vector_type(4)));
__device__ __forceinline__ void kload8(bf16x8* kf, lds_cptr kp) {
    kf[0] = *(const LAS bf16x8*)(kp);        kf[1] = *(const LAS bf16x8*)(kp + 512);
    kf[2] = *(const LAS bf16x8*)(kp + 2048); kf[3] = *(const LAS bf16x8*)(kp + 2560);
    kf[4] = *(const LAS bf16x8*)(kp + 4096); kf[5] = *(const LAS bf16x8*)(kp + 4608);
    kf[6] = *(const LAS bf16x8*)(kp + 6144); kf[7] = *(const LAS bf16x8*)(kp + 6656);
}
__device__ __forceinline__ void kload2(bf16x8* kf, lds_cptr kp, int j) { kf[2 * j] = *(const LAS bf16x8*)(kp + j * 2048); kf[2 * j + 1] = *(const LAS bf16x8*)(kp + j * 2048 + 512); }
__device__ __forceinline__ s16x4 vtr(lds_cptr p) { return __builtin_bit_cast(s16x4, __builtin_amdgcn_ds_read_tr16_b64_v4i16((LAS v4i16_t*)p)); }
__device__ __forceinline__ float rowmax(const f32x16& p0, const f32x16& p1) {
    float a = max3f(p0[0], p0[1], p1[0]), b = max3f(p0[2], p0[3], p1[1]); a = max3f(a, p1[2], p1[3]);
#pragma unroll
    for (int r = 4; r < 16; r += 4) { a = max3f(a, p0[r], p0[r + 1]); b = max3f(b, p0[r + 2], p0[r + 3]); a = max3f(a, p1[r], p1[r + 1]); b = max3f(b, p1[r + 2], p1[r + 3]); }
    const float m = max2f(a, b);
    auto rr = __builtin_amdgcn_permlane32_swap(__float_as_uint(m), __float_as_uint(m), false, false);
    return max2f(__uint_as_float(rr[0]), __uint_as_float(rr[1]));
}
__device__ __forceinline__ void pv(f32x16* o, int vb, bf16x8 pa0, bf16x8 pa1, bf16x8 pa2, bf16x8 pa3) {
#pragma unroll
    for (int d0 = 0; d0 < 2; ++d0) { s16x4 lo[4], hi[4];
#pragma unroll
        for (int ks = 0; ks < 4; ++ks) {
            asm volatile("ds_read_b64_tr_b16 %0,%1 offset:%c2" : "=&v"(lo[ks]) : "v"(vb), "i"(d0 * 4096 + ks * 1024) : "memory");
            asm volatile("ds_read_b64_tr_b16 %0,%1 offset:%c2" : "=&v"(hi[ks]) : "v"(vb), "i"(d0 * 4096 + ks * 1024 + 512) : "memory"); }
        asm volatile("s_waitcnt lgkmcnt(0)" ::: "memory"); SBAR();
#define PK(k) (bf16x8){lo[k][0], lo[k][1], lo[k][2], lo[k][3], hi[k][0], hi[k][1], hi[k][2], hi[k][3]}
        o[d0] = __builtin_amdgcn_mfma_f32_32x32x16_bf16(pa0, PK(0), o[d0], 0, 0, 0);
        o[d0] = __builtin_amdgcn_mfma_f32_32x32x16_bf16(pa1, PK(1), o[d0], 0, 0, 0);
        o[d0] = __builtin_amdgcn_mfma_f32_32x32x16_bf16(pa2, PK(2), o[d0], 0, 0, 0);
        o[d0] = __builtin_amdgcn_mfma_f32_32x32x16_bf16(pa3, PK(3), o[d0], 0, 0, 0);
#undef PK
    }
}
__device__ __forceinline__ void wmask(f32x16& p0, f32x16& p1, int dk0, int hi) {
    const float NEG = -INFINITY; const int kb = dk0 + 4 * hi;
#pragma unroll
    for (int r = 0; r < 16; ++r) { const int d = kb + (r & 3) + 8 * (r >> 2); if (d > 128 || d < -128) p0[r] = NEG; if (d + 32 > 128 || d + 32 < -128) p1[r] = NEG; }
}

struct AttnArgs { bf16* P; const float* qg; const float* ropec; const float* ropes; const float* sinkp; float sink; bool dry; };

constexpr int LDS_QST = LDS_BYTES;
template <int MODE> __device__ __forceinline__ const bf16* q_wave_ptr(const AttnArgs& aa, int wid, int b, int h, int qb) {
    constexpr bool LAT = (MODE < 2), WIN = (MODE == 1); constexpr int QCOL = (MODE == 0 || MODE == 2) ? C_GQ : C_WQ;
    const int wq = WIN ? (wid & 3) : wid, hh = WIN ? 2 * h + (wid >> 2) : h;
    const long qrow0 = (long)b * TB + (LAT ? NCTX : 0) + qb * (WIN ? QB / 2 : QB) + wq * QBLK;
    return aa.P + qrow0 * DM + QCOL + hh * 64;
}
template <int MODE, int THRL, bool NOMAX> __device__ __forceinline__ void attn_unit(int tid0, int b, int h, int qb, const AttnArgs& aa, char* shm, bool staged = false, bool has_next = false, const bf16* Qnext = nullptr) {
    constexpr bool LAT = (MODE < 2), WIN = (MODE == 1), SINK = (MODE == 1 || MODE == 3);
    constexpr int NT = (MODE == 0) ? 68 : (MODE == 1 ? 10 : 4);
    constexpr int QCOL = (MODE == 0 || MODE == 2) ? C_GQ : C_WQ, KCOL = (MODE == 0 || MODE == 2) ? C_GK : C_WK, VCOL = (MODE == 0 || MODE == 2) ? C_GV : C_WV;
    int tid_ = tid0; asm volatile("" : "+v"(tid_));
    const int tid = tid_, lane = tid & 63, r32 = lane & 31, hi = lane >> 5; const int wid = __builtin_amdgcn_readfirstlane(tid >> 6);
    const int wq = WIN ? (wid & 3) : wid, hh = WIN ? 2 * h + (wid >> 2) : h;
    const long rowbase = (long)b * TB; const int q0 = qb * (WIN ? QB / 2 : QB);
    const long qrow0 = rowbase + (LAT ? NCTX : 0) + q0 + wq * QBLK;
    const int kvh = hh >> 2;
    const bf16* Qw = q_wave_ptr<MODE>(aa, wid, b, h, qb);
    const float sinkv = SINK ? (WIN ? *(const __attribute__((address_space(4))) float*)(aa.sinkp + hh) : aa.sink) : 0.f;
    const bf16* Kh = aa.P + rowbase * DM + KCOL + kvh * 64, *Vh = aa.P + rowbase * DM + VCOL + kvh * 64;
    const unsigned lds0 = (unsigned)(uintptr_t)shm;
    float* wsf = (float*)(shm + LDS_WS) + wid * 64;
    const bf16* ksrc = Kh + (long)lane * DM + wid * 8;
    const bf16* vsrc = Vh + (long)(16 * (wid & 3) + (lane >> 2)) * DM + (wid >> 2) * 32 + (lane & 3) * 8;
    const unsigned kdst = lds0 + LDS_K + wid * 1024, vdst = lds0 + LDS_V + wid * 1024;
    int kstart = 0; if (WIN) { kstart = q0 - 128; kstart = kstart < 0 ? 0 : kstart; kstart = kstart > SEQ - 384 ? SEQ - 384 : kstart; }
#define TROW(t) (WIN ? (((t) < 4) ? 64 * (t) : NCTX + kstart + 64 * ((t) - 4)) : 64 * (t))
#define DMA_K(t, slot) glds16(ksrc + (long)TROW(t) * DM, (unsigned)__builtin_amdgcn_readfirstlane(kdst + (slot)))
#define DMA_V(t, slot) glds16(vsrc + (long)TROW(t) * DM, (unsigned)__builtin_amdgcn_readfirstlane(vdst + (slot)))
    const int vb0 = (int)(lds0 + LDS_V) + ((lane >> 4) & 1) * 32 + (lane & 3) * 8 + (4 * hi + ((lane & 15) >> 2)) * 64;
    const char* Kbase = shm + LDS_K; bf16x8 kf[8];
    const lds_cptr shm3 = (lds_cptr)shm; const lds_cptr kp0 = shm3 + LDS_K + hi * 1024 + r32 * 16; const lds_cptr vp0 = shm3 + LDS_V + ((lane >> 4) & 1) * 32 + (lane & 3) * 8 + (4 * hi + ((lane & 15) >> 2)) * 64;
    DMA_K(0, 0); DMA_V(0, 0); DMA_K(1, SLOTB); DMA_K(2, 2 * SLOTB); DMA_V(1, SLOTB);
    bf16x8 qr[4];
    {
        bf16x8 qraw[4];
        if (staged) { const lds_cptr qs = shm3 + LDS_QST + wid * 4096 + r32 * 128 + hi * 16;
#pragma unroll
            for (int d0 = 0; d0 < 4; ++d0) qraw[d0] = *(const LAS bf16x8*)(qs + d0 * 32);
            asm volatile("s_waitcnt lgkmcnt(0)" ::: "memory"); }
        else {
#pragma unroll
            for (int d0 = 0; d0 < 4; ++d0) qraw[d0] = *reinterpret_cast<const bf16x8*>(&Qw[(long)r32 * DM + d0 * 16 + hi * 8]); }
        if (has_next) {
#pragma unroll
            for (int i = 0; i < 4; ++i) glds16(Qnext + (long)(8 * i + (lane >> 3)) * DM + (lane & 7) * 8, (unsigned)__builtin_amdgcn_readfirstlane(lds0 + LDS_QST + wid * 4096 + i * 1024)); }
        float qf[4][8]; float ss = 0.f;
#pragma unroll
        for (int d0 = 0; d0 < 4; ++d0)
#pragma unroll
            for (int j = 0; j < 8; ++j) { qf[d0][j] = __uint_as_float(((unsigned)(unsigned short)qraw[d0][j]) << 16); ss += qf[d0][j] * qf[d0][j]; }
        { auto rr = __builtin_amdgcn_permlane32_swap(__float_as_uint(ss), __float_as_uint(ss), false, false); ss = __uint_as_float(rr[0]) + __uint_as_float(rr[1]); }
        const float rinv = 1.0f / sqrtf(ss * (1.0f / 64.0f) + EPS);
#pragma unroll
        for (int d0 = 0; d0 < 4; ++d0) { const f32x4 g0 = *(const f32x4*)(aa.qg + d0 * 16 + hi * 8), g1 = *(const f32x4*)(aa.qg + d0 * 16 + hi * 8 + 4);
#pragma unroll
            for (int j = 0; j < 4; ++j) { qf[d0][j] *= rinv * g0[j]; qf[d0][4 + j] *= rinv * g1[j]; } }
        if (LAT) {
            const int pos = q0 + wq * QBLK + r32;
#pragma unroll
            for (int pr = 0; pr < 2; ++pr) {
                const float* cp = aa.ropec + (size_t)pos * 32 + pr * 16 + hi * 8; const float* sp = aa.ropes + (size_t)pos * 32 + pr * 16 + hi * 8;
                const f32x4 c0 = *(const f32x4*)cp, c1 = *(const f32x4*)(cp + 4), s0 = *(const f32x4*)sp, s1 = *(const f32x4*)(sp + 4);
#pragma unroll
                for (int j = 0; j < 8; ++j) { const float c = j < 4 ? c0[j & 3] : c1[j & 3], s = j < 4 ? s0[j & 3] : s1[j & 3];
                    const float t1 = qf[pr][j], t2 = qf[pr + 2][j]; qf[pr][j] = t1 * c - t2 * s; qf[pr + 2][j] = t2 * c + t1 * s; } }
        }
#pragma unroll
        for (int d0 = 0; d0 < 4; ++d0) { u32x4 w; w.x = cvtpk_s(qf[d0][0] * C2, qf[d0][1] * C2); w.y = cvtpk_s(qf[d0][2] * C2, qf[d0][3] * C2); w.z = cvtpk_s(qf[d0][4] * C2, qf[d0][5] * C2); w.w = cvtpk_s(qf[d0][6] * C2, qf[d0][7] * C2);
            qr[d0] = __builtin_bit_cast(bf16x8, w); }
    }
    float zf = 0.f; asm volatile("" : "+v"(zf));
    float mhat = 0.f, l_reg = 0.f; f32x16 o[2], negm;
#pragma unroll
    for (int r = 0; r < 16; ++r) { o[0][r] = zf; o[1][r] = zf; negm[r] = zf; }
    if constexpr (!NOMAX) asm volatile("" : "+v"(negm));
    const f32x16 zero16 = f32x16{};
#define CINIT (NOMAX ? zero16 : negm)
    const int dkq = kstart - (q0 + wq * QBLK + r32);
#define CMASK(P0, P1, t) do { if (WIN && (t) >= 4) wmask(P0, P1, dkq + 64 * ((t) - 4), hi); } while (0)
    bool resc = false;
#define START(P0, P1) do { resc = false; if constexpr (!NOMAX) { const float rm = rowmax(P0, P1); \
    { const float dl = rm; mhat = fadd_s(mhat, dl); \
      _Pragma("unroll") for (int r = 0; r < 16; ++r) { P0[r] = fsub_s(P0[r], dl); P1[r] = fsub_s(P1[r], dl); } \
      _Pragma("unroll") for (int r = 0; r < 16; ++r) negm[r] = -mhat; asm volatile("" : "+v"(negm)); } } \
    _Pragma("unroll") for (int r = 0; r < 16; ++r) P0[r] = __builtin_amdgcn_exp2f(P0[r]); } while (0)
#define RESC() do { if constexpr (!NOMAX) if (resc) { asm volatile("s_waitcnt lgkmcnt(0)" ::: "memory"); \
      _Pragma("unroll") for (int d_ = 0; d_ < 2; ++d_) _Pragma("unroll") for (int r = 0; r < 16; ++r) o[d_][r] *= wsf[crow(r, hi)]; } } while (0)
    f32x16 pA0, pA1, pB0, pB1;
    int sl_prev = 0, sl_cur = 0, sl_next = SLOTB;
#define ROT() do { sl_prev = sl_cur; sl_cur = sl_next; sl_next = (sl_next == (NSLOT - 1) * SLOTB) ? 0 : sl_next + SLOTB; } while (0)
    if (has_next) { WAIT_BAR(4); } else { WAIT_BAR(0); }
    qkt(pA0, pA1, Kbase, qr, CINIT, r32, hi); asm volatile("s_nop 15\n\ts_nop 7" : "+v"(pA0), "+v"(pA1)); CMASK(pA0, pA1, 0);
    START(pA0, pA1);
    _Pragma("unroll") for (int r = 0; r < 16; ++r) pA1[r] = __builtin_amdgcn_exp2f(pA1[r]);
    if (has_next) { WAIT_BAR(4); } else { WAIT_BAR(0); }
    DMA_K(3, 0);
    ROT();
    kload8(kf, kp0 + sl_cur);
    if (has_next) { WAIT_BAR(5); } else { WAIT_BAR(2); }
    s16x4 vlo[8], vhi[8]; u32x4 pw0, pw1, pw2, pw3;
#define PKW(P, B) cvtpk_s(P[B], P[B + 1])
#define PAF(k) __builtin_bit_cast(bf16x8, pw##k)
#define VFR(i) (bf16x8){vlo[i][0], vlo[i][1], vlo[i][2], vlo[i][3], vhi[i][0], vhi[i][1], vhi[i][2], vhi[i][3]}
#define PIN(x) asm volatile("" : "+v"(x))
#define MX3(a, b, c) __builtin_fmaxf(__builtin_fmaxf((a), (b)), (c))
#define GAPA(MF, A0, A1, A2, A3, W0, W1, PW) do { MF; sacc += A0; sacc += A1; sacc += A2; sacc += A3; PIN(sacc); W0; W1; PIN(PW); SBAR(); } while (0)
#define EX(v) __builtin_amdgcn_exp2f(v)
#define GAPB(MF, X, B) do { MF; X[B] = EX(X[B]); X[B + 1] = EX(X[B + 1]); X[B + 2] = EX(X[B + 2]); X[B + 3] = EX(X[B + 3]); PIN(X); SBAR(); } while (0)
#define VRD(i) do { vlo[i] = vtr(vp_ + (((i) >> 2) * 4096 + ((i) & 3) * 1024)); vhi[i] = vtr(vp_ + (((i) >> 2) * 4096 + ((i) & 3) * 1024 + 512)); } while (0)
#define KRD(G, j) do { if (G) { kload2(kf, kp0 + sl_next, j); SBAR(); } } while (0)
#define STEP(C0, C1, P0, P1, t, GK, GV, GL) do { SBAR(); \
    const lds_cptr vp_ = vp0 + sl_prev; \
    VRD(0); SBAR(); float sacc = (P0[0] + P0[1]); \
    GAPA(C0 = __builtin_amdgcn_mfma_f32_32x32x16_bf16(kf[0], qr[0], CINIT, 0, 0, 0), P0[2], P0[3], P0[4], P0[5],     pw0[0] = PKW(P0, 0), pw0[1] = PKW(P0, 2), pw0); \
    VRD(4); SBAR(); GAPA(C1 = __builtin_amdgcn_mfma_f32_32x32x16_bf16(kf[1], qr[0], CINIT, 0, 0, 0), P0[6], P0[7], P0[8], P0[9],     pw0[2] = PKW(P0, 4), pw0[3] = PKW(P0, 6), pw0); \
    VRD(1); SBAR(); GAPA(C0 = __builtin_amdgcn_mfma_f32_32x32x16_bf16(kf[2], qr[1], C0, 0, 0, 0),   P0[10], P0[11], P0[12], P0[13], pw1[0] = PKW(P0, 8), pw1[1] = PKW(P0, 10), pw1); \
    VRD(5); SBAR(); GAPA(C1 = __builtin_amdgcn_mfma_f32_32x32x16_bf16(kf[3], qr[1], C1, 0, 0, 0),   P0[14], P0[15], P1[0], P1[1],   pw1[2] = PKW(P0, 12), pw1[3] = PKW(P0, 14), pw1); \
    VRD(2); SBAR(); GAPA(C0 = __builtin_amdgcn_mfma_f32_32x32x16_bf16(kf[4], qr[2], C0, 0, 0, 0),   P1[2], P1[3], P1[4], P1[5],     pw2[0] = PKW(P1, 0), pw2[1] = PKW(P1, 2), pw2); \
    VRD(6); SBAR(); GAPA(C1 = __builtin_amdgcn_mfma_f32_32x32x16_bf16(kf[5], qr[2], C1, 0, 0, 0),   P1[6], P1[7], P1[8], P1[9],     pw2[2] = PKW(P1, 4), pw2[3] = PKW(P1, 6), pw2); \
    VRD(3); SBAR(); GAPA(C0 = __builtin_amdgcn_mfma_f32_32x32x16_bf16(kf[6], qr[3], C0, 0, 0, 0),   P1[10], P1[11], P1[12], P1[13], pw3[0] = PKW(P1, 8), pw3[1] = PKW(P1, 10), pw3); \
    VRD(7); SBAR(); GAPA(C1 = __builtin_amdgcn_mfma_f32_32x32x16_bf16(kf[7], qr[3], C1, 0, 0, 0),   P1[14], P1[15], 0.f, 0.f,       pw3[2] = PKW(P1, 12), pw3[3] = PKW(P1, 14), pw3); \
    l_reg += sacc; \
    if (GK) { DMA_K((t) + 3, sl_cur); } if (GV) { DMA_V((t) + 1, sl_next); } \
    CMASK(C0, C1, t); \
    if constexpr (!NOMAX) { float a = MX3(C0[0], C0[1], C1[0]), b = MX3(C0[2], C0[3], C1[1]); a = MX3(a, C1[2], C1[3]); \
      _Pragma("unroll") for (int r = 4; r < 16; r += 4) { a = MX3(a, C0[r], C0[r + 1]); b = MX3(b, C0[r + 2], C0[r + 3]); a = MX3(a, C1[r], C1[r + 1]); b = MX3(b, C1[r + 2], C1[r + 3]); } \
      float rm = __builtin_fmaxf(a, b); { auto rr = __builtin_amdgcn_permlane32_swap(__float_as_uint(rm), __float_as_uint(rm), false, false); rm = __builtin_fmaxf(__uint_as_float(rr[0]), __uint_as_float(rr[1])); } \
      resc = false; \
      if (__builtin_expect(__any(rm > (float)THRL), 0)) { const float dl = __builtin_fmaxf(rm, 0.f); mhat += dl; \
        _Pragma("unroll") for (int r = 0; r < 16; ++r) { C0[r] -= dl; C1[r] -= dl; } \
        _Pragma("unroll") for (int r = 0; r < 16; ++r) negm[r] = -mhat; asm volatile("" : "+v"(negm)); \
        const float f = __builtin_amdgcn_exp2f(-dl); l_reg *= f; if (hi == 0) wsf[r32] = f; resc = true; } } \
    SBAR(); \
    GAPB(o[0] = __builtin_amdgcn_mfma_f32_32x32x16_bf16(PAF(0), VFR(0), o[0], 0, 0, 0), C0, 0); \
    GAPB(o[1] = __builtin_amdgcn_mfma_f32_32x32x16_bf16(PAF(0), VFR(4), o[1], 0, 0, 0), C0, 4); \
    KRD(GL, 0); GAPB(o[0] = __builtin_amdgcn_mfma_f32_32x32x16_bf16(PAF(1), VFR(1), o[0], 0, 0, 0), C0, 8); \
    KRD(GL, 1); GAPB(o[1] = __builtin_amdgcn_mfma_f32_32x32x16_bf16(PAF(1), VFR(5), o[1], 0, 0, 0), C0, 12); \
    KRD(GL, 2); GAPB(o[0] = __builtin_amdgcn_mfma_f32_32x32x16_bf16(PAF(2), VFR(2), o[0], 0, 0, 0), C1, 0); \
    KRD(GL, 3); GAPB(o[1] = __builtin_amdgcn_mfma_f32_32x32x16_bf16(PAF(2), VFR(6), o[1], 0, 0, 0), C1, 4); \
    GAPB(o[0] = __builtin_amdgcn_mfma_f32_32x32x16_bf16(PAF(3), VFR(3), o[0], 0, 0, 0), C1, 8); \
    GAPB(o[1] = __builtin_amdgcn_mfma_f32_32x32x16_bf16(PAF(3), VFR(7), o[1], 0, 0, 0), C1, 12); \
    } while (0)
    int t = 1;
    for (; t + 5 < NT; t += 2) {
        STEP(pB0, pB1, pA0, pA1, t, true, true, true);     WAIT_BAR(2); RESC(); ROT();
        STEP(pA0, pA1, pB0, pB1, t + 1, true, true, true); WAIT_BAR(2); RESC(); ROT();
    }
#define ENDW(tt) do { if ((tt) + 3 < NT) { WAIT_BAR(2); } else if ((tt) + 2 < NT) { WAIT_BAR(1); } else { WAIT_BAR(0); } } while (0)
    for (; t + 1 < NT; t += 2) {
        STEP(pB0, pB1, pA0, pA1, t, (t + 3 < NT), (t + 1 < NT), (t + 1 < NT));         ENDW(t);     RESC(); ROT();
        STEP(pA0, pA1, pB0, pB1, t + 1, (t + 4 < NT), (t + 2 < NT), (t + 2 < NT));     ENDW(t + 1); RESC(); ROT();
    }
    STEP(pB0, pB1, pA0, pA1, NT - 1, false, false, false); RESC();
    { float sacc = pB0[0] + pB0[1]; _Pragma("unroll") for (int r = 2; r < 16; ++r) sacc += pB0[r]; _Pragma("unroll") for (int r = 0; r < 16; ++r) sacc += pB1[r]; l_reg += sacc;
      pw0 = (u32x4){PKW(pB0, 0), PKW(pB0, 2), PKW(pB0, 4), PKW(pB0, 6)}; pw1 = (u32x4){PKW(pB0, 8), PKW(pB0, 10), PKW(pB0, 12), PKW(pB0, 14)}; pw2 = (u32x4){PKW(pB1, 0), PKW(pB1, 2), PKW(pB1, 4), PKW(pB1, 6)}; pw3 = (u32x4){PKW(pB1, 8), PKW(pB1, 10), PKW(pB1, 12), PKW(pB1, 14)};
      SBAR(); pv(o, vb0 + sl_cur, PAF(0), PAF(1), PAF(2), PAF(3)); }
#undef PKW
#undef PAF
#undef VFR
#undef PIN
#undef MX3
#undef GAPA
#undef GAPB
#undef EX
#undef VRD
#undef KRD
#undef STEP
#undef ENDW
    { auto rr = __builtin_amdgcn_permlane32_swap(__float_as_uint(l_reg), __float_as_uint(l_reg), false, false); l_reg = __uint_as_float(rr[0]) + __uint_as_float(rr[1]); }
    if (SINK) l_reg += __builtin_amdgcn_exp2f(sinkv * LOG2E - mhat);
    if (hi == 0) wsf[32 + r32] = l_reg; asm volatile("s_waitcnt lgkmcnt(0)" ::: "memory");
    float rli[16];
#pragma unroll
    for (int r = 0; r < 16; ++r) rli[r] = __builtin_amdgcn_rcpf(wsf[32 + crow(r, hi)]);
    bf16* Ow = aa.P + qrow0 * DM + QCOL + hh * 64;
    { bf16* stg = (bf16*)(shm + LDS_OST) + wid * 2048;
#pragma unroll
      for (int r = 0; r < 16; ++r) { const int orow = crow(r, hi);
#pragma unroll
          for (int d0 = 0; d0 < 2; ++d0) stg[orow * 64 + d0 * 32 + r32] = __float2bfloat16(o[d0][r] * rli[r]); }
      asm volatile("s_waitcnt lgkmcnt(0)" ::: "memory");
#pragma unroll
      for (int i = 0; i < 4; ++i) { const int row = i * 8 + (lane >> 3), ch = lane & 7; const u32x4 v = *(const u32x4*)(stg + row * 64 + ch * 8); if (!aa.dry) *(u32x4*)(Ow + (long)row * DM + ch * 8) = v; } }
    asm volatile("s_waitcnt lgkmcnt(0)\n\ts_barrier" ::: "memory");
#undef DMA_K
#undef DMA_V
#undef TROW
#undef CMASK
#undef START
#undef CINIT
#undef RESC
#undef ROT
}
#undef SBAR
#undef WAIT_BAR
}
constexpr size_t MiB = 1u << 20;
constexpr size_t WS_CTL = 0, CTL_ZERO_BYTES = 64 * 1024;
constexpr size_t WS_MOD = 1 * MiB;
constexpr size_t WS_ROPE = 2 * MiB;
constexpr size_t WS_ROUTE = 3 * MiB;
constexpr size_t WS_WIN = 6 * MiB;
constexpr size_t WS_WBR = 28 * MiB;
constexpr size_t WS_WOUT = 34 * MiB;
constexpr size_t WS_XC = 38 * MiB;
constexpr size_t WS_A = 54 * MiB;
constexpr size_t WS_PROJ = 190 * MiB;
constexpr size_t WS_YBUF = WS_PROJ;
constexpr size_t WS_HG = WS_PROJ + 420 * MiB;
constexpr size_t WS_H8 = WS_A;
constexpr size_t WS_YP = WS_PROJ;
constexpr size_t WS_X1 = WS_PROJ + 140 * MiB;
constexpr size_t WS_HID = WS_PROJ + 280 * MiB;
constexpr size_t WS_W13 = WS_PROJ + 748 * MiB;
constexpr size_t WS_W2 = WS_PROJ + 780 * MiB;
constexpr size_t WS_HIN8 = WS_PROJ + 748 * MiB;
constexpr size_t WS_WIN8 = WS_HIN8 + 68 * MiB;
constexpr size_t WS_PL = WS_WIN8 + 11 * MiB;
constexpr size_t WS_END = WS_PL + (size_t)NE * T * 4;
constexpr int PSPLIT = 4;
static_assert((size_t)T * NIN * 2 == 748 * MiB && (size_t)T * D * 2 == 136 * MiB && (size_t)PMAX * D * 2 == 280 * MiB, "buffer sizes");
static_assert(WS_END <= 1024 * MiB, "workspace map fits 1 GiB");
constexpr int CW_CNT = 64, CNT_STRIDE = 32;
constexpr int CW_BAR = 4096;

constexpr int RING_OFF = 0, RING_BYTES = 131072;
constexpr int LDSCTL_OFF = RING_BYTES, MISC_OFF = LDSCTL_OFF + 320, BIAS_OFF = LDSCTL_OFF + 4096;
constexpr int LDS_BYTES = 147456;
constexpr int NWAVES = 8;

typedef GAS unsigned gu32;
#define RLX_AGENT __ATOMIC_RELAXED, __HIP_MEMORY_SCOPE_AGENT
#define LDS_WAIT() asm volatile("s_waitcnt lgkmcnt(0)" ::: "memory")
#define VM_WAIT() asm volatile("s_waitcnt vmcnt(0)" ::: "memory")

#define XB_TMO      128
#define XB_XCNT(j)  (256  + 64 * (j))
#define XB_XSUB(j)  (1280 + 64 * (j))
#define XB_XGEN(j)  (2304 + 64 * (j))
#define XB_TOP      3328
#define XB_TOPGEN   3392
#define XCD_BAR_WORDS 3456
#define XB_SPIN_CAP (1u << 18)
__device__ __forceinline__ unsigned xb_ld(unsigned* p)              { return __hip_atomic_load(p, __ATOMIC_RELAXED, __HIP_MEMORY_SCOPE_AGENT); }
__device__ __forceinline__ unsigned xb_add(unsigned* p, unsigned v) { return __hip_atomic_fetch_add(p, v, __ATOMIC_RELAXED, __HIP_MEMORY_SCOPE_AGENT); }
__device__ __forceinline__ unsigned xb_xcc_id() { return (unsigned)__builtin_amdgcn_s_getreg((3 << 11) | 20) & 0xFu; }
#define XB_SPIN(cond, bar) do { unsigned _sp = 0; while (cond) { __builtin_amdgcn_s_sleep(1); \
    if ((++_sp & 255u) == 0u) { if (xb_ld(&(bar)[XB_TMO])) break; if (_sp > XB_SPIN_CAP) { atomicAdd(&(bar)[XB_TMO], 1u); break; } } } } while (0)
struct XcdBarrier { unsigned* bar; unsigned x; volatile LAS unsigned* st; };
__device__ __forceinline__ XcdBarrier xcd_barrier_post(unsigned* bar, volatile LAS unsigned* st) {
    XcdBarrier b; b.bar = bar; b.x = xb_xcc_id(); b.st = st;
    if (threadIdx.x == 0) (void)xb_add(&bar[XB_XCNT(b.x)], 1u);
    return b;
}
__device__ __forceinline__ void xcd_barrier_complete(unsigned* bar, unsigned x, unsigned& nloc, unsigned& nx) {
    const unsigned G = gridDim.x * gridDim.y * gridDim.z;
    unsigned sum, cnt, mine, sp = 0u;
    for (;;) {
        sum = 0u; cnt = 0u; mine = 0u;
#pragma unroll
        for (unsigned j = 0; j < 16; ++j) { const unsigned c = xb_ld(&bar[XB_XCNT(j)]); sum += c; cnt += (c > 0u) ? 1u : 0u; mine = (j == x) ? c : mine; }
        if (sum == G) break;
        __builtin_amdgcn_s_sleep(1);
        if ((++sp & 255u) == 0u) { if (xb_ld(&bar[XB_TMO])) break; if (sp > XB_SPIN_CAP) { atomicAdd(&bar[XB_TMO], 1u); break; } }
    }
    nloc = mine > 0u ? mine : 1u; nx = cnt > 0u ? cnt : 1u;
}
__device__ __forceinline__ void xcd_barrier(const XcdBarrier& b, bool leader) {
    asm volatile("s_waitcnt vmcnt(0)" ::: "memory");
    __syncthreads();
    if (leader) {
        unsigned* bar = b.bar;
        __builtin_amdgcn_s_waitcnt(0);
        unsigned nloc = b.st[0], nx = b.st[1];
        if (nloc == 0u) { xcd_barrier_complete(bar, b.x, nloc, nx); b.st[0] = nloc; b.st[1] = nx; }
        const unsigned old = xb_add(&bar[XB_XSUB(b.x)], 1u);
        const unsigned gen = old / nloc;
        if (old + 1u == (gen + 1u) * nloc) {
            __builtin_amdgcn_fence(__ATOMIC_RELEASE, "agent");
            asm volatile("s_waitcnt vmcnt(0)" ::: "memory");
            const unsigned og = xb_add(&bar[XB_TOP], 1u);
            const unsigned tg = og / nx;
            if (og + 1u == (tg + 1u) * nx) xb_add(&bar[XB_TOPGEN], 1u);
            else XB_SPIN(xb_ld(&bar[XB_TOPGEN]) == tg, bar);
            __builtin_amdgcn_fence(__ATOMIC_ACQUIRE, "agent");
            xb_add(&bar[XB_XGEN(b.x)], 1u);
            asm volatile("s_waitcnt vmcnt(0)" ::: "memory");
        } else {
            XB_SPIN(xb_ld(&bar[XB_XGEN(b.x)]) == gen, bar);
            __builtin_amdgcn_fence(__ATOMIC_ACQUIRE, "agent");
            asm volatile("s_waitcnt vmcnt(0)" ::: "memory");
        }
    }
    __syncthreads();
}

struct Args { const float* in[27]; float* out; unsigned char* ws; };
struct KArgs { const GAS float* in[27]; GAS float* out; GAS unsigned char* ws; };
typedef const __attribute__((address_space(4))) KArgs* kargs_p;
__device__ __forceinline__ kargs_p kargs() { kargs_p p = (kargs_p)__builtin_amdgcn_kernarg_segment_ptr(); asm volatile("" : "+s"(p)); return p; }
struct Frame {
    LAS unsigned char* lds;
    int tid, lane, wave, vcu, G, gw, NGW, bid;
#define KIN(name, idx) __device__ __forceinline__ const float* name() const { return (const float*)kargs()->in[idx]; }
    KIN(x, 0) KIN(c, 1) KIN(ctx, 2) KIN(c_ctx, 3) KIN(w_mod, 4) KIN(b_mod, 5) KIN(norm1_g, 6) KIN(norm2_g, 7) KIN(w_in, 8) KIN(b_merge, 9) KIN(conv_w, 10) KIN(conv_b, 11)
    KIN(lru_wa, 12) KIN(lru_ba, 13) KIN(lru_wx, 14) KIN(lru_bx, 15) KIN(lru_lambda, 16) KIN(q_norm_g, 17) KIN(k_norm_g, 18) KIN(sink, 19) KIN(w_branch, 20) KIN(w_out, 21)
    KIN(router_w, 22) KIN(router_b, 23) KIN(ew1, 24) KIN(ew3, 25) KIN(ew2, 26)
#undef KIN
    __device__ __forceinline__ float* out() const { return (float*)kargs()->out; }
    __device__ __forceinline__ unsigned char* ws() const { return (unsigned char*)kargs()->ws; }
    __device__ __forceinline__ gu32* ctl() const { return (gu32*)(ws() + WS_CTL); }
#define KWS(type, name, off) __device__ __forceinline__ type* name() const { return (type*)(ws() + (off)); }
    KWS(float, MOD, WS_MOD) KWS(float, ROPEC, WS_ROPE) KWS(float, ROPES, WS_ROPE + (size_t)SEQ * 32 * 4) KWS(bf16_t, XC, WS_XC) KWS(bf16_t, X1, WS_X1) KWS(float, HT, WS_A) KWS(unsigned, ROUTE, WS_ROUTE)
    KWS(bf16_t, WIN, WS_WIN) KWS(bf16_t, WBR, WS_WBR) KWS(bf16_t, WOUT, WS_WOUT) KWS(bf16_t, A, WS_A) KWS(bf16_t, PROJ, WS_PROJ) KWS(bf16_t, YBUF, WS_YBUF) KWS(unsigned char, HG, WS_HG)
    KWS(unsigned char, YP, WS_YP) KWS(unsigned char, HID, WS_HID) KWS(unsigned char, W13, WS_W13) KWS(unsigned char, W2, WS_W2) KWS(unsigned char, H8, WS_H8) KWS(unsigned char, HIN8, WS_HIN8) KWS(unsigned char, WIN8, WS_WIN8) KWS(int, PL, WS_PL)
#undef KWS
};
__device__ __forceinline__ Frame fresh(const Frame& F0) { Frame F = F0; unsigned ones_ = ~0u; asm volatile("" : "+s"(ones_)); F.lane = (int)__builtin_amdgcn_mbcnt_hi(ones_, __builtin_amdgcn_mbcnt_lo(ones_, 0u)); F.tid = F.wave * 64 + F.lane;
    asm volatile("" : "+s"(F.wave), "+s"(F.vcu), "+s"(F.G), "+s"(F.gw), "+s"(F.NGW), "+s"(F.bid), "+v"(F.tid), "+v"(F.lane)); return F; }
__device__ __forceinline__ float dpp_f(float v, int ctrl) { return __builtin_bit_cast(float, ctrl == 0xB1 ? __builtin_amdgcn_mov_dpp(__builtin_bit_cast(int, v), 0xB1, 0xf, 0xf, true) :
    ctrl == 0x4E ? __builtin_amdgcn_mov_dpp(__builtin_bit_cast(int, v), 0x4E, 0xf, 0xf, true) : ctrl == 0x141 ? __builtin_amdgcn_mov_dpp(__builtin_bit_cast(int, v), 0x141, 0xf, 0xf, true) :
    __builtin_amdgcn_mov_dpp(__builtin_bit_cast(int, v), 0x140, 0xf, 0xf, true)); }
__device__ __forceinline__ float row16_sum(float v) {
    v += dpp_f(v, 0xB1); v += dpp_f(v, 0x4E); v += dpp_f(v, 0x141); v += dpp_f(v, 0x140); return v; }
__device__ __forceinline__ float wave_sum(float v) {
    v = row16_sum(v);
    v += __builtin_bit_cast(float, __builtin_amdgcn_ds_swizzle(__builtin_bit_cast(int, v), 0x401F));
    { auto rr = __builtin_amdgcn_permlane32_swap(__float_as_uint(v), __float_as_uint(v), false, false); v = __uint_as_float(rr[0]) + __uint_as_float(rr[1]); }
    return v;
}
__device__ __forceinline__ float wave_max(float v) {
    v = fmaxf(v, dpp_f(v, 0xB1)); v = fmaxf(v, dpp_f(v, 0x4E)); v = fmaxf(v, dpp_f(v, 0x141)); v = fmaxf(v, dpp_f(v, 0x140));
    v = fmaxf(v, __builtin_bit_cast(float, __builtin_amdgcn_ds_swizzle(__builtin_bit_cast(int, v), 0x401F)));
    { auto rr = __builtin_amdgcn_permlane32_swap(__float_as_uint(v), __float_as_uint(v), false, false); v = fmaxf(__uint_as_float(rr[0]), __uint_as_float(rr[1])); }
    return v;
}
__device__ __forceinline__ const float* modp(const float* MODb, int l, int sel, int chunk) { return MODb + ((size_t)(l * 17 + sel) * 6 + chunk) * D; }

constexpr float WSCALE = 64.0f;
struct CvtTile { const float* W; void* WT; int N, k0, n0, Kd, drow0, fp8; float bscale; int pad_; };
__device__ __forceinline__ void cvt_load(const CvtTile& t, int tid, f32x4 (&r)[8]) {
#pragma unroll
    for (int i = 0; i < 8; ++i) r[i] = *(const GAS f32x4*)(t.W + (size_t)(t.k0 + 16 * i + (tid >> 5)) * t.N + t.n0 + 4 * (tid & 31));
}
__device__ __forceinline__ void cvt_to_lds(LAS float* Tl, int tid, const f32x4 (&r)[8]) {
#pragma unroll
    for (int i = 0; i < 8; ++i) { LAS float* p = Tl + (16 * i + (tid >> 5)) * 129 + 4 * (tid & 31); p[0] = r[i][0]; p[1] = r[i][1]; p[2] = r[i][2]; p[3] = r[i][3]; }
}
__device__ __forceinline__ void cvt_emit(const CvtTile& t, LAS float* Tl, int tid) {
#pragma unroll
    for (int p = 0; p < 4; ++p) { const int idx = tid + 512 * p, n = idx >> 4, kg = idx & 15; const LAS float* s = Tl + (8 * kg) * 129 + n; float v[8];
#pragma unroll
        for (int j = 0; j < 8; ++j) v[j] = s[j * 129];
        if (t.fp8) { u32x2 o; o.x = pk4_fp8(v[0] * WSCALE, v[1] * WSCALE, v[2] * WSCALE, v[3] * WSCALE); o.y = pk4_fp8(v[4] * WSCALE, v[5] * WSCALE, v[6] * WSCALE, v[7] * WSCALE);
            *(GAS u32x2*)((unsigned char*)t.WT + (size_t)(t.drow0 + n) * t.Kd + t.k0 + 8 * kg) = o; }
        else { const float bs = t.bscale; u32x4 o; o.x = cvt_pk_bf16(v[0] * bs, v[1] * bs); o.y = cvt_pk_bf16(v[2] * bs, v[3] * bs); o.z = cvt_pk_bf16(v[4] * bs, v[5] * bs); o.w = cvt_pk_bf16(v[6] * bs, v[7] * bs);
            *(GAS u32x4*)((bf16_t*)t.WT + (size_t)(t.drow0 + n) * t.Kd + t.k0 + 8 * kg) = o; } }
}
template <class Get> __device__ __forceinline__ void cvt_run(const Frame& F, int first, int step, int count, const Get& get) {
    LAS float* Tl = (LAS float*)(F.lds + RING_OFF);
    if (first >= count) return;
    f32x4 r[8]; CvtTile cur = get(first); cvt_load(cur, F.tid, r);
    for (int it = first; it < count; it += step) {
        cvt_to_lds(Tl, F.tid, r);
        CvtTile nxt = cur; const bool more = it + step < count;
        if (more) { nxt = get(it + step); cvt_load(nxt, F.tid, r); }
        __syncthreads();
        cvt_emit(cur, Tl, F.tid);
        __syncthreads();
        cur = nxt;
    }
}
struct GetSmall {
    const float* win; const float* wbr; const float* wout; bf16_t* WINb; unsigned char* WIN8b; bf16_t* WBRb; bf16_t* WOUTb;
    static constexpr int T_IN = (D / 128) * (NIN / 128), T_BR = (512 / 128) * (D / 128), T_OUT = (D / 128) * (D / 128), T_L = T_IN + 3 * T_BR + T_OUT;
    __device__ __forceinline__ CvtTile operator()(int it) const { CvtTile t; t.bscale = 1.0f; t.pad_ = 0; const int l = it / T_L; int r = it - l * T_L;
        if (r < T_IN) { const int nb = NIN / 128, kb = r / nb, n0 = 128 * (r % nb); const bool f8 = n0 >= 256 * PSPLIT;
            t.W = win + (size_t)l * D * NIN; t.N = NIN; t.k0 = 128 * kb; t.n0 = n0; t.WT = f8 ? (void*)(WIN8b + (size_t)l * NIN * D) : (void*)(WINb + (size_t)l * NIN * D); t.Kd = D; t.drow0 = n0; t.fp8 = f8; return t; }
        r -= T_IN;
        if (r < 3 * T_BR) { const int b = r / T_BR; r -= b * T_BR; const int nb = D / 128, kb = r / nb, n0 = 128 * (r % nb);
            t.W = wbr + (size_t)(l * 3 + b) * 512 * D; t.N = D; t.k0 = 128 * kb; t.n0 = n0; t.WT = (void*)(WBRb + (size_t)(l * 3 + b) * D * 512); t.Kd = 512; t.drow0 = n0; t.fp8 = false; t.bscale = 1.0f / 255.0f; return t; }
        r -= 3 * T_BR;
        const int nb = D / 128, kb = r / nb, n0 = 128 * (r % nb);
        t.W = wout + (size_t)l * D * D; t.N = D; t.k0 = 128 * kb; t.n0 = n0; t.WT = (void*)(WOUTb + (size_t)l * D * D); t.Kd = D; t.drow0 = n0; t.fp8 = false; return t; }
};
struct GetExperts {
    const float* e1; const float* e3; const float* e2; unsigned char* W13b; unsigned char* W2b; int l;
    static constexpr int T_M = (D / 128) * (D / 128);
    __device__ __forceinline__ CvtTile operator()(int it) const { CvtTile t; t.bscale = 1.0f; t.pad_ = 0; const int e = it / (3 * T_M); int r = it - e * 3 * T_M; const int which = r / T_M; r -= which * T_M;
        const int kb = r / (D / 128), n0 = 128 * (r % (D / 128)); const size_t eoff = (size_t)(l * NE + e) * D * D;
        t.N = D; t.k0 = 128 * kb; t.n0 = n0; t.Kd = D; t.fp8 = true;
        if (which == 0) { t.W = e1 + eoff; t.WT = (void*)(W13b + (size_t)e * 2048 * D); t.drow0 = 2 * n0; }
        else if (which == 1) { t.W = e3 + eoff; t.WT = (void*)(W13b + (size_t)e * 2048 * D); t.drow0 = 2 * n0 + 128; }
        else { t.W = e2 + eoff; t.WT = (void*)(W2b + (size_t)e * D * D); t.drow0 = n0; }
        return t; }
};
__device__ __forceinline__ void convert_small(Frame& F) {
    GetSmall get{F.w_in(), F.w_branch(), F.w_out(), F.WIN(), F.WIN8(), F.WBR(), F.WOUT()}; cvt_run(F, (int)blockIdx.x, F.G, NL * GetSmall::T_L, get);
}
__device__ __forceinline__ void p0_prologue(Frame& F) {
    float* RC = F.ROPEC(); float* RS = F.ROPES();
    for (int i = blockIdx.x * (NWAVES * 64) + F.tid; i < SEQ * 32; i += F.G * NWAVES * 64) {
        const int pos = i >> 5, f = i & 31; const float inv = exp2f(-(float)(f & 15) * (13.287712379549449f / 16.0f));
        const float ang = (float)(f < 16 ? (pos >> 6) : (pos & 63)) * inv;
        const float rev = ang * 0.15915494309189535f; RC[i] = __builtin_amdgcn_cosf(rev); RS[i] = __builtin_amdgcn_sinf(rev);
    }
    __syncthreads();
    {
        LAS float* sc = (LAS float*)(F.lds + RING_OFF);
        LAS float* part = (LAS float*)(F.lds + RING_OFF + 17 * 1024 * 4);
        bool have_sc = false;
        for (int it = blockIdx.x; it < NL * 96; it += F.G) {
            if (!have_sc) { const float* cp = F.c(); const float* ccp = F.c_ctx(); float cv[34];
#pragma unroll
                for (int q = 0; q < 34; ++q) { const int i = F.tid + NWAVES * 64 * q, s = i >> 10, k = i & 1023; cv[q] = s < 16 ? cp[s * D + k] : ccp[k]; }
                asm volatile("" ::: "memory");
#pragma unroll
                for (int q = 0; q < 34; ++q) { const int i = F.tid + NWAVES * 64 * q; sc[i] = cv[q] * fast_sigmoid(cv[q]); }
                have_sc = true; __syncthreads(); }
            const int l = it / 96, cg = it % 96, col = cg * 64 + F.lane;
            const float* wp = F.w_mod() + (size_t)l * D * 6 * D + col;
            float acc[17];
#pragma unroll
            for (int s = 0; s < 17; ++s) acc[s] = 0.f;
            const int kbeg = F.wave * 128;
#pragma unroll 4
            for (int k = kbeg; k < kbeg + 128; ++k) { const float w = wp[(size_t)k * 6 * D];
#pragma unroll
                for (int s = 0; s < 17; ++s) acc[s] += sc[s * 1024 + k] * w; }
#pragma unroll
            for (int s = 0; s < 17; ++s) part[(F.wave * 17 + s) * 64 + F.lane] = acc[s];
            __syncthreads();
            for (int i = F.tid; i < 17 * 64; i += NWAVES * 64) { const int s = i >> 6, cl = i & 63; float v = F.b_mod()[l * 6 * D + cg * 64 + cl];
#pragma unroll
                for (int w = 0; w < 8; ++w) v += part[(w * 17 + s) * 64 + cl];
                F.MOD()[(size_t)(l * 17 + s) * 6 * D + cg * 64 + cl] = v; }
            __syncthreads();
        }
    }
}

__device__ __forceinline__ void convert_experts(Frame& F, int l, int first, int step) {
    GetExperts get{F.ew1(), F.ew3(), F.ew2(), F.W13(), F.W2(), l}; cvt_run(F, first, step, NE * 3 * GetExperts::T_M, get);
}

__device__ __forceinline__ void ld_row_f32(const float* p, int lane, f32x4 (&v)[4]) {
#pragma unroll
    for (int j = 0; j < 4; ++j) v[j] = *((const GAS f32x4*)p + lane + 64 * j);
}
__device__ __forceinline__ void st_row_f32(float* p, int lane, const f32x4 (&v)[4]) {
#pragma unroll
    for (int j = 0; j < 4; ++j) *((GAS f32x4*)p + lane + 64 * j) = v[j];
}
__device__ __forceinline__ void ld_row_bf16(const bf16_t* p, int lane, f32x4 (&v)[4]) {
#pragma unroll
    for (int j = 0; j < 4; ++j) { const u32x2 w = *((const GAS u32x2*)p + lane + 64 * j); v[j] = (f32x4){bf_lo(w.x), bf_hi(w.x), bf_lo(w.y), bf_hi(w.y)}; }
}
__device__ __forceinline__ void st_row_bf16(bf16_t* p, int lane, const f32x4 (&v)[4]) {
#pragma unroll
    for (int j = 0; j < 4; ++j) { u32x2 w; w.x = cvt_pk_bf16(v[j][0], v[j][1]); w.y = cvt_pk_bf16(v[j][2], v[j][3]); *((GAS u32x2*)p + lane + 64 * j) = w; }
}
__device__ __forceinline__ void st_row_fp8(unsigned char* p, int lane, const f32x4 (&v)[4]) {
#pragma unroll
    for (int j = 0; j < 4; ++j) *((GAS unsigned*)p + lane + 64 * j) = pk4_fp8(v[j][0], v[j][1], v[j][2], v[j][3]);
}
__device__ __forceinline__ void norm_mod(const f32x4 (&v)[4], const float* g, const float* shift, const float* scale, int lane, f32x4 (&h)[4]) {
    float ss = 0.f;
#pragma unroll
    for (int j = 0; j < 4; ++j) ss += (v[j][0] * v[j][0] + v[j][1] * v[j][1]) + (v[j][2] * v[j][2] + v[j][3] * v[j][3]);
    const float rinv = 1.0f / sqrtf(wave_sum(ss) * (1.0f / D) + EPS);
#pragma unroll
    for (int j = 0; j < 4; ++j) { const f32x4 gg = *((const GAS f32x4*)g + lane + 64 * j), sh = *((const GAS f32x4*)shift + lane + 64 * j), sc = *((const GAS f32x4*)scale + lane + 64 * j);
        h[j] = (v[j] * rinv) * gg * (sc + 1.0f) + sh; }
}

struct RowRange { int lo, hi; };
__device__ __forceinline__ RowRange wave_rows(const Frame& F, int n) { const int per = (n + F.NGW - 1) / F.NGW; RowRange r; r.lo = F.gw * per; r.hi = r.lo + per; if (r.hi > n) r.hi = n; if (r.lo > n) r.lo = n; return r; }
__device__ __forceinline__ void row_decode(int idx, bool all, int& b, int& p) { if (all) { b = idx / TB; p = idx - b * TB; } else { b = idx / SEQ; p = NCTX + idx - b * SEQ; } }
__device__ __forceinline__ void ld_vec(const float* p, int lane, f32x4 (&v)[4]) {
#pragma unroll
    for (int j = 0; j < 4; ++j) v[j] = *((const GAS f32x4*)p + lane + 64 * j);
}
__device__ __forceinline__ float row_rinv(const f32x4 (&v)[4]) {
    float ss = 0.f;
#pragma unroll
    for (int j = 0; j < 4; ++j) ss += (v[j][0] * v[j][0] + v[j][1] * v[j][1]) + (v[j][2] * v[j][2] + v[j][3] * v[j][3]);
    return 1.0f / sqrtf(wave_sum(ss) * (1.0f / D) + EPS);
}
__device__ __forceinline__ void r1_phase(Frame& F) {
    const float* MODb = F.MOD(); const float* xin = F.x(); const float* cin = F.ctx(); const float* g1n = F.norm1_g(); bf16_t* Ab = F.A(); unsigned char* H8i = F.HIN8();
    const RowRange rr = wave_rows(F, T);
    int cursel = -1; f32x4 gm[4], sh[4], vn[4];
#define R1_SRC(idx_) ({ int b_, p_; row_decode((idx_), true, b_, p_); (p_ < NCTX) ? cin + (size_t)(b_ * NCTX + p_) * D : xin + (size_t)(b_ * SEQ + p_ - NCTX) * D; })
    if (rr.lo < rr.hi) ld_row_f32(R1_SRC(rr.lo), F.lane, vn);
    for (int idx = rr.lo; idx < rr.hi; ++idx) {
        int b, p; row_decode(idx, true, b, p); const int sel = p < NCTX ? 16 : b;
        f32x4 v[4];
#pragma unroll
        for (int j = 0; j < 4; ++j) v[j] = vn[j];
        if (idx + 1 < rr.hi) ld_row_f32(R1_SRC(idx + 1), F.lane, vn);
        if (sel != cursel) { cursel = sel; f32x4 g[4], sc[4]; ld_vec(g1n, F.lane, g); ld_vec(modp(MODb, 0, sel, 1), F.lane, sc); ld_vec(modp(MODb, 0, sel, 0), F.lane, sh);
#pragma unroll
            for (int j = 0; j < 4; ++j) gm[j] = g[j] * (sc[j] + 1.0f); }
        const float rinv = row_rinv(v); f32x4 h[4];
#pragma unroll
        for (int j = 0; j < 4; ++j) h[j] = (v[j] * rinv) * gm[j] + sh[j];
        if (PSPLIT > 0) st_row_bf16(Ab + (size_t)idx * D, F.lane, h);
        st_row_fp8(H8i + (size_t)idx * D, F.lane, h);
    }
#undef R1_SRC
}

__device__ __forceinline__ void kfix_phase(Frame& F, int l, bool dry = false) {
    const int hs = F.lane >> 4, j4 = F.lane & 15, br = hs >> 1;
    const int col = (br ? C_WK : C_GK) + (hs & 1) * 64 + 2 * j4;
    const float* kg = F.k_norm_g() + (size_t)(l * 2 + br) * 64;
    const float g0 = kg[2 * j4], g1 = kg[2 * j4 + 1], g2 = kg[32 + 2 * j4], g3 = kg[32 + 2 * j4 + 1];
    bf16_t* Pb = F.PROJ(); const float* RC = F.ROPEC(); const float* RS = F.ROPES();
    const RowRange rr = wave_rows(F, T);
    unsigned w1n[4], w2n[4]; f32x2 csn[4], snn[4];
#define KF_LOAD(r0_) do { _Pragma("unroll") for (int k = 0; k < 4; ++k) { const int row = ((r0_) + k < rr.hi) ? (r0_) + k : rr.hi - 1; const int p = row % TB; const int pos = p >= NCTX ? p - NCTX : 0; \
            const bf16_t* rp = Pb + (size_t)row * NIN + col; w1n[k] = *(const GAS unsigned*)rp; w2n[k] = *(const GAS unsigned*)(rp + 32); \
            csn[k] = *(const GAS f32x2*)(RC + (size_t)pos * 32 + 2 * j4); snn[k] = *(const GAS f32x2*)(RS + (size_t)pos * 32 + 2 * j4); } } while (0)
    if (rr.lo < rr.hi) KF_LOAD(rr.lo);
    for (int r0 = rr.lo; r0 < rr.hi; r0 += 4) {
        unsigned w1[4], w2[4]; f32x2 cs[4], sn[4];
#pragma unroll
        for (int k = 0; k < 4; ++k) { w1[k] = w1n[k]; w2[k] = w2n[k]; cs[k] = csn[k]; sn[k] = snn[k]; }
        if (r0 + 4 < rr.hi) KF_LOAD(r0 + 4);
        asm volatile("" ::: "memory");
#pragma unroll
        for (int k = 0; k < 4; ++k) { const int row = r0 + k; if (row >= rr.hi) break; const int p = row % TB;
            float a0 = bf_lo(w1[k]), a1 = bf_hi(w1[k]), b0 = bf_lo(w2[k]), b1 = bf_hi(w2[k]);
            float ss = a0 * a0 + a1 * a1 + b0 * b0 + b1 * b1;
            ss = row16_sum(ss);
            const float rinv = 1.0f / sqrtf(ss * (1.0f / 64.0f) + EPS);
            a0 *= rinv * g0; a1 *= rinv * g1; b0 *= rinv * g2; b1 *= rinv * g3;
            if (p >= NCTX) { const float t0 = a0 * cs[k].x - b0 * sn[k].x, t1 = a1 * cs[k].y - b1 * sn[k].y, u0 = b0 * cs[k].x + a0 * sn[k].x, u1 = b1 * cs[k].y + a1 * sn[k].y; a0 = t0; a1 = t1; b0 = u0; b1 = u1; }
            bf16_t* rp = Pb + (size_t)row * NIN + col;
            if (!dry) { *(GAS unsigned*)rp = cvt_pk_bf16(a0, a1); *(GAS unsigned*)(rp + 32) = cvt_pk_bf16(b0, b1); } }
    }
#undef KF_LOAD
}
constexpr int SC_AOP = 0, SC_AOP_B = 64 * 144, SC_XCV = 2 * SC_AOP_B, SC_XCV_B = 64 * 68 * 4, SC_TOT = SC_XCV + 2 * SC_XCV_B, SC_TOT_B = 4 * 2 * 16 * 8;
__device__ __forceinline__ void scan_unit(Frame& F, int l, int uid, bool last_layer, bool dry = false) {
    const int b = uid >> 4, n = (uid >> 1) & 7, chh = uid & 1;
    const int dir = F.wave >> 2, ht = F.tid & 255, w = F.wave & 3, lane = F.lane, col = lane & 15, quad = lane >> 4;
    LAS unsigned char* aop = F.lds + SC_AOP + dir * SC_AOP_B;
    LAS float* xcv = (LAS float*)(F.lds + SC_XCV + dir * SC_XCV_B);
    LAS f32x2* tot = (LAS f32x2*)(F.lds + SC_TOT + dir * SC_TOT_B);
    bf16x8 Bf[4][2];
    {
        const size_t wbase = ((size_t)((l * 2 + dir) * 8 + n)) * 64 * 64; const float* lwa = F.lru_wa(); const float* lwx = F.lru_wx();
        float wv[4][2][8];
#pragma unroll
        for (int q = 0; q < 4; ++q) { const float* wp = ((q < 2) ? lwa : lwx) + wbase + 32 * chh + 16 * (q & 1) + col;
#pragma unroll
            for (int ks = 0; ks < 2; ++ks)
#pragma unroll
                for (int j = 0; j < 8; ++j) wv[q][ks][j] = wp[(size_t)(32 * ks + 8 * quad + j) * 64]; }
        asm volatile("" ::: "memory");
#pragma unroll
        for (int q = 0; q < 4; ++q)
#pragma unroll
            for (int ks = 0; ks < 2; ++ks) { u32x4 pk;
                pk.x = cvt_pk_bf16(wv[q][ks][0], wv[q][ks][1]); pk.y = cvt_pk_bf16(wv[q][ks][2], wv[q][ks][3]);
                pk.z = cvt_pk_bf16(wv[q][ks][4], wv[q][ks][5]); pk.w = cvt_pk_bf16(wv[q][ks][6], wv[q][ks][7]);
                Bf[q][ks] = __builtin_bit_cast(bf16x8, pk); }
    }
    float ba[2], bx[2], nla[2]; const float* lba = F.lru_ba(); const float* lbx = F.lru_bx(); const float* llam = F.lru_lambda();
#pragma unroll
    for (int q = 0; q < 2; ++q) { const int gch = 64 * n + 32 * chh + 16 * q + col; const size_t o = (size_t)(l * 2 + dir) * 512 + gch;
        ba[q] = lba[o] * -1.4426950409f; bx[q] = lbx[o] * -1.4426950409f; const float lam = llam[o];
        const float ex = __expf(-lam);
        const float sp = (ex < 0.05f) ? ex * (1.0f - ex * (0.5f - ex * (0.33333334f - ex * 0.25f))) : __logf(1.0f + ex);
        nla[q] = -8.0f * sp * 1.4426950409f; }
    const int cg = ht & 7; float cw[4][8], cb[8]; const float* cwp = F.conv_w(); const float* cbp = F.conv_b();
#pragma unroll
    for (int k = 0; k < 4; ++k)
#pragma unroll
        for (int c = 0; c < 8; ++c) cw[k][c] = cwp[(size_t)(l * 4 + k) * 512 + 64 * n + 8 * cg + c];
#pragma unroll
    for (int c = 0; c < 8; ++c) cb[c] = cbp[(size_t)l * 512 + 64 * n + 8 * cg + c];
    float hcar[2] = {0.f, 0.f};
    const int up16 = (lane >= 16 ? lane - 16 : lane) * 4, up32 = (lane >= 32 ? lane - 32 : lane) * 4;
#define SHUP(x, a) __builtin_bit_cast(float, __builtin_amdgcn_ds_bpermute((a), __builtin_bit_cast(int, (x))))
    bf16_t* Pb = F.PROJ(); float* HTb = F.HT();
    const bf16_t* xrb = Pb + C_XR + 64 * n + 8 * cg;

    for (int seg = 0; seg < 2; ++seg) {
        const int nch = seg ? 64 : 4, seglen = nch * 64; const size_t rowseg0 = (size_t)b * TB + (seg ? NCTX : 0);
        const bool want_out = !(seg == 0 && last_layer) && !dry;
        const int sbase = 16 * w + 4 * quad, gch0 = 64 * n + 32 * chh + col;
        const int tlo0 = dir ? 64 * (nch - 1) + 60 - sbase : sbase;
        char* htc = (char*)HTb + ((rowseg0 + tlo0) * 512 + gch0) * 4; char* grc = (char*)Pb + ((rowseg0 + tlo0) * NIN + C_GR + gch0) * 2;
        const ptrdiff_t hstep = (ptrdiff_t)(dir ? -64 : 64) * 2048, gstep = (ptrdiff_t)(dir ? -64 : 64) * NIN * 2;
        u32x4 raw[5];
#define SC_LOAD(i_) do { const int cidx_ = dir ? nch - 1 - (i_) : (i_); const int s0_ = (ht >> 3) << 1; const int tl_ = 64 * cidx_ + (dir ? 62 - s0_ : s0_); \
        const bf16_t* rp_ = xrb + (rowseg0 + tl_) * NIN; \
        if (cidx_ == 0 || cidx_ == nch - 1) { _Pragma("unroll") for (int dt = 0; dt < 5; ++dt) { const int tt = tl_ + dt - 2; \
                raw[dt] = (tt >= 0 && tt < seglen) ? *(const GAS u32x4*)(rp_ + (ptrdiff_t)(dt - 2) * NIN) : (u32x4){0u, 0u, 0u, 0u}; } } \
        else { _Pragma("unroll") for (int dt = 0; dt < 5; ++dt) raw[dt] = *(const GAS u32x4*)(rp_ + (ptrdiff_t)(dt - 2) * NIN); } } while (0)
        SC_LOAD(0);
        for (int i = 0; i < nch; ++i) {
            const int cidx = dir ? nch - 1 - i : i, t0 = 64 * cidx;
            { const int s0 = (ht >> 3) << 1; float xl[5][8];
#pragma unroll
                for (int dt = 0; dt < 5; ++dt)
#pragma unroll
                    for (int c2 = 0; c2 < 4; ++c2) { const unsigned wv = raw[dt][c2]; xl[dt][2 * c2] = bf_lo(wv); xl[dt][2 * c2 + 1] = bf_hi(wv); }
#pragma unroll
                for (int it = 0; it < 2; ++it) { const int s = dir ? s0 + 1 - it : s0 + it; float cv[8];
#pragma unroll
                    for (int c = 0; c < 8; ++c) { float a = cb[c];
#pragma unroll
                        for (int dt = 0; dt < 4; ++dt) a += cw[dt][c] * xl[it + dt][c];
                        cv[c] = a; }
                    u32x4 pk; pk.x = cvt_pk_bf16(cv[0], cv[1]); pk.y = cvt_pk_bf16(cv[2], cv[3]); pk.z = cvt_pk_bf16(cv[4], cv[5]); pk.w = cvt_pk_bf16(cv[6], cv[7]);
                    *(LAS u32x4*)(aop + s * 144 + cg * 16) = pk;
                    *(LAS f32x4*)(xcv + s * 68 + cg * 8) = (f32x4){cv[0], cv[1], cv[2], cv[3]}; *(LAS f32x4*)(xcv + s * 68 + cg * 8 + 4) = (f32x4){cv[4], cv[5], cv[6], cv[7]}; } }
            if (i + 1 < nch) SC_LOAD(i + 1);
            if (i == nch / 2) VM_WAIT();
            __syncthreads();
            float othv[2][4]; unsigned grv[2][4]; const bool fin = want_out && i >= nch / 2;
            if (fin) {
#pragma unroll
                for (int q = 0; q < 2; ++q)
#pragma unroll
                    for (int k = 0; k < 4; ++k) { othv[q][k] = __hip_atomic_load((const float*)(htc + k * 2048 + q * 64), __ATOMIC_RELAXED, __HIP_MEMORY_SCOPE_AGENT); grv[q][k] = *(const GAS bf16_t*)(grc + (ptrdiff_t)k * NIN * 2 + q * 32); } }
            f32x4 gacc[4];
#pragma unroll
            for (int q = 0; q < 4; ++q) gacc[q] = (f32x4){0.f, 0.f, 0.f, 0.f};
#pragma unroll
            for (int ks = 0; ks < 2; ++ks) { const bf16x8 af = *(const LAS bf16x8*)(aop + (16 * w + col) * 144 + ks * 64 + quad * 16);
#pragma unroll
                for (int q = 0; q < 4; ++q) gacc[q] = __builtin_amdgcn_mfma_f32_16x16x32_bf16(af, Bf[q][ks], gacc[q], 0, 0, 0); }
            float av[2][4], bv[2][4], cA[2], cB[2];
#pragma unroll
            for (int q = 0; q < 2; ++q) {
#pragma unroll
                for (int j = 0; j < 4; ++j) { const float r = __builtin_amdgcn_rcpf(1.0f + __builtin_amdgcn_exp2f(__builtin_fmaf(gacc[q][j], -1.4426950409f, ba[q]))),
                                                            ig = __builtin_amdgcn_rcpf(1.0f + __builtin_amdgcn_exp2f(__builtin_fmaf(gacc[q + 2][j], -1.4426950409f, bx[q])));
                    const float a = __builtin_amdgcn_exp2f(nla[q] * r);
                    const float om = __builtin_fmaf(-a, a, 1.0f);
                    const float xv = xcv[(16 * w + 4 * quad + j) * 68 + 32 * chh + 16 * q + col];
                    av[q][j] = a; bv[q][j] = __builtin_amdgcn_sqrtf(om) * ig * xv; }
                cA[q] = av[q][0]; cB[q] = bv[q][0];
#pragma unroll
                for (int j = 1; j < 4; ++j) { cB[q] = av[q][j] * cB[q] + bv[q][j]; cA[q] *= av[q][j]; }
            }
            float iA[2], iB[2], eA[2], eB[2];
#pragma unroll
            for (int q = 0; q < 2; ++q) { iA[q] = cA[q]; iB[q] = cB[q];
                float pA = SHUP(iA[q], up16), pB = SHUP(iB[q], up16); if (quad >= 1) { iB[q] = iA[q] * pB + iB[q]; iA[q] = iA[q] * pA; }
                pA = SHUP(iA[q], up32); pB = SHUP(iB[q], up32); if (quad >= 2) { iB[q] = iA[q] * pB + iB[q]; iA[q] = iA[q] * pA; }
                eA[q] = SHUP(iA[q], up16); eB[q] = SHUP(iB[q], up16); if (quad == 0) { eA[q] = 1.0f; eB[q] = 0.0f; }
                if (quad == 3) tot[(w * 2 + q) * 16 + col] = (f32x2){iA[q], iB[q]}; }
            __syncthreads();
            float hvs[2][4];
#pragma unroll
            for (int q = 0; q < 2; ++q) { float hin = hcar[q], hall = hcar[q];
#pragma unroll
                for (int ww = 0; ww < 4; ++ww) { const f32x2 tw = tot[(ww * 2 + q) * 16 + col]; hall = tw.x * hall + tw.y; if (ww < w) hin = hall; }
                hcar[q] = hall;
                float hv = eA[q] * hin + eB[q];
#pragma unroll
                for (int j = 0; j < 4; ++j) { hv = av[q][j] * hv + bv[q][j]; hvs[q][j] = hv; } }
            if (want_out) {
#pragma unroll
                for (int q = 0; q < 2; ++q)
#pragma unroll
                    for (int k = 0; k < 4; ++k) { const float hv = dir ? hvs[q][3 - k] : hvs[q][k];
                        if (!fin) *(GAS float*)(htc + k * 2048 + q * 64) = hv;
                        else { const float gr = __uint_as_float(grv[q][k] << 16); *(GAS bf16_t*)(grc + (ptrdiff_t)k * NIN * 2 + q * 32) = (bf16_t)(cvt_pk_bf16((hv + othv[q][k]) * gr, 0.f) & 0xffffu); } }
            }
            htc += hstep; grc += gstep;
        }
#undef SC_LOAD
        __syncthreads();
    }
}

__device__ __forceinline__ void r2_phase(Frame& F, int l, bool dry = false) {
    LAS float* rw = (LAS float*)(F.lds + RING_OFF);
    LAS float* tt = (LAS float*)(F.lds + RING_OFF + 65536);
    LAS float* part = (LAS float*)(F.lds + LDSCTL_OFF + 8192);
    { const float* rwp = F.router_w(); for (int i = F.tid; i < 16 * 1024 / 4; i += NWAVES * 64) *((LAS f32x4*)rw + i) = *((const GAS f32x4*)rwp + i); }
    __syncthreads();
    float rb[16]; const float* rbp = F.router_b();
#pragma unroll
    for (int e = 0; e < 16; ++e) rb[e] = rbp[e];
    const bool all = (l == 0); const int nrows = all ? T : NB * SEQ;
    const float* MODb = F.MOD(); bf16_t* XCb = F.XC(); bf16_t* X1b = F.X1(); const bf16_t* X2b = (const bf16_t*)F.out(); const float* xin = F.x(); const float* cin = F.ctx(); const bf16_t* YB = F.YBUF(); unsigned char* H8b = F.H8();
    const float* n2g = F.norm2_g() + (size_t)l * D; unsigned* RT = F.ROUTE(); gu32* cnt = F.ctl() + CW_CNT + l * 1024; int* PLb = F.PL();
    const int perwg = (((nrows + F.G - 1) / F.G) + 15) & ~15, wg0 = F.vcu * perwg, ngroups = perwg / 16;
    int cursel = -1; f32x4 g1v[4], gm[4], sh[4], vn[4]; u32x2 yn[4];
    unsigned my_e0 = 0u, my_e1 = 0u; float my_w0 = 0.f, my_w1 = 0.f; int my_row = -1;
#define R2_XI(b_, p_) (((p_) < NCTX) ? cin + (size_t)((b_) * NCTX + (p_)) * D : xin + (size_t)((b_) * SEQ + (p_) - NCTX) * D)
#define R2_LOAD(idx_) do { if ((idx_) < nrows) { int b_, p_; row_decode((idx_), all, b_, p_); \
        if (l == 0) ld_row_f32(R2_XI(b_, p_), F.lane, vn); \
        else { const bf16_t* s_ = X2b + (size_t)(b_ * SEQ + p_ - NCTX) * D; _Pragma("unroll") for (int j = 0; j < 4; ++j) { const u32x2 w_ = *((const GAS u32x2*)s_ + F.lane + 64 * j); vn[j][0] = __uint_as_float(w_.x); vn[j][1] = __uint_as_float(w_.y); } } \
        _Pragma("unroll") for (int j = 0; j < 4; ++j) yn[j] = *((const GAS u32x2*)(YB + (size_t)(b_ * TB + p_) * D) + F.lane + 64 * j); } } while (0)
    R2_LOAD(wg0 + 2 * F.wave);
    for (int gI = 0; gI < ngroups; ++gI) {
#pragma unroll
        for (int rr = 0; rr < 2; ++rr) {
            const int idx = wg0 + 16 * gI + 2 * F.wave + rr; const int trow = 2 * F.wave + rr;
            f32x4 v[4], h[4];
#pragma unroll
            for (int j = 0; j < 4; ++j) { const u32x2 w = yn[j]; h[j] = (f32x4){bf_lo(w.x), bf_hi(w.x), bf_lo(w.y), bf_hi(w.y)};
                if (l == 0) v[j] = vn[j]; else { const unsigned xa = __float_as_uint(vn[j][0]), xb = __float_as_uint(vn[j][1]); v[j] = (f32x4){bf_lo(xa), bf_hi(xa), bf_lo(xb), bf_hi(xb)}; } }
            const int nidx = rr == 0 ? idx + 1 : idx + 15;
            if (rr == 0 || gI + 1 < ngroups) R2_LOAD(nidx);
            if (idx < nrows) {
                int b, p; row_decode(idx, all, b, p);
                const int row = b * TB + p; const bool isc = p < NCTX; const int sel = isc ? 16 : b;
                bf16_t* xo = isc ? XCb + (size_t)(b * NCTX + p) * D : X1b + (size_t)(b * SEQ + p - NCTX) * D;
                if (sel != cursel) { cursel = sel; f32x4 g[4], sc[4]; ld_vec(n2g, F.lane, g); ld_vec(modp(MODb, l, sel, 4), F.lane, sc); ld_vec(modp(MODb, l, sel, 3), F.lane, sh); ld_vec(modp(MODb, l, sel, 2), F.lane, g1v);
#pragma unroll
                    for (int j = 0; j < 4; ++j) gm[j] = g[j] * (sc[j] + 1.0f); }
#pragma unroll
                for (int j = 0; j < 4; ++j) v[j] = v[j] + g1v[j] * h[j];
                if (!dry) st_row_bf16(xo, F.lane, v);
                const float rinv = row_rinv(v);
#pragma unroll
                for (int j = 0; j < 4; ++j) h[j] = (v[j] * rinv) * gm[j] + sh[j];
                if (!dry) st_row_fp8(H8b + (size_t)row * D, F.lane, h);
#pragma unroll
                for (int j = 0; j < 4; ++j) *(LAS f32x4*)(tt + trow * 1024 + ((256 * j + 4 * F.lane) ^ (4 * trow))) = h[j];
                if (F.lane == 2 * gI + rr) my_row = row;
            }
        }
        __syncthreads();
        {
            f32x4 acc = {0.f, 0.f, 0.f, 0.f}; const int r16 = F.lane & 15, quad = F.lane >> 4;
#pragma unroll 8
            for (int i = 0; i < 32; ++i) { const int k = 128 * F.wave + 4 * i + quad;
                const float a = tt[r16 * 1024 + (k ^ (4 * r16))], bq = rw[k * 16 + r16];
                acc = __builtin_amdgcn_mfma_f32_16x16x4f32(a, bq, acc, 0, 0, 0); }
#pragma unroll
            for (int j = 0; j < 4; ++j) part[F.wave * 256 + (4 * quad + j) * 16 + r16] = acc[j];
        }
        __syncthreads();
#pragma unroll
        for (int rr = 0; rr < 2; ++rr) {
            const int trow = 2 * F.wave + rr; float lgl = 0.f;
#pragma unroll
            for (int w = 0; w < 8; ++w) lgl += part[w * 256 + trow * 16 + (F.lane & 15)];
            float lg[16];
#pragma unroll
            for (int e = 0; e < 16; ++e) lg[e] = __builtin_bit_cast(float, __builtin_amdgcn_readlane(__builtin_bit_cast(int, lgl), e));
            float s[16], sl[16];
#pragma unroll
            for (int e = 0; e < 16; ++e) { s[e] = __builtin_amdgcn_rcpf(1.0f + __builtin_amdgcn_exp2f(-1.4426950409f * lg[e])); sl[e] = s[e] + rb[e]; }
            float bestg = -INFINITY; int gi = 0;
#pragma unroll
            for (int g = 0; g < 4; ++g) { float m1 = -INFINITY, m2 = -INFINITY;
#pragma unroll
                for (int k = 0; k < 4; ++k) { const float t = sl[4 * g + k]; if (t > m1) { m2 = m1; m1 = t; } else if (t > m2) m2 = t; }
                const float gs = m1 + m2; if (gs > bestg) { bestg = gs; gi = g; } }
            float c4[4], s4[4];
#pragma unroll
            for (int k = 0; k < 4; ++k) { c4[k] = gi == 0 ? sl[k] : gi == 1 ? sl[4 + k] : gi == 2 ? sl[8 + k] : sl[12 + k]; s4[k] = gi == 0 ? s[k] : gi == 1 ? s[4 + k] : gi == 2 ? s[8 + k] : s[12 + k]; }
            int i0 = 0; float v0 = c4[0], w0 = s4[0];
#pragma unroll
            for (int k = 1; k < 4; ++k) if (c4[k] > v0) { v0 = c4[k]; i0 = k; w0 = s4[k]; }
            int i1 = -1; float v1 = -INFINITY, w1 = 0.f;
#pragma unroll
            for (int k = 0; k < 4; ++k) if (k != i0 && c4[k] > v1) { v1 = c4[k]; i1 = k; w1 = s4[k]; }
            const float rws = __builtin_amdgcn_rcpf(w0 + w1); w0 *= rws; w1 *= rws;
            if (F.lane == 2 * gI + rr) { my_e0 = (unsigned)(4 * gi + i0); my_e1 = (unsigned)(4 * gi + i1); my_w0 = w0; my_w1 = w1; }
        }
    }
#undef R2_LOAD
#undef R2_XI
    if (!dry) {
        const bool have = my_row >= 0;
        unsigned r0 = 0u, r1 = 0u, mycnt = 0u;
        const unsigned long long ltm = (1ull << F.lane) - 1ull;
#pragma unroll
        for (int e = 0; e < 16; ++e) { const unsigned long long m0 = __ballot(have && my_e0 == (unsigned)e), m1 = __ballot(have && my_e1 == (unsigned)e);
            const unsigned c0 = (unsigned)__popcll(m0), c1 = (unsigned)__popcll(m1);
            if (my_e0 == (unsigned)e) r0 = (unsigned)__popcll(m0 & ltm);
            if (my_e1 == (unsigned)e) r1 = c0 + (unsigned)__popcll(m1 & ltm);
            if (F.lane == e) mycnt = c0 + c1; }
        unsigned base = 0u; if (F.lane < 16 && mycnt) base = __hip_atomic_fetch_add(cnt + F.lane * CNT_STRIDE, mycnt, RLX_AGENT);
        const unsigned b0 = (unsigned)__builtin_amdgcn_ds_bpermute((int)(my_e0 * 4u), (int)base), b1 = (unsigned)__builtin_amdgcn_ds_bpermute((int)(my_e1 * 4u), (int)base);
        if (have) { const u32x4 q0 = {my_e0, b0 + r0, my_e1, b1 + r1}; const u32x4 q1 = {__float_as_uint(my_w0), __float_as_uint(my_w1), 0u, 0u};
            *(GAS u32x4*)(RT + (size_t)my_row * 8) = q0; *(GAS u32x4*)(RT + (size_t)my_row * 8 + 4) = q1;
            PLb[(size_t)my_e0 * T + b0 + r0] = my_row; PLb[(size_t)my_e1 * T + b1 + r1] = my_row; }
    }
    __syncthreads();
}

constexpr int ETAB_OFF = 256, IDXBUF_OFF = 1024;
__device__ __forceinline__ void build_ptab(Frame& F, int l, LAS int* ptab) {
    gu32* cntb = F.ctl() + CW_CNT + l * 1024; const int e = F.tid & 15;
    const int c = (int)__hip_atomic_load(cntb + e * CNT_STRIDE, RLX_AGENT);
    if (F.tid < 16) { ptab[32 + e] = c; ptab[48 + e] = (c + 255) >> 8; }
    __syncthreads();
    int tl[16], tot = 0, mys = 0;
#pragma unroll
    for (int k = 0; k < 16; ++k) { tl[k] = ptab[48 + k]; if (k < e) mys += tl[k]; tot += tl[k]; }
    if (F.tid < 16) ptab[e] = mys << 8;
    if (F.tid == 16) ptab[NE] = tot << 8;
    for (int j = F.tid; j < tot; j += NWAVES * 64) { int ee = 0, acc = 0;
#pragma unroll
        for (int k = 0; k < 15; ++k) { acc += tl[k]; ee += (j >= acc) ? 1 : 0; }
        ptab[ETAB_OFF + j] = ee; }
    __syncthreads();
}
__device__ __forceinline__ void gather_phase(Frame& F, int l, LAS int* ptab) {
    const bool all = (l == 0); const int nrows = all ? T : NB * SEQ;
    const unsigned* RT = F.ROUTE(); const unsigned char* Ab = F.H8(); unsigned char* HGb = F.HG();
    const RowRange rr = wave_rows(F, nrows);
    for (int idx = rr.lo; idx < rr.hi; idx += 4) {
        u32x4 a[4]; size_t p0[4], p1[4];
#pragma unroll
        for (int k = 0; k < 4; ++k) if (idx + k < rr.hi) { int b, p; row_decode(idx + k, all, b, p); const int row = b * TB + p;
            const u32x4 r0 = *(const GAS u32x4*)(RT + (size_t)row * 8); p0[k] = (size_t)ptab[r0.x] + r0.y; p1[k] = (size_t)ptab[r0.z] + r0.w;
            a[k] = *((const GAS u32x4*)(Ab + (size_t)row * D) + F.lane); }
#pragma unroll
        for (int k = 0; k < 4; ++k) if (idx + k < rr.hi) { *((GAS u32x4*)(HGb + p0[k] * D) + F.lane) = a[k]; *((GAS u32x4*)(HGb + p1[k] * D) + F.lane) = a[k]; }
    }
}
__device__ __forceinline__ void r3_phase(Frame& F, int l, LAS int* ptab, bool dry = false) {
    const bool all = (l == 0); const int nrows = all ? T : NB * SEQ;
    const float* MODb = F.MOD(); const bf16_t* XCb = F.XC(); const bf16_t* X1b = F.X1(); float* outb = F.out(); const unsigned char* YPb = F.YP(); bf16_t* Ab = F.A(); unsigned char* H8i = F.HIN8(); const unsigned* RT = F.ROUTE();
    const float* n1g = F.norm1_g() + (size_t)(l == 0 ? 1 : 0) * D;
    const RowRange rr = wave_rows(F, nrows);
    int cursel = -1; f32x4 g2v[4], gm[4], sh[4]; u32x2 xn[4]; unsigned y0n[4], y1n[4]; float w0n = 0.f, w1n = 0.f;
    u32x4 ra = {0u, 0u, 0u, 0u}; u32x2 rb2 = {0u, 0u};
#define R3_ROUTE(idx_) do { int b_, p_; row_decode((idx_), all, b_, p_); const int row_ = b_ * TB + p_; ra = *(const GAS u32x4*)(RT + (size_t)row_ * 8); rb2 = *(const GAS u32x2*)(RT + (size_t)row_ * 8 + 4); } while (0)
#define R3_LOAD(idx_) do { int b_, p_; row_decode((idx_), all, b_, p_); const u32x4 r0_ = ra; const u32x2 r1_ = rb2; \
        const size_t q0_ = (size_t)ptab[r0_.x] + r0_.y, q1_ = (size_t)ptab[r0_.z] + r0_.w; w0n = __uint_as_float(r1_.x); w1n = __uint_as_float(r1_.y); \
        { const bf16_t* s_ = (p_ < NCTX) ? XCb + (size_t)(b_ * NCTX + p_) * D : X1b + (size_t)(b_ * SEQ + p_ - NCTX) * D; _Pragma("unroll") for (int j = 0; j < 4; ++j) xn[j] = *((const GAS u32x2*)s_ + F.lane + 64 * j); } \
        _Pragma("unroll") for (int j = 0; j < 4; ++j) { y0n[j] = *((const GAS unsigned*)(YPb + q0_ * D) + F.lane + 64 * j); y1n[j] = *((const GAS unsigned*)(YPb + q1_ * D) + F.lane + 64 * j); } } while (0)
    if (rr.lo < rr.hi) { R3_ROUTE(rr.lo); R3_LOAD(rr.lo); if (rr.lo + 1 < rr.hi) R3_ROUTE(rr.lo + 1); }
    for (int idx = rr.lo; idx < rr.hi; ++idx) {
        int b, p; row_decode(idx, all, b, p);
        const int row = b * TB + p; const bool isc = p < NCTX; const int sel = isc ? 16 : b;
        const size_t lrow = (size_t)(b * SEQ + p - NCTX);
        f32x4 v[4], m[4]; const float w0 = w0n, w1 = w1n;
#pragma unroll
        for (int j = 0; j < 4; ++j) { const f32x2 a0 = __builtin_amdgcn_cvt_pk_f32_fp8((int)y0n[j], false), a1 = __builtin_amdgcn_cvt_pk_f32_fp8((int)y0n[j], true),
                c0 = __builtin_amdgcn_cvt_pk_f32_fp8((int)y1n[j], false), c1 = __builtin_amdgcn_cvt_pk_f32_fp8((int)y1n[j], true); v[j] = (f32x4){bf_lo(xn[j].x), bf_hi(xn[j].x), bf_lo(xn[j].y), bf_hi(xn[j].y)};
            m[j] = (f32x4){a0.x * w0 + c0.x * w1, a0.y * w0 + c0.y * w1, a1.x * w0 + c1.x * w1, a1.y * w0 + c1.y * w1}; }
        if (idx + 1 < rr.hi) { R3_LOAD(idx + 1); if (idx + 2 < rr.hi) R3_ROUTE(idx + 2); }
        if (sel != cursel) { cursel = sel; ld_vec(modp(MODb, l, sel, 5), F.lane, g2v);
            if (l == 0) { f32x4 g[4], sc[4]; ld_vec(n1g, F.lane, g); ld_vec(modp(MODb, l + 1, sel, 1), F.lane, sc); ld_vec(modp(MODb, l + 1, sel, 0), F.lane, sh);
#pragma unroll
                for (int j = 0; j < 4; ++j) gm[j] = g[j] * (sc[j] + 1.0f); } }
#pragma unroll
        for (int j = 0; j < 4; ++j) v[j] = v[j] + g2v[j] * m[j];
        if (!isc && !dry) { if (l == 0) st_row_bf16((bf16_t*)outb + lrow * D, F.lane, v); else st_row_f32(outb + lrow * D, F.lane, v); }
        if (l == 0) { const float rinv = row_rinv(v); f32x4 h[4];
#pragma unroll
            for (int j = 0; j < 4; ++j) h[j] = (v[j] * rinv) * gm[j] + sh[j];
            if (!dry) { if (PSPLIT > 0) st_row_bf16(Ab + (size_t)row * D, F.lane, h); st_row_fp8(H8i + (size_t)row * D, F.lane, h); } }
    }
#undef R3_LOAD
#undef R3_ROUTE
}

__device__ __forceinline__ int lat_tile(int pe) { return (pe >> 4) * 17 + 1 + (pe & 15); }
struct SchedProj {
    const char* A; const char* B; int G, c, pn0, npn, rowB, kv_ctx;
    __device__ __forceinline__ bool next(int i, pg8::Unit& u) const { int pm, pn; const long L = (long)i * G + c;
        if (!kv_ctx) { if (!pg8::tile_order(L, T / 256, npn, pm, pn)) return false; pn += pn0; }
        else if (L < (long)(NB * SEQ / 256) * npn) { pg8::tile_order(L, NB * SEQ / 256, npn, pm, pn); pm = lat_tile(pm); pn += pn0; }
        else { const int r = (int)(L - (long)(NB * SEQ / 256) * npn); if (r >= 2 * NB) return false; pm = (r >> 1) * 17; pn = (r & 1) ? C_WK / 256 : C_GK / 256; }
        u.pm = pm; u.pn = pn; u.aux = 0; u.A = A + (size_t)pm * 256 * rowB; u.B = B + (size_t)pn * 256 * rowB; return true; }
};
struct SchedMerge {
    const char* P; const char* B; int G, c, nM; bool lat_only;
    __device__ __forceinline__ bool next(int i, pg8::Unit& u) const { const int rnd = i / 3, br = i - rnd * 3; int pm, pn; if (!pg8::tile_order((long)rnd * G + c, nM, 4, pm, pn)) return false;
        if (lat_only) pm = lat_tile(pm);
        const int acol = br == 0 ? C_GR : (br == 1 ? C_GQ : C_WQ);
        u.pm = pm; u.pn = pn; u.aux = br; u.A = P + ((size_t)pm * 256 * NIN + acol) * 2; u.B = B + ((size_t)br * D + pn * 256) * 512 * 2; return true; }
};
struct SchedOut {
    const char* A; const char* B; int G, c, nM; bool lat_only;
    __device__ __forceinline__ bool next(int i, pg8::Unit& u) const { int pm, pn; if (!pg8::tile_order((long)i * G + c, nM, 4, pm, pn)) return false;
        if (lat_only) pm = lat_tile(pm);
        u.pm = pm; u.pn = pn; u.aux = 0; u.A = A + (size_t)pm * 256 * D * 2; u.B = B + (size_t)pn * 256 * D * 2; return true; }
};
struct SchedMoe {
    const char* A; const char* B; const LAS int* ptab; const int* PLb; int G, c, npn;
    __device__ __forceinline__ bool next(int i, pg8::Unit& u) const { const int ntile = __builtin_amdgcn_readfirstlane(ptab[NE]) >> 8; int L;
        if ((G & 7) == 0) { const int per = G >> 3, x = c / per, r = c - x * per, U = ntile * npn, q = (U + 7) >> 3, k = i * per + r; if (k >= q) return false; L = x * q + k; if (L >= U) return false; }
        else { L = i * G + c; if (L >= ntile * npn) return false; }
        const int j = L / npn, pn = L - j * npn; const int e = __builtin_amdgcn_readfirstlane(ptab[ETAB_OFF + j]); const int tin = j - (__builtin_amdgcn_readfirstlane(ptab[e]) >> 8); const int left = __builtin_amdgcn_readfirstlane(ptab[32 + e]) - tin * 256;
        u.pm = j; u.pn = pn; u.aux = e; u.B = B + ((size_t)e * npn + pn) * 256 * D;
        if (PLb) { u.A = A; u.gl = PLb + (size_t)e * T + tin * 256; u.nvalid = left < 256 ? left : 256; } else { u.A = A + (size_t)j * 256 * D; u.gl = nullptr; u.nvalid = 256; }
        return true; }
};

#ifndef PROBE
#define PROBE 0
#endif
#ifndef STAGGER
#define STAGGER 0
#endif
static_assert(sizeof(Args) == sizeof(KArgs), "kernarg views");
__global__ void __launch_bounds__(NWAVES * 64, 2) mega_fwd(Args args) {
    extern __shared__ __attribute__((aligned(16))) unsigned char lds[];
    volatile LAS unsigned* MISC = (volatile LAS unsigned*)((LAS unsigned char*)lds + MISC_OFF);
    LAS int* ptab = (LAS int*)((LAS unsigned char*)lds + LDSCTL_OFF);
    Frame F0; {
    Frame& F = F0;
    F.lds = (LAS unsigned char*)lds;
    F.tid = threadIdx.x; F.lane = F.tid & 63; F.wave = __builtin_amdgcn_readfirstlane(F.tid >> 6);
    F.G = gridDim.x; { const int bx = blockIdx.x; F.vcu = (F.G % 8 == 0) ? (bx % 8) * (F.G / 8) + bx / 8 : bx; }
    F.gw = F.vcu * NWAVES + F.wave; F.NGW = F.G * NWAVES; F.bid = blockIdx.x; }
    for (int u = F0.tid; u < (LDS_BYTES - LDSCTL_OFF) / 4; u += NWAVES * 64) ((LAS unsigned*)(F0.lds + LDSCTL_OFF))[u] = 0u;
    __syncthreads();
    XcdBarrier bar = xcd_barrier_post((unsigned*)(F0.ctl() + CW_BAR), MISC + 8);
#define GRID_BAR() do { XcdBarrier b_ = bar; asm volatile("" : "+s"(b_.bar), "+s"(b_.x)); int w_ = F0.wave; asm volatile("" : "+s"(w_)); \
        unsigned o_ = ~0u; asm volatile("" : "+s"(o_)); xcd_barrier(b_, w_ == 0 && __builtin_amdgcn_mbcnt_hi(o_, __builtin_amdgcn_mbcnt_lo(o_, 0u)) == 0u); } while (0)

    { Frame F = fresh(F0); p0_prologue(F); }
    if (PROBE == 13) { __syncthreads(); Frame F = fresh(F0); p0_prologue(F); }
    GRID_BAR();
    { Frame F = fresh(F0); convert_small(F); }
    { Frame F = fresh(F0); r1_phase(F); }
    if (PROBE == 17) { Frame F = fresh(F0); r1_phase(F); }
    GRID_BAR();

    for (int l = 0; l < NL; ++l) {
        const bool last = (l == NL - 1);
        if (PSPLIT > 0) { Frame F = fresh(F0);
            pg8::Gemm g{D / 64, D * 2, D * 2, STAGGER}; SchedProj S{(const char*)F.A(), (const char*)(F.WIN() + (size_t)l * NIN * D), F.G, F.bid, 0, PSPLIT, D * 2, 0};
            pg8::EpiProj E{F.PROJ(), (const LAS float*)(F.lds + BIAS_OFF), 1.0f, 0, 0};
            pg8::gemm_phase(F.tid, F.lds + RING_OFF, g, S, E);
            if (PROBE == 1) { __syncthreads(); pg8::gemm_phase(F.tid, F.lds + RING_OFF, g, S, E); }
        }
        { Frame F = fresh(F0);
            pg8::Gemm g{D / 128, D, D, STAGGER}; SchedProj S{(const char*)F.HIN8(), (const char*)(F.WIN8() + (size_t)l * NIN * D), F.G, (F.bid + (3 * F.G) / 4) % F.G, PSPLIT, NIN / 256 - PSPLIT, D, last ? 1 : 0};
            { LAS float* bl = (LAS float*)(F.lds + BIAS_OFF); const float* bm = F.b_merge() + (size_t)l * 3 * D;
              for (int i = F.tid; i < 3 * D / 4; i += NWAVES * 64) *((LAS f32x4*)bl + i) = *((const GAS f32x4*)bm + i) * -1.4426950409f; }
            __syncthreads();
            pg8::EpiProj E{F.PROJ(), (const LAS float*)(F.lds + BIAS_OFF), 1.0f / WSCALE, 0, 0};
            if (PROBE == 52) { pg8::EpiProj E2 = E; E2.dry = __builtin_amdgcn_readfirstlane((int)(__hip_atomic_load(F.ctl() + 8, RLX_AGENT) == 0u)); pg8::gemm_phase<pg8::EpiProj, SchedProj, true>(F.tid, F.lds + RING_OFF, g, S, E2); __syncthreads(); }
            if (PROBE == 50 || PROBE == 51) { pg8::Gemm g2{PROBE == 51 ? D / 64 : D / 128, D, D, STAGGER}; pg8::gemm_phase<pg8::EpiProj, SchedProj, true>(F.tid, F.lds + RING_OFF, g2, S, E); __syncthreads(); }
            pg8::gemm_phase<pg8::EpiProj, SchedProj, true>(F.tid, F.lds + RING_OFF, g, S, E);
            if (PROBE == 1) { __syncthreads(); pg8::gemm_phase<pg8::EpiProj, SchedProj, true>(F.tid, F.lds + RING_OFF, g, S, E); }
        }
        GRID_BAR();
        if (PROBE == 14) { Frame F = fresh(F0); kfix_phase(F, l, __hip_atomic_load(F.ctl() + 8, RLX_AGENT) == 0u); }
        { Frame F = fresh(F0); kfix_phase(F, l); }
        GRID_BAR();
        if (PROBE == 4) { Frame F = fresh(F0); const bool dry = __hip_atomic_load(F.ctl() + 8, RLX_AGENT) == 0u; for (int uid = F.vcu; uid < 256; uid += F.G) scan_unit(F, l, uid, last, dry); __syncthreads(); }
        { Frame F = fresh(F0); for (int uid = F.vcu; uid < 256; uid += F.G) scan_unit(F, l, uid, last); }
        __syncthreads();
        { Frame F = fresh(F0);
            const int per = (2048 + F.G - 1) / F.G;
            bool nomax0, nomax1;
            { const float* qgp = F.q_norm_g() + (size_t)l * 128; const float* kgp = F.k_norm_g() + (size_t)l * 128;
              const float mq0 = wave_max(fabsf(qgp[F.lane])), mk0 = wave_max(fabsf(kgp[F.lane])), mq1 = wave_max(fabsf(qgp[64 + F.lane])), mk1 = wave_max(fabsf(kgp[64 + F.lane]));
              nomax0 = __builtin_amdgcn_readfirstlane((int)(8.0f * 1.4426950409f * mq0 * mk0 < 100.0f)) != 0; nomax1 = __builtin_amdgcn_readfirstlane((int)(8.0f * 1.4426950409f * mq1 * mk1 < 100.0f)) != 0; }
            attn_body::AttnArgs aa; aa.P = (attn_body::bf16*)F.PROJ(); aa.ropec = F.ROPEC(); aa.ropes = F.ROPES(); aa.dry = false; aa.sinkp = F.sink() + l * 8;
            aa.qg = F.q_norm_g() + (size_t)(l * 2 + 0) * 64; aa.sink = 0.f;
            if (PROBE == 11) { aa.dry = __hip_atomic_load(F.ctl() + 8, RLX_AGENT) == 0u; for (int gid = F.vcu * per; gid < (F.vcu + 1) * per && gid < 2048; ++gid) { const int pair = gid >> 6, uu = gid & 63; const int b = pair >> 1, h = (pair & 1) * 4 + (uu >> 4), qb = uu & 15;
                if (nomax0) attn_body::attn_unit<0, 8, true>(F.tid, b, h, qb, aa, (char*)lds + RING_OFF); else attn_body::attn_unit<0, 8, false>(F.tid, b, h, qb, aa, (char*)lds + RING_OFF); } aa.dry = false; }
            const int gid0 = F.vcu * per, gid1 = ((F.vcu + 1) * per < 2048) ? (F.vcu + 1) * per : 2048;
            if (PROBE != 9) for (int gid = gid0; gid < gid1; ++gid) { const int pair = gid >> 6, uu = gid & 63; const int b = pair >> 1, h = (pair & 1) * 4 + (uu >> 4), qb = uu & 15;
                const int gn = gid + 1, pn_ = gn >> 6, un_ = gn & 63; const bool st = gid > gid0, hn = gn < gid1;
                const attn_body::bf16* qn = attn_body::q_wave_ptr<0>(aa, F.wave, pn_ >> 1, (pn_ & 1) * 4 + (un_ >> 4), un_ & 15);
                if (nomax0) attn_body::attn_unit<0, 8, true>(F.tid, b, h, qb, aa, (char*)lds + RING_OFF, st, hn, qn); else attn_body::attn_unit<0, 8, false>(F.tid, b, h, qb, aa, (char*)lds + RING_OFF, st, hn, qn); }
            aa.qg = F.q_norm_g() + (size_t)(l * 2 + 1) * 64;
            if (PROBE == 12) { aa.dry = __hip_atomic_load(F.ctl() + 8, RLX_AGENT) == 0u; for (int gid = F.vcu * per; gid < (F.vcu + 1) * per && gid < 2048; ++gid) { const int pair = gid >> 6, uu = gid & 63; const int b = pair >> 1, h = (pair & 1) * 4 + (uu >> 4), qb = uu & 15;
                aa.sink = 0.f; if (nomax1) attn_body::attn_unit<1, 8, true>(F.tid, b, h, qb, aa, (char*)lds + RING_OFF); else attn_body::attn_unit<1, 8, false>(F.tid, b, h, qb, aa, (char*)lds + RING_OFF); } aa.dry = false; }
            aa.sinkp = F.sink() + l * 8;
            if (PROBE != 10) for (int gid = gid0; gid < gid1; ++gid) { const int b = gid >> 7, h = (gid >> 5) & 3, qb = gid & 31;
                aa.sink = 0.f;
                const int gn = gid + 1; const bool st = gid > gid0, hn = gn < gid1;
                const attn_body::bf16* qn = attn_body::q_wave_ptr<1>(aa, F.wave, gn >> 7, (gn >> 5) & 3, gn & 31);
                if (nomax1) attn_body::attn_unit<1, 8, true>(F.tid, b, h, qb, aa, (char*)lds + RING_OFF, st, hn, qn); else attn_body::attn_unit<1, 8, false>(F.tid, b, h, qb, aa, (char*)lds + RING_OFF, st, hn, qn); }
            if (!last) {
                for (int cid = F.vcu; cid < 256; cid += F.G) { const int b = cid >> 4, h = (cid >> 1) & 7;
                    if (cid & 1) { aa.qg = F.q_norm_g() + (size_t)(l * 2 + 1) * 64; aa.sink = F.sink()[l * 8 + h]; if (nomax1) attn_body::attn_unit<3, 8, true>(F.tid, b, h, 0, aa, (char*)lds + RING_OFF); else attn_body::attn_unit<3, 8, false>(F.tid, b, h, 0, aa, (char*)lds + RING_OFF); }
                    else { aa.qg = F.q_norm_g() + (size_t)(l * 2 + 0) * 64; aa.sink = 0.f; if (nomax0) attn_body::attn_unit<2, 8, true>(F.tid, b, h, 0, aa, (char*)lds + RING_OFF); else attn_body::attn_unit<2, 8, false>(F.tid, b, h, 0, aa, (char*)lds + RING_OFF); } }
            }
        }
        GRID_BAR();
        { Frame F = fresh(F0);
            pg8::Gemm g{512 / 64, NIN * 2, 512 * 2, STAGGER}; SchedMerge S{(const char*)F.PROJ(), (const char*)(F.WBR() + (size_t)l * 3 * D * 512), F.G, F.bid, last ? 256 : 272, last};
            pg8::EpiMerge E{F.PROJ(), F.A()};
            pg8::gemm_phase(F.tid, F.lds + RING_OFF, g, S, E);
            if (PROBE == 2) { __syncthreads(); pg8::gemm_phase(F.tid, F.lds + RING_OFF, g, S, E); }
        }
        { Frame F = fresh(F0); const int nfull = ((last ? 256 : 272) * 4) % F.G; if (nfull != 0 && F.bid >= nfull) convert_experts(F, l, F.bid - nfull, F.G - nfull); }
        GRID_BAR();
        if (PROBE == 30) { for (int k = 0; k < 10; ++k) GRID_BAR(); }
        { Frame F = fresh(F0);
            pg8::Gemm g{D / 64, D * 2, D * 2, STAGGER}; SchedOut S{(const char*)F.A(), (const char*)(F.WOUT() + (size_t)l * D * D), F.G, F.bid, last ? 256 : 272, last};
            pg8::EpiPlain E{F.YBUF(), D, 1.0f};
            pg8::gemm_phase(F.tid, F.lds + RING_OFF, g, S, E);
            if (PROBE == 3) { __syncthreads(); pg8::gemm_phase(F.tid, F.lds + RING_OFF, g, S, E); }
        }
        GRID_BAR();
        if ((((last ? 256 : 272) * 4) % F0.G) == 0) { Frame F = fresh(F0); convert_experts(F, l, (int)blockIdx.x, F.G); }
        __syncthreads();
        if (PROBE == 7) { Frame F = fresh(F0); convert_experts(F, l, (int)blockIdx.x, F.G); __syncthreads(); }
        if (PROBE == 15) { Frame F = fresh(F0); r2_phase(F, l, __hip_atomic_load(F.ctl() + 8, RLX_AGENT) == 0u); }
        { Frame F = fresh(F0); r2_phase(F, l); }
        GRID_BAR();
        { Frame F = fresh(F0); LAS int* pt = ptab; asm volatile("" : "+v"(pt)); build_ptab(F, l, pt); }
        { Frame F = fresh(F0);
            pg8::Gemm g{D / 128, D, D, STAGGER}; LAS int* pt = ptab; asm volatile("" : "+v"(pt)); SchedMoe S{(const char*)F.H8(), (const char*)F.W13(), pt, F.PL(), F.G, F.vcu, 8};
            pg8::EpiSwiglu E{F.HID(), 1.0f / WSCALE};
            pg8::gemm_phase<pg8::EpiSwiglu, SchedMoe, true, true>(F.tid, F.lds + RING_OFF, g, S, E, pt + IDXBUF_OFF);
        }
        GRID_BAR();
        { Frame F = fresh(F0);
            pg8::Gemm g{D / 128, D, D, STAGGER}; LAS int* pt = ptab; asm volatile("" : "+v"(pt)); SchedMoe S{(const char*)F.HID(), (const char*)F.W2(), pt, nullptr, F.G, F.vcu, 4};
            pg8::EpiPlain8 E{F.YP(), D, 1.0f / WSCALE};
            pg8::gemm_phase<pg8::EpiPlain8, SchedMoe, true>(F.tid, F.lds + RING_OFF, g, S, E);
        }
        GRID_BAR();
        if (PROBE == 16) { Frame F = fresh(F0); LAS int* pt = ptab; asm volatile("" : "+v"(pt)); r3_phase(F, l, pt, __hip_atomic_load(F.ctl() + 8, RLX_AGENT) == 0u); }
        { Frame F = fresh(F0); LAS int* pt = ptab; asm volatile("" : "+v"(pt)); r3_phase(F, l, pt); }
        if (!last) GRID_BAR();
    }
}

extern "C" void kernel_launch(void* const* d_in, const int* in_sizes, int n_in, void* d_out, int out_size, void* d_ws, size_t ws_size, hipStream_t stream) {
    static int grid = 0;
    if (grid == 0) {
        if (n_in != 27 || in_sizes[0] != NB * SEQ * D || out_size != NB * SEQ * D || ws_size < WS_END) { fprintf(stderr, "kernel_launch: unexpected shapes / workspace (n_in %d, ws %zu < %zu)\n", n_in, ws_size, (size_t)WS_END); grid = -1; return; }
        int dev = 0, cus = 0, per_cu = 0;
        if (hipGetDevice(&dev) != hipSuccess || hipDeviceGetAttribute(&cus, hipDeviceAttributeMultiprocessorCount, dev) != hipSuccess) { grid = -1; return; }
        if (hipFuncSetAttribute((const void*)mega_fwd, hipFuncAttributeMaxDynamicSharedMemorySize, LDS_BYTES) != hipSuccess) { fprintf(stderr, "kernel_launch: hipFuncSetAttribute failed\n"); grid = -1; return; }
        if (hipOccupancyMaxActiveBlocksPerMultiprocessor(&per_cu, (const void*)mega_fwd, NWAVES * 64, LDS_BYTES) != hipSuccess || per_cu < 1) { fprintf(stderr, "kernel_launch: occupancy query says %d\n", per_cu); }
        (void)hipGetLastError();
        if (cus < 137) { fprintf(stderr, "kernel_launch: built for >= 137 CUs (the router pass keeps at most 64 rows per wave), device has %d\n", cus); grid = -1; return; }
        grid = cus;
    }
    if (grid < 0) return;
    if (hipMemsetAsync((char*)d_ws + WS_CTL, 0, CTL_ZERO_BYTES, stream) != hipSuccess) return;
    Args a{};
    for (int i = 0; i < 27; ++i) a.in[i] = (const float*)d_in[i];
    a.out = (float*)d_out; a.ws = (unsigned char*)d_ws;
    hipLaunchKernelGGL(mega_fwd, dim3(grid), dim3(NWAVES * 64), LDS_BYTES, stream, a);
}
```
